# Optimizing an MI355X kernel written in HIP

```python
import math
import jax
import jax.numpy as jnp
from jax import lax
import numpy as np

D_MODEL = 1024
BATCH = 4
SEQ = 4096
DEPTH = 2

SB_HEADS = 4
SB_DIM = 64
DIFF_HEADS = 4
DIFF_DIM = 32
DIFF_V_DIM = 2 * DIFF_DIM
FOX_HEADS = 4
FOX_DIM = 64
MLA_HEADS = 4
MLA_Q_RANK = 256
MLA_KV_RANK = 128
MLA_NOPE_DIM = 64
MLA_ROPE_DIM = 32
MLA_V_DIM = 64
MIX_WIDTH = SB_HEADS * SB_DIM + DIFF_HEADS * DIFF_V_DIM + FOX_HEADS * FOX_DIM + MLA_HEADS * MLA_V_DIM
N_EXPERTS = 32
TOP_K = 4
D_FF = 1024
SWIGLU_LIMIT = 7.0
SWIGLU_ALPHA = 1.702
ROPE_THETA = 10000.0
Q_BLOCK = 128
MOE_BLOCK = 256
LN_EPS = 1e-5
RMS_EPS = 1e-6
DEEPNORM_ALPHA = (2 * DEPTH) ** 0.25
DEEPNORM_BETA = (8 * DEPTH) ** -0.25
IN_SPLITS = (SB_HEADS * SB_DIM, SB_HEADS * SB_DIM, SB_HEADS * SB_DIM,
             DIFF_HEADS * 2 * DIFF_DIM, DIFF_HEADS * 2 * DIFF_DIM, DIFF_HEADS * DIFF_V_DIM,
             FOX_HEADS * FOX_DIM, FOX_HEADS * FOX_DIM, FOX_HEADS * FOX_DIM, FOX_HEADS,
             MLA_Q_RANK, MLA_KV_RANK, MLA_ROPE_DIM)
IN_COLS = sum(IN_SPLITS)

kernel_name = 'hybrid_sb_diff_fox_mla_moe_deepnorm'


def _layer_norm(x, g, b):
    xf = x.astype(jnp.float32)
    mu = jnp.mean(xf, axis=-1, keepdims=True)
    var = jnp.mean(jnp.square(xf - mu), axis=-1, keepdims=True)
    y = (xf - mu) * lax.rsqrt(var + LN_EPS) * g.astype(jnp.float32) + b.astype(jnp.float32)
    return y.astype(x.dtype)


def _rms_norm(x, g):
    xf = x.astype(jnp.float32)
    y = xf * lax.rsqrt(jnp.mean(jnp.square(xf), axis=-1, keepdims=True) + RMS_EPS) * g.astype(jnp.float32)
    return y.astype(x.dtype)


def _rope(x, positions):
    d = x.shape[-1]
    inv_freq = ROPE_THETA ** (-jnp.arange(0, d, 2, dtype=jnp.float32) / d)
    ang = positions.astype(jnp.float32)[..., None] * inv_freq
    cos = jnp.cos(ang)[:, :, None, :]
    sin = jnp.sin(ang)[:, :, None, :]
    xf = x.astype(jnp.float32)
    x1, x2 = xf[..., : d // 2], xf[..., d // 2:]
    return jnp.concatenate([x1 * cos - x2 * sin, x2 * cos + x1 * sin], axis=-1).astype(x.dtype)


def _rows(t, q0):
    return lax.dynamic_slice_in_dim(t, q0, Q_BLOCK, axis=1)


def _causal_mask(q0, seq_len, strict):
    t = q0 + jnp.arange(Q_BLOCK)
    s = jnp.arange(seq_len)
    return (s[None, :] < t[:, None]) if strict else (s[None, :] <= t[:, None])


def _masked_softmax(logits, mask):
    return jax.nn.softmax(jnp.where(mask, logits, -jnp.inf), axis=-1)


def _sweep_query_blocks(block_fn, seq_len):
    starts = jnp.arange(seq_len // Q_BLOCK, dtype=jnp.int32) * Q_BLOCK
    out = lax.map(block_fn, starts)
    nb, b, qb, h, dv = out.shape
    return jnp.transpose(out, (1, 0, 2, 3, 4)).reshape(b, nb * qb, h, dv)


def _stick_breaking(q, k, v):
    seq_len = q.shape[1]
    scale = 1.0 / math.sqrt(q.shape[-1])

    def block(q0):
        z = jnp.einsum('bqhd,bkhd->bhqk', _rows(q, q0), k).astype(jnp.float32) * scale
        strict = _causal_mask(q0, seq_len, strict=True)
        log_keep = jnp.where(strict, jax.nn.log_sigmoid(-z), 0.0)
        after = lax.cumsum(log_keep, axis=3, reverse=True) - log_keep
        w = jnp.where(strict, jnp.exp(jax.nn.log_sigmoid(z) + after), 0.0)
        return jnp.einsum('bhqk,bkhd->bqhd', w.astype(v.dtype), v)

    return _sweep_query_blocks(block, seq_len)


def _differential(q1, q2, k1, k2, v, lam):
    seq_len = q1.shape[1]
    scale = 1.0 / math.sqrt(q1.shape[-1])

    def block(q0):
        mask = _causal_mask(q0, seq_len, strict=False)
        s1 = jnp.einsum('bqhd,bkhd->bhqk', _rows(q1, q0), k1).astype(jnp.float32) * scale
        s2 = jnp.einsum('bqhd,bkhd->bhqk', _rows(q2, q0), k2).astype(jnp.float32) * scale
        w = _masked_softmax(s1, mask) - lam * _masked_softmax(s2, mask)
        return jnp.einsum('bhqk,bkhd->bqhd', w.astype(v.dtype), v)

    return _sweep_query_blocks(block, seq_len)


def _forgetting(q, k, v, cum_log_f):
    seq_len = q.shape[1]
    scale = 1.0 / math.sqrt(q.shape[-1])
    f_key = jnp.transpose(cum_log_f, (0, 2, 1))[:, :, None, :]

    def block(q0):
        mask = _causal_mask(q0, seq_len, strict=False)
        f_q = jnp.transpose(_rows(cum_log_f, q0), (0, 2, 1))[:, :, :, None]
        s = jnp.einsum('bqhd,bkhd->bhqk', _rows(q, q0), k).astype(jnp.float32) * scale + f_q - f_key
        return jnp.einsum('bhqk,bkhd->bqhd', _masked_softmax(s, mask).astype(v.dtype), v)

    return _sweep_query_blocks(block, seq_len)


def _mla(q_nope, q_rope, k_nope, k_rope, v):
    seq_len = q_nope.shape[1]
    scale = 1.0 / math.sqrt(q_nope.shape[-1] + q_rope.shape[-1])

    def block(q0):
        mask = _causal_mask(q0, seq_len, strict=False)
        s = (jnp.einsum('bqhd,bkhd->bhqk', _rows(q_nope, q0), k_nope)
             + jnp.einsum('bqhr,bkr->bhqk', _rows(q_rope, q0), k_rope)).astype(jnp.float32) * scale
        return jnp.einsum('bhqk,bkhd->bqhd', _masked_softmax(s, mask).astype(v.dtype), v)

    return _sweep_query_blocks(block, seq_len)


def _hybrid_mixer(h, positions, lambda_init, w_in, b_forget, diff_lambda, diff_subln_g,
                  mla_q_norm_g, mla_w_uq, mla_kv_norm_g, mla_w_ukv, w_out):
    b, s, _ = h.shape
    split_points = np.cumsum(IN_SPLITS)[:-1].tolist()
    (sb_q, sb_k, sb_v, df_q, df_k, df_v, fx_q, fx_k, fx_v, fx_f,
     mla_cq, mla_ckv, mla_kr) = jnp.split(h @ w_in, split_points, axis=-1)

    def heads(t, n):
        return t.reshape(b, s, n, -1)

    out_a = _stick_breaking(heads(sb_q, SB_HEADS), heads(sb_k, SB_HEADS), heads(sb_v, SB_HEADS))

    dq = _rope(heads(df_q, 2 * DIFF_HEADS), positions).reshape(b, s, DIFF_HEADS, 2, DIFF_DIM)
    dk = _rope(heads(df_k, 2 * DIFF_HEADS), positions).reshape(b, s, DIFF_HEADS, 2, DIFF_DIM)
    lp = diff_lambda.astype(jnp.float32)
    lam = jnp.exp(jnp.sum(lp[0] * lp[1])) - jnp.exp(jnp.sum(lp[2] * lp[3])) + lambda_init
    out_b = _differential(dq[:, :, :, 0], dq[:, :, :, 1], dk[:, :, :, 0], dk[:, :, :, 1],
                          heads(df_v, DIFF_HEADS), lam)
    out_b = _rms_norm(out_b, diff_subln_g) * (1.0 - lambda_init)

    log_f = jax.nn.log_sigmoid((fx_f + b_forget).astype(jnp.float32))
    out_c = _forgetting(heads(fx_q, FOX_HEADS), heads(fx_k, FOX_HEADS), heads(fx_v, FOX_HEADS),
                        jnp.cumsum(log_f, axis=1))

    q_d = heads(_rms_norm(mla_cq, mla_q_norm_g) @ mla_w_uq, MLA_HEADS)
    q_nope, q_rope = q_d[..., :MLA_NOPE_DIM], _rope(q_d[..., MLA_NOPE_DIM:], positions)
    kv_d = heads(_rms_norm(mla_ckv, mla_kv_norm_g) @ mla_w_ukv, MLA_HEADS)
    k_nope, v_d = kv_d[..., :MLA_NOPE_DIM], kv_d[..., MLA_NOPE_DIM:]
    k_rope = _rope(mla_kr[:, :, None, :], positions)[:, :, 0, :]
    out_d = _mla(q_nope, q_rope, k_nope, k_rope, v_d)

    mixed = jnp.concatenate([out_a.reshape(b, s, -1), out_b.reshape(b, s, -1),
                             out_c.reshape(b, s, -1), out_d.reshape(b, s, -1)], axis=-1)
    return mixed @ w_out


def _clamped_swiglu(gu):
    glu, lin = gu[..., :D_FF], gu[..., D_FF:]
    glu = jnp.minimum(glu, SWIGLU_LIMIT)
    lin = jnp.clip(lin, -SWIGLU_LIMIT, SWIGLU_LIMIT)
    return glu * jax.nn.sigmoid(SWIGLU_ALPHA * glu) * (lin + 1.0)


def _moe(h, router_w, router_b, w_gate_up, b_gate_up, w_down, b_down):
    b, s, d = h.shape
    n_tok = b * s
    xt = h.reshape(n_tok, d)
    logits = (xt @ router_w + router_b).astype(jnp.float32)
    top_logit, top_exp = lax.top_k(logits, TOP_K)
    gate = jax.nn.softmax(top_logit, axis=-1)
    n_assign = n_tok * TOP_K
    flat_exp = top_exp.reshape(-1)
    flat_tok = jnp.arange(n_assign, dtype=jnp.int32) // TOP_K
    order = jnp.argsort(flat_exp)
    sorted_exp = flat_exp[order]
    sorted_tok = flat_tok[order]
    sorted_gate = gate.reshape(-1)[order]
    counts = jnp.bincount(flat_exp, length=N_EXPERTS)
    start = jnp.cumsum(counts) - counts
    padded = (counts + MOE_BLOCK - 1) // MOE_BLOCK * MOE_BLOCK
    padded_end = jnp.cumsum(padded)
    padded_start = padded_end - padded
    slot = padded_start[sorted_exp] + (jnp.arange(n_assign, dtype=jnp.int32) - start[sorted_exp])
    n_blocks = n_assign // MOE_BLOCK + N_EXPERTS
    n_slots = n_blocks * MOE_BLOCK
    slot_tok = jnp.full((n_slots,), n_tok, jnp.int32).at[slot].set(sorted_tok)
    x_pad = jnp.concatenate([xt, jnp.zeros((1, d), xt.dtype)], axis=0)
    x_slots = x_pad[slot_tok].reshape(n_blocks, MOE_BLOCK, d)
    block_start = jnp.arange(n_blocks, dtype=jnp.int32) * MOE_BLOCK
    block_exp = jnp.minimum(jnp.sum(padded_end[None, :] <= block_start[:, None], axis=1), N_EXPERTS - 1)

    def expert_block(args):
        xb, e = args
        gu = xb @ w_gate_up[e] + b_gate_up[e]
        return _clamped_swiglu(gu) @ w_down[e] + b_down[e]

    y_slots = lax.map(expert_block, (x_slots, block_exp)).reshape(n_slots, d)
    y_assign = y_slots[slot] * sorted_gate[:, None].astype(h.dtype)
    y = jax.ops.segment_sum(y_assign, sorted_tok, num_segments=n_tok)
    return y.reshape(b, s, d)


def setup_inputs(seed: int = 0) -> dict:
    key = jax.random.key(seed)
    ks = jax.random.split(key, 24)
    f32 = jnp.float32

    def nrm(k, shape, scale):
        return jax.random.normal(k, shape, f32) * scale

    def gain(k, shape):
        return 1.0 + 0.02 * jax.random.normal(k, shape, f32)

    return {
        'x': nrm(ks[0], (BATCH, SEQ, D_MODEL), 1.0),
        'positions': jnp.broadcast_to(jnp.arange(SEQ, dtype=jnp.int32), (BATCH, SEQ)),
        'ln_in_g': gain(ks[1], (D_MODEL,)),
        'ln_in_b': nrm(ks[2], (D_MODEL,), 0.02),
        'w_in': nrm(ks[3], (DEPTH, D_MODEL, IN_COLS), D_MODEL ** -0.5),
        'b_forget': 3.0 + nrm(ks[4], (DEPTH, FOX_HEADS), 0.1),
        'diff_lambda': nrm(ks[5], (DEPTH, 4, DIFF_DIM), 0.1),
        'diff_subln_g': gain(ks[6], (DEPTH, DIFF_V_DIM)),
        'mla_q_norm_g': gain(ks[7], (DEPTH, MLA_Q_RANK)),
        'mla_w_uq': nrm(ks[8], (DEPTH, MLA_Q_RANK, MLA_HEADS * (MLA_NOPE_DIM + MLA_ROPE_DIM)), MLA_Q_RANK ** -0.5),
        'mla_kv_norm_g': gain(ks[9], (DEPTH, MLA_KV_RANK)),
        'mla_w_ukv': nrm(ks[10], (DEPTH, MLA_KV_RANK, MLA_HEADS * (MLA_NOPE_DIM + MLA_V_DIM)), MLA_KV_RANK ** -0.5),
        'w_out': nrm(ks[11], (DEPTH, MIX_WIDTH, D_MODEL), MIX_WIDTH ** -0.5 * DEEPNORM_BETA),
        'ln1_g': gain(ks[12], (DEPTH, D_MODEL)),
        'ln1_b': nrm(ks[13], (DEPTH, D_MODEL), 0.02),
        'router_w': nrm(ks[14], (DEPTH, D_MODEL, N_EXPERTS), D_MODEL ** -0.5),
        'router_b': nrm(ks[15], (DEPTH, N_EXPERTS), 0.01),
        'w_gate_up': nrm(ks[16], (DEPTH, N_EXPERTS, D_MODEL, 2 * D_FF), D_MODEL ** -0.5),
        'b_gate_up': nrm(ks[17], (DEPTH, N_EXPERTS, 2 * D_FF), 0.01),
        'w_down': nrm(ks[18], (DEPTH, N_EXPERTS, D_FF, D_MODEL), D_FF ** -0.5 * DEEPNORM_BETA),
        'b_down': nrm(ks[19], (DEPTH, N_EXPERTS, D_MODEL), 0.01),
        'ln2_g': gain(ks[20], (DEPTH, D_MODEL)),
        'ln2_b': nrm(ks[21], (DEPTH, D_MODEL), 0.02),
    }


def reference(x, positions, ln_in_g, ln_in_b, w_in, b_forget, diff_lambda, diff_subln_g,
              mla_q_norm_g, mla_w_uq, mla_kv_norm_g, mla_w_ukv, w_out, ln1_g, ln1_b,
              router_w, router_b, w_gate_up, b_gate_up, w_down, b_down, ln2_g, ln2_b):
    h = _layer_norm(x, ln_in_g, ln_in_b)
    for l in range(DEPTH):
        lambda_init = 0.8 - 0.6 * math.exp(-0.3 * l)
        mix = _hybrid_mixer(h, positions, lambda_init, w_in[l], b_forget[l], diff_lambda[l],
                            diff_subln_g[l], mla_q_norm_g[l], mla_w_uq[l], mla_kv_norm_g[l],
                            mla_w_ukv[l], w_out[l])
        h = _layer_norm(DEEPNORM_ALPHA * h + mix, ln1_g[l], ln1_b[l])
        ffn = _moe(h, router_w[l], router_b[l], w_gate_up[l], b_gate_up[l], w_down[l], b_down[l])
        h = _layer_norm(DEEPNORM_ALPHA * h + ffn, ln2_g[l], ln2_b[l])
    return h
```

```cpp
#include <hip/hip_runtime.h>
#include <hip/hip_cooperative_groups.h>
#include <cstdio>
#include <cstdint>
namespace cg = cooperative_groups;

#define LAS __attribute__((address_space(3)))
typedef unsigned short bf16_t;
typedef short bf16x8 __attribute__((ext_vector_type(8)));
typedef short s16x4 __attribute__((ext_vector_type(4)));
typedef float f32x16 __attribute__((ext_vector_type(16)));
typedef float f32x4 __attribute__((ext_vector_type(4)));
typedef float f32x2 __attribute__((ext_vector_type(2)));
typedef unsigned u32x4 __attribute__((ext_vector_type(4)));
typedef unsigned u32x2 __attribute__((ext_vector_type(2)));
typedef __bf16 bf16x2_t __attribute__((ext_vector_type(2)));

constexpr int M_TOK = 16384, DM = 1024, SEQ = 4096, NBATCH = 4, DEPTH = 2;
constexpr int NP = 2816;
constexpr int NE = 32, DFF = 1024, TOPK = 4;
constexpr int C_SBQ = 0, C_SBK = 256, C_SBV = 512, C_DFQ = 768, C_DFK = 1024, C_DFV = 1280, C_FXQ = 1536, C_FXK = 1792, C_FXV = 2048,
              C_CQ = 2304, C_CKV = 2560, C_KR = 2688, C_FXF = 2720, C_END = 2724;
constexpr float LOG2E = 1.4426950408889634f;
constexpr float DN_ALPHA = 1.4142135623730951f;
constexpr float LN_EPS = 1e-5f, RMS_EPS = 1e-6f;
constexpr float S8_H = 16.f, S8_WGU = 64.f, S8_ACT = 8.f, S8_WDN = 128.f;

constexpr size_t MB = 1ull << 20;
constexpr size_t OFF_CTRL = 0, CTRL_BYTES = 65536;
constexpr size_t OFF_ROPE = 1 * MB;
constexpr size_t OFF_GATEF = 3 * MB;
constexpr size_t OFF_FK = 3 * MB + 512 * 1024;
constexpr size_t OFF_LIST = 4 * MB;
constexpr size_t OFF_TOKE = 6 * MB;
constexpr size_t OFF_TOKG = 6 * MB + 512 * 1024;
constexpr size_t OFF_WUQ = 7 * MB;
constexpr size_t OFF_WUKV = 7 * MB + 512 * 1024;
constexpr size_t OFF_WOUT = 8 * MB;
constexpr size_t OFF_WIN = 12 * MB;
constexpr size_t OFF_HF = 24 * MB;
constexpr size_t OFF_HB = 88 * MB;
constexpr size_t OFF_P = 120 * MB;
constexpr size_t OFF_CQN = 208 * MB;
constexpr size_t OFF_CKVN = 216 * MB;
constexpr size_t OFF_QD = 220 * MB;
constexpr size_t OFF_KVD = 232 * MB;
constexpr size_t OFF_MIX = 248 * MB;
constexpr size_t OFF_TMPF = 280 * MB;
constexpr size_t OFF_KN = 3 * MB + 768 * 1024;
constexpr size_t OFF_H8 = 220 * MB;
constexpr size_t OFF_ACT = 344 * MB;
constexpr size_t OFF_Y = 473 * MB;
constexpr size_t OFF_WGU = 602 * MB;
constexpr size_t OFF_WD = 858 * MB;
constexpr size_t WS_END = 986 * MB;
constexpr int CW_CNT = 0;
constexpr int CW_ATTQ = 128;
constexpr int CW_LAM = 160;
constexpr int CW_CONVQ = 192;
constexpr int CW_BAR = 4096;

constexpr int LDS_ROWTAB = 131072;
constexpr int LDS_GEMM = 143360;
constexpr int LDS_MISC = LDS_GEMM + 1024;
constexpr int LDS_BIASTAB = 147456;
constexpr int LDS_BYTES = 159744;

struct Params {
  const float* x; const int* pos; const float* ln_in_g; const float* ln_in_b; const float* w_in; const float* b_forget;
  const float* diff_lambda; const float* diff_subln_g; const float* mla_q_norm_g; const float* mla_w_uq; const float* mla_kv_norm_g;
  const float* mla_w_ukv; const float* w_out; const float* ln1_g; const float* ln1_b; const float* router_w; const float* router_b;
  const float* w_gate_up; const float* b_gate_up; const float* w_down; const float* b_down; const float* ln2_g; const float* ln2_b;
  float* out; unsigned char* ws;
};

__device__ __forceinline__ unsigned cvtpk(float lo, float hi) { f32x2 v = {lo, hi}; bf16x2_t b = __builtin_convertvector(v, bf16x2_t); return __builtin_bit_cast(unsigned, b); }
__device__ __forceinline__ unsigned pk4_fp8(float a, float b, float c, float d) {
  int w = __builtin_amdgcn_cvt_pk_fp8_f32(a, b, 0, false);
  w = __builtin_amdgcn_cvt_pk_fp8_f32(c, d, w, true);
  return (unsigned)w;
}
__device__ __forceinline__ float clamp448(float x) { return fminf(fmaxf(x, -448.f), 448.f); }
__device__ __forceinline__ float bf2f(unsigned short b) { return __uint_as_float(((unsigned)b) << 16); }
__device__ __forceinline__ float bflo(unsigned w) { return __uint_as_float(w << 16); }
__device__ __forceinline__ float bfhi(unsigned w) { return __uint_as_float(w & 0xffff0000u); }
__device__ __forceinline__ float wave_sum(float v) {
#pragma unroll
  for (int o = 1; o < 64; o <<= 1) v += __shfl_xor(v, o);
  return v;
}
__device__ __forceinline__ int get_bid() { int b = blockIdx.x; asm volatile("" : "+s"(b)); return b; }
__device__ __forceinline__ int get_nblk() { int g = gridDim.x; asm volatile("" : "+s"(g)); return g; }
__device__ __forceinline__ int get_tid() { int t = threadIdx.x; asm volatile("" : "+v"(t)); return t; }
__device__ __forceinline__ int crow(int r, int hi) { return (r & 3) + 8 * (r >> 2) + 4 * hi; }
__device__ __forceinline__ void pair_vals(float v, float& v0, float& v1) {
  auto rr = __builtin_amdgcn_permlane32_swap(__float_as_uint(v), __float_as_uint(v), false, false);
  v0 = __uint_as_float(rr[0]); v1 = __uint_as_float(rr[1]);
}


#define XB_TMO      128
#define XB_XCNT(j)  (256  + 64 * (j))
#define XB_XSUB(j)  (1280 + 64 * (j))
#define XB_XGEN(j)  (2304 + 64 * (j))
#define XB_TOP      3328
#define XB_TOPGEN   3392
#define XCD_BAR_WORDS 3456
#define XB_SPIN_CAP (1u << 22)
__device__ __forceinline__ unsigned xb_ld(unsigned* p)              { return __hip_atomic_load(p, __ATOMIC_RELAXED, __HIP_MEMORY_SCOPE_AGENT); }
__device__ __forceinline__ unsigned xb_add(unsigned* p, unsigned v) { return __hip_atomic_fetch_add(p, v, __ATOMIC_RELAXED, __HIP_MEMORY_SCOPE_AGENT); }
__device__ __forceinline__ unsigned xb_xcc_id() { return (unsigned)__builtin_amdgcn_s_getreg((3 << 11) | 20) & 0xFu; }
#define XB_SPIN(cond, bar) do { unsigned _sp = 0; while (cond) { __builtin_amdgcn_s_sleep(1); \
    if ((++_sp & 255u) == 0u) { if (xb_ld(&(bar)[XB_TMO])) break; if (_sp > XB_SPIN_CAP) { atomicAdd(&(bar)[XB_TMO], 1u); break; } } } } while (0)
struct XcdBarrier { unsigned* bar; unsigned x; volatile LAS unsigned* st; };
__device__ __forceinline__ XcdBarrier xcd_barrier_post(unsigned* bar, volatile LAS unsigned* st) {
  XcdBarrier b; b.bar = bar; b.x = xb_xcc_id(); b.st = st;
  if (threadIdx.x == 0) (void)xb_add(&bar[XB_XCNT(b.x)], 1u);
  return b;
}
__device__ __forceinline__ void xcd_barrier_complete(unsigned* bar, unsigned x, unsigned& nloc, unsigned& nx) {
  const unsigned G = gridDim.x * gridDim.y * gridDim.z;
  unsigned sum, cnt, mine, sp = 0u;
  for (;;) {
    sum = 0u; cnt = 0u; mine = 0u;
#pragma unroll
    for (unsigned j = 0; j < 16; ++j) { const unsigned c = xb_ld(&bar[XB_XCNT(j)]); sum += c; cnt += (c > 0u) ? 1u : 0u; mine = (j == x) ? c : mine; }
    if (sum == G) break;
    __builtin_amdgcn_s_sleep(1);
    if ((++sp & 255u) == 0u) { if (xb_ld(&bar[XB_TMO])) break; if (sp > XB_SPIN_CAP) { atomicAdd(&bar[XB_TMO], 1u); break; } }
  }
  nloc = mine > 0u ? mine : 1u; nx = cnt > 0u ? cnt : 1u;
}
__device__ __forceinline__ void xcd_barrier(const XcdBarrier& b) {
  asm volatile("s_waitcnt vmcnt(0)" ::: "memory");
  __syncthreads();
  if (threadIdx.x == 0) {
    unsigned* bar = b.bar;
    __builtin_amdgcn_s_waitcnt(0);
    unsigned nloc = b.st[0], nx = b.st[1];
    if (nloc == 0u) { xcd_barrier_complete(bar, b.x, nloc, nx); b.st[0] = nloc; b.st[1] = nx; }
    const unsigned old = xb_add(&bar[XB_XSUB(b.x)], 1u);
    const unsigned gen = old / nloc;
    if (old + 1u == (gen + 1u) * nloc) {
      __builtin_amdgcn_fence(__ATOMIC_RELEASE, "agent");
      asm volatile("s_waitcnt vmcnt(0)" ::: "memory");
      const unsigned og = xb_add(&bar[XB_TOP], 1u);
      const unsigned tg = og / nx;
      if (og + 1u == (tg + 1u) * nx) xb_add(&bar[XB_TOPGEN], 1u);
      else XB_SPIN(xb_ld(&bar[XB_TOPGEN]) == tg, bar);
      __builtin_amdgcn_fence(__ATOMIC_ACQUIRE, "agent");
      xb_add(&bar[XB_XGEN(b.x)], 1u);
      asm volatile("s_waitcnt vmcnt(0)" ::: "memory");
    } else {
      XB_SPIN(xb_ld(&bar[XB_XGEN(b.x)]) == gen, bar);
      __builtin_amdgcn_fence(__ATOMIC_ACQUIRE, "agent");
      asm volatile("s_waitcnt vmcnt(0)" ::: "memory");
    }
  }
  __syncthreads();
}

struct ConvDesc { const float* src; bf16_t* dst; const float* kscale; int K, Ndst, srcld, mode, kb, nb; };
constexpr int CV_U_IN = 16 * 11, CV_U_OUT = 16 * 4, CV_U_UQ = 4 * 2, CV_U_UKV = 2 * 2;
constexpr int CV_SMALL = 2 * (CV_U_IN + CV_U_OUT + CV_U_UQ + CV_U_UKV);
__device__ __forceinline__ bool conv_desc(const Params& p, int u, ConvDesc& d) {
  unsigned char* ws = p.ws;
  constexpr int T_IN = 2 * CV_U_IN, T_OUT = 2 * CV_U_OUT, T_UQ = 2 * CV_U_UQ;
  const float* src; bf16_t* dst; const float* ksc = nullptr; int K, Ndst, srcld, mode, q, nbn;
  int r = u;
  if (r < T_IN) { const int inst = r / CV_U_IN; q = r % CV_U_IN; src = p.w_in + (size_t)inst * 1024 * 2724; dst = (bf16_t*)(ws + OFF_WIN) + (size_t)inst * NP * 1024; K = 1024; Ndst = NP; srcld = 2724; mode = 1; nbn = 11; }
  else if ((r -= T_IN) < T_OUT) { const int inst = r / CV_U_OUT; q = r % CV_U_OUT; src = p.w_out + (size_t)inst * 1024 * 1024; dst = (bf16_t*)(ws + OFF_WOUT) + (size_t)inst * 1024 * 1024; K = 1024; Ndst = 1024; srcld = 1024; mode = 0; nbn = 4; }
  else if ((r -= T_OUT) < T_UQ) { const int inst = r / CV_U_UQ; q = r % CV_U_UQ; src = p.mla_w_uq + (size_t)inst * 256 * 384; dst = (bf16_t*)(ws + OFF_WUQ) + (size_t)inst * 384 * 256; K = 256; Ndst = 384; srcld = 384; mode = 0; nbn = 2; ksc = p.mla_q_norm_g + inst * 256; }
  else { r -= T_UQ; const int inst = r / CV_U_UKV; q = r % CV_U_UKV; src = p.mla_w_ukv + (size_t)inst * 128 * 512; dst = (bf16_t*)(ws + OFF_WUKV) + (size_t)inst * 512 * 128; K = 128; Ndst = 512; srcld = 512; mode = 0; nbn = 2; ksc = p.mla_kv_norm_g + inst * 128; }
  d.src = src; d.dst = dst; d.kscale = ksc; d.K = K; d.Ndst = Ndst; d.srcld = srcld; d.mode = mode; d.kb = q / nbn; d.nb = q % nbn;
  return u < CV_SMALL;
}
__device__ __forceinline__ void conv_load(const ConvDesc& d, float (&v)[4][8], int lane, int w) {
  const int k0 = d.kb * 64 + 8 * w;
#pragma unroll
  for (int u = 0; u < 4; ++u) {
    const int n = d.nb * 256 + u * 64 + lane;
    int sc = n; bool ok = n < d.Ndst;
    if (d.mode == 1) { if (n < 2304) sc = n; else if (n < C_FXF) sc = n + 4; else if (n < C_END) sc = 2304 + (n - C_FXF); else ok = false; }
    const float* sp = d.src + (size_t)k0 * d.srcld + sc;
#pragma unroll
    for (int j = 0; j < 8; ++j) v[u][j] = ok ? __builtin_nontemporal_load(sp + (size_t)j * d.srcld) : 0.f;
  }
}
__device__ __forceinline__ void conv_store(const ConvDesc& d, const float (&v)[4][8], int lane, int w) {
  const int k0 = d.kb * 64 + 8 * w;
#pragma unroll
  for (int u = 0; u < 4; ++u) {
    const int n = d.nb * 256 + u * 64 + lane;
    if (n < d.Ndst) {
      int dr = n;
      if (d.mode == 2) { const int j = n & 1023; dr = (j >> 4) * 32 + (j & 15) + ((n >= 1024) ? 16 : 0); }
      float g[8];
#pragma unroll
      for (int j = 0; j < 8; ++j) g[j] = d.kscale ? d.kscale[k0 + j] : 1.f;
      u32x4 o; o.x = cvtpk(v[u][0] * g[0], v[u][1] * g[1]); o.y = cvtpk(v[u][2] * g[2], v[u][3] * g[3]); o.z = cvtpk(v[u][4] * g[4], v[u][5] * g[5]); o.w = cvtpk(v[u][6] * g[6], v[u][7] * g[7]);
      *(u32x4*)(d.dst + (size_t)dr * d.K + k0) = o;
    }
  }
}
__device__ __forceinline__ void phase_convert(const Params& p) {
  const int tid = get_tid(), lane = tid & 63, w = tid >> 6;
  const int G = get_nblk();
  for (int u = get_bid(); u < CV_SMALL; u += G) {
    ConvDesc d; float va[4][8];
    conv_desc(p, u, d);
    conv_load(d, va, lane, w);
    conv_store(d, va, lane, w);
  }
}

__device__ __forceinline__ void ln_row(f32x4 (&v)[4], const float* g, const float* b, int lane) {
  float s = 0.f;
#pragma unroll
  for (int j = 0; j < 4; ++j) s += (v[j].x + v[j].y) + (v[j].z + v[j].w);
  const float mean = wave_sum(s) * (1.f / DM);
  float s2 = 0.f;
#pragma unroll
  for (int j = 0; j < 4; ++j) { v[j] = v[j] - mean; s2 += (v[j].x * v[j].x + v[j].y * v[j].y) + (v[j].z * v[j].z + v[j].w * v[j].w); }
  const float rstd = rsqrtf(wave_sum(s2) * (1.f / DM) + LN_EPS);
#pragma unroll
  for (int j = 0; j < 4; ++j) {
    const f32x4 gg = *(const f32x4*)(g + 4 * lane + 256 * j), bb = *(const f32x4*)(b + 4 * lane + 256 * j);
    v[j] = v[j] * rstd * gg + bb;
  }
}
__device__ __forceinline__ void store_row_f32_bf16(const f32x4 (&v)[4], float* of, bf16_t* ob, int lane) {
#pragma unroll
  for (int j = 0; j < 4; ++j) {
    if (of) *(f32x4*)(of + 4 * lane + 256 * j) = v[j];
    if (ob) { u32x2 w; w.x = cvtpk(v[j].x, v[j].y); w.y = cvtpk(v[j].z, v[j].w); *(u32x2*)(ob + 4 * lane + 256 * j) = w; }
  }
}

__device__ __forceinline__ void phase_prologue_misc(const Params& p) {
  unsigned char* ws = p.ws;
  const int lane = get_tid() & 63, gw = get_bid() * 8 + (get_tid() >> 6), ngw = get_nblk() * 8;
  float* hF = (float*)(ws + OFF_HF); bf16_t* hB = (bf16_t*)(ws + OFF_HB);
  for (int m = gw; m < M_TOK; m += ngw) {
    f32x4 v[4];
#pragma unroll
    for (int j = 0; j < 4; ++j) v[j] = *(const f32x4*)(p.x + (size_t)m * DM + 4 * lane + 256 * j);
    ln_row(v, p.ln_in_g, p.ln_in_b, lane);
    store_row_f32_bf16(v, nullptr, hB + (size_t)m * DM, lane);
  }
  f32x2* cs = (f32x2*)(ws + OFF_ROPE);
  const int gt = get_bid() * 512 + get_tid(), ngt = get_nblk() * 512;
  for (int i = gt; i < M_TOK * 16; i += ngt) {
    const int m = i >> 4, f = i & 15;
    const double invf = exp2(-(double)f * (13.287712379549449 / 16.0));
    double a = (double)p.pos[m] * invf;
    a = a - 6.283185307179586476925 * rint(a * 0.15915494309189533577);
    float sn, cn; __sincosf((float)a, &sn, &cn);
    cs[i] = (f32x2){cn, sn};
  }
  if (get_bid() == 0 && get_tid() < DEPTH) {
    const int l = get_tid(); const float* lp = p.diff_lambda + l * 128;
    float s1 = 0.f, s2 = 0.f;
    for (int i = 0; i < 32; ++i) { s1 += lp[i] * lp[32 + i]; s2 += lp[64 + i] * lp[96 + i]; }
    const float linit = 0.8f - 0.6f * expf(-0.3f * (float)l);
    ((float*)(ws + OFF_CTRL))[CW_LAM + l] = expf(s1) - expf(s2) + linit;
  }
}

struct GemmDesc { const bf16_t* A; int lda; const int* rowidx; int row0; int mvalid; const bf16_t* Bt; int ldb; int K; };

template <int NI>
__device__ __forceinline__ void gemm_tile(LAS unsigned char* lds, const GemmDesc& g, f32x16 (&acc)[2][NI]) {
  constexpr int BN = 64 * NI;
  constexpr int A_BYTES = 256 * 128, B_BYTES = BN * 128, STAGE = A_BYTES + B_BYTES;
  constexpr int NBL = BN / 64;
  const int tid = get_tid(), lane = tid & 63, w = tid >> 6, wm = w >> 1, wn = w & 1, c31 = lane & 31, hi = lane >> 5;
  const int lr = tid >> 3, lc = (tid & 7) ^ ((tid >> 4) & 7);
  const bf16_t* ap[4];
#pragma unroll
  for (int i = 0; i < 4; ++i) {
    const int r = lr + 64 * i;
    int row;
    if (g.rowidx) row = g.rowidx[g.row0 + (r < g.mvalid ? r : 0)]; else row = g.row0 + r;
    ap[i] = g.A + (size_t)row * g.lda + lc * 8;
  }
  const bf16_t* bp = g.Bt + (size_t)lr * g.ldb + lc * 8;
  const int wbase = w * 1024;
  const int xr = (lane >> 1) & 7;
  int roff[4];
#pragma unroll
  for (int ks = 0; ks < 4; ++ks) roff[ks] = ((2 * ks + hi) ^ xr) << 4;
  const int a_base = (wm * 64 + c31) * 128, b_base = A_BYTES + (wn * 32 * NI + c31) * 128;
#pragma unroll
  for (int mi = 0; mi < 2; ++mi)
#pragma unroll
    for (int ni = 0; ni < NI; ++ni)
#pragma unroll
      for (int r = 0; r < 16; ++r) acc[mi][ni][r] = 0.f;
  const int nk = g.K >> 6;
#define GT_STAGE(stg, ko) do { LAS unsigned char* s_ = lds + (stg) * STAGE + wbase; \
    _Pragma("unroll") for (int i = 0; i < 4; ++i) __builtin_amdgcn_global_load_lds((const unsigned*)(ap[i] + (ko)), (LAS unsigned*)(s_ + 8192 * i), 16, 0, 0); \
    _Pragma("unroll") for (int i = 0; i < NBL; ++i) __builtin_amdgcn_global_load_lds((const unsigned*)(bp + (size_t)(64 * i) * g.ldb + (ko)), (LAS unsigned*)(s_ + A_BYTES + 8192 * i), 16, 0, 0); } while (0)
  GT_STAGE(0, 0);
  __syncthreads();
  bf16x8 af[2][2], bfr[2][NI];
  for (int kt = 0; kt < nk; ++kt) {
    LAS unsigned char* cur = lds + (kt & 1) * STAGE;
    if (kt + 1 < nk) GT_STAGE((kt + 1) & 1, (kt + 1) * 64);
#pragma unroll
    for (int mi = 0; mi < 2; ++mi) af[0][mi] = *(const LAS bf16x8*)(cur + a_base + mi * 4096 + roff[0]);
#pragma unroll
    for (int ni = 0; ni < NI; ++ni) bfr[0][ni] = *(const LAS bf16x8*)(cur + b_base + ni * 4096 + roff[0]);
#pragma unroll
    for (int ks = 0; ks < 4; ++ks) {
      if (ks < 3) {
#pragma unroll
        for (int mi = 0; mi < 2; ++mi) af[(ks + 1) & 1][mi] = *(const LAS bf16x8*)(cur + a_base + mi * 4096 + roff[ks + 1]);
#pragma unroll
        for (int ni = 0; ni < NI; ++ni) bfr[(ks + 1) & 1][ni] = *(const LAS bf16x8*)(cur + b_base + ni * 4096 + roff[ks + 1]);
      }
      __builtin_amdgcn_s_setprio(1);
#pragma unroll
      for (int mi = 0; mi < 2; ++mi)
#pragma unroll
        for (int ni = 0; ni < NI; ++ni) acc[mi][ni] = __builtin_amdgcn_mfma_f32_32x32x16_bf16(bfr[ks & 1][ni], af[ks & 1][mi], acc[mi][ni], 0, 0, 0);
      __builtin_amdgcn_s_setprio(0);
    }
    __syncthreads();
  }
#undef GT_STAGE
}


namespace pg8 {
typedef float f32x4v __attribute__((ext_vector_type(4)));
constexpr int BM = 256, BK = 64, HALF = 128, HTB = HALF * BK * 2, STAGE_BYTES = 8 * HTB, KK = 1024;
typedef int v8i_t __attribute__((ext_vector_type(8)));
typedef int v4i_t __attribute__((ext_vector_type(4)));
__device__ __forceinline__ v8i_t cat8(bf16x8 a, bf16x8 b) { const v4i_t x = __builtin_bit_cast(v4i_t, a), y = __builtin_bit_cast(v4i_t, b); return __builtin_shufflevector(x, y, 0, 1, 2, 3, 4, 5, 6, 7); }
__device__ __forceinline__ int lds_byte(int r, int c) { const int st = (r >> 4) * 2 + (c >> 5), rr = r & 15, cc = c & 31, ob = rr * 64 + cc * 2; return st * 1024 + (ob ^ (((ob >> 9) & 1) << 5)); }
__device__ __forceinline__ void stage_rc(int b, int& R, int& C) { const int st = b / 1024, sb = b % 1024, swz = sb ^ (((sb >> 9) & 1) << 5); R = (st >> 1) * 16 + swz / 64; C = (st & 1) * 32 + (swz % 64) / 2; }
struct Unit { unsigned boff; int arow0; int mvalid; int e, mt, nt, slot0; };
template <bool GATHER, bool FP8, class Sched, class Epi>
__device__ __forceinline__ void gemm_phase(LAS unsigned char* lds, const bf16_t* Abuf, const bf16_t* Bbuf, const Sched& S, const Epi& E) {
  const int tid = get_tid(), wid = __builtin_amdgcn_readfirstlane(tid >> 6), lane = tid & 63, wr = wid >> 2, wc = wid & 3, fr = lane & 15, fq = lane >> 4;
  const __amdgpu_buffer_rsrc_t rsA = __builtin_amdgcn_make_buffer_rsrc((void*)Abuf, (short)0, 0x7ffffff0, 0x00020000);
  const __amdgpu_buffer_rsrc_t rsB = __builtin_amdgcn_make_buffer_rsrc((void*)Bbuf, (short)0, 0x7ffffff0, 0x00020000);
  constexpr int RS = FP8 ? KK : 2 * KK;
  constexpr int NT_K = FP8 ? 8 : 16;
  const int lrow = (wid >> 1) * 16 + (lane >> 2);
  const int cbyte = (wid & 1) * 64 + (((lane & 3) * 16) ^ (((lane >> 5) & 1) << 5));
  const unsigned vB = (unsigned)(lrow * RS + cbyte);
  const LAS int* rowtab = (const LAS int*)(lds + LDS_ROWTAB) + lrow;
#define PG8_ROWS(V, u) do { if (GATHER) { _Pragma("unroll") for (int h_ = 0; h_ < 2; ++h_) _Pragma("unroll") for (int i_ = 0; i_ < 2; ++i_) \
      V[h_][i_] = (unsigned)(rowtab[(u).arow0 * 256 + h_ * HALF + i_ * 64] * RS + cbyte); } } while (0)
#define PG8_ABASE(u) (GATHER ? 0u : (unsigned)(u).arow0 * (unsigned)RS)
  constexpr unsigned kstep = BK * 2;
  const unsigned ldsw = (unsigned)wid * 1024u;
  const int aoff = lds_byte(wr * 64 + fr, fq * 8), boff = lds_byte(wc * 32 + fr, fq * 8);
#define PG8_SA(b, h) (((b) * 2 + (h)) * HTB)
#define PG8_SB(b, h) ((4 + (b) * 2 + (h)) * HTB)
#define PG8_LOAD1(rs, ldsoff, voff, soff) __builtin_amdgcn_raw_ptr_buffer_load_lds(rs, (LAS void*)(lds + (ldsoff) + ldsw), 16, (int)(voff), (int)(soff), 0, 0)
#define PG8_STAGE_B(bufoff, soff, h) do { PG8_LOAD1(rsB, (bufoff), vB, (soff) + (unsigned)((h) * HALF * RS)); PG8_LOAD1(rsB, (bufoff) + 8192, vB, (soff) + (unsigned)(((h) * HALF + 64) * RS)); } while (0)
#define PG8_STAGE_A(bufoff, soff, h, v0, v1) do { if (GATHER) { PG8_LOAD1(rsA, (bufoff), (v0), (soff)); PG8_LOAD1(rsA, (bufoff) + 8192, (v1), (soff)); } \
    else { PG8_LOAD1(rsA, (bufoff), vB, (soff) + (unsigned)((h) * HALF * RS)); PG8_LOAD1(rsA, (bufoff) + 8192, vB, (soff) + (unsigned)(((h) * HALF + 64) * RS)); } } while (0)
#define PG8_LDA(dst, b, h) do { if (FP8) { _Pragma("unroll") for (int m = 0; m < 4; ++m) { \
      const v4i_t lo_ = *(const LAS v4i_t*)(lds + PG8_SA(b, h) + aoff + m * 2048), hi_ = *(const LAS v4i_t*)(lds + PG8_SA(b, h) + aoff + m * 2048 + 1024); \
      dst##8[m] = __builtin_shufflevector(lo_, hi_, 0, 1, 2, 3, 4, 5, 6, 7); } } \
    else { _Pragma("unroll") for (int m = 0; m < 4; ++m) _Pragma("unroll") for (int k = 0; k < 2; ++k) dst[m][k] = *(const LAS bf16x8*)(lds + PG8_SA(b, h) + aoff + m * 2048 + k * 1024); } } while (0)
#define PG8_LDB(dst, b, h) do { if (FP8) { _Pragma("unroll") for (int n = 0; n < 2; ++n) { \
      const v4i_t lo_ = *(const LAS v4i_t*)(lds + PG8_SB(b, h) + boff + n * 2048), hi_ = *(const LAS v4i_t*)(lds + PG8_SB(b, h) + boff + n * 2048 + 1024); \
      dst##8[n] = __builtin_shufflevector(lo_, hi_, 0, 1, 2, 3, 4, 5, 6, 7); } } \
    else { _Pragma("unroll") for (int n = 0; n < 2; ++n) _Pragma("unroll") for (int k = 0; k < 2; ++k) dst[n][k] = *(const LAS bf16x8*)(lds + PG8_SB(b, h) + boff + n * 2048 + k * 1024); } } while (0)
#define PG8_MMA(ai, bj, At, Bt) do { __builtin_amdgcn_s_setprio(1); _Pragma("unroll") for (int m = 0; m < 4; ++m) _Pragma("unroll") for (int n = 0; n < 2; ++n) { \
    if (FP8) asm volatile("v_mfma_scale_f32_16x16x128_f8f6f4 %0, %1, %2, %0, %3, %3 op_sel_hi:[0,0,0]" : "+v"(acc[ai][bj][m][n]) : "v"(Bt##8[n]), "v"(At##8[m]), "v"(sc1));   \
    else { _Pragma("unroll") for (int k = 0; k < 2; ++k) acc[ai][bj][m][n] = __builtin_amdgcn_mfma_f32_16x16x32_bf16(Bt[n][k], At[m][k], acc[ai][bj][m][n], 0, 0, 0); } } \
    __builtin_amdgcn_s_setprio(0); } while (0)
#define PG8_WAIT_V(n) asm volatile("s_waitcnt vmcnt(" #n ")" ::: "memory")
#define PG8_WAIT_L(n) asm volatile("s_waitcnt lgkmcnt(" #n ")" ::: "memory")
#define PG8_BAR __builtin_amdgcn_s_barrier()
#define PG8_SCHED __builtin_amdgcn_sched_barrier(0)
  Unit cur, nxt; int ui = 0;
  if (!S.next(0, cur)) return;
  f32x4v acc[2][2][4][2];
#pragma unroll
  for (int a = 0; a < 2; ++a)
#pragma unroll
    for (int b = 0; b < 2; ++b)
#pragma unroll
      for (int m = 0; m < 4; ++m)
#pragma unroll
        for (int n = 0; n < 2; ++n) acc[a][b][m][n] = (f32x4v){0.f, 0.f, 0.f, 0.f};
  unsigned sc1 = 0x7f7f7f7fu; asm volatile("" : "+v"(sc1));
  bf16x8 At[4][2], B0[2][2], B1[2][2];
  v8i_t At8[4], B08[2], B18[2];
  unsigned cV[2][2];
#pragma unroll
  for (int h = 0; h < 2; ++h)
#pragma unroll
    for (int i = 0; i < 2; ++i) cV[h][i] = 0u;
  PG8_ROWS(cV, cur);
  unsigned cA = PG8_ABASE(cur), cB = cur.boff;
  PG8_STAGE_B(PG8_SB(0, 0), cB, 0); PG8_STAGE_B(PG8_SB(0, 1), cB, 1);
  PG8_STAGE_A(PG8_SA(0, 0), cA, 0, cV[0][0], cV[0][1]); PG8_STAGE_A(PG8_SA(0, 1), cA, 1, cV[1][0], cV[1][1]);
  if (wr == 1) PG8_BAR;
  PG8_WAIT_V(2); PG8_BAR;
  PG8_STAGE_B(PG8_SB(1, 0), cB + kstep, 0); PG8_STAGE_A(PG8_SA(1, 0), cA + kstep, 0, cV[0][0], cV[0][1]); PG8_STAGE_B(PG8_SB(1, 1), cB + kstep, 1);
  PG8_WAIT_V(6); PG8_BAR;
  for (;;) {
    const bool has_next = S.next(ui + 1, nxt);
    const unsigned nB = has_next ? nxt.boff : cB;
    const unsigned nA = has_next ? PG8_ABASE(nxt) : cA;
#pragma unroll 1
    for (int t = 0; t < NT_K; t += 2) {
      const bool last = (t == NT_K - 2);
      const unsigned a1 = cA + (unsigned)(t + 1) * kstep;
      const unsigned a2 = last ? nA : cA + (unsigned)(t + 2) * kstep, b2 = last ? nB : cB + (unsigned)(t + 2) * kstep;
      const unsigned a3 = a2 + kstep, b3 = b2 + kstep;
      unsigned w00 = cV[0][0], w01 = cV[0][1], w10 = cV[1][0], w11 = cV[1][1];
      if (GATHER && last && has_next) { unsigned nV[2][2]; PG8_ROWS(nV, nxt); w00 = nV[0][0]; w01 = nV[0][1]; w10 = nV[1][0]; w11 = nV[1][1]; }
      PG8_LDB(B0, 0, 0); PG8_LDB(B1, 0, 1); PG8_SCHED; PG8_LDA(At, 0, 0); PG8_STAGE_A(PG8_SA(1, 1), a1, 1, cV[1][0], cV[1][1]);
      PG8_WAIT_V(8); PG8_WAIT_L(0); PG8_BAR; PG8_MMA(0, 0, At, B0); PG8_MMA(0, 1, At, B1); PG8_BAR; PG8_SCHED;
      PG8_LDA(At, 0, 1); PG8_STAGE_B(PG8_SB(0, 0), b2, 0); PG8_STAGE_B(PG8_SB(0, 1), b2, 1); PG8_STAGE_A(PG8_SA(0, 0), a2, 0, w00, w01);
      PG8_WAIT_V(8); PG8_WAIT_L(0); PG8_BAR; PG8_MMA(1, 0, At, B0); PG8_MMA(1, 1, At, B1); PG8_BAR; PG8_SCHED;
      PG8_LDB(B0, 1, 0); PG8_LDB(B1, 1, 1); PG8_SCHED; PG8_LDA(At, 1, 0); PG8_STAGE_A(PG8_SA(0, 1), a2, 1, w10, w11);
      PG8_WAIT_V(8); PG8_WAIT_L(0); PG8_BAR; PG8_MMA(0, 0, At, B0); PG8_MMA(0, 1, At, B1); PG8_BAR; PG8_SCHED;
      PG8_LDA(At, 1, 1); PG8_STAGE_B(PG8_SB(1, 0), b3, 0); PG8_STAGE_B(PG8_SB(1, 1), b3, 1); PG8_STAGE_A(PG8_SA(1, 0), a3, 0, w00, w01);
      PG8_WAIT_V(8); PG8_WAIT_L(0); PG8_BAR; PG8_MMA(1, 0, At, B0); PG8_MMA(1, 1, At, B1); PG8_BAR; PG8_SCHED;
    }
    if (wr == 0) PG8_BAR;
    if (FP8) asm volatile("s_nop 15\n\ts_nop 15" ::: "memory");
    E(acc, cur, wr, wc, fr, fq);
    if (!has_next) break;
#pragma unroll
    for (int a = 0; a < 2; ++a)
#pragma unroll
      for (int b = 0; b < 2; ++b)
#pragma unroll
        for (int m = 0; m < 4; ++m)
#pragma unroll
          for (int n = 0; n < 2; ++n) acc[a][b][m][n] = (f32x4v){0.f, 0.f, 0.f, 0.f};
    if (FP8) asm volatile("s_nop 7" ::: "memory");
    cur = nxt; cB = nB; cA = nA; ++ui;
    PG8_ROWS(cV, cur);
    if (wr == 1) PG8_BAR;
  }
  PG8_WAIT_V(0);
  PG8_BAR;
#undef PG8_ROWS
#undef PG8_ABASE
#undef PG8_SA
#undef PG8_SB
#undef PG8_LOAD1
#undef PG8_STAGE_A
#undef PG8_STAGE_B
#undef PG8_LDA
#undef PG8_LDB
#undef PG8_MMA
#undef PG8_WAIT_V
#undef PG8_WAIT_L
#undef PG8_BAR
#undef PG8_SCHED
}
}

struct InprojSched {
  int grid, bid;
  __device__ __forceinline__ bool next(int i, pg8::Unit& u) const {
    constexpr int NT = NP / 256;
    int mt, nt;
    if (grid == 256) { const int xcd = bid & 7, j = bid >> 3, q = j + 32 * i; if (q >= 8 * NT) return false; mt = 8 * xcd + q / NT; nt = q % NT; }
    else { const int t = bid + i * grid; if (t >= 64 * NT) return false; mt = t / NT; nt = t % NT; }
    u.boff = (unsigned)nt * (256u * 1024u * 2u); u.arow0 = mt * 256; u.mvalid = 256; u.e = 0; u.mt = mt; u.nt = nt; u.slot0 = 0;
    return true;
  }
};
struct InprojEpi {
  bf16_t* P; float* gateF; const f32x2* cs; float* ssq;
  __device__ __forceinline__ void operator()(const pg8::f32x4v (&acc)[2][2][4][2], const pg8::Unit& u, int wr, int wc, int fr, int fq) const {
    const int nt = u.nt;
    const bool rope_all = (nt == 3) || (nt == 4);
#pragma unroll
    for (int ai = 0; ai < 2; ++ai)
#pragma unroll
      for (int m = 0; m < 4; ++m) {
        const int row = u.mt * 256 + 128 * ai + 64 * wr + 16 * m + fr;
        bf16_t* prow = P + (size_t)row * NP + nt * 256 + 32 * wc + 4 * fq;
        f32x2 c4[4];
        if (rope_all || nt == 10) {
#pragma unroll
          for (int j = 0; j < 4; ++j) c4[j] = cs[(size_t)row * 16 + 4 * fq + j];
        }
        float sq = 0.f;
#pragma unroll
        for (int bj = 0; bj < 2; ++bj) {
          pg8::f32x4v v0 = acc[ai][bj][m][0], v1 = acc[ai][bj][m][1];
          if (rope_all || (nt == 10 && bj == 1 && wc == 0)) {
#pragma unroll
            for (int j = 0; j < 4; ++j) { const float x1 = v0[j], x2 = v1[j]; v0[j] = x1 * c4[j].x - x2 * c4[j].y; v1[j] = x2 * c4[j].x + x1 * c4[j].y; }
          }
          if (nt == 9 || (nt == 10 && bj == 0)) {
#pragma unroll
            for (int j = 0; j < 4; ++j) sq += v0[j] * v0[j] + v1[j] * v1[j];
          }
          u32x2 o; o.x = cvtpk(v0[0], v0[1]); o.y = cvtpk(v0[2], v0[3]);
          *(u32x2*)(prow + 128 * bj) = o;
          o.x = cvtpk(v1[0], v1[1]); o.y = cvtpk(v1[2], v1[3]);
          *(u32x2*)(prow + 128 * bj + 16) = o;
          if (nt == 10 && bj == 1 && wc == 1 && fq == 0) *(f32x4*)(gateF + (size_t)row * 4) = (f32x4){v0[0], v0[1], v0[2], v0[3]};
        }
        if (nt == 9 || nt == 10) {
          sq += __shfl_xor(sq, 16); sq += __shfl_xor(sq, 32);
          if (fq == 0) ssq[(size_t)row * 8 + (nt == 9 ? 0 : 4) + wc] = sq;
        }
      }
  }
};
__device__ __forceinline__ void phase_inproj(const Params& p, int layer, LAS unsigned char* lds) {
  unsigned char* ws = p.ws;
  InprojSched S{get_nblk(), get_bid()};
  InprojEpi E{(bf16_t*)(ws + OFF_P), (float*)(ws + OFF_GATEF), (const f32x2*)(ws + OFF_ROPE), (float*)(ws + OFF_CQN)};
  pg8::gemm_phase<false, false>(lds, (const bf16_t*)(ws + OFF_HB), (const bf16_t*)(ws + OFF_WIN) + (size_t)layer * NP * 1024, S, E);
}

__device__ __forceinline__ void rope4(bf16_t* base, const f32x2* cs4) {
  const u32x2 a = *(const u32x2*)base, b = *(const u32x2*)(base + 16);
  float x1[4] = {bflo(a.x), bfhi(a.x), bflo(a.y), bfhi(a.y)}, x2[4] = {bflo(b.x), bfhi(b.x), bflo(b.y), bfhi(b.y)};
  float y1[4], y2[4];
#pragma unroll
  for (int i = 0; i < 4; ++i) { const f32x2 c = cs4[i]; y1[i] = x1[i] * c.x - x2[i] * c.y; y2[i] = x2[i] * c.x + x1[i] * c.y; }
  u32x2 oa, ob; oa.x = cvtpk(y1[0], y1[1]); oa.y = cvtpk(y1[2], y1[3]); ob.x = cvtpk(y2[0], y2[1]); ob.y = cvtpk(y2[2], y2[3]);
  *(u32x2*)base = oa; *(u32x2*)(base + 16) = ob;
}
__device__ __forceinline__ void phase_post(const Params& p, int layer, LAS unsigned char* lds) {
  unsigned char* ws = p.ws;
  bf16_t* P = (bf16_t*)(ws + OFF_P);
  const f32x2* cs = (const f32x2*)(ws + OFF_ROPE);
  bf16_t* cqn = (bf16_t*)(ws + OFF_CQN); bf16_t* ckvn = (bf16_t*)(ws + OFF_CKVN);
  const int lane = get_tid() & 63, gw = get_bid() * 8 + (get_tid() >> 6), ngw = get_nblk() * 8;
  const float* gq = p.mla_q_norm_g + layer * 256; const float* gkv = p.mla_kv_norm_g + layer * 128;
  for (int m = gw; m < M_TOK; m += ngw) {
    bf16_t* row = P + (size_t)m * NP;
    const f32x2* csm = cs + (size_t)m * 16;
    { const int sh = lane >> 2, pg = lane & 3; rope4(row + C_DFQ + sh * 32 + 4 * pg, csm + 4 * pg); }
    if (lane < 4) rope4(row + C_KR + 4 * lane, csm + 4 * lane);
    {
      const u32x2 a = *(const u32x2*)(row + C_CQ + 4 * lane);
      float x[4] = {bflo(a.x), bfhi(a.x), bflo(a.y), bfhi(a.y)};
      const float ss = wave_sum(x[0] * x[0] + x[1] * x[1] + x[2] * x[2] + x[3] * x[3]);
      const float rs = rsqrtf(ss * (1.f / 256.f) + RMS_EPS);
      const f32x4 gg = *(const f32x4*)(gq + 4 * lane);
      u32x2 o; o.x = cvtpk(x[0] * rs * gg.x, x[1] * rs * gg.y); o.y = cvtpk(x[2] * rs * gg.z, x[3] * rs * gg.w);
      *(u32x2*)(cqn + (size_t)m * 256 + 4 * lane) = o;
    }
    {
      const unsigned a = *(const unsigned*)(row + C_CKV + 2 * lane);
      const float x0 = bflo(a), x1 = bfhi(a);
      const float ss = wave_sum(x0 * x0 + x1 * x1);
      const float rs = rsqrtf(ss * (1.f / 128.f) + RMS_EPS);
      const f32x2 gg = *(const f32x2*)(gkv + 2 * lane);
      *(unsigned*)(ckvn + (size_t)m * 128 + 2 * lane) = cvtpk(x0 * rs * gg.x, x1 * rs * gg.y);
    }
  }
  if (get_bid() < 16) {
    const int b = get_bid() >> 2, h = get_bid() & 3, tid = get_tid();
    const float* gateF = (const float*)(ws + OFF_GATEF);
    float* Fk = (float*)(ws + OFF_FK) + (size_t)get_bid() * SEQ;
    const float bf = p.b_forget[layer * 4 + h];
    LAS float* sc = (LAS float*)lds;
    float v[8]; float run = 0.f;
#pragma unroll
    for (int i = 0; i < 8; ++i) {
      const float xx = gateF[(size_t)(b * SEQ + tid * 8 + i) * 4 + h] + bf;
      const float ls = fminf(xx, 0.f) - log1pf(expf(-fabsf(xx)));
      run += ls; v[i] = run;
    }
    float inc = run;
#pragma unroll
    for (int o = 1; o < 64; o <<= 1) { const float t = __shfl_up(inc, o); if (lane >= o) inc += t; }
    __syncthreads();
    if (lane == 63) sc[tid >> 6] = inc;
    __syncthreads();
    float wbase = 0.f;
    for (int i = 0; i < (tid >> 6); ++i) wbase += sc[i];
    const float excl = wbase + inc - run;
#pragma unroll
    for (int i = 0; i < 8; ++i) Fk[tid * 8 + i] = -8.f * (excl + v[i]);
    __syncthreads();
  }
}

__device__ __forceinline__ void phase_mla_up(const Params& p, int layer, LAS unsigned char* lds) {
  unsigned char* ws = p.ws;
  const bf16_t* P = (const bf16_t*)(ws + OFF_P);
  const float* ssq = (const float*)(ws + OFF_CQN);
  const bf16_t* Wq = (const bf16_t*)(ws + OFF_WUQ) + (size_t)layer * 384 * 256;
  const bf16_t* Wkv = (const bf16_t*)(ws + OFF_WUKV) + (size_t)layer * 512 * 128;
  bf16_t* qd = (bf16_t*)(ws + OFF_QD); bf16_t* kvd = (bf16_t*)(ws + OFF_KVD);
  const int sb = get_bid() - (get_nblk() - 16);
  if (sb >= 0) {
    const int b = sb >> 2, h = sb & 3, tid = get_tid(), lane = tid & 63;
    const float* gateF = (const float*)(ws + OFF_GATEF);
    float* Fk = (float*)(ws + OFF_FK) + (size_t)sb * SEQ;
    const float bf = p.b_forget[layer * 4 + h];
    LAS float* sc = (LAS float*)lds;
    float v[8]; float run = 0.f;
#pragma unroll
    for (int i = 0; i < 8; ++i) {
      const float xx = gateF[(size_t)(b * SEQ + tid * 8 + i) * 4 + h] + bf;
      const float ls = fminf(xx, 0.f) - log1pf(expf(-fabsf(xx)));
      run += ls; v[i] = run;
    }
    float inc = run;
#pragma unroll
    for (int o = 1; o < 64; o <<= 1) { const float t = __shfl_up(inc, o); if (lane >= o) inc += t; }
    __syncthreads();
    if (lane == 63) sc[tid >> 6] = inc;
    __syncthreads();
    float wbase = 0.f;
    for (int i = 0; i < (tid >> 6); ++i) wbase += sc[i];
    const float excl = wbase + inc - run;
#pragma unroll
    for (int i = 0; i < 8; ++i) Fk[tid * 8 + i] = -8.f * (excl + v[i]);
    __syncthreads();
  }
  const int lane = get_tid() & 63, w = get_tid() >> 6, wm = w >> 1, wn = w & 1, c31 = lane & 31, hi = lane >> 5;
  for (int item = get_bid() * 8 + w; item < 16 * 64; item += get_nblk() * 8) {
    const int bh = item >> 6, tl = item & 63, b = bh >> 2, h = bh & 3;
    const bf16_t* kr = P + (size_t)(b * SEQ + 64 * tl + lane) * NP + C_FXK + h * 64;
    float ss = 0.f;
#pragma unroll
    for (int c = 0; c < 8; ++c) {
      const u32x4 x = *(const u32x4*)(kr + 8 * c);
      ss += bflo(x.x) * bflo(x.x) + bfhi(x.x) * bfhi(x.x) + bflo(x.y) * bflo(x.y) + bfhi(x.y) * bfhi(x.y) + bflo(x.z) * bflo(x.z) + bfhi(x.z) * bfhi(x.z) + bflo(x.w) * bflo(x.w) + bfhi(x.w) * bfhi(x.w);
    }
    float nv = sqrtf(ss) * 1.0001f;
#pragma unroll
    for (int o = 1; o < 64; o <<= 1) nv = fmaxf(nv, __shfl_xor(nv, o));
    if (lane == 0) ((float*)(ws + OFF_KN))[item] = nv;
  }
  constexpr int TQ = 64 * 3, TKV = 64 * 4;
  for (int t = get_bid(); t < TQ + TKV; t += get_nblk()) {
    const bool isq = t < TQ; const int tt = isq ? t : t - TQ; const int ntn = isq ? 3 : 4; const int mt = tt / ntn, nt = tt % ntn;
    GemmDesc g;
    if (isq) g = GemmDesc{P + C_CQ, NP, nullptr, mt * 256, 256, Wq + (size_t)nt * 128 * 256, 256, 256};
    else g = GemmDesc{P + C_CKV, NP, nullptr, mt * 256, 256, Wkv + (size_t)nt * 128 * 128, 128, 128};
    f32x16 acc[2][2];
    gemm_tile<2>(lds, g, acc);
    bf16_t* O = isq ? qd : kvd; const int ldo = isq ? 384 : 512;
#pragma unroll
    for (int mi = 0; mi < 2; ++mi) {
      const int m = mt * 256 + wm * 64 + mi * 32 + c31;
      const f32x4 s4 = *(const f32x4*)(ssq + (size_t)m * 8 + (isq ? 0 : 4));
      const float rs = rsqrtf(((s4.x + s4.y) + (s4.z + s4.w)) * (isq ? (1.f / 256.f) : (1.f / 128.f)) + RMS_EPS);
#pragma unroll
      for (int ni = 0; ni < 2; ++ni)
#pragma unroll
        for (int g4 = 0; g4 < 4; ++g4) {
          const int n = nt * 128 + wn * 64 + ni * 32 + 4 * hi + 8 * g4;
          u32x2 o; o.x = cvtpk(acc[mi][ni][4 * g4] * rs, acc[mi][ni][4 * g4 + 1] * rs); o.y = cvtpk(acc[mi][ni][4 * g4 + 2] * rs, acc[mi][ni][4 * g4 + 3] * rs);
          *(u32x2*)(O + (size_t)m * ldo + n) = o;
        }
    }
  }
}

constexpr int CMU_UP = 32 * 8 * 32, CMU_DN = 32 * 8 * 16, CMU_TOTAL = CMU_UP + CMU_DN;
struct ConvCtx { const float* wgu; const float* wdn; unsigned char* dgu; unsigned char* ddn; int* ctr; };
__device__ __forceinline__ void cmu_load(const ConvCtx& c, int idx, int lane, int w, float (&v)[16]) {
  const bool up = idx < CMU_UP;
  const int i2 = up ? idx : idx - CMU_UP;
  const int e = up ? (i2 >> 8) : (i2 >> 7), rem = up ? (i2 & 255) : (i2 & 127);
  const int kb = up ? (rem >> 5) : (rem >> 4), nb = up ? (rem & 31) : (rem & 15);
  const int N = up ? 2048 : 1024;
  const float* base = up ? c.wgu : c.wdn;
  const float* sp = base + ((size_t)e * 1024 + kb * 128 + 16 * w) * N + nb * 64 + lane;
#pragma unroll
  for (int j = 0; j < 16; ++j) v[j] = __builtin_nontemporal_load(sp + (size_t)j * N);
}
__device__ __forceinline__ void cmu_store(const ConvCtx& c, int idx, int lane, int w, const float (&v)[16]) {
  const bool up = idx < CMU_UP;
  const int i2 = up ? idx : idx - CMU_UP;
  const int e = up ? (i2 >> 8) : (i2 >> 7), rem = up ? (i2 & 255) : (i2 & 127);
  const int kb = up ? (rem >> 5) : (rem >> 4), nb = up ? (rem & 31) : (rem & 15);
  const int N = up ? 2048 : 1024;
  const int n = nb * 64 + lane;
  int dr = n;
  if (up) { const int j = n & 1023; dr = (j >> 4) * 32 + (j & 15) + ((n >= 1024) ? 16 : 0); }
  unsigned char* base = up ? c.dgu : c.ddn;
  const float sc = up ? S8_WGU : S8_WDN;
  u32x4 o;
  o.x = pk4_fp8(v[0] * sc, v[1] * sc, v[2] * sc, v[3] * sc); o.y = pk4_fp8(v[4] * sc, v[5] * sc, v[6] * sc, v[7] * sc);
  o.z = pk4_fp8(v[8] * sc, v[9] * sc, v[10] * sc, v[11] * sc); o.w = pk4_fp8(v[12] * sc, v[13] * sc, v[14] * sc, v[15] * sc);
  *(u32x4*)(base + ((size_t)e * N + dr) * 1024 + kb * 128 + 16 * w) = o;
}

__device__ __forceinline__ void cmu_to_lds(const ConvCtx& c, int idx, int lane, int w, const float (&v)[16], LAS unsigned char* tile) {
  const float sc = (idx < CMU_UP) ? S8_WGU : S8_WDN;
  u32x4 o;
  o.x = pk4_fp8(v[0] * sc, v[1] * sc, v[2] * sc, v[3] * sc); o.y = pk4_fp8(v[4] * sc, v[5] * sc, v[6] * sc, v[7] * sc);
  o.z = pk4_fp8(v[8] * sc, v[9] * sc, v[10] * sc, v[11] * sc); o.w = pk4_fp8(v[12] * sc, v[13] * sc, v[14] * sc, v[15] * sc);
  *(LAS u32x4*)(tile + lane * 128 + ((w ^ (lane & 7)) << 4)) = o;
}
__device__ __forceinline__ void cmu_from_lds(const ConvCtx& c, int idx, int lane, int w, const LAS unsigned char* tile) {
  const bool up = idx < CMU_UP;
  const int i2 = up ? idx : idx - CMU_UP;
  const int e = up ? (i2 >> 8) : (i2 >> 7), rem = up ? (i2 & 255) : (i2 & 127);
  const int kb = up ? (rem >> 5) : (rem >> 4), nb = up ? (rem & 31) : (rem & 15);
  const int N = up ? 2048 : 1024;
  const int r = 8 * w + (lane >> 3), ch = lane & 7;
  const u32x4 o = *(const LAS u32x4*)(tile + r * 128 + ((ch ^ (r & 7)) << 4));
  const int n = nb * 64 + r;
  int dr = n;
  if (up) { const int j = n & 1023; dr = (j >> 4) * 32 + (j & 15) + ((n >= 1024) ? 16 : 0); }
  unsigned char* base = up ? c.dgu : c.ddn;
  *(u32x4*)(base + ((size_t)e * N + dr) * 1024 + kb * 128 + 16 * ch) = o;
}

enum { AT_SB = 0, AT_DIFF = 1, AT_FOX = 2, AT_MLA = 3 };
struct AttnArgs {
  const bf16_t* Q; int ldq; const bf16_t* K; int ldk; const bf16_t* V; int ldv; const bf16_t* K2; int ldk2;
  const float* Fk; const f32x2* cs; bf16_t* O; int ldo; float lam, oscale; const float* subg; const float* kn;
};
constexpr int ATT_K1 = 0, ATT_V = 8192, ATT_K2 = 16384, ATT_F = 20480, ATT_BUF = 20992;

__device__ __forceinline__ float max3f(float a, float b, float c) { float r; asm("v_max3_f32 %0, %1, %2, %3" : "=v"(r) : "v"(a), "v"(b), "v"(c)); return r; }
__device__ __forceinline__ float max2f(float a, float b) { float r; asm("v_max_f32_e32 %0, %1, %2" : "=v"(r) : "v"(a), "v"(b)); return r; }
__device__ __forceinline__ bool softmax_tile(f32x16& p0, f32x16& p1, float& m, float& l, float c, bool domask, int kbase, int q, int hi, float& alpha) {
  if (domask) {
#pragma unroll
    for (int r = 0; r < 16; ++r) { const int key = kbase + crow(r, hi); if (key > q) p0[r] = -INFINITY; if (key + 32 > q) p1[r] = -INFINITY; }
  }
  asm volatile("s_nop 15\n\ts_nop 7" : "+v"(p0), "+v"(p1));
  float a = max3f(p0[0], p0[1], p1[0]), b = max3f(p0[2], p0[3], p1[1]); a = max3f(a, p1[2], p1[3]);
#pragma unroll
  for (int r = 4; r < 16; r += 4) { a = max3f(a, p0[r], p0[r + 1]); b = max3f(b, p0[r + 2], p0[r + 3]); a = max3f(a, p1[r], p1[r + 1]); b = max3f(b, p1[r + 2], p1[r + 3]); }
  float a0, a1; pair_vals(max2f(a, b), a0, a1);
  const float rm = max2f(a0, a1);
  const bool resc = __any((rm - m) * c > 8.0f);
  alpha = 1.f;
  if (resc) { const float mn = max2f(m, rm); alpha = __builtin_amdgcn_exp2f((m - mn) * c); l *= alpha; m = mn; }
  const float mc = m * c;
  float s = 0.f;
#pragma unroll
  for (int r = 0; r < 16; ++r) { p0[r] = __builtin_amdgcn_exp2f(fmaf(p0[r], c, -mc)); p1[r] = __builtin_amdgcn_exp2f(fmaf(p1[r], c, -mc)); s += p0[r] + p1[r]; }
  l += s;
  return resc;
}
__device__ __forceinline__ bf16x8 pack8(const f32x16& p, int b) {
  u32x4 w; w.x = cvtpk(p[b], p[b + 1]); w.y = cvtpk(p[b + 2], p[b + 3]); w.z = cvtpk(p[b + 4], p[b + 5]); w.w = cvtpk(p[b + 6], p[b + 7]);
  return __builtin_bit_cast(bf16x8, w);
}
__device__ __forceinline__ bf16x8 vfrag(LAS unsigned char* vb, int off) {
  const s16x4 lo = __builtin_bit_cast(s16x4, __builtin_amdgcn_ds_read_tr16_b64_v4i16((LAS s16x4*)(vb + off)));
  const s16x4 hh = __builtin_bit_cast(s16x4, __builtin_amdgcn_ds_read_tr16_b64_v4i16((LAS s16x4*)(vb + off + 1024)));
  return (bf16x8){lo[0], lo[1], lo[2], lo[3], hh[0], hh[1], hh[2], hh[3]};
}

template <int T>
__device__ __forceinline__ void attn_unit(LAS unsigned char* lds, const AttnArgs& a, int qb, const ConvCtx& cc, int& gi, int& pidx, int& qidx, float (&cv)[16]) {
  const int tid = get_tid(), lane = tid & 63, w = tid >> 6, c31 = lane & 31, hi = lane >> 5;
  const int t0 = qb * 256 + w * 32, q = t0 + c31;
  constexpr int NKS = (T == AT_MLA) ? 6 : 4;
  constexpr float CSC = (T == AT_DIFF) ? 0.17677669529663687f * LOG2E : (T == AT_MLA) ? 0.10206207261596577f * LOG2E : 0.125f * LOG2E;
  bf16x8 qf[NKS];
  {
    const bf16_t* qrow = a.Q + (size_t)q * a.ldq;
#pragma unroll
    for (int ks = 0; ks < NKS; ++ks) qf[ks] = *(const bf16x8*)(qrow + 16 * ks + 8 * hi);
    if (T == AT_MLA) {
      const f32x2* csq = a.cs + (size_t)q * 16 + 8 * hi;
      bf16x8 n4, n5;
#pragma unroll
      for (int j = 0; j < 8; j += 2) {
        const f32x2 c0 = csq[j], c1 = csq[j + 1];
        const float x1a = bf2f((unsigned short)qf[4][j]), x1b = bf2f((unsigned short)qf[4][j + 1]);
        const float x2a = bf2f((unsigned short)qf[5][j]), x2b = bf2f((unsigned short)qf[5][j + 1]);
        const unsigned w1 = cvtpk(x1a * c0.x - x2a * c0.y, x1b * c1.x - x2b * c1.y);
        const unsigned w2 = cvtpk(x2a * c0.x + x1a * c0.y, x2b * c1.x + x1b * c1.y);
        n4[j] = (short)(w1 & 0xffff); n4[j + 1] = (short)(w1 >> 16); n5[j] = (short)(w2 & 0xffff); n5[j + 1] = (short)(w2 >> 16);
      }
      qf[4] = n4; qf[5] = n5;
    }
  }
  const int skey = tid >> 3, sch = tid & 7;
  const int k1_st = ATT_K1 + skey * 128 + ((sch ^ ((skey >> 1) & 7)) << 4);
  const int v_st = ATT_V + skey * 128 + ((sch ^ (((skey >> 1) & 1) << 2)) << 4);
  const int k2key = tid >> 2, k2ch = tid & 3;
  const int k2_st = ATT_K2 + k2key * 64 + ((k2ch ^ ((k2key >> 2) & 3)) << 4);
  const int xr = (lane >> 1) & 7;
  int kro[4];
#pragma unroll
  for (int ks = 0; ks < 4; ++ks) kro[ks] = ATT_K1 + c31 * 128 + (((2 * ks + hi) ^ xr) << 4);
  int k2ro[2];
#pragma unroll
  for (int ks = 0; ks < 2; ++ks) k2ro[ks] = ATT_K2 + c31 * 64 + (((2 * ks + hi) ^ ((c31 >> 2) & 3)) << 4);
  int vro[2];
  {
    const int i = lane & 15, qq = i >> 2, pp = i & 3, gg = (lane >> 4) & 1, bit = (qq >> 1) & 1;
#pragma unroll
    for (int d0 = 0; d0 < 2; ++d0) vro[d0] = ATT_V + (4 * hi + qq) * 128 + ((4 * (d0 ^ bit) + 2 * gg + (pp >> 1)) << 4) + (pp & 1) * 8;
  }
  const int ntiles = 4 * (qb + 1);
  const int wave_last = (t0 + 31) >> 6;
  LAS float* kpre = (LAS float*)(lds + 2 * ATT_BUF + 256);
  LAS float* fend = kpre + 64;
  float qn = 0.f;
  if (T == AT_FOX) {
    if (w == 0) {
      float v = (lane < ntiles) ? a.kn[lane] : 0.f;
#pragma unroll
      for (int o = 1; o < 64; o <<= 1) { const float u_ = __shfl_up(v, o); if (lane >= o) v = fmaxf(v, u_); }
      kpre[lane] = v;
      fend[lane] = (lane < ntiles) ? a.Fk[64 * lane + 63] : 0.f;
    }
    float ss = 0.f;
#pragma unroll
    for (int ks = 0; ks < 4; ++ks)
#pragma unroll
      for (int j = 0; j < 8; ++j) { const float x = bf2f((unsigned short)qf[ks][j]); ss += x * x; }
    float s0_, s1_; pair_vals(ss, s0_, s1_);
    qn = sqrtf(s0_ + s1_) * 1.0001f;
  }
  f32x16 o0[2], o1[2];
#pragma unroll
  for (int d0 = 0; d0 < 2; ++d0)
#pragma unroll
    for (int r = 0; r < 16; ++r) { o0[d0][r] = 0.f; o1[d0][r] = 0.f; }
  float m0 = -INFINITY, l0 = 0.f, m1 = -INFINITY, l1 = 0.f;
  float Crun = 0.f;
  bool fin = false;
  u32x4 rk, rv, rk2; float rf = 0.f;
#define ATT_TILE(it) ((T == AT_SB || T == AT_FOX) ? (ntiles - 1 - (it)) : (it))
#define ATT_GLOAD(t) do { const int key_ = 64 * (t) + skey; \
    rk = *(const u32x4*)(a.K + (size_t)key_ * a.ldk + sch * 8); rv = *(const u32x4*)(a.V + (size_t)key_ * a.ldv + sch * 8); \
    if (T == AT_MLA) { if (tid < 256) rk2 = *(const u32x4*)(a.K2 + (size_t)(64 * (t) + k2key) * a.ldk2 + k2ch * 8); } \
    if (T == AT_FOX) { if (tid < 64) rf = a.Fk[64 * (t) + tid]; } } while (0)
#define ATT_LSTORE(buf) do { LAS unsigned char* b_ = lds + (buf) * ATT_BUF; \
    *(LAS u32x4*)(b_ + k1_st) = rk; *(LAS u32x4*)(b_ + v_st) = rv; \
    if (T == AT_MLA) { if (tid < 256) *(LAS u32x4*)(b_ + k2_st) = rk2; } \
    if (T == AT_FOX) { if (tid < 64) *(LAS float*)(b_ + ATT_F + 4 * tid) = rf; } } while (0)
  LAS int* s_conv = (LAS int*)(lds + 2 * ATT_BUF + 64);
  ATT_GLOAD(ATT_TILE(0));
  ATT_LSTORE(0);
  __syncthreads();
  for (int it = 0; it < ntiles; ++it) {
    const int t = ATT_TILE(it);
    LAS unsigned char* cur = lds + (it & 1) * ATT_BUF;
    const bool more = (it + 1 < ntiles);
    const int cidx = __builtin_amdgcn_readfirstlane(s_conv[(gi >> 3) & 1]) + (gi & 7);
    int cnext = 0;
    const bool cfetch = (gi & 7) == 0;
    if (cfetch && tid == 0) cnext = atomicAdd(cc.ctr, 8);
    if (more) ATT_GLOAD(ATT_TILE(it + 1));
    const bool active = (t <= wave_last) && !fin;
    if (active) {
      const bool domask = (64 * t + 63 > t0);
      const int kbase = 64 * t;
      if (T == AT_DIFF) {
        f32x16 pa0, pa1, pb0, pb1;
#pragma unroll
        for (int r = 0; r < 16; ++r) { pa0[r] = 0.f; pa1[r] = 0.f; pb0[r] = 0.f; pb1[r] = 0.f; }
#pragma unroll
        for (int ks = 0; ks < 2; ++ks) {
          const bf16x8 k0 = *(const LAS bf16x8*)(cur + kro[ks]), k1 = *(const LAS bf16x8*)(cur + kro[ks] + 4096);
          pa0 = __builtin_amdgcn_mfma_f32_32x32x16_bf16(k0, qf[ks], pa0, 0, 0, 0); pa1 = __builtin_amdgcn_mfma_f32_32x32x16_bf16(k1, qf[ks], pa1, 0, 0, 0);
        }
#pragma unroll
        for (int ks = 2; ks < 4; ++ks) {
          const bf16x8 k0 = *(const LAS bf16x8*)(cur + kro[ks]), k1 = *(const LAS bf16x8*)(cur + kro[ks] + 4096);
          pb0 = __builtin_amdgcn_mfma_f32_32x32x16_bf16(k0, qf[ks], pb0, 0, 0, 0); pb1 = __builtin_amdgcn_mfma_f32_32x32x16_bf16(k1, qf[ks], pb1, 0, 0, 0);
        }
        float al0, al1;
        const bool rs0 = softmax_tile(pa0, pa1, m0, l0, CSC, domask, kbase, q, hi, al0);
        const bool rs1 = softmax_tile(pb0, pb1, m1, l1, CSC, domask, kbase, q, hi, al1);
        if (rs0) {
#pragma unroll
          for (int d0 = 0; d0 < 2; ++d0)
#pragma unroll
            for (int r = 0; r < 16; ++r) o0[d0][r] *= al0;
        }
        if (rs1) {
#pragma unroll
          for (int d0 = 0; d0 < 2; ++d0)
#pragma unroll
            for (int r = 0; r < 16; ++r) o1[d0][r] *= al1;
        }
#pragma unroll
        for (int s = 0; s < 4; ++s) {
          const bf16x8 pfa = pack8((s < 2) ? pa0 : pa1, 8 * (s & 1)), pfb = pack8((s < 2) ? pb0 : pb1, 8 * (s & 1));
#pragma unroll
          for (int d0 = 0; d0 < 2; ++d0) {
            const bf16x8 vf = vfrag(cur, vro[d0] + 2048 * s);
            o0[d0] = __builtin_amdgcn_mfma_f32_32x32x16_bf16(vf, pfa, o0[d0], 0, 0, 0);
            o1[d0] = __builtin_amdgcn_mfma_f32_32x32x16_bf16(vf, pfb, o1[d0], 0, 0, 0);
          }
        }
      } else {
        f32x16 p0, p1;
        if (T == AT_FOX) {
#pragma unroll
          for (int g4 = 0; g4 < 4; ++g4) {
            const f32x4 f0 = *(const LAS f32x4*)(cur + ATT_F + (8 * g4 + 4 * hi) * 4), f1 = *(const LAS f32x4*)(cur + ATT_F + (32 + 8 * g4 + 4 * hi) * 4);
            p0[4 * g4] = f0.x; p0[4 * g4 + 1] = f0.y; p0[4 * g4 + 2] = f0.z; p0[4 * g4 + 3] = f0.w;
            p1[4 * g4] = f1.x; p1[4 * g4 + 1] = f1.y; p1[4 * g4 + 2] = f1.z; p1[4 * g4 + 3] = f1.w;
          }
        } else {
#pragma unroll
          for (int r = 0; r < 16; ++r) { p0[r] = 0.f; p1[r] = 0.f; }
        }
#pragma unroll
        for (int ks = 0; ks < 4; ++ks) {
          const bf16x8 k0 = *(const LAS bf16x8*)(cur + kro[ks]), k1 = *(const LAS bf16x8*)(cur + kro[ks] + 4096);
          p0 = __builtin_amdgcn_mfma_f32_32x32x16_bf16(k0, qf[ks], p0, 0, 0, 0); p1 = __builtin_amdgcn_mfma_f32_32x32x16_bf16(k1, qf[ks], p1, 0, 0, 0);
        }
        if (T == AT_MLA) {
#pragma unroll
          for (int ks = 0; ks < 2; ++ks) {
            const bf16x8 k0 = *(const LAS bf16x8*)(cur + k2ro[ks]), k1 = *(const LAS bf16x8*)(cur + k2ro[ks] + 2048);
            p0 = __builtin_amdgcn_mfma_f32_32x32x16_bf16(k0, qf[(NKS == 6) ? 4 + ks : ks], p0, 0, 0, 0);
            p1 = __builtin_amdgcn_mfma_f32_32x32x16_bf16(k1, qf[(NKS == 6) ? 4 + ks : ks], p1, 0, 0, 0);
          }
        }
        if (T == AT_SB) {
          f32x16 e0, e1;
          float T8[8];
#pragma unroll
          for (int half = 0; half < 2; ++half) {
            f32x16& pp = half ? p1 : p0; f32x16& ee = half ? e1 : e0;
#pragma unroll
            for (int r = 0; r < 16; ++r) {
              const float z2 = pp[r] * CSC;
              float lk = -__builtin_amdgcn_logf(1.0f + __builtin_amdgcn_exp2f(fminf(z2, 126.f)));
              const bool valid = !domask || (kbase + 32 * half + crow(r, hi) < q);
              lk = valid ? lk : 0.f;
              pp[r] = valid ? (z2 + lk) : -INFINITY;
              ee[r] = lk;
            }
#pragma unroll
            for (int g4 = 0; g4 < 4; ++g4) {
              const float x0 = ee[4 * g4], x1 = ee[4 * g4 + 1], x2 = ee[4 * g4 + 2], x3 = ee[4 * g4 + 3];
              ee[4 * g4 + 3] = 0.f; ee[4 * g4 + 2] = x3; ee[4 * g4 + 1] = x3 + x2; ee[4 * g4] = x3 + x2 + x1;
              T8[4 * half + g4] = x3 + x2 + x1 + x0;
            }
          }
          float Tl[8], Th[8];
#pragma unroll
          for (int i = 0; i < 8; ++i) pair_vals(T8[i], Tl[i], Th[i]);
          float ps = 0.f; float base[8];
#pragma unroll
          for (int i = 7; i >= 0; --i) { base[i] = Crun + ps + (hi ? 0.f : Th[i]); ps += Tl[i] + Th[i]; }
          Crun += ps;
#pragma unroll
          for (int r = 0; r < 16; ++r) {
            p0[r] = __builtin_amdgcn_exp2f(p0[r] + e0[r] + base[r >> 2]);
            p1[r] = __builtin_amdgcn_exp2f(p1[r] + e1[r] + base[4 + (r >> 2)]);
          }
          if (__all(Crun < -48.f)) fin = true;
        } else {
          float al;
          if (softmax_tile(p0, p1, m0, l0, CSC, domask, kbase, q, hi, al)) {
#pragma unroll
            for (int d0 = 0; d0 < 2; ++d0)
#pragma unroll
              for (int r = 0; r < 16; ++r) o0[d0][r] *= al;
          }
          if (T == AT_FOX) { if (t > 0) { if (__all((qn * kpre[t - 1] + fend[t - 1] - m0) * CSC < -40.f)) fin = true; } }
        }
#pragma unroll
        for (int s = 0; s < 4; ++s) {
          const bf16x8 pf = pack8((s < 2) ? p0 : p1, 8 * (s & 1));
#pragma unroll
          for (int d0 = 0; d0 < 2; ++d0) {
            const bf16x8 vf = vfrag(cur, vro[d0] + 2048 * s);
            o0[d0] = __builtin_amdgcn_mfma_f32_32x32x16_bf16(vf, pf, o0[d0], 0, 0, 0);
          }
        }
      }
    }
    if (more) ATT_LSTORE((it + 1) & 1);
    {
      LAS unsigned char* ctile = lds + 2 * ATT_BUF + 1024;
      if (qidx < CMU_TOTAL) cmu_from_lds(cc, qidx, lane, w, ctile + ((gi + 1) & 1) * 8192);
      if (pidx < CMU_TOTAL) cmu_to_lds(cc, pidx, lane, w, cv, ctile + (gi & 1) * 8192);
      qidx = pidx;
      pidx = cidx;
      if (pidx < CMU_TOTAL) cmu_load(cc, pidx, lane, w, cv);
    }
    if (cfetch && tid == 0) s_conv[((gi >> 3) + 1) & 1] = cnext;
    ++gi;
    if (T == AT_SB || T == AT_FOX) {
      const bool wave_done = fin || (t == 0);
      if (__syncthreads_and(wave_done ? 1 : 0)) break;
    } else {
      __syncthreads();
    }
  }
  __syncthreads();
#undef ATT_TILE
#undef ATT_GLOAD
#undef ATT_LSTORE
  if (T == AT_DIFF) {
    float la, lb; pair_vals(l0, la, lb); const float inv0 = 1.f / (la + lb);
    pair_vals(l1, la, lb); const float inv1 = a.lam / (la + lb);
    float ss = 0.f;
#pragma unroll
    for (int d0 = 0; d0 < 2; ++d0)
#pragma unroll
      for (int r = 0; r < 16; ++r) { const float v = o0[d0][r] * inv0 - o1[d0][r] * inv1; o0[d0][r] = v; ss += v * v; }
    float sa, sb; pair_vals(ss, sa, sb);
    const float rs = rsqrtf((sa + sb) * (1.f / 64.f) + RMS_EPS) * a.oscale;
#pragma unroll
    for (int d0 = 0; d0 < 2; ++d0)
#pragma unroll
      for (int g4 = 0; g4 < 4; ++g4) {
        const int dv = 32 * d0 + 8 * g4 + 4 * hi;
        const f32x4 gg = *(const f32x4*)(a.subg + dv);
        u32x2 o; o.x = cvtpk(o0[d0][4 * g4] * rs * gg.x, o0[d0][4 * g4 + 1] * rs * gg.y); o.y = cvtpk(o0[d0][4 * g4 + 2] * rs * gg.z, o0[d0][4 * g4 + 3] * rs * gg.w);
        *(u32x2*)(a.O + (size_t)q * a.ldo + dv) = o;
      }
  } else {
    float inv = 1.f;
    if (T != AT_SB) { float la, lb; pair_vals(l0, la, lb); inv = 1.f / (la + lb); }
#pragma unroll
    for (int d0 = 0; d0 < 2; ++d0)
#pragma unroll
      for (int g4 = 0; g4 < 4; ++g4) {
        const int dv = 32 * d0 + 8 * g4 + 4 * hi;
        u32x2 o; o.x = cvtpk(o0[d0][4 * g4] * inv, o0[d0][4 * g4 + 1] * inv); o.y = cvtpk(o0[d0][4 * g4 + 2] * inv, o0[d0][4 * g4 + 3] * inv);
        *(u32x2*)(a.O + (size_t)q * a.ldo + dv) = o;
      }
  }
}

__device__ __forceinline__ void phase_attention(const Params& p, int layer, LAS unsigned char* lds) {
  unsigned char* ws = p.ws;
  const bf16_t* P = (const bf16_t*)(ws + OFF_P);
  const bf16_t* qd = (const bf16_t*)(ws + OFF_QD); const bf16_t* kvd = (const bf16_t*)(ws + OFF_KVD);
  bf16_t* mix = (bf16_t*)(ws + OFF_MIX);
  int* ctrl = (int*)(ws + OFF_CTRL);
  const float lam = ((const float*)ctrl)[CW_LAM + layer];
  const float linit = 0.8f - 0.6f * expf(-0.3f * (float)layer);
  LAS int* s_unit = (LAS int*)(lds + 2 * ATT_BUF);
  ConvCtx cc;
  cc.wgu = p.w_gate_up + (size_t)layer * NE * 1024 * 2048; cc.wdn = p.w_down + (size_t)layer * NE * 1024 * 1024;
  cc.dgu = ws + OFF_WGU + (size_t)layer * NE * 2048 * 1024; cc.ddn = ws + OFF_WD + (size_t)layer * NE * 1024 * 1024;
  cc.ctr = ctrl + CW_CONVQ + layer;
  int gi = 0, pidx = CMU_TOTAL, qidx = CMU_TOTAL; float cv[16];
#pragma unroll
  for (int j = 0; j < 16; ++j) cv[j] = 0.f;
  if (get_tid() == 0) ((LAS int*)(lds + 2 * ATT_BUF + 64))[0] = atomicAdd(cc.ctr, 8);
  for (;;) {
    if (get_tid() == 0) *s_unit = atomicAdd(&ctrl[CW_ATTQ + layer], 1);
    __syncthreads();
    const int u = *s_unit;
    __syncthreads();
    if (u >= 1024) break;
    const int qb = 15 - (u >> 6), rem = u & 63, type = rem & 3, bh = rem >> 2, b = bh >> 2, h = bh & 3;
    const size_t rb = (size_t)b * SEQ;
    AttnArgs a{};
    a.O = mix + rb * DM + type * 256 + h * 64; a.ldo = DM;
    if (type == AT_SB) {
      a.Q = P + rb * NP + C_SBQ + h * 64; a.K = P + rb * NP + C_SBK + h * 64; a.V = P + rb * NP + C_SBV + h * 64; a.ldq = a.ldk = a.ldv = NP;
      attn_unit<AT_SB>(lds, a, qb, cc, gi, pidx, qidx, cv);
    } else if (type == AT_DIFF) {
      a.Q = P + rb * NP + C_DFQ + h * 64; a.K = P + rb * NP + C_DFK + h * 64; a.V = P + rb * NP + C_DFV + h * 64; a.ldq = a.ldk = a.ldv = NP;
      a.lam = lam; a.oscale = 1.f - linit; a.subg = p.diff_subln_g + layer * 64;
      attn_unit<AT_DIFF>(lds, a, qb, cc, gi, pidx, qidx, cv);
    } else if (type == AT_FOX) {
      a.Q = P + rb * NP + C_FXQ + h * 64; a.K = P + rb * NP + C_FXK + h * 64; a.V = P + rb * NP + C_FXV + h * 64; a.ldq = a.ldk = a.ldv = NP;
      a.Fk = (const float*)(ws + OFF_FK) + (size_t)bh * SEQ; a.kn = (const float*)(ws + OFF_KN) + bh * 64;
      attn_unit<AT_FOX>(lds, a, qb, cc, gi, pidx, qidx, cv);
    } else {
      a.Q = qd + rb * 384 + h * 96; a.ldq = 384; a.K = kvd + rb * 512 + h * 128; a.ldk = 512; a.V = kvd + rb * 512 + h * 128 + 64; a.ldv = 512;
      a.K2 = P + rb * NP + C_KR; a.ldk2 = NP; a.cs = (const f32x2*)(ws + OFF_ROPE) + rb * 16;
      attn_unit<AT_MLA>(lds, a, qb, cc, gi, pidx, qidx, cv);
    }
  }
  {
    __syncthreads();
    const LAS int* sc = (const LAS int*)(lds + 2 * ATT_BUF + 64);
    const int k = gi >> 3, used = gi & 7;
    const int b0 = __builtin_amdgcn_readfirstlane(sc[k & 1]);
    const int b1 = (used >= 1) ? __builtin_amdgcn_readfirstlane(sc[(k + 1) & 1]) : CMU_TOTAL;
    const int tid = get_tid(), lane = tid & 63, w = tid >> 6;
    if (qidx < CMU_TOTAL) cmu_from_lds(cc, qidx, lane, w, lds + 2 * ATT_BUF + 1024 + ((gi + 1) & 1) * 8192);
    if (pidx < CMU_TOTAL) cmu_store(cc, pidx, lane, w, cv);
#pragma unroll 1
    for (int j = used; j < 16; ++j) {
      const int ci = (j < 8) ? b0 + j : b1 + (j - 8);
      if (ci < CMU_TOTAL) { float v0[16]; cmu_load(cc, ci, lane, w, v0); cmu_store(cc, ci, lane, w, v0); }
    }
    __syncthreads();
  }
  for (;;) {
    if (get_tid() == 0) s_unit[0] = atomicAdd(cc.ctr, 2);
    __syncthreads();
    const int c0 = __builtin_amdgcn_readfirstlane(s_unit[0]);
    __syncthreads();
    if (c0 >= CMU_TOTAL) break;
    const int tid = get_tid(), lane = tid & 63, w = tid >> 6;
    float v0[16], v1[16];
    cmu_load(cc, c0, lane, w, v0);
    if (c0 + 1 < CMU_TOTAL) cmu_load(cc, c0 + 1, lane, w, v1);
    cmu_store(cc, c0, lane, w, v0);
    if (c0 + 1 < CMU_TOTAL) cmu_store(cc, c0 + 1, lane, w, v1);
  }
}

__device__ __forceinline__ size_t tmp_blocked(int row, int col) {
  return (size_t)(row >> 6) * 65536 + (size_t)((((((col >> 7) * 4 + ((col >> 5) & 3)) * 4 + ((col >> 3) & 3)) * 2 + ((row >> 5) & 1)) * 64 + (((col >> 2) & 1) * 32 + (row & 31))) * 4);
}
struct OutprojSched {
  int grid, bid;
  __device__ __forceinline__ bool next(int i, pg8::Unit& u) const {
    int mt, nt;
    if (grid == 256) { if (i > 0) return false; const int xcd = bid & 7, j = bid >> 3; mt = 8 * xcd + (j >> 2); nt = j & 3; }
    else { const int t = bid + i * grid; if (t >= 256) return false; mt = t >> 2; nt = t & 3; }
    u.boff = (unsigned)nt * (256u * 1024u * 2u); u.arow0 = mt * 256; u.mvalid = 256; u.e = 0; u.mt = mt; u.nt = nt; u.slot0 = 0;
    return true;
  }
};
struct OutprojEpi {
  const bf16_t* hB; float* tmp;
  __device__ __forceinline__ void operator()(const pg8::f32x4v (&acc)[2][2][4][2], const pg8::Unit& u, int wr, int wc, int fr, int fq) const {
#pragma unroll
    for (int ai = 0; ai < 2; ++ai)
#pragma unroll
      for (int m = 0; m < 4; ++m) {
        const int row = u.mt * 256 + 128 * ai + 64 * wr + 16 * m + fr;
#pragma unroll
        for (int bj = 0; bj < 2; ++bj)
#pragma unroll
          for (int n = 0; n < 2; ++n) {
            const int col = u.nt * 256 + 128 * bj + 32 * wc + 16 * n + 4 * fq;
            const u32x2 hb = *(const u32x2*)(hB + (size_t)row * DM + col);
            const pg8::f32x4v v = acc[ai][bj][m][n];
            *(f32x4*)(tmp + tmp_blocked(row, col)) = (f32x4){DN_ALPHA * bflo(hb.x) + v[0], DN_ALPHA * bfhi(hb.x) + v[1], DN_ALPHA * bflo(hb.y) + v[2], DN_ALPHA * bfhi(hb.y) + v[3]};
          }
      }
  }
};
__device__ __forceinline__ void phase_outproj(const Params& p, int layer, LAS unsigned char* lds) {
  unsigned char* ws = p.ws;
  OutprojSched S{get_nblk(), get_bid()};
  OutprojEpi E{(const bf16_t*)(ws + OFF_HB), (float*)(ws + OFF_TMPF)};
  pg8::gemm_phase<false, false>(lds, (const bf16_t*)(ws + OFF_MIX), (const bf16_t*)(ws + OFF_WOUT) + (size_t)layer * 1024 * 1024, S, E);
}

__device__ __forceinline__ void phase_ln1_router(const Params& p, int layer, LAS unsigned char* lds) {
  unsigned char* ws = p.ws;
  const float* tmp = (const float*)(ws + OFF_TMPF);
  float* hF = (float*)(ws + OFF_HF); bf16_t* hB = (bf16_t*)(ws + OFF_HB);
  int* ctrl = (int*)(ws + OFF_CTRL); int* cnt = ctrl + CW_CNT + layer * 32;
  int* list = (int*)(ws + OFF_LIST); int* toke = (int*)(ws + OFF_TOKE); float* tokg = (float*)(ws + OFF_TOKG);
  const float* Wr = p.router_w + (size_t)layer * DM * NE; const float* rb = p.router_b + layer * NE;
  const float* g1 = p.ln1_g + layer * DM; const float* b1 = p.ln1_b + layer * DM;
  LAS float* red = (LAS float*)lds;
  LAS float* lg = (LAS float*)(lds + 32768);
  LAS float* part = (LAS float*)(lds + 136192);
  LAS float* part2 = (LAS float*)(lds + 137216);
  LAS int* lcnt = (LAS int*)(lds + 138240);
#pragma unroll 1
  for (int hs = get_bid(); hs < M_TOK / 32; hs += get_nblk()) {
    const int m0 = hs * 32, mi = hs & 1;
    const int tid = get_tid(), lane = tid & 63, w = tid >> 6, c31 = lane & 31, hi = lane >> 5;
    f32x16 acc[4];
    {
      const float* tb = tmp + (size_t)(hs >> 1) * 65536 + (size_t)(w * 32 * 64 + lane) * 4;
#pragma unroll
      for (int ni = 0; ni < 4; ++ni)
#pragma unroll
        for (int g4 = 0; g4 < 4; ++g4) {
          const f32x4 v = *(const f32x4*)(tb + (size_t)(((ni * 4 + g4) * 2 + mi) * 64) * 4);
          acc[ni][4 * g4] = v.x; acc[ni][4 * g4 + 1] = v.y; acc[ni][4 * g4 + 2] = v.z; acc[ni][4 * g4 + 3] = v.w;
        }
    }
    float mean, rstd;
    {
      float sacc = 0.f;
#pragma unroll
      for (int ni = 0; ni < 4; ++ni)
#pragma unroll
        for (int r = 0; r < 16; ++r) sacc += acc[ni][r];
      float s0, s1; pair_vals(sacc, s0, s1);
      if (hi == 0) part[c31 * 8 + w] = s0 + s1;
    }
    __syncthreads();
    {
      const f32x4 pa = *(const LAS f32x4*)(part + c31 * 8), pb = *(const LAS f32x4*)(part + c31 * 8 + 4);
      mean = ((pa.x + pa.y) + (pa.z + pa.w) + (pb.x + pb.y) + (pb.z + pb.w)) * (1.f / DM);
      float q = 0.f;
#pragma unroll
      for (int ni = 0; ni < 4; ++ni)
#pragma unroll
        for (int r = 0; r < 16; ++r) { const float d = acc[ni][r] - mean; q += d * d; }
      float q0, q1; pair_vals(q, q0, q1);
      if (hi == 0) part2[c31 * 8 + w] = q0 + q1;
    }
    __syncthreads();
    {
      const f32x4 pa = *(const LAS f32x4*)(part2 + c31 * 8), pb = *(const LAS f32x4*)(part2 + c31 * 8 + 4);
      rstd = rsqrtf(((pa.x + pa.y) + (pa.z + pa.w) + (pb.x + pb.y) + (pb.z + pb.w)) * (1.f / DM) + LN_EPS);
    }
    LAS unsigned char* wt = lds + w * 16896;
#pragma unroll
    for (int ni = 0; ni < 4; ++ni)
#pragma unroll
      for (int g4 = 0; g4 < 4; ++g4) {
        const int n = 128 * w + ni * 32 + 8 * g4 + 4 * hi;
        const f32x4 gg = *(const f32x4*)(g1 + n), bb = *(const f32x4*)(b1 + n);
        f32x4 y;
        y.x = (acc[ni][4 * g4] - mean) * rstd * gg.x + bb.x; y.y = (acc[ni][4 * g4 + 1] - mean) * rstd * gg.y + bb.y;
        y.z = (acc[ni][4 * g4 + 2] - mean) * rstd * gg.z + bb.z; y.w = (acc[ni][4 * g4 + 3] - mean) * rstd * gg.w + bb.w;
        acc[ni][4 * g4] = y.x; acc[ni][4 * g4 + 1] = y.y; acc[ni][4 * g4 + 2] = y.z; acc[ni][4 * g4 + 3] = y.w;
        *(LAS f32x4*)(wt + c31 * 528 + (ni * 32 + 8 * g4 + 4 * hi) * 4) = y;
      }
    {
      const int cl = (lane & 31) * 4;
      const size_t off0 = (size_t)(m0 + hi) * DM + 128 * w + cl;
      bf16_t* pB = hB + off0; unsigned char* p8 = ws + OFF_H8 + off0;
      const LAS unsigned char* rp = wt + hi * 528 + cl * 4;
#pragma unroll 4
      for (int it = 0; it < 16; ++it) {
        const f32x4 y = *(const LAS f32x4*)rp;
        u32x2 o; o.x = cvtpk(y.x, y.y); o.y = cvtpk(y.z, y.w);
        *(u32x2*)pB = o;
        *(unsigned*)p8 = pk4_fp8(clamp448(y.x * S8_H), clamp448(y.y * S8_H), clamp448(y.z * S8_H), clamp448(y.w * S8_H));
        rp += 2 * 528; pB += 2 * DM; p8 += 2 * DM;
      }
    }
    f32x16 D0;
#pragma unroll
    for (int r = 0; r < 16; ++r) D0[r] = 0.f;
    {
      const float* wrp = Wr + (128 * w + 4 * hi) * 32 + c31;
      float wa[16], wb[16];
#pragma unroll
      for (int r = 0; r < 16; ++r) wa[r] = wrp[(8 * (r >> 2) + (r & 3)) * 32];
#pragma unroll
      for (int ni = 0; ni < 4; ++ni) {
        __builtin_amdgcn_sched_barrier(0);
        if (ni < 3) {
#pragma unroll
          for (int r = 0; r < 16; ++r) wb[r] = wrp[((ni + 1) * 32 + 8 * (r >> 2) + (r & 3)) * 32];
        }
        __builtin_amdgcn_sched_barrier(0);
#pragma unroll
        for (int r = 0; r < 16; ++r) D0 = __builtin_amdgcn_mfma_f32_32x32x2f32(acc[ni][r], wa[r], D0, 0, 0, 0);
        __builtin_amdgcn_sched_barrier(0);
#pragma unroll
        for (int r = 0; r < 16; ++r) wa[r] = wb[r];
      }
    }
    __syncthreads();
#pragma unroll
    for (int r = 0; r < 16; ++r) red[(w * 32 + crow(r, hi)) * 32 + c31] = D0[r];
    __syncthreads();
#pragma unroll
    for (int i = 0; i < 2; ++i) {
      const int idx = tid + 512 * i;
      float sv = rb[idx & 31];
#pragma unroll
      for (int ww = 0; ww < 8; ++ww) sv += red[ww * 1024 + idx];
      lg[(idx & 31) * 32 + (idx >> 5)] = sv;
    }
    if (tid < 32) lcnt[tid] = 0;
    __syncthreads();
    float gt[4]; int li[4], rk[4];
    if (tid < 32) {
      float lv[4]; unsigned used = 0u;
#pragma unroll
      for (int k = 0; k < 4; ++k) {
        float best = -INFINITY; int bi = 0;
        for (int e = 0; e < 32; ++e) { const float v = lg[e * 32 + tid]; if (!((used >> e) & 1u) && v > best) { best = v; bi = e; } }
        used |= 1u << bi; lv[k] = best; li[k] = bi;
      }
      float sm = 0.f;
#pragma unroll
      for (int k = 0; k < 4; ++k) { gt[k] = expf(lv[k] - lv[0]); sm += gt[k]; }
      const float inv = 1.f / sm;
#pragma unroll
      for (int k = 0; k < 4; ++k) { gt[k] *= inv; rk[k] = __hip_atomic_fetch_add(&lcnt[li[k]], 1, __ATOMIC_RELAXED, __HIP_MEMORY_SCOPE_WORKGROUP); }
    }
    __syncthreads();
    if (tid < 32) { const int c = lcnt[tid]; lcnt[32 + tid] = c ? atomicAdd(&cnt[tid], c) : 0; }
    __syncthreads();
    if (tid < 32) {
      const int m = m0 + tid;
#pragma unroll
      for (int k = 0; k < 4; ++k) {
        const int ps = lcnt[32 + li[k]] + rk[k];
        list[li[k] * M_TOK + ps] = m;
        toke[m * 4 + k] = (li[k] << 16) | ps;
        tokg[m * 4 + k] = gt[k];
      }
    }
    __syncthreads();
  }
}

__device__ __forceinline__ void moe_prefix(const int* cnt, LAS int* s_start, LAS int* s_tstart, LAS int* s_cnt) {
  if (get_tid() < 64) {
    const int lane = get_tid();
    const int c = (lane < 32) ? cnt[lane] : 0;
    const int tl = (c + 255) >> 8;
    int ic = c, it = tl;
#pragma unroll
    for (int o = 1; o < 32; o <<= 1) { const int a = __shfl_up(ic, o), b = __shfl_up(it, o); if (lane >= o) { ic += a; it += b; } }
    if (lane < 32) { s_cnt[lane] = c; s_start[lane] = ic - c; s_tstart[lane] = it - tl; }
    if (lane == 31) { s_start[32] = ic; s_tstart[32] = it; }
  }
  __syncthreads();
}

struct MoeSched {
  unsigned estride; int NT, total_mt, grid, bid; const LAS int* s_start; const LAS int* s_tstart; const LAS int* s_cnt;
  __device__ __forceinline__ bool next(int i, pg8::Unit& u) const {
    int mtg, nt; bool ok;
    if (grid == 256) { const int MG = 32 / NT; const int xcd = bid & 7, j = bid >> 3; mtg = MG * (xcd + 8 * i) + j / NT; nt = j % NT; ok = (MG * (8 * i) < total_mt); }
    else { const int item = bid + i * grid; ok = (item < total_mt * NT); mtg = item / NT; nt = item % NT; }
    const bool live = ok && (mtg < total_mt);
    const int mq = live ? mtg : 0;
    int e = 0;
    while (__builtin_amdgcn_readfirstlane(s_tstart[e + 1]) <= mq) ++e;
    const int mt = mq - __builtin_amdgcn_readfirstlane(s_tstart[e]);
    const int mv = live ? min(256, __builtin_amdgcn_readfirstlane(s_cnt[e]) - mt * 256) : 0;
    const int sl = __builtin_amdgcn_readfirstlane(s_start[e]) + mt * 256;
    const unsigned bo = (unsigned)e * estride + (unsigned)nt * (256u * 1024u);
    u.boff = bo; u.arow0 = i; u.mvalid = mv; u.e = e; u.mt = mt; u.nt = nt; u.slot0 = sl;
    return ok;
  }
};
struct MoeUpEpi {
  unsigned char* act; const LAS float* btab;
  __device__ __forceinline__ void operator()(const pg8::f32x4v (&acc)[2][2][4][2], const pg8::Unit& u, int wr, int wc, int fr, int fq) const {
    constexpr float US = 1.f / (S8_H * S8_WGU);
    constexpr float KEXP = -1.702f * LOG2E;
    const LAS float* bt = btab + u.arow0 * 256 + 16 * wc + 4 * fq;
    f32x4 bg[2], bl[2];
#pragma unroll
    for (int bj = 0; bj < 2; ++bj) { bg[bj] = *(const LAS f32x4*)(bt + 64 * bj); bl[bj] = *(const LAS f32x4*)(bt + 128 + 64 * bj); }
#pragma unroll
    for (int ai = 0; ai < 2; ++ai)
#pragma unroll
      for (int m = 0; m < 4; ++m) {
        const int rl = 128 * ai + 64 * wr + 16 * m + fr;
        if (rl < u.mvalid) {
          unsigned char* orow = act + (size_t)(u.slot0 + rl) * DFF + 16 * (8 * u.nt + wc) + 4 * fq;
#pragma unroll
          for (int bj = 0; bj < 2; ++bj) {
            float o[4];
#pragma unroll
            for (int i = 0; i < 4; ++i) {
              const float gl = fminf(fmaf(acc[ai][bj][m][0][i], US, bg[bj][i]), 7.f);
              const float ln = fminf(fmaxf(fmaf(acc[ai][bj][m][1][i], US, bl[bj][i]), -7.f), 7.f);
              const float sg = __builtin_amdgcn_rcpf(1.f + __builtin_amdgcn_exp2f(KEXP * gl));
              o[i] = fminf(gl * sg * fmaf(ln, S8_ACT, S8_ACT), 448.f);
            }
            *(unsigned*)(orow + 64 * bj) = pk4_fp8(o[0], o[1], o[2], o[3]);
          }
        }
      }
  }
};
struct MoeDownEpi {
  bf16_t* yb; const LAS float* btab;
  __device__ __forceinline__ void operator()(const pg8::f32x4v (&acc)[2][2][4][2], const pg8::Unit& u, int wr, int wc, int fr, int fq) const {
    constexpr float us = 1.f / (S8_ACT * S8_WDN);
    const LAS float* bt = btab + u.e * 256 + 32 * wc + 4 * fq;
    f32x4 b4[2][2];
#pragma unroll
    for (int bj = 0; bj < 2; ++bj)
#pragma unroll
      for (int n = 0; n < 2; ++n) b4[bj][n] = *(const LAS f32x4*)(bt + 128 * bj + 16 * n);
#pragma unroll
    for (int ai = 0; ai < 2; ++ai)
#pragma unroll
      for (int m = 0; m < 4; ++m) {
        const int rl = 128 * ai + 64 * wr + 16 * m + fr;
        if (rl < u.mvalid) {
          bf16_t* orow = yb + (size_t)(u.slot0 + rl) * DM + u.nt * 256 + 32 * wc + 4 * fq;
#pragma unroll
          for (int bj = 0; bj < 2; ++bj)
#pragma unroll
            for (int n = 0; n < 2; ++n) {
              const pg8::f32x4v v = acc[ai][bj][m][n];
              u32x2 ov; ov.x = cvtpk(fmaf(v[0], us, b4[bj][n].x), fmaf(v[1], us, b4[bj][n].y)); ov.y = cvtpk(fmaf(v[2], us, b4[bj][n].z), fmaf(v[3], us, b4[bj][n].w));
              *(u32x2*)(orow + 128 * bj + 16 * n) = ov;
            }
        }
      }
  }
};
__device__ __forceinline__ void phase_moe_up(const Params& p, int layer, LAS unsigned char* lds) {
  unsigned char* ws = p.ws;
  const int* cnt = (const int*)(ws + OFF_CTRL) + CW_CNT + layer * 32;
  const int* list = (const int*)(ws + OFF_LIST);
  LAS int* s_start = (LAS int*)(lds + LDS_GEMM); LAS int* s_tstart = s_start + 40; LAS int* s_cnt = s_start + 80;
  moe_prefix(cnt, s_start, s_tstart, s_cnt);
  MoeSched S{2048u * 1024u, 8, __builtin_amdgcn_readfirstlane(s_tstart[32]), get_nblk(), get_bid(), s_start, s_tstart, s_cnt};
  {
    const int tid = get_tid();
    LAS int* rowtab = (LAS int*)(lds + LDS_ROWTAB);
    LAS float* btab = (LAS float*)(lds + LDS_BIASTAB);
    const float* bgu = p.b_gate_up + (size_t)layer * NE * 2048;
    pg8::Unit u;
    for (int i = 0; i < 12 && S.next(i, u); ++i) {
      if (tid < 256) {
        int v = 0;
        if (u.mvalid > 0) v = list[u.e * M_TOK + u.mt * 256 + min(tid, u.mvalid - 1)];
        rowtab[i * 256 + tid] = v;
      } else {
        const int c = tid - 256;
        btab[i * 256 + c] = bgu[(size_t)u.e * 2048 + (c >> 7) * 1024 + u.nt * 128 + (c & 127)];
      }
    }
    __syncthreads();
  }
  MoeUpEpi E{(unsigned char*)(ws + OFF_ACT), (const LAS float*)(lds + LDS_BIASTAB)};
  pg8::gemm_phase<true, true>(lds, (const bf16_t*)(ws + OFF_H8), (const bf16_t*)(ws + OFF_WGU + (size_t)layer * NE * 2048 * 1024), S, E);
}
struct MoeDownSched {
  MoeSched base;
  __device__ __forceinline__ bool next(int i, pg8::Unit& u) const { const bool ok = base.next(i, u); if (ok) { u.arow0 = u.slot0; u.e = i; } return ok; }
};
__device__ __forceinline__ void phase_moe_down(const Params& p, int layer, LAS unsigned char* lds) {
  unsigned char* ws = p.ws;
  const int* cnt = (const int*)(ws + OFF_CTRL) + CW_CNT + layer * 32;
  LAS int* s_start = (LAS int*)(lds + LDS_GEMM); LAS int* s_tstart = s_start + 40; LAS int* s_cnt = s_start + 80;
  moe_prefix(cnt, s_start, s_tstart, s_cnt);
  MoeDownSched S{MoeSched{1024u * 1024u, 4, __builtin_amdgcn_readfirstlane(s_tstart[32]), get_nblk(), get_bid(), s_start, s_tstart, s_cnt}};
  {
    const int tid = get_tid();
    LAS float* btab = (LAS float*)(lds + LDS_BIASTAB);
    const float* bd = p.b_down + (size_t)layer * NE * 1024;
    pg8::Unit u;
    for (int i = 0; i < 12 && S.base.next(i, u); ++i)
      if (tid < 256) btab[i * 256 + tid] = bd[(size_t)u.e * 1024 + u.nt * 256 + tid];
    __syncthreads();
  }
  MoeDownEpi E{(bf16_t*)(ws + OFF_Y), (const LAS float*)(lds + LDS_BIASTAB)};
  pg8::gemm_phase<false, true>(lds, (const bf16_t*)(ws + OFF_ACT), (const bf16_t*)(ws + OFF_WD + (size_t)layer * NE * 1024 * 1024), S, E);
}

__device__ __forceinline__ void phase_combine_ln2(const Params& p, int layer, LAS unsigned char* lds) {
  unsigned char* ws = p.ws;
  const bf16_t* yb = (const bf16_t*)(ws + OFF_Y);
  float* hF = (float*)(ws + OFF_HF); bf16_t* hB = (bf16_t*)(ws + OFF_HB);
  const int* cnt = (const int*)(ws + OFF_CTRL) + CW_CNT + layer * 32;
  const int* toke = (const int*)(ws + OFF_TOKE); const float* tokg = (const float*)(ws + OFF_TOKG);
  LAS int* s_start = (LAS int*)(lds + LDS_GEMM); LAS int* s_tstart = s_start + 40; LAS int* s_cnt = s_start + 80;
  moe_prefix(cnt, s_start, s_tstart, s_cnt);
  const float* g2 = p.ln2_g + layer * DM; const float* b2 = p.ln2_b + layer * DM;
  const bool last = (layer == DEPTH - 1);
  const int lane = get_tid() & 63, gw = get_bid() * 8 + (get_tid() >> 6), ngw = get_nblk() * 8;
  for (int m = gw; m < M_TOK; m += ngw) {
    f32x4 v[4];
#pragma unroll
    for (int j = 0; j < 4; ++j) { const u32x2 hb = *(const u32x2*)(hB + (size_t)m * DM + 4 * lane + 256 * j); v[j] = (f32x4){bflo(hb.x), bfhi(hb.x), bflo(hb.y), bfhi(hb.y)} * DN_ALPHA; }
#pragma unroll
    for (int k = 0; k < 4; ++k) {
      const int ep = toke[m * 4 + k]; const float gt = tokg[m * 4 + k];
      const int slot = s_start[ep >> 16] + (ep & 0xffff);
      const bf16_t* yr = yb + (size_t)slot * DM;
#pragma unroll
      for (int j = 0; j < 4; ++j) {
        const u32x2 a = *(const u32x2*)(yr + 4 * lane + 256 * j);
        v[j].x += gt * bflo(a.x); v[j].y += gt * bfhi(a.x); v[j].z += gt * bflo(a.y); v[j].w += gt * bfhi(a.y);
      }
    }
    ln_row(v, g2, b2, lane);
    if (last) store_row_f32_bf16(v, p.out + (size_t)m * DM, nullptr, lane);
    else store_row_f32_bf16(v, nullptr, hB + (size_t)m * DM, lane);
  }
}

#if defined(__HIP_DEVICE_COMPILE__)
#define PH(call) do { const __attribute__((address_space(4))) Params* q_ = pp; asm volatile("" : "+s"(q_)); Params p; __builtin_memcpy(&p, q_, sizeof(Params)); call; } while (0)
#else
#define PH(call) do { const Params& p = p_unused; (void)pp; call; } while (0)
#endif
__global__ void __launch_bounds__(512) fwd_kernel(Params p_unused) {
  cg::grid_group grid = cg::this_grid();
  extern __shared__ __attribute__((aligned(16))) unsigned char smem[];
  LAS unsigned char* lds = (LAS unsigned char*)smem;
  const __attribute__((address_space(4))) Params* pp = (const __attribute__((address_space(4))) Params*)__builtin_amdgcn_kernarg_segment_ptr();
  if (threadIdx.x < 4) ((volatile LAS unsigned*)(lds + LDS_MISC))[threadIdx.x] = 0u;
  __syncthreads();
#define GRID_BAR() do { XcdBarrier b_; PH(b_.bar = (unsigned*)(p.ws + OFF_CTRL) + CW_BAR); b_.x = xb_xcc_id(); b_.st = (volatile LAS unsigned*)(lds + LDS_MISC); xcd_barrier(b_); } while (0)
  { unsigned* bw; PH(bw = (unsigned*)(p.ws + OFF_CTRL) + CW_BAR); (void)xcd_barrier_post(bw, (volatile LAS unsigned*)(lds + LDS_MISC)); }
  PH(phase_convert(p));
  PH(phase_prologue_misc(p));
  grid.sync();
#pragma unroll 1
  for (int layer = 0; layer < DEPTH; ++layer) {
    PH(phase_inproj(p, layer, lds));
    GRID_BAR();
    PH(phase_mla_up(p, layer, lds));
    GRID_BAR();
    PH(phase_attention(p, layer, lds));
    GRID_BAR();
    PH(phase_outproj(p, layer, lds));
    GRID_BAR();
    PH(phase_ln1_router(p, layer, lds));
    GRID_BAR();
    PH(phase_moe_up(p, layer, lds));
    GRID_BAR();
    PH(phase_moe_down(p, layer, lds));
    GRID_BAR();
    PH(phase_combine_ln2(p, layer, lds));
    if (layer + 1 < DEPTH) GRID_BAR();
  }
}

extern "C" void kernel_launch(void* const* d_in, const int* in_sizes, int n_in, void* d_out, int out_size,
                              void* d_ws, size_t ws_size, hipStream_t stream) {
  static int grid_blocks = 0;
  if (!grid_blocks) {
    int dev = 0, cus = 0, per_cu = 0;
    (void)hipGetDevice(&dev);
    (void)hipDeviceGetAttribute(&cus, hipDeviceAttributeMultiprocessorCount, dev);
    (void)hipFuncSetAttribute((const void*)fwd_kernel, hipFuncAttributeMaxDynamicSharedMemorySize, LDS_BYTES);
    (void)hipOccupancyMaxActiveBlocksPerMultiprocessor(&per_cu, fwd_kernel, 512, LDS_BYTES);
    if (per_cu < 1) { fprintf(stderr, "kernel_launch: occupancy query returned %d\n", per_cu); per_cu = 1; }
    if (per_cu > 1) per_cu = 1;
    grid_blocks = cus * per_cu;
    if (n_in != 23 || ws_size < WS_END) { fprintf(stderr, "kernel_launch: unexpected n_in %d or ws_size %zu (< %zu)\n", n_in, ws_size, (size_t)WS_END); }
  }
  if (ws_size < WS_END) return;
  (void)hipMemsetAsync((char*)d_ws + OFF_CTRL, 0, CTRL_BYTES, stream);
  Params p{};
  p.x = (const float*)d_in[0]; p.pos = (const int*)d_in[1]; p.ln_in_g = (const float*)d_in[2]; p.ln_in_b = (const float*)d_in[3];
  p.w_in = (const float*)d_in[4]; p.b_forget = (const float*)d_in[5]; p.diff_lambda = (const float*)d_in[6]; p.diff_subln_g = (const float*)d_in[7];
  p.mla_q_norm_g = (const float*)d_in[8]; p.mla_w_uq = (const float*)d_in[9]; p.mla_kv_norm_g = (const float*)d_in[10]; p.mla_w_ukv = (const float*)d_in[11];
  p.w_out = (const float*)d_in[12]; p.ln1_g = (const float*)d_in[13]; p.ln1_b = (const float*)d_in[14]; p.router_w = (const float*)d_in[15];
  p.router_b = (const float*)d_in[16]; p.w_gate_up = (const float*)d_in[17]; p.b_gate_up = (const float*)d_in[18]; p.w_down = (const float*)d_in[19];
  p.b_down = (const float*)d_in[20]; p.ln2_g = (const float*)d_in[21]; p.ln2_b = (const float*)d_in[22];
  p.out = (float*)d_out; p.ws = (unsigned char*)d_ws;
  void* args[] = {&p};
  hipError_t e = hipLaunchCooperativeKernel((void*)fwd_kernel, dim3(grid_blocks), dim3(512), args, LDS_BYTES, stream);
  if (e != hipSuccess) fprintf(stderr, "cooperative launch failed: %s (grid %d)\n", hipGetErrorString(e), grid_blocks);
}
```

```cpp
#include <hip/hip_runtime.h>
#include <hip/hip_cooperative_groups.h>
#include <cstdio>
#include <cstdint>
namespace cg = cooperative_groups;

#define LAS __attribute__((address_space(3)))
typedef unsigned short bf16_t;
typedef short bf16x8 __attribute__((ext_vector_type(8)));
typedef short s16x4 __attribute__((ext_vector_type(4)));
typedef float f32x16 __attribute__((ext_vector_type(16)));
typedef float f32x4 __attribute__((ext_vector_type(4)));
typedef float f32x2 __attribute__((ext_vector_type(2)));
typedef unsigned u32x4 __attribute__((ext_vector_type(4)));
typedef unsigned u32x2 __attribute__((ext_vector_type(2)));
typedef __bf16 bf16x2_t __attribute__((ext_vector_type(2)));

constexpr int M_TOK = 16384, DM = 1024, SEQ = 4096, NBATCH = 4, DEPTH = 2;
constexpr int NP = 2816;
constexpr int NE = 32, DFF = 1024, TOPK = 4;
constexpr int C_SBQ = 0, C_SBK = 256, C_SBV = 512, C_DFQ = 768, C_DFK = 1024, C_DFV = 1280, C_FXQ = 1536, C_FXK = 1792, C_FXV = 2048,
              C_CQ = 2304, C_CKV = 2560, C_KR = 2688, C_FXF = 2720, C_END = 2724;
constexpr float LOG2E = 1.4426950408889634f;
constexpr float DN_ALPHA = 1.4142135623730951f;
constexpr float LN_EPS = 1e-5f, RMS_EPS = 1e-6f;
constexpr float S8_H = 16.f, S8_WGU = 64.f, S8_ACT = 8.f, S8_WDN = 128.f;

constexpr size_t MB = 1ull << 20;
constexpr size_t OFF_CTRL = 0, CTRL_BYTES = 65536;
constexpr size_t OFF_ROPE = 1 * MB;
constexpr size_t OFF_GATEF = 3 * MB;
constexpr size_t OFF_FK = 3 * MB + 512 * 1024;
constexpr size_t OFF_LIST = 4 * MB;
constexpr size_t OFF_TOKE = 6 * MB;
constexpr size_t OFF_TOKG = 6 * MB + 512 * 1024;
constexpr size_t OFF_WUQ = 7 * MB;
constexpr size_t OFF_WUKV = 7 * MB + 512 * 1024;
constexpr size_t OFF_WOUT = 8 * MB;
constexpr size_t OFF_WIN = 12 * MB;
constexpr size_t OFF_HF = 24 * MB;
constexpr size_t OFF_HB = 88 * MB;
constexpr size_t OFF_P = 120 * MB;
constexpr size_t OFF_CQN = 208 * MB;
constexpr size_t OFF_CKVN = 216 * MB;
constexpr size_t OFF_QD = 220 * MB;
constexpr size_t OFF_KVD = 232 * MB;
constexpr size_t OFF_MIX = 248 * MB;
constexpr size_t OFF_TMPF = 280 * MB;
constexpr size_t OFF_KN = 3 * MB + 768 * 1024;
constexpr size_t OFF_H8 = 220 * MB;
constexpr size_t OFF_ACT = 344 * MB;
constexpr size_t OFF_Y = 473 * MB;
constexpr size_t OFF_WGU = 602 * MB;
constexpr size_t OFF_WD = 858 * MB;
constexpr size_t WS_END = 986 * MB;
constexpr int CW_CNT = 0;
constexpr int CW_ATTQ = 128;
constexpr int CW_LAM = 160;
constexpr int CW_CONVQ = 192;
constexpr int CW_BAR = 4096;

constexpr int LDS_ROWTAB = 131072;
constexpr int LDS_GEMM = 143360;
constexpr int LDS_MISC = LDS_GEMM + 1024;
constexpr int LDS_BIASTAB = 147456;
constexpr int LDS_BYTES = 159744;

struct Params {
  const float* x; const int* pos; const float* ln_in_g; const float* ln_in_b; const float* w_in; const float* b_forget;
  const float* diff_lambda; const float* diff_subln_g; const float* mla_q_norm_g; const float* mla_w_uq; const float* mla_kv_norm_g;
  const float* mla_w_ukv; const float* w_out; const float* ln1_g; const float* ln1_b; const float* router_w; const float* router_b;
  const float* w_gate_up; const float* b_gate_up; const float* w_down; const float* b_down; const float* ln2_g; const float* ln2_b;
  float* out; unsigned char* ws;
};

__device__ __forceinline__ unsigned cvtpk(float lo, float hi) { f32x2 v = {lo, hi}; bf16x2_t b = __builtin_convertvector(v, bf16x2_t); return __builtin_bit_cast(unsigned, b); }
__device__ __forceinline__ unsigned pk4_fp8(float a, float b, float c, float d) {
  int w = __builtin_amdgcn_cvt_pk_fp8_f32(a, b, 0, false);
  w = __builtin_amdgcn_cvt_pk_fp8_f32(c, d, w, true);
  return (unsigned)w;
}
__device__ __forceinline__ float clamp448(float x) { return fminf(fmaxf(x, -448.f), 448.f); }
__device__ __forceinline__ float bf2f(unsigned short b) { return __uint_as_float(((unsigned)b) << 16); }
__device__ __forceinline__ float bflo(unsigned w) { return __uint_as_float(w << 16); }
__device__ __forceinline__ float bfhi(unsigned w) { return __uint_as_float(w & 0xffff0000u); }
__device__ __forceinline__ float wave_sum(float v) {
#pragma unroll
  for (int o = 1; o < 64; o <<= 1) v += __shfl_xor(v, o);
  return v;
}
__device__ __forceinline__ int get_bid() { int b = blockIdx.x; asm volatile("" : "+s"(b)); return b; }
__device__ __forceinline__ int get_nblk() { int g = gridDim.x; asm volatile("" : "+s"(g)); return g; }
__device__ __forceinline__ int get_tid() { int t = threadIdx.x; asm volatile("" : "+v"(t)); return t; }
__device__ __forceinline__ int crow(int r, int hi) { return (r & 3) + 8 * (r >> 2) + 4 * hi; }
__device__ __forceinline__ void pair_vals(float v, float& v0, float& v1) {
  auto rr = __builtin_amdgcn_permlane32_swap(__float_as_uint(v), __float_as_uint(v), false, false);
  v0 = __uint_as_float(rr[0]); v1 = __uint_as_float(rr[1]);
}


#define XB_TMO      128
#define XB_XCNT(j)  (256  + 64 * (j))
#define XB_XSUB(j)  (1280 + 64 * (j))
#define XB_XGEN(j)  (2304 + 64 * (j))
#define XB_TOP      3328
#define XB_TOPGEN   3392
#define XCD_BAR_WORDS 3456
#define XB_SPIN_CAP (1u << 22)
__device__ __forceinline__ unsigned xb_ld(unsigned* p)              { return __hip_atomic_load(p, __ATOMIC_RELAXED, __HIP_MEMORY_SCOPE_AGENT); }
__device__ __forceinline__ unsigned xb_add(unsigned* p, unsigned v) { return __hip_atomic_fetch_add(p, v, __ATOMIC_RELAXED, __HIP_MEMORY_SCOPE_AGENT); }
__device__ __forceinline__ unsigned xb_xcc_id() { return (unsigned)__builtin_amdgcn_s_getreg((3 << 11) | 20) & 0xFu; }
#define XB_SPIN(cond, bar) do { unsigned _sp = 0; while (cond) { __builtin_amdgcn_s_sleep(1); \
    if ((++_sp & 255u) == 0u) { if (xb_ld(&(bar)[XB_TMO])) break; if (_sp > XB_SPIN_CAP) { atomicAdd(&(bar)[XB_TMO], 1u); break; } } } } while (0)
struct XcdBarrier { unsigned* bar; unsigned x; volatile LAS unsigned* st; };
__device__ __forceinline__ XcdBarrier xcd_barrier_post(unsigned* bar, volatile LAS unsigned* st) {
  XcdBarrier b; b.bar = bar; b.x = xb_xcc_id(); b.st = st;
  if (threadIdx.x == 0) (void)xb_add(&bar[XB_XCNT(b.x)], 1u);
  return b;
}
__device__ __forceinline__ void xcd_barrier_complete(unsigned* bar, unsigned x, unsigned& nloc, unsigned& nx) {
  const unsigned G = gridDim.x * gridDim.y * gridDim.z;
  unsigned sum, cnt, mine, sp = 0u;
  for (;;) {
    sum = 0u; cnt = 0u; mine = 0u;
#pragma unroll
    for (unsigned j = 0; j < 16; ++j) { const unsigned c = xb_ld(&bar[XB_XCNT(j)]); sum += c; cnt += (c > 0u) ? 1u : 0u; mine = (j == x) ? c : mine; }
    if (sum == G) break;
    __builtin_amdgcn_s_sleep(1);
    if ((++sp & 255u) == 0u) { if (xb_ld(&bar[XB_TMO])) break; if (sp > XB_SPIN_CAP) { atomicAdd(&bar[XB_TMO], 1u); break; } }
  }
  nloc = mine > 0u ? mine : 1u; nx = cnt > 0u ? cnt : 1u;
}
__device__ __forceinline__ void xcd_barrier(const XcdBarrier& b) {
  asm volatile("s_waitcnt vmcnt(0)" ::: "memory");
  __syncthreads();
  if (threadIdx.x == 0) {
    unsigned* bar = b.bar;
    __builtin_amdgcn_s_waitcnt(0);
    unsigned nloc = b.st[0], nx = b.st[1];
    if (nloc == 0u) { xcd_barrier_complete(bar, b.x, nloc, nx); b.st[0] = nloc; b.st[1] = nx; }
    const unsigned old = xb_add(&bar[XB_XSUB(b.x)], 1u);
    const unsigned gen = old / nloc;
    if (old + 1u == (gen + 1u) * nloc) {
      __builtin_amdgcn_fence(__ATOMIC_RELEASE, "agent");
      asm volatile("s_waitcnt vmcnt(0)" ::: "memory");
      const unsigned og = xb_add(&bar[XB_TOP], 1u);
      const unsigned tg = og / nx;
      if (og + 1u == (tg + 1u) * nx) xb_add(&bar[XB_TOPGEN], 1u);
      else XB_SPIN(xb_ld(&bar[XB_TOPGEN]) == tg, bar);
      __builtin_amdgcn_fence(__ATOMIC_ACQUIRE, "agent");
      xb_add(&bar[XB_XGEN(b.x)], 1u);
      asm volatile("s_waitcnt vmcnt(0)" ::: "memory");
    } else {
      XB_SPIN(xb_ld(&bar[XB_XGEN(b.x)]) == gen, bar);
      __builtin_amdgcn_fence(__ATOMIC_ACQUIRE, "agent");
      asm volatile("s_waitcnt vmcnt(0)" ::: "memory");
    }
  }
  __syncthreads();
}

struct ConvDesc { const float* src; bf16_t* dst; const float* kscale; int K, Ndst, srcld, mode, kb, nb; };
constexpr int CV_U_IN = 16 * 11, CV_U_OUT = 16 * 4, CV_U_UQ = 4 * 2, CV_U_UKV = 2 * 2;
constexpr int CV_SMALL = 2 * (CV_U_IN + CV_U_OUT + CV_U_UQ + CV_U_UKV);
__device__ __forceinline__ bool conv_desc(const Params& p, int u, ConvDesc& d) {
  unsigned char* ws = p.ws;
  constexpr int T_IN = 2 * CV_U_IN, T_OUT = 2 * CV_U_OUT, T_UQ = 2 * CV_U_UQ;
  const float* src; bf16_t* dst; const float* ksc = nullptr; int K, Ndst, srcld, mode, q, nbn;
  int r = u;
  if (r < T_IN) { const int inst = r / CV_U_IN; q = r % CV_U_IN; src = p.w_in + (size_t)inst * 1024 * 2724; dst = (bf16_t*)(ws + OFF_WIN) + (size_t)inst * NP * 1024; K = 1024; Ndst = NP; srcld = 2724; mode = 1; nbn = 11; }
  else if ((r -= T_IN) < T_OUT) { const int inst = r / CV_U_OUT; q = r % CV_U_OUT; src = p.w_out + (size_t)inst * 1024 * 1024; dst = (bf16_t*)(ws + OFF_WOUT) + (size_t)inst * 1024 * 1024; K = 1024; Ndst = 1024; srcld = 1024; mode = 0; nbn = 4; }
  else if ((r -= T_OUT) < T_UQ) { const int inst = r / CV_U_UQ; q = r % CV_U_UQ; src = p.mla_w_uq + (size_t)inst * 256 * 384; dst = (bf16_t*)(ws + OFF_WUQ) + (size_t)inst * 384 * 256; K = 256; Ndst = 384; srcld = 384; mode = 0; nbn = 2; ksc = p.mla_q_norm_g + inst * 256; }
  else { r -= T_UQ; const int inst = r / CV_U_UKV; q = r % CV_U_UKV; src = p.mla_w_ukv + (size_t)inst * 128 * 512; dst = (bf16_t*)(ws + OFF_WUKV) + (size_t)inst * 512 * 128; K = 128; Ndst = 512; srcld = 512; mode = 0; nbn = 2; ksc = p.mla_kv_norm_g + inst * 128; }
  d.src = src; d.dst = dst; d.kscale = ksc; d.K = K; d.Ndst = Ndst; d.srcld = srcld; d.mode = mode; d.kb = q / nbn; d.nb = q % nbn;
  return u < CV_SMALL;
}
__device__ __forceinline__ void conv_load(const ConvDesc& d, float (&v)[4][8], int lane, int w) {
  const int k0 = d.kb * 64 + 8 * w;
#pragma unroll
  for (int u = 0; u < 4; ++u) {
    const int n = d.nb * 256 + u * 64 + lane;
    int sc = n; bool ok = n < d.Ndst;
    if (d.mode == 1) { if (n < 2304) sc = n; else if (n < C_FXF) sc = n + 4; else if (n < C_END) sc = 2304 + (n - C_FXF); else ok = false; }
    const float* sp = d.src + (size_t)k0 * d.srcld + sc;
#pragma unroll
    for (int j = 0; j < 8; ++j) v[u][j] = ok ? __builtin_nontemporal_load(sp + (size_t)j * d.srcld) : 0.f;
  }
}
__device__ __forceinline__ void conv_store(const ConvDesc& d, const float (&v)[4][8], int lane, int w) {
  const int k0 = d.kb * 64 + 8 * w;
#pragma unroll
  for (int u = 0; u < 4; ++u) {
    const int n = d.nb * 256 + u * 64 + lane;
    if (n < d.Ndst) {
      int dr = n;
      if (d.mode == 2) { const int j = n & 1023; dr = (j >> 4) * 32 + (j & 15) + ((n >= 1024) ? 16 : 0); }
      float g[8];
#pragma unroll
      for (int j = 0; j < 8; ++j) g[j] = d.kscale ? d.kscale[k0 + j] : 1.f;
      u32x4 o; o.x = cvtpk(v[u][0] * g[0], v[u][1] * g[1]); o.y = cvtpk(v[u][2] * g[2], v[u][3] * g[3]); o.z = cvtpk(v[u][4] * g[4], v[u][5] * g[5]); o.w = cvtpk(v[u][6] * g[6], v[u][7] * g[7]);
      *(u32x4*)(d.dst + (size_t)dr * d.K + k0) = o;
    }
  }
}
__device__ __forceinline__ void phase_convert(const Params& p) {
  const int tid = get_tid(), lane = tid & 63, w = tid >> 6;
  const int G = get_nblk();
  for (int u = get_bid(); u < CV_SMALL; u += G) {
    ConvDesc d; float va[4][8];
    conv_desc(p, u, d);
    conv_load(d, va, lane, w);
    conv_store(d, va, lane, w);
  }
}

__device__ __forceinline__ void ln_row(f32x4 (&v)[4], const float* g, const float* b, int lane) {
  float s = 0.f;
#pragma unroll
  for (int j = 0; j < 4; ++j) s += (v[j].x + v[j].y) + (v[j].z + v[j].w);
  const float mean = wave_sum(s) * (1.f / DM);
  float s2 = 0.f;
#pragma unroll
  for (int j = 0; j < 4; ++j) { v[j] = v[j] - mean; s2 += (v[j].x * v[j].x + v[j].y * v[j].y) + (v[j].z * v[j].z + v[j].w * v[j].w); }
  const float rstd = rsqrtf(wave_sum(s2) * (1.f / DM) + LN_EPS);
#pragma unroll
  for (int j = 0; j < 4; ++j) {
    const f32x4 gg = *(const f32x4*)(g + 4 * lane + 256 * j), bb = *(const f32x4*)(b + 4 * lane + 256 * j);
    v[j] = v[j] * rstd * gg + bb;
  }
}
__device__ __forceinline__ void store_row_f32_bf16(const f32x4 (&v)[4], float* of, bf16_t* ob, int lane) {
#pragma unroll
  for (int j = 0; j < 4; ++j) {
    if (of) *(f32x4*)(of + 4 * lane + 256 * j) = v[j];
    if (ob) { u32x2 w; w.x = cvtpk(v[j].x, v[j].y); w.y = cvtpk(v[j].z, v[j].w); *(u32x2*)(ob + 4 * lane + 256 * j) = w; }
  }
}

__device__ __forceinline__ void phase_prologue_misc(const Params& p) {
  unsigned char* ws = p.ws;
  const int lane = get_tid() & 63, gw = get_bid() * 8 + (get_tid() >> 6), ngw = get_nblk() * 8;
  float* hF = (float*)(ws + OFF_HF); bf16_t* hB = (bf16_t*)(ws + OFF_HB);
#pragma unroll 1
  for (int m = gw; m < M_TOK; m += 4 * ngw) {
    f32x4 v[4][4]; int mm[4];
#pragma unroll
    for (int q = 0; q < 4; ++q) {
      mm[q] = (m + q * ngw < M_TOK) ? m + q * ngw : m;
#pragma unroll
      for (int j = 0; j < 4; ++j) v[q][j] = __builtin_nontemporal_load((const f32x4*)(p.x + (size_t)mm[q] * DM + 4 * lane + 256 * j));
    }
#pragma unroll
    for (int q = 0; q < 4; ++q) {
      ln_row(v[q], p.ln_in_g, p.ln_in_b, lane);
      if (q == 0 || m + q * ngw < M_TOK) store_row_f32_bf16(v[q], nullptr, hB + (size_t)mm[q] * DM, lane);
    }
  }
  f32x2* cs = (f32x2*)(ws + OFF_ROPE);
  const int gt = get_bid() * 512 + get_tid(), ngt = get_nblk() * 512;
  for (int i = gt; i < M_TOK * 16; i += ngt) {
    const int m = i >> 4, f = i & 15;
    const double invf = exp2(-(double)f * (13.287712379549449 / 16.0));
    double a = (double)p.pos[m] * invf;
    a = a - 6.283185307179586476925 * rint(a * 0.15915494309189533577);
    float sn, cn; __sincosf((float)a, &sn, &cn);
    cs[i] = (f32x2){cn, sn};
  }
  if (get_bid() == 0 && get_tid() < DEPTH) {
    const int l = get_tid(); const float* lp = p.diff_lambda + l * 128;
    float s1 = 0.f, s2 = 0.f;
    for (int i = 0; i < 32; ++i) { s1 += lp[i] * lp[32 + i]; s2 += lp[64 + i] * lp[96 + i]; }
    const float linit = 0.8f - 0.6f * expf(-0.3f * (float)l);
    ((float*)(ws + OFF_CTRL))[CW_LAM + l] = expf(s1) - expf(s2) + linit;
  }
}

struct GemmDesc { const bf16_t* A; int lda; const int* rowidx; int row0; int mvalid; const bf16_t* Bt; int ldb; int K; };

template <int NI>
__device__ __forceinline__ void gemm_tile(LAS unsigned char* lds, const GemmDesc& g, f32x16 (&acc)[2][NI]) {
  constexpr int BN = 64 * NI;
  constexpr int A_BYTES = 256 * 128, B_BYTES = BN * 128, STAGE = A_BYTES + B_BYTES;
  constexpr int NBL = BN / 64;
  const int tid = get_tid(), lane = tid & 63, w = tid >> 6, wm = w >> 1, wn = w & 1, c31 = lane & 31, hi = lane >> 5;
  const int lr = tid >> 3, lc = (tid & 7) ^ ((tid >> 4) & 7);
  const bf16_t* ap[4];
#pragma unroll
  for (int i = 0; i < 4; ++i) {
    const int r = lr + 64 * i;
    int row;
    if (g.rowidx) row = g.rowidx[g.row0 + (r < g.mvalid ? r : 0)]; else row = g.row0 + r;
    ap[i] = g.A + (size_t)row * g.lda + lc * 8;
  }
  const bf16_t* bp = g.Bt + (size_t)lr * g.ldb + lc * 8;
  const int wbase = w * 1024;
  const int xr = (lane >> 1) & 7;
  int roff[4];
#pragma unroll
  for (int ks = 0; ks < 4; ++ks) roff[ks] = ((2 * ks + hi) ^ xr) << 4;
  const int a_base = (wm * 64 + c31) * 128, b_base = A_BYTES + (wn * 32 * NI + c31) * 128;
#pragma unroll
  for (int mi = 0; mi < 2; ++mi)
#pragma unroll
    for (int ni = 0; ni < NI; ++ni)
#pragma unroll
      for (int r = 0; r < 16; ++r) acc[mi][ni][r] = 0.f;
  const int nk = g.K >> 6;
#define GT_STAGE(stg, ko) do { LAS unsigned char* s_ = lds + (stg) * STAGE + wbase; \
    _Pragma("unroll") for (int i = 0; i < 4; ++i) __builtin_amdgcn_global_load_lds((const unsigned*)(ap[i] + (ko)), (LAS unsigned*)(s_ + 8192 * i), 16, 0, 0); \
    _Pragma("unroll") for (int i = 0; i < NBL; ++i) __builtin_amdgcn_global_load_lds((const unsigned*)(bp + (size_t)(64 * i) * g.ldb + (ko)), (LAS unsigned*)(s_ + A_BYTES + 8192 * i), 16, 0, 0); } while (0)
  GT_STAGE(0, 0);
  __syncthreads();
  bf16x8 af[2][2], bfr[2][NI];
  for (int kt = 0; kt < nk; ++kt) {
    LAS unsigned char* cur = lds + (kt & 1) * STAGE;
    if (kt + 1 < nk) GT_STAGE((kt + 1) & 1, (kt + 1) * 64);
#pragma unroll
    for (int mi = 0; mi < 2; ++mi) af[0][mi] = *(const LAS bf16x8*)(cur + a_base + mi * 4096 + roff[0]);
#pragma unroll
    for (int ni = 0; ni < NI; ++ni) bfr[0][ni] = *(const LAS bf16x8*)(cur + b_base + ni * 4096 + roff[0]);
#pragma unroll
    for (int ks = 0; ks < 4; ++ks) {
      if (ks < 3) {
#pragma unroll
        for (int mi = 0; mi < 2; ++mi) af[(ks + 1) & 1][mi] = *(const LAS bf16x8*)(cur + a_base + mi * 4096 + roff[ks + 1]);
#pragma unroll
        for (int ni = 0; ni < NI; ++ni) bfr[(ks + 1) & 1][ni] = *(const LAS bf16x8*)(cur + b_base + ni * 4096 + roff[ks + 1]);
      }
      __builtin_amdgcn_s_setprio(1);
#pragma unroll
      for (int mi = 0; mi < 2; ++mi)
#pragma unroll
        for (int ni = 0; ni < NI; ++ni) acc[mi][ni] = __builtin_amdgcn_mfma_f32_32x32x16_bf16(bfr[ks & 1][ni], af[ks & 1][mi], acc[mi][ni], 0, 0, 0);
      __builtin_amdgcn_s_setprio(0);
    }
    __syncthreads();
  }
#undef GT_STAGE
}


namespace pg8 {
typedef float f32x4v __attribute__((ext_vector_type(4)));
constexpr int BM = 256, BK = 64, HALF = 128, HTB = HALF * BK * 2, STAGE_BYTES = 8 * HTB, KK = 1024;
typedef int v8i_t __attribute__((ext_vector_type(8)));
typedef int v4i_t __attribute__((ext_vector_type(4)));
__device__ __forceinline__ v8i_t cat8(bf16x8 a, bf16x8 b) { const v4i_t x = __builtin_bit_cast(v4i_t, a), y = __builtin_bit_cast(v4i_t, b); return __builtin_shufflevector(x, y, 0, 1, 2, 3, 4, 5, 6, 7); }
__device__ __forceinline__ int lds_byte(int r, int c) { const int st = (r >> 4) * 2 + (c >> 5), rr = r & 15, cc = c & 31, ob = rr * 64 + cc * 2; return st * 1024 + (ob ^ (((ob >> 9) & 1) << 5)); }
__device__ __forceinline__ void stage_rc(int b, int& R, int& C) { const int st = b / 1024, sb = b % 1024, swz = sb ^ (((sb >> 9) & 1) << 5); R = (st >> 1) * 16 + swz / 64; C = (st & 1) * 32 + (swz % 64) / 2; }
struct Unit { unsigned boff; int arow0; int mvalid; int e, mt, nt, slot0; };
template <bool GATHER, bool FP8, class Sched, class Epi>
__device__ __forceinline__ void gemm_phase(LAS unsigned char* lds, const bf16_t* Abuf, const bf16_t* Bbuf, const Sched& S, const Epi& E) {
  const int tid = get_tid(), wid = __builtin_amdgcn_readfirstlane(tid >> 6), lane = tid & 63, wr = wid >> 2, wc = wid & 3, fr = lane & 15, fq = lane >> 4;
  const __amdgpu_buffer_rsrc_t rsA = __builtin_amdgcn_make_buffer_rsrc((void*)Abuf, (short)0, 0x7ffffff0, 0x00020000);
  const __amdgpu_buffer_rsrc_t rsB = __builtin_amdgcn_make_buffer_rsrc((void*)Bbuf, (short)0, 0x7ffffff0, 0x00020000);
  constexpr int RS = FP8 ? KK : 2 * KK;
  constexpr int NT_K = FP8 ? 8 : 16;
  const int lrow = (wid >> 1) * 16 + (lane >> 2);
  const int cbyte = (wid & 1) * 64 + (((lane & 3) * 16) ^ (((lane >> 5) & 1) << 5));
  const unsigned vB = (unsigned)(lrow * RS + cbyte);
  const LAS int* rowtab = (const LAS int*)(lds + LDS_ROWTAB) + lrow;
#define PG8_ROWS(V, u) do { if (GATHER) { _Pragma("unroll") for (int h_ = 0; h_ < 2; ++h_) _Pragma("unroll") for (int i_ = 0; i_ < 2; ++i_) \
      V[h_][i_] = (unsigned)(rowtab[(u).arow0 * 256 + h_ * HALF + i_ * 64] * RS + cbyte); } } while (0)
#define PG8_ABASE(u) (GATHER ? 0u : (unsigned)(u).arow0 * (unsigned)RS)
  constexpr unsigned kstep = BK * 2;
  const unsigned ldsw = (unsigned)wid * 1024u;
  const int aoff = lds_byte(wr * 64 + fr, fq * 8), boff = lds_byte(wc * 32 + fr, fq * 8);
#define PG8_SA(b, h) (((b) * 2 + (h)) * HTB)
#define PG8_SB(b, h) ((4 + (b) * 2 + (h)) * HTB)
#define PG8_LOAD1(rs, ldsoff, voff, soff) __builtin_amdgcn_raw_ptr_buffer_load_lds(rs, (LAS void*)(lds + (ldsoff) + ldsw), 16, (int)(voff), (int)(soff), 0, 0)
#define PG8_STAGE_B(bufoff, soff, h) do { PG8_LOAD1(rsB, (bufoff), vB, (soff) + (unsigned)((h) * HALF * RS)); PG8_LOAD1(rsB, (bufoff) + 8192, vB, (soff) + (unsigned)(((h) * HALF + 64) * RS)); } while (0)
#define PG8_STAGE_A(bufoff, soff, h, v0, v1) do { if (GATHER) { PG8_LOAD1(rsA, (bufoff), (v0), (soff)); PG8_LOAD1(rsA, (bufoff) + 8192, (v1), (soff)); } \
    else { PG8_LOAD1(rsA, (bufoff), vB, (soff) + (unsigned)((h) * HALF * RS)); PG8_LOAD1(rsA, (bufoff) + 8192, vB, (soff) + (unsigned)(((h) * HALF + 64) * RS)); } } while (0)
#define PG8_LDA(dst, b, h) do { if (FP8) { _Pragma("unroll") for (int m = 0; m < 4; ++m) { \
      const v4i_t lo_ = *(const LAS v4i_t*)(lds + PG8_SA(b, h) + aoff + m * 2048), hi_ = *(const LAS v4i_t*)(lds + PG8_SA(b, h) + aoff + m * 2048 + 1024); \
      dst##8[m] = __builtin_shufflevector(lo_, hi_, 0, 1, 2, 3, 4, 5, 6, 7); } } \
    else { _Pragma("unroll") for (int m = 0; m < 4; ++m) _Pragma("unroll") for (int k = 0; k < 2; ++k) dst[m][k] = *(const LAS bf16x8*)(lds + PG8_SA(b, h) + aoff + m * 2048 + k * 1024); } } while (0)
#define PG8_LDB(dst, b, h) do { if (FP8) { _Pragma("unroll") for (int n = 0; n < 2; ++n) { \
      const v4i_t lo_ = *(const LAS v4i_t*)(lds + PG8_SB(b, h) + boff + n * 2048), hi_ = *(const LAS v4i_t*)(lds + PG8_SB(b, h) + boff + n * 2048 + 1024); \
      dst##8[n] = __builtin_shufflevector(lo_, hi_, 0, 1, 2, 3, 4, 5, 6, 7); } } \
    else { _Pragma("unroll") for (int n = 0; n < 2; ++n) _Pragma("unroll") for (int k = 0; k < 2; ++k) dst[n][k] = *(const LAS bf16x8*)(lds + PG8_SB(b, h) + boff + n * 2048 + k * 1024); } } while (0)
#define PG8_MMA(ai, bj, At, Bt) do { __builtin_amdgcn_s_setprio(1); _Pragma("unroll") for (int m = 0; m < 4; ++m) _Pragma("unroll") for (int n = 0; n < 2; ++n) { \
    if (FP8) asm volatile("v_mfma_scale_f32_16x16x128_f8f6f4 %0, %1, %2, %0, %3, %3 op_sel_hi:[0,0,0]" : "+v"(acc[ai][bj][m][n]) : "v"(Bt##8[n]), "v"(At##8[m]), "v"(sc1));   \
    else { _Pragma("unroll") for (int k = 0; k < 2; ++k) acc[ai][bj][m][n] = __builtin_amdgcn_mfma_f32_16x16x32_bf16(Bt[n][k], At[m][k], acc[ai][bj][m][n], 0, 0, 0); } } \
    __builtin_amdgcn_s_setprio(0); } while (0)
#define PG8_WAIT_V(n) asm volatile("s_waitcnt vmcnt(" #n ")" ::: "memory")
#define PG8_WAIT_L(n) asm volatile("s_waitcnt lgkmcnt(" #n ")" ::: "memory")
#define PG8_BAR __builtin_amdgcn_s_barrier()
#define PG8_SCHED __builtin_amdgcn_sched_barrier(0)
  Unit cur, nxt; int ui = 0;
  if (!S.next(0, cur)) return;
  f32x4v acc[2][2][4][2];
#pragma unroll
  for (int a = 0; a < 2; ++a)
#pragma unroll
    for (int b = 0; b < 2; ++b)
#pragma unroll
      for (int m = 0; m < 4; ++m)
#pragma unroll
        for (int n = 0; n < 2; ++n) acc[a][b][m][n] = (f32x4v){0.f, 0.f, 0.f, 0.f};
  unsigned sc1 = 0x7f7f7f7fu; asm volatile("" : "+v"(sc1));
  bf16x8 At[4][2], B0[2][2], B1[2][2];
  v8i_t At8[4], B08[2], B18[2];
  unsigned cV[2][2];
#pragma unroll
  for (int h = 0; h < 2; ++h)
#pragma unroll
    for (int i = 0; i < 2; ++i) cV[h][i] = 0u;
  PG8_ROWS(cV, cur);
  unsigned cA = PG8_ABASE(cur), cB = cur.boff;
  PG8_STAGE_B(PG8_SB(0, 0), cB, 0); PG8_STAGE_B(PG8_SB(0, 1), cB, 1);
  PG8_STAGE_A(PG8_SA(0, 0), cA, 0, cV[0][0], cV[0][1]); PG8_STAGE_A(PG8_SA(0, 1), cA, 1, cV[1][0], cV[1][1]);
  if (wr == 1) PG8_BAR;
  PG8_WAIT_V(2); PG8_BAR;
  PG8_STAGE_B(PG8_SB(1, 0), cB + kstep, 0); PG8_STAGE_A(PG8_SA(1, 0), cA + kstep, 0, cV[0][0], cV[0][1]); PG8_STAGE_B(PG8_SB(1, 1), cB + kstep, 1);
  PG8_WAIT_V(6); PG8_BAR;
  for (;;) {
    const bool has_next = S.next(ui + 1, nxt);
    const unsigned nB = has_next ? nxt.boff : cB;
    const unsigned nA = has_next ? PG8_ABASE(nxt) : cA;
#pragma unroll 1
    for (int t = 0; t < NT_K; t += 2) {
      const bool last = (t == NT_K - 2);
      const unsigned a1 = cA + (unsigned)(t + 1) * kstep;
      const unsigned a2 = last ? nA : cA + (unsigned)(t + 2) * kstep, b2 = last ? nB : cB + (unsigned)(t + 2) * kstep;
      const unsigned a3 = a2 + kstep, b3 = b2 + kstep;
      unsigned w00 = cV[0][0], w01 = cV[0][1], w10 = cV[1][0], w11 = cV[1][1];
      if (GATHER && last && has_next) { unsigned nV[2][2]; PG8_ROWS(nV, nxt); w00 = nV[0][0]; w01 = nV[0][1]; w10 = nV[1][0]; w11 = nV[1][1]; }
      PG8_LDB(B0, 0, 0); PG8_LDB(B1, 0, 1); PG8_SCHED; PG8_LDA(At, 0, 0); PG8_STAGE_A(PG8_SA(1, 1), a1, 1, cV[1][0], cV[1][1]);
      PG8_WAIT_V(8); PG8_WAIT_L(0); PG8_BAR; PG8_MMA(0, 0, At, B0); PG8_MMA(0, 1, At, B1); PG8_BAR; PG8_SCHED;
      PG8_LDA(At, 0, 1); PG8_STAGE_B(PG8_SB(0, 0), b2, 0); PG8_STAGE_B(PG8_SB(0, 1), b2, 1); PG8_STAGE_A(PG8_SA(0, 0), a2, 0, w00, w01);
      PG8_WAIT_V(8); PG8_WAIT_L(0); PG8_BAR; PG8_MMA(1, 0, At, B0); PG8_MMA(1, 1, At, B1); PG8_BAR; PG8_SCHED;
      PG8_LDB(B0, 1, 0); PG8_LDB(B1, 1, 1); PG8_SCHED; PG8_LDA(At, 1, 0); PG8_STAGE_A(PG8_SA(0, 1), a2, 1, w10, w11);
      PG8_WAIT_V(8); PG8_WAIT_L(0); PG8_BAR; PG8_MMA(0, 0, At, B0); PG8_MMA(0, 1, At, B1); PG8_BAR; PG8_SCHED;
      PG8_LDA(At, 1, 1); PG8_STAGE_B(PG8_SB(1, 0), b3, 0); PG8_STAGE_B(PG8_SB(1, 1), b3, 1); PG8_STAGE_A(PG8_SA(1, 0), a3, 0, w00, w01);
      PG8_WAIT_V(8); PG8_WAIT_L(0); PG8_BAR; PG8_MMA(1, 0, At, B0); PG8_MMA(1, 1, At, B1); PG8_BAR; PG8_SCHED;
    }
    if (wr == 0) PG8_BAR;
    if (FP8) asm volatile("s_nop 15\n\ts_nop 15" ::: "memory");
    E(acc, cur, wr, wc, fr, fq);
    if (!has_next) break;
#pragma unroll
    for (int a = 0; a < 2; ++a)
#pragma unroll
      for (int b = 0; b < 2; ++b)
#pragma unroll
        for (int m = 0; m < 4; ++m)
#pragma unroll
          for (int n = 0; n < 2; ++n) acc[a][b][m][n] = (f32x4v){0.f, 0.f, 0.f, 0.f};
    if (FP8) asm volatile("s_nop 7" ::: "memory");
    cur = nxt; cB = nB; cA = nA; ++ui;
    PG8_ROWS(cV, cur);
    if (wr == 1) PG8_BAR;
  }
  PG8_WAIT_V(0);
  PG8_BAR;
#undef PG8_ROWS
#undef PG8_ABASE
#undef PG8_SA
#undef PG8_SB
#undef PG8_LOAD1
#undef PG8_STAGE_A
#undef PG8_STAGE_B
#undef PG8_LDA
#undef PG8_LDB
#undef PG8_MMA
#undef PG8_WAIT_V
#undef PG8_WAIT_L
#undef PG8_BAR
#undef PG8_SCHED
}
}

struct InprojSched {
  int grid, bid;
  __device__ __forceinline__ bool next(int i, pg8::Unit& u) const {
    constexpr int NT = NP / 256;
    int mt, nt;
    if (grid == 256) { const int xcd = bid & 7, j = bid >> 3, q = j + 32 * i; if (q >= 8 * NT) return false; mt = 8 * xcd + q / NT; nt = q % NT; }
    else { const int t = bid + i * grid; if (t >= 64 * NT) return false; mt = t / NT; nt = t % NT; }
    u.boff = (unsigned)nt * (256u * 1024u * 2u); u.arow0 = mt * 256; u.mvalid = 256; u.e = 0; u.mt = mt; u.nt = nt; u.slot0 = 0;
    return true;
  }
};
struct InprojEpi {
  bf16_t* P; float* gateF; const f32x2* cs; float* ssq;
  __device__ __forceinline__ void operator()(const pg8::f32x4v (&acc)[2][2][4][2], const pg8::Unit& u, int wr, int wc, int fr, int fq) const {
    const int nt = u.nt;
    const bool rope_all = (nt == 3) || (nt == 4);
#pragma unroll
    for (int ai = 0; ai < 2; ++ai)
#pragma unroll
      for (int m = 0; m < 4; ++m) {
        const int row = u.mt * 256 + 128 * ai + 64 * wr + 16 * m + fr;
        bf16_t* prow = P + (size_t)row * NP + nt * 256 + 32 * wc + 4 * fq;
        f32x2 c4[4];
        if (rope_all || nt == 10) {
#pragma unroll
          for (int j = 0; j < 4; ++j) c4[j] = cs[(size_t)row * 16 + 4 * fq + j];
        }
        float sq = 0.f;
#pragma unroll
        for (int bj = 0; bj < 2; ++bj) {
          pg8::f32x4v v0 = acc[ai][bj][m][0], v1 = acc[ai][bj][m][1];
          if (rope_all || (nt == 10 && bj == 1 && wc == 0)) {
#pragma unroll
            for (int j = 0; j < 4; ++j) { const float x1 = v0[j], x2 = v1[j]; v0[j] = x1 * c4[j].x - x2 * c4[j].y; v1[j] = x2 * c4[j].x + x1 * c4[j].y; }
          }
          if (nt == 9 || (nt == 10 && bj == 0)) {
#pragma unroll
            for (int j = 0; j < 4; ++j) sq += v0[j] * v0[j] + v1[j] * v1[j];
          }
          u32x2 o; o.x = cvtpk(v0[0], v0[1]); o.y = cvtpk(v0[2], v0[3]);
          *(u32x2*)(prow + 128 * bj) = o;
          o.x = cvtpk(v1[0], v1[1]); o.y = cvtpk(v1[2], v1[3]);
          *(u32x2*)(prow + 128 * bj + 16) = o;
          if (nt == 10 && bj == 1 && wc == 1 && fq == 0) *(f32x4*)(gateF + (size_t)row * 4) = (f32x4){v0[0], v0[1], v0[2], v0[3]};
        }
        if (nt == 9 || nt == 10) {
          sq += __shfl_xor(sq, 16); sq += __shfl_xor(sq, 32);
          if (fq == 0) ssq[(size_t)row * 8 + (nt == 9 ? 0 : 4) + wc] = sq;
        }
      }
  }
};
__device__ __forceinline__ void phase_inproj(const Params& p, int layer, LAS unsigned char* lds) {
  unsigned char* ws = p.ws;
  InprojSched S{get_nblk(), get_bid()};
  InprojEpi E{(bf16_t*)(ws + OFF_P), (float*)(ws + OFF_GATEF), (const f32x2*)(ws + OFF_ROPE), (float*)(ws + OFF_CQN)};
  pg8::gemm_phase<false, false>(lds, (const bf16_t*)(ws + OFF_HB), (const bf16_t*)(ws + OFF_WIN) + (size_t)layer * NP * 1024, S, E);
}

__device__ __forceinline__ void rope4(bf16_t* base, const f32x2* cs4) {
  const u32x2 a = *(const u32x2*)base, b = *(const u32x2*)(base + 16);
  float x1[4] = {bflo(a.x), bfhi(a.x), bflo(a.y), bfhi(a.y)}, x2[4] = {bflo(b.x), bfhi(b.x), bflo(b.y), bfhi(b.y)};
  float y1[4], y2[4];
#pragma unroll
  for (int i = 0; i < 4; ++i) { const f32x2 c = cs4[i]; y1[i] = x1[i] * c.x - x2[i] * c.y; y2[i] = x2[i] * c.x + x1[i] * c.y; }
  u32x2 oa, ob; oa.x = cvtpk(y1[0], y1[1]); oa.y = cvtpk(y1[2], y1[3]); ob.x = cvtpk(y2[0], y2[1]); ob.y = cvtpk(y2[2], y2[3]);
  *(u32x2*)base = oa; *(u32x2*)(base + 16) = ob;
}
__device__ __forceinline__ void phase_post(const Params& p, int layer, LAS unsigned char* lds) {
  unsigned char* ws = p.ws;
  bf16_t* P = (bf16_t*)(ws + OFF_P);
  const f32x2* cs = (const f32x2*)(ws + OFF_ROPE);
  bf16_t* cqn = (bf16_t*)(ws + OFF_CQN); bf16_t* ckvn = (bf16_t*)(ws + OFF_CKVN);
  const int lane = get_tid() & 63, gw = get_bid() * 8 + (get_tid() >> 6), ngw = get_nblk() * 8;
  const float* gq = p.mla_q_norm_g + layer * 256; const float* gkv = p.mla_kv_norm_g + layer * 128;
  for (int m = gw; m < M_TOK; m += ngw) {
    bf16_t* row = P + (size_t)m * NP;
    const f32x2* csm = cs + (size_t)m * 16;
    { const int sh = lane >> 2, pg = lane & 3; rope4(row + C_DFQ + sh * 32 + 4 * pg, csm + 4 * pg); }
    if (lane < 4) rope4(row + C_KR + 4 * lane, csm + 4 * lane);
    {
      const u32x2 a = *(const u32x2*)(row + C_CQ + 4 * lane);
      float x[4] = {bflo(a.x), bfhi(a.x), bflo(a.y), bfhi(a.y)};
      const float ss = wave_sum(x[0] * x[0] + x[1] * x[1] + x[2] * x[2] + x[3] * x[3]);
      const float rs = rsqrtf(ss * (1.f / 256.f) + RMS_EPS);
      const f32x4 gg = *(const f32x4*)(gq + 4 * lane);
      u32x2 o; o.x = cvtpk(x[0] * rs * gg.x, x[1] * rs * gg.y); o.y = cvtpk(x[2] * rs * gg.z, x[3] * rs * gg.w);
      *(u32x2*)(cqn + (size_t)m * 256 + 4 * lane) = o;
    }
    {
      const unsigned a = *(const unsigned*)(row + C_CKV + 2 * lane);
      const float x0 = bflo(a), x1 = bfhi(a);
      const float ss = wave_sum(x0 * x0 + x1 * x1);
      const float rs = rsqrtf(ss * (1.f / 128.f) + RMS_EPS);
      const f32x2 gg = *(const f32x2*)(gkv + 2 * lane);
      *(unsigned*)(ckvn + (size_t)m * 128 + 2 * lane) = cvtpk(x0 * rs * gg.x, x1 * rs * gg.y);
    }
  }
  if (get_bid() < 16) {
    const int b = get_bid() >> 2, h = get_bid() & 3, tid = get_tid();
    const float* gateF = (const float*)(ws + OFF_GATEF);
    float* Fk = (float*)(ws + OFF_FK) + (size_t)get_bid() * SEQ;
    const float bf = p.b_forget[layer * 4 + h];
    LAS float* sc = (LAS float*)lds;
    float v[8]; float run = 0.f;
#pragma unroll
    for (int i = 0; i < 8; ++i) {
      const float xx = gateF[(size_t)(b * SEQ + tid * 8 + i) * 4 + h] + bf;
      const float ls = fminf(xx, 0.f) - log1pf(expf(-fabsf(xx)));
      run += ls; v[i] = run;
    }
    float inc = run;
#pragma unroll
    for (int o = 1; o < 64; o <<= 1) { const float t = __shfl_up(inc, o); if (lane >= o) inc += t; }
    __syncthreads();
    if (lane == 63) sc[tid >> 6] = inc;
    __syncthreads();
    float wbase = 0.f;
    for (int i = 0; i < (tid >> 6); ++i) wbase += sc[i];
    const float excl = wbase + inc - run;
#pragma unroll
    for (int i = 0; i < 8; ++i) Fk[tid * 8 + i] = -8.f * (excl + v[i]);
    __syncthreads();
  }
}

__device__ __forceinline__ void phase_mla_up(const Params& p, int layer, LAS unsigned char* lds) {
  unsigned char* ws = p.ws;
  const bf16_t* P = (const bf16_t*)(ws + OFF_P);
  const float* ssq = (const float*)(ws + OFF_CQN);
  const bf16_t* Wq = (const bf16_t*)(ws + OFF_WUQ) + (size_t)layer * 384 * 256;
  const bf16_t* Wkv = (const bf16_t*)(ws + OFF_WUKV) + (size_t)layer * 512 * 128;
  bf16_t* qd = (bf16_t*)(ws + OFF_QD); bf16_t* kvd = (bf16_t*)(ws + OFF_KVD);
  const int sb = get_bid() - (get_nblk() - 16);
  if (sb >= 0) {
    const int b = sb >> 2, h = sb & 3, tid = get_tid(), lane = tid & 63;
    const float* gateF = (const float*)(ws + OFF_GATEF);
    float* Fk = (float*)(ws + OFF_FK) + (size_t)sb * SEQ;
    const float bf = p.b_forget[layer * 4 + h];
    LAS float* sc = (LAS float*)lds;
    float v[8]; float run = 0.f;
#pragma unroll
    for (int i = 0; i < 8; ++i) {
      const float xx = gateF[(size_t)(b * SEQ + tid * 8 + i) * 4 + h] + bf;
      const float ls = fminf(xx, 0.f) - log1pf(expf(-fabsf(xx)));
      run += ls; v[i] = run;
    }
    float inc = run;
#pragma unroll
    for (int o = 1; o < 64; o <<= 1) { const float t = __shfl_up(inc, o); if (lane >= o) inc += t; }
    __syncthreads();
    if (lane == 63) sc[tid >> 6] = inc;
    __syncthreads();
    float wbase = 0.f;
    for (int i = 0; i < (tid >> 6); ++i) wbase += sc[i];
    const float excl = wbase + inc - run;
#pragma unroll
    for (int i = 0; i < 8; ++i) Fk[tid * 8 + i] = -8.f * (excl + v[i]);
    __syncthreads();
  }
  const int lane = get_tid() & 63, w = get_tid() >> 6, wm = w >> 1, wn = w & 1, c31 = lane & 31, hi = lane >> 5;
  for (int item = get_bid() * 8 + w; item < 16 * 64; item += get_nblk() * 8) {
    const int bh = item >> 6, tl = item & 63, b = bh >> 2, h = bh & 3;
    const bf16_t* kr = P + (size_t)(b * SEQ + 64 * tl + lane) * NP + C_FXK + h * 64;
    float ss = 0.f;
#pragma unroll
    for (int c = 0; c < 8; ++c) {
      const u32x4 x = *(const u32x4*)(kr + 8 * c);
      ss += bflo(x.x) * bflo(x.x) + bfhi(x.x) * bfhi(x.x) + bflo(x.y) * bflo(x.y) + bfhi(x.y) * bfhi(x.y) + bflo(x.z) * bflo(x.z) + bfhi(x.z) * bfhi(x.z) + bflo(x.w) * bflo(x.w) + bfhi(x.w) * bfhi(x.w);
    }
    float nv = sqrtf(ss) * 1.0001f;
#pragma unroll
    for (int o = 1; o < 64; o <<= 1) nv = fmaxf(nv, __shfl_xor(nv, o));
    if (lane == 0) ((float*)(ws + OFF_KN))[item] = nv;
  }
  constexpr int TQ = 64 * 3, TKV = 64 * 4;
  for (int t = get_bid(); t < TQ + TKV; t += get_nblk()) {
    const bool isq = t < TQ; const int tt = isq ? t : t - TQ; const int ntn = isq ? 3 : 4; const int mt = tt / ntn, nt = tt % ntn;
    GemmDesc g;
    if (isq) g = GemmDesc{P + C_CQ, NP, nullptr, mt * 256, 256, Wq + (size_t)nt * 128 * 256, 256, 256};
    else g = GemmDesc{P + C_CKV, NP, nullptr, mt * 256, 256, Wkv + (size_t)nt * 128 * 128, 128, 128};
    f32x16 acc[2][2];
    gemm_tile<2>(lds, g, acc);
    bf16_t* O = isq ? qd : kvd; const int ldo = isq ? 384 : 512;
#pragma unroll
    for (int mi = 0; mi < 2; ++mi) {
      const int m = mt * 256 + wm * 64 + mi * 32 + c31;
      const f32x4 s4 = *(const f32x4*)(ssq + (size_t)m * 8 + (isq ? 0 : 4));
      const float rs = rsqrtf(((s4.x + s4.y) + (s4.z + s4.w)) * (isq ? (1.f / 256.f) : (1.f / 128.f)) + RMS_EPS);
#pragma unroll
      for (int ni = 0; ni < 2; ++ni)
#pragma unroll
        for (int g4 = 0; g4 < 4; ++g4) {
          const int n = nt * 128 + wn * 64 + ni * 32 + 4 * hi + 8 * g4;
          u32x2 o; o.x = cvtpk(acc[mi][ni][4 * g4] * rs, acc[mi][ni][4 * g4 + 1] * rs); o.y = cvtpk(acc[mi][ni][4 * g4 + 2] * rs, acc[mi][ni][4 * g4 + 3] * rs);
          *(u32x2*)(O + (size_t)m * ldo + n) = o;
        }
    }
  }
}

constexpr int CMU_UP = 32 * 8 * 32, CMU_DN = 32 * 8 * 16, CMU_TOTAL = CMU_UP + CMU_DN;
struct ConvCtx { const float* wgu; const float* wdn; unsigned char* dgu; unsigned char* ddn; int* ctr; };
__device__ __forceinline__ void cmu_load(const ConvCtx& c, int idx, int lane, int w, float (&v)[16]) {
  const bool up = idx < CMU_UP;
  const int i2 = up ? idx : idx - CMU_UP;
  const int e = up ? (i2 >> 8) : (i2 >> 7), rem = up ? (i2 & 255) : (i2 & 127);
  const int kb = up ? (rem >> 5) : (rem >> 4), nb = up ? (rem & 31) : (rem & 15);
  const int N = up ? 2048 : 1024;
  const float* base = up ? c.wgu : c.wdn;
  const float* sp = base + ((size_t)e * 1024 + kb * 128 + 16 * w) * N + nb * 64 + lane;
#pragma unroll
  for (int j = 0; j < 16; ++j) v[j] = __builtin_nontemporal_load(sp + (size_t)j * N);
}
__device__ __forceinline__ void cmu_store(const ConvCtx& c, int idx, int lane, int w, const float (&v)[16]) {
  const bool up = idx < CMU_UP;
  const int i2 = up ? idx : idx - CMU_UP;
  const int e = up ? (i2 >> 8) : (i2 >> 7), rem = up ? (i2 & 255) : (i2 & 127);
  const int kb = up ? (rem >> 5) : (rem >> 4), nb = up ? (rem & 31) : (rem & 15);
  const int N = up ? 2048 : 1024;
  const int n = nb * 64 + lane;
  int dr = n;
  if (up) { const int j = n & 1023; dr = (j >> 4) * 32 + (j & 15) + ((n >= 1024) ? 16 : 0); }
  unsigned char* base = up ? c.dgu : c.ddn;
  const float sc = up ? S8_WGU : S8_WDN;
  u32x4 o;
  o.x = pk4_fp8(v[0] * sc, v[1] * sc, v[2] * sc, v[3] * sc); o.y = pk4_fp8(v[4] * sc, v[5] * sc, v[6] * sc, v[7] * sc);
  o.z = pk4_fp8(v[8] * sc, v[9] * sc, v[10] * sc, v[11] * sc); o.w = pk4_fp8(v[12] * sc, v[13] * sc, v[14] * sc, v[15] * sc);
  *(u32x4*)(base + ((size_t)e * N + dr) * 1024 + kb * 128 + 16 * w) = o;
}

__device__ __forceinline__ void cmu_to_lds(const ConvCtx& c, int idx, int lane, int w, const float (&v)[16], LAS unsigned char* tile) {
  const float sc = (idx < CMU_UP) ? S8_WGU : S8_WDN;
  u32x4 o;
  o.x = pk4_fp8(v[0] * sc, v[1] * sc, v[2] * sc, v[3] * sc); o.y = pk4_fp8(v[4] * sc, v[5] * sc, v[6] * sc, v[7] * sc);
  o.z = pk4_fp8(v[8] * sc, v[9] * sc, v[10] * sc, v[11] * sc); o.w = pk4_fp8(v[12] * sc, v[13] * sc, v[14] * sc, v[15] * sc);
  *(LAS u32x4*)(tile + lane * 128 + ((w ^ (lane & 7)) << 4)) = o;
}
__device__ __forceinline__ void cmu_from_lds(const ConvCtx& c, int idx, int lane, int w, const LAS unsigned char* tile) {
  const bool up = idx < CMU_UP;
  const int i2 = up ? idx : idx - CMU_UP;
  const int e = up ? (i2 >> 8) : (i2 >> 7), rem = up ? (i2 & 255) : (i2 & 127);
  const int kb = up ? (rem >> 5) : (rem >> 4), nb = up ? (rem & 31) : (rem & 15);
  const int N = up ? 2048 : 1024;
  const int r = 8 * w + (lane >> 3), ch = lane & 7;
  const u32x4 o = *(const LAS u32x4*)(tile + r * 128 + ((ch ^ (r & 7)) << 4));
  const int n = nb * 64 + r;
  int dr = n;
  if (up) { const int j = n & 1023; dr = (j >> 4) * 32 + (j & 15) + ((n >= 1024) ? 16 : 0); }
  unsigned char* base = up ? c.dgu : c.ddn;
  *(u32x4*)(base + ((size_t)e * N + dr) * 1024 + kb * 128 + 16 * ch) = o;
}

enum { AT_SB = 0, AT_DIFF = 1, AT_FOX = 2, AT_MLA = 3 };
struct AttnArgs {
  const bf16_t* Q; int ldq; const bf16_t* K; int ldk; const bf16_t* V; int ldv; const bf16_t* K2; int ldk2;
  const float* Fk; const f32x2* cs; bf16_t* O; int ldo; float lam, oscale; const float* subg; const float* kn;
};
constexpr int ATT_K1 = 0, ATT_V = 8192, ATT_K2 = 16384, ATT_F = 20480, ATT_BUF = 20992;

__device__ __forceinline__ float max3f(float a, float b, float c) { float r; asm("v_max3_f32 %0, %1, %2, %3" : "=v"(r) : "v"(a), "v"(b), "v"(c)); return r; }
__device__ __forceinline__ float max2f(float a, float b) { float r; asm("v_max_f32_e32 %0, %1, %2" : "=v"(r) : "v"(a), "v"(b)); return r; }
__device__ __forceinline__ bool softmax_tile(f32x16& p0, f32x16& p1, float& m, float& l, float c, bool domask, int kbase, int q, int hi, float& alpha) {
  if (domask) {
#pragma unroll
    for (int r = 0; r < 16; ++r) { const int key = kbase + crow(r, hi); if (key > q) p0[r] = -INFINITY; if (key + 32 > q) p1[r] = -INFINITY; }
  }
  asm volatile("s_nop 15\n\ts_nop 7" : "+v"(p0), "+v"(p1));
  float a = max3f(p0[0], p0[1], p1[0]), b = max3f(p0[2], p0[3], p1[1]); a = max3f(a, p1[2], p1[3]);
#pragma unroll
  for (int r = 4; r < 16; r += 4) { a = max3f(a, p0[r], p0[r + 1]); b = max3f(b, p0[r + 2], p0[r + 3]); a = max3f(a, p1[r], p1[r + 1]); b = max3f(b, p1[r + 2], p1[r + 3]); }
  float a0, a1; pair_vals(max2f(a, b), a0, a1);
  const float rm = max2f(a0, a1);
  const bool resc = __any((rm - m) * c > 8.0f);
  alpha = 1.f;
  if (resc) { const float mn = max2f(m, rm); alpha = __builtin_amdgcn_exp2f((m - mn) * c); l *= alpha; m = mn; }
  const float mc = m * c;
  float s = 0.f;
#pragma unroll
  for (int r = 0; r < 16; ++r) { p0[r] = __builtin_amdgcn_exp2f(fmaf(p0[r], c, -mc)); p1[r] = __builtin_amdgcn_exp2f(fmaf(p1[r], c, -mc)); s += p0[r] + p1[r]; }
  l += s;
  return resc;
}
__device__ __forceinline__ bf16x8 pack8(const f32x16& p, int b) {
  u32x4 w; w.x = cvtpk(p[b], p[b + 1]); w.y = cvtpk(p[b + 2], p[b + 3]); w.z = cvtpk(p[b + 4], p[b + 5]); w.w = cvtpk(p[b + 6], p[b + 7]);
  return __builtin_bit_cast(bf16x8, w);
}
__device__ __forceinline__ bf16x8 vfrag(LAS unsigned char* vb, int off) {
  const s16x4 lo = __builtin_bit_cast(s16x4, __builtin_amdgcn_ds_read_tr16_b64_v4i16((LAS s16x4*)(vb + off)));
  const s16x4 hh = __builtin_bit_cast(s16x4, __builtin_amdgcn_ds_read_tr16_b64_v4i16((LAS s16x4*)(vb + off + 1024)));
  return (bf16x8){lo[0], lo[1], lo[2], lo[3], hh[0], hh[1], hh[2], hh[3]};
}

template <int T>
__device__ __forceinline__ void attn_unit(LAS unsigned char* lds, const AttnArgs& a, int qb, const ConvCtx& cc, int& gi, int& pidx, int& qidx, float (&cv)[16]) {
  const int tid = get_tid(), lane = tid & 63, w = tid >> 6, c31 = lane & 31, hi = lane >> 5;
  const int t0 = qb * 256 + w * 32, q = t0 + c31;
  constexpr int NKS = (T == AT_MLA) ? 6 : 4;
  constexpr float CSC = (T == AT_DIFF) ? 0.17677669529663687f * LOG2E : (T == AT_MLA) ? 0.10206207261596577f * LOG2E : 0.125f * LOG2E;
  bf16x8 qf[NKS];
  {
    const bf16_t* qrow = a.Q + (size_t)q * a.ldq;
#pragma unroll
    for (int ks = 0; ks < NKS; ++ks) qf[ks] = *(const bf16x8*)(qrow + 16 * ks + 8 * hi);
    if (T == AT_MLA) {
      const f32x2* csq = a.cs + (size_t)q * 16 + 8 * hi;
      bf16x8 n4, n5;
#pragma unroll
      for (int j = 0; j < 8; j += 2) {
        const f32x2 c0 = csq[j], c1 = csq[j + 1];
        const float x1a = bf2f((unsigned short)qf[4][j]), x1b = bf2f((unsigned short)qf[4][j + 1]);
        const float x2a = bf2f((unsigned short)qf[5][j]), x2b = bf2f((unsigned short)qf[5][j + 1]);
        const unsigned w1 = cvtpk(x1a * c0.x - x2a * c0.y, x1b * c1.x - x2b * c1.y);
        const unsigned w2 = cvtpk(x2a * c0.x + x1a * c0.y, x2b * c1.x + x1b * c1.y);
        n4[j] = (short)(w1 & 0xffff); n4[j + 1] = (short)(w1 >> 16); n5[j] = (short)(w2 & 0xffff); n5[j + 1] = (short)(w2 >> 16);
      }
      qf[4] = n4; qf[5] = n5;
    }
  }
  const int skey = tid >> 3, sch = tid & 7;
  const int k1_st = ATT_K1 + skey * 128 + ((sch ^ ((skey >> 1) & 7)) << 4);
  const int v_st = ATT_V + skey * 128 + ((sch ^ (((skey >> 1) & 1) << 2)) << 4);
  const int k2key = tid >> 2, k2ch = tid & 3;
  const int k2_st = ATT_K2 + k2key * 64 + ((k2ch ^ ((k2key >> 2) & 3)) << 4);
  const int xr = (lane >> 1) & 7;
  int kro[4];
#pragma unroll
  for (int ks = 0; ks < 4; ++ks) kro[ks] = ATT_K1 + c31 * 128 + (((2 * ks + hi) ^ xr) << 4);
  int k2ro[2];
#pragma unroll
  for (int ks = 0; ks < 2; ++ks) k2ro[ks] = ATT_K2 + c31 * 64 + (((2 * ks + hi) ^ ((c31 >> 2) & 3)) << 4);
  int vro[2];
  {
    const int i = lane & 15, qq = i >> 2, pp = i & 3, gg = (lane >> 4) & 1, bit = (qq >> 1) & 1;
#pragma unroll
    for (int d0 = 0; d0 < 2; ++d0) vro[d0] = ATT_V + (4 * hi + qq) * 128 + ((4 * (d0 ^ bit) + 2 * gg + (pp >> 1)) << 4) + (pp & 1) * 8;
  }
  const int ntiles = 4 * (qb + 1);
  const int wave_last = (t0 + 31) >> 6;
  LAS float* kpre = (LAS float*)(lds + 2 * ATT_BUF + 256);
  LAS float* fend = kpre + 64;
  float qn = 0.f;
  if (T == AT_FOX) {
    if (w == 0) {
      float v = (lane < ntiles) ? a.kn[lane] : 0.f;
#pragma unroll
      for (int o = 1; o < 64; o <<= 1) { const float u_ = __shfl_up(v, o); if (lane >= o) v = fmaxf(v, u_); }
      kpre[lane] = v;
      fend[lane] = (lane < ntiles) ? a.Fk[64 * lane + 63] : 0.f;
    }
    float ss = 0.f;
#pragma unroll
    for (int ks = 0; ks < 4; ++ks)
#pragma unroll
      for (int j = 0; j < 8; ++j) { const float x = bf2f((unsigned short)qf[ks][j]); ss += x * x; }
    float s0_, s1_; pair_vals(ss, s0_, s1_);
    qn = sqrtf(s0_ + s1_) * 1.0001f;
  }
  f32x16 o0[2], o1[2];
#pragma unroll
  for (int d0 = 0; d0 < 2; ++d0)
#pragma unroll
    for (int r = 0; r < 16; ++r) { o0[d0][r] = 0.f; o1[d0][r] = 0.f; }
  float m0 = -INFINITY, l0 = 0.f, m1 = -INFINITY, l1 = 0.f;
  float Crun = 0.f;
  bool fin = false;
  u32x4 rk, rv, rk2; float rf = 0.f;
#define ATT_TILE(it) ((T == AT_SB || T == AT_FOX) ? (ntiles - 1 - (it)) : (it))
#define ATT_GLOAD(t) do { const int key_ = 64 * (t) + skey; \
    rk = *(const u32x4*)(a.K + (size_t)key_ * a.ldk + sch * 8); rv = *(const u32x4*)(a.V + (size_t)key_ * a.ldv + sch * 8); \
    if (T == AT_MLA) { if (tid < 256) rk2 = *(const u32x4*)(a.K2 + (size_t)(64 * (t) + k2key) * a.ldk2 + k2ch * 8); } \
    if (T == AT_FOX) { if (tid < 64) rf = a.Fk[64 * (t) + tid]; } } while (0)
#define ATT_LSTORE(buf) do { LAS unsigned char* b_ = lds + (buf) * ATT_BUF; \
    *(LAS u32x4*)(b_ + k1_st) = rk; *(LAS u32x4*)(b_ + v_st) = rv; \
    if (T == AT_MLA) { if (tid < 256) *(LAS u32x4*)(b_ + k2_st) = rk2; } \
    if (T == AT_FOX) { if (tid < 64) *(LAS float*)(b_ + ATT_F + 4 * tid) = rf; } } while (0)
  LAS int* s_conv = (LAS int*)(lds + 2 * ATT_BUF + 64);
  ATT_GLOAD(ATT_TILE(0));
  ATT_LSTORE(0);
  __syncthreads();
  for (int it = 0; it < ntiles; ++it) {
    const int t = ATT_TILE(it);
    LAS unsigned char* cur = lds + (it & 1) * ATT_BUF;
    const bool more = (it + 1 < ntiles);
    const int cidx = __builtin_amdgcn_readfirstlane(s_conv[(gi >> 3) & 1]) + (gi & 7);
    int cnext = 0;
    const bool cfetch = (gi & 7) == 0;
    if (cfetch && tid == 0) cnext = atomicAdd(cc.ctr, 8);
    if (more) ATT_GLOAD(ATT_TILE(it + 1));
    const bool active = (t <= wave_last) && !fin;
    if (active) {
      const bool domask = (64 * t + 63 > t0);
      const int kbase = 64 * t;
      if (T == AT_DIFF) {
        f32x16 pa0, pa1, pb0, pb1;
#pragma unroll
        for (int r = 0; r < 16; ++r) { pa0[r] = 0.f; pa1[r] = 0.f; pb0[r] = 0.f; pb1[r] = 0.f; }
#pragma unroll
        for (int ks = 0; ks < 2; ++ks) {
          const bf16x8 k0 = *(const LAS bf16x8*)(cur + kro[ks]), k1 = *(const LAS bf16x8*)(cur + kro[ks] + 4096);
          pa0 = __builtin_amdgcn_mfma_f32_32x32x16_bf16(k0, qf[ks], pa0, 0, 0, 0); pa1 = __builtin_amdgcn_mfma_f32_32x32x16_bf16(k1, qf[ks], pa1, 0, 0, 0);
        }
#pragma unroll
        for (int ks = 2; ks < 4; ++ks) {
          const bf16x8 k0 = *(const LAS bf16x8*)(cur + kro[ks]), k1 = *(const LAS bf16x8*)(cur + kro[ks] + 4096);
          pb0 = __builtin_amdgcn_mfma_f32_32x32x16_bf16(k0, qf[ks], pb0, 0, 0, 0); pb1 = __builtin_amdgcn_mfma_f32_32x32x16_bf16(k1, qf[ks], pb1, 0, 0, 0);
        }
        float al0, al1;
        const bool rs0 = softmax_tile(pa0, pa1, m0, l0, CSC, domask, kbase, q, hi, al0);
        const bool rs1 = softmax_tile(pb0, pb1, m1, l1, CSC, domask, kbase, q, hi, al1);
        if (rs0) {
#pragma unroll
          for (int d0 = 0; d0 < 2; ++d0)
#pragma unroll
            for (int r = 0; r < 16; ++r) o0[d0][r] *= al0;
        }
        if (rs1) {
#pragma unroll
          for (int d0 = 0; d0 < 2; ++d0)
#pragma unroll
            for (int r = 0; r < 16; ++r) o1[d0][r] *= al1;
        }
#pragma unroll
        for (int s = 0; s < 4; ++s) {
          const bf16x8 pfa = pack8((s < 2) ? pa0 : pa1, 8 * (s & 1)), pfb = pack8((s < 2) ? pb0 : pb1, 8 * (s & 1));
#pragma unroll
          for (int d0 = 0; d0 < 2; ++d0) {
            const bf16x8 vf = vfrag(cur, vro[d0] + 2048 * s);
            o0[d0] = __builtin_amdgcn_mfma_f32_32x32x16_bf16(vf, pfa, o0[d0], 0, 0, 0);
            o1[d0] = __builtin_amdgcn_mfma_f32_32x32x16_bf16(vf, pfb, o1[d0], 0, 0, 0);
          }
        }
      } else {
        f32x16 p0, p1;
        if (T == AT_FOX) {
#pragma unroll
          for (int g4 = 0; g4 < 4; ++g4) {
            const f32x4 f0 = *(const LAS f32x4*)(cur + ATT_F + (8 * g4 + 4 * hi) * 4), f1 = *(const LAS f32x4*)(cur + ATT_F + (32 + 8 * g4 + 4 * hi) * 4);
            p0[4 * g4] = f0.x; p0[4 * g4 + 1] = f0.y; p0[4 * g4 + 2] = f0.z; p0[4 * g4 + 3] = f0.w;
            p1[4 * g4] = f1.x; p1[4 * g4 + 1] = f1.y; p1[4 * g4 + 2] = f1.z; p1[4 * g4 + 3] = f1.w;
          }
        } else {
#pragma unroll
          for (int r = 0; r < 16; ++r) { p0[r] = 0.f; p1[r] = 0.f; }
        }
#pragma unroll
        for (int ks = 0; ks < 4; ++ks) {
          const bf16x8 k0 = *(const LAS bf16x8*)(cur + kro[ks]), k1 = *(const LAS bf16x8*)(cur + kro[ks] + 4096);
          p0 = __builtin_amdgcn_mfma_f32_32x32x16_bf16(k0, qf[ks], p0, 0, 0, 0); p1 = __builtin_amdgcn_mfma_f32_32x32x16_bf16(k1, qf[ks], p1, 0, 0, 0);
        }
        if (T == AT_MLA) {
#pragma unroll
          for (int ks = 0; ks < 2; ++ks) {
            const bf16x8 k0 = *(const LAS bf16x8*)(cur + k2ro[ks]), k1 = *(const LAS bf16x8*)(cur + k2ro[ks] + 2048);
            p0 = __builtin_amdgcn_mfma_f32_32x32x16_bf16(k0, qf[(NKS == 6) ? 4 + ks : ks], p0, 0, 0, 0);
            p1 = __builtin_amdgcn_mfma_f32_32x32x16_bf16(k1, qf[(NKS == 6) ? 4 + ks : ks], p1, 0, 0, 0);
          }
        }
        if (T == AT_SB) {
          f32x16 e0, e1;
          float T8[8];
#pragma unroll
          for (int half = 0; half < 2; ++half) {
            f32x16& pp = half ? p1 : p0; f32x16& ee = half ? e1 : e0;
#pragma unroll
            for (int r = 0; r < 16; ++r) {
              const float z2 = pp[r] * CSC;
              float lk = -__builtin_amdgcn_logf(1.0f + __builtin_amdgcn_exp2f(fminf(z2, 126.f)));
              const bool valid = !domask || (kbase + 32 * half + crow(r, hi) < q);
              lk = valid ? lk : 0.f;
              pp[r] = valid ? (z2 + lk) : -INFINITY;
              ee[r] = lk;
            }
#pragma unroll
            for (int g4 = 0; g4 < 4; ++g4) {
              const float x0 = ee[4 * g4], x1 = ee[4 * g4 + 1], x2 = ee[4 * g4 + 2], x3 = ee[4 * g4 + 3];
              ee[4 * g4 + 3] = 0.f; ee[4 * g4 + 2] = x3; ee[4 * g4 + 1] = x3 + x2; ee[4 * g4] = x3 + x2 + x1;
              T8[4 * half + g4] = x3 + x2 + x1 + x0;
            }
          }
          float Tl[8], Th[8];
#pragma unroll
          for (int i = 0; i < 8; ++i) pair_vals(T8[i], Tl[i], Th[i]);
          float ps = 0.f; float base[8];
#pragma unroll
          for (int i = 7; i >= 0; --i) { base[i] = Crun + ps + (hi ? 0.f : Th[i]); ps += Tl[i] + Th[i]; }
          Crun += ps;
#pragma unroll
          for (int r = 0; r < 16; ++r) {
            p0[r] = __builtin_amdgcn_exp2f(p0[r] + e0[r] + base[r >> 2]);
            p1[r] = __builtin_amdgcn_exp2f(p1[r] + e1[r] + base[4 + (r >> 2)]);
          }
          if (__all(Crun < -48.f)) fin = true;
        } else {
          float al;
          if (softmax_tile(p0, p1, m0, l0, CSC, domask, kbase, q, hi, al)) {
#pragma unroll
            for (int d0 = 0; d0 < 2; ++d0)
#pragma unroll
              for (int r = 0; r < 16; ++r) o0[d0][r] *= al;
          }
          if (T == AT_FOX) { if (t > 0) { if (__all((qn * kpre[t - 1] + fend[t - 1] - m0) * CSC < -40.f)) fin = true; } }
        }
#pragma unroll
        for (int s = 0; s < 4; ++s) {
          const bf16x8 pf = pack8((s < 2) ? p0 : p1, 8 * (s & 1));
#pragma unroll
          for (int d0 = 0; d0 < 2; ++d0) {
            const bf16x8 vf = vfrag(cur, vro[d0] + 2048 * s);
            o0[d0] = __builtin_amdgcn_mfma_f32_32x32x16_bf16(vf, pf, o0[d0], 0, 0, 0);
          }
        }
      }
    }
    if (more) ATT_LSTORE((it + 1) & 1);
    {
      LAS unsigned char* ctile = lds + 2 * ATT_BUF + 1024;
      if (qidx < CMU_TOTAL) cmu_from_lds(cc, qidx, lane, w, ctile + ((gi + 1) & 1) * 8192);
      if (pidx < CMU_TOTAL) cmu_to_lds(cc, pidx, lane, w, cv, ctile + (gi & 1) * 8192);
      qidx = pidx;
      pidx = cidx;
      if (pidx < CMU_TOTAL) cmu_load(cc, pidx, lane, w, cv);
    }
    if (cfetch && tid == 0) s_conv[((gi >> 3) + 1) & 1] = cnext;
    ++gi;
    if (T == AT_SB || T == AT_FOX) {
      const bool wave_done = fin || (t == 0);
      if (__syncthreads_and(wave_done ? 1 : 0)) break;
    } else {
      __syncthreads();
    }
  }
  __syncthreads();
#undef ATT_TILE
#undef ATT_GLOAD
#undef ATT_LSTORE
  if (T == AT_DIFF) {
    float la, lb; pair_vals(l0, la, lb); const float inv0 = 1.f / (la + lb);
    pair_vals(l1, la, lb); const float inv1 = a.lam / (la + lb);
    float ss = 0.f;
#pragma unroll
    for (int d0 = 0; d0 < 2; ++d0)
#pragma unroll
      for (int r = 0; r < 16; ++r) { const float v = o0[d0][r] * inv0 - o1[d0][r] * inv1; o0[d0][r] = v; ss += v * v; }
    float sa, sb; pair_vals(ss, sa, sb);
    const float rs = rsqrtf((sa + sb) * (1.f / 64.f) + RMS_EPS) * a.oscale;
#pragma unroll
    for (int d0 = 0; d0 < 2; ++d0)
#pragma unroll
      for (int g4 = 0; g4 < 4; ++g4) {
        const int dv = 32 * d0 + 8 * g4 + 4 * hi;
        const f32x4 gg = *(const f32x4*)(a.subg + dv);
        u32x2 o; o.x = cvtpk(o0[d0][4 * g4] * rs * gg.x, o0[d0][4 * g4 + 1] * rs * gg.y); o.y = cvtpk(o0[d0][4 * g4 + 2] * rs * gg.z, o0[d0][4 * g4 + 3] * rs * gg.w);
        *(u32x2*)(a.O + (size_t)q * a.ldo + dv) = o;
      }
  } else {
    float inv = 1.f;
    if (T != AT_SB) { float la, lb; pair_vals(l0, la, lb); inv = 1.f / (la + lb); }
#pragma unroll
    for (int d0 = 0; d0 < 2; ++d0)
#pragma unroll
      for (int g4 = 0; g4 < 4; ++g4) {
        const int dv = 32 * d0 + 8 * g4 + 4 * hi;
        u32x2 o; o.x = cvtpk(o0[d0][4 * g4] * inv, o0[d0][4 * g4 + 1] * inv); o.y = cvtpk(o0[d0][4 * g4 + 2] * inv, o0[d0][4 * g4 + 3] * inv);
        *(u32x2*)(a.O + (size_t)q * a.ldo + dv) = o;
      }
  }
}

__device__ __forceinline__ void phase_attention(const Params& p, int layer, LAS unsigned char* lds) {
  unsigned char* ws = p.ws;
  const bf16_t* P = (const bf16_t*)(ws + OFF_P);
  const bf16_t* qd = (const bf16_t*)(ws + OFF_QD); const bf16_t* kvd = (const bf16_t*)(ws + OFF_KVD);
  bf16_t* mix = (bf16_t*)(ws + OFF_MIX);
  int* ctrl = (int*)(ws + OFF_CTRL);
  const float lam = ((const float*)ctrl)[CW_LAM + layer];
  const float linit = 0.8f - 0.6f * expf(-0.3f * (float)layer);
  LAS int* s_unit = (LAS int*)(lds + 2 * ATT_BUF);
  ConvCtx cc;
  cc.wgu = p.w_gate_up + (size_t)layer * NE * 1024 * 2048; cc.wdn = p.w_down + (size_t)layer * NE * 1024 * 1024;
  cc.dgu = ws + OFF_WGU + (size_t)layer * NE * 2048 * 1024; cc.ddn = ws + OFF_WD + (size_t)layer * NE * 1024 * 1024;
  cc.ctr = ctrl + CW_CONVQ + layer;
  int gi = 0, pidx = CMU_TOTAL, qidx = CMU_TOTAL; float cv[16];
#pragma unroll
  for (int j = 0; j < 16; ++j) cv[j] = 0.f;
  if (get_tid() == 0) ((LAS int*)(lds + 2 * ATT_BUF + 64))[0] = atomicAdd(cc.ctr, 8);
  for (;;) {
    if (get_tid() == 0) *s_unit = atomicAdd(&ctrl[CW_ATTQ + layer], 1);
    __syncthreads();
    const int u = *s_unit;
    __syncthreads();
    if (u >= 1024) break;
    const int qb = 15 - (u >> 6), rem = u & 63, type = rem & 3, bh = rem >> 2, b = bh >> 2, h = bh & 3;
    const size_t rb = (size_t)b * SEQ;
    AttnArgs a{};
    a.O = mix + rb * DM + type * 256 + h * 64; a.ldo = DM;
    if (type == AT_SB) {
      a.Q = P + rb * NP + C_SBQ + h * 64; a.K = P + rb * NP + C_SBK + h * 64; a.V = P + rb * NP + C_SBV + h * 64; a.ldq = a.ldk = a.ldv = NP;
      attn_unit<AT_SB>(lds, a, qb, cc, gi, pidx, qidx, cv);
    } else if (type == AT_DIFF) {
      a.Q = P + rb * NP + C_DFQ + h * 64; a.K = P + rb * NP + C_DFK + h * 64; a.V = P + rb * NP + C_DFV + h * 64; a.ldq = a.ldk = a.ldv = NP;
      a.lam = lam; a.oscale = 1.f - linit; a.subg = p.diff_subln_g + layer * 64;
      attn_unit<AT_DIFF>(lds, a, qb, cc, gi, pidx, qidx, cv);
    } else if (type == AT_FOX) {
      a.Q = P + rb * NP + C_FXQ + h * 64; a.K = P + rb * NP + C_FXK + h * 64; a.V = P + rb * NP + C_FXV + h * 64; a.ldq = a.ldk = a.ldv = NP;
      a.Fk = (const float*)(ws + OFF_FK) + (size_t)bh * SEQ; a.kn = (const float*)(ws + OFF_KN) + bh * 64;
      attn_unit<AT_FOX>(lds, a, qb, cc, gi, pidx, qidx, cv);
    } else {
      a.Q = qd + rb * 384 + h * 96; a.ldq = 384; a.K = kvd + rb * 512 + h * 128; a.ldk = 512; a.V = kvd + rb * 512 + h * 128 + 64; a.ldv = 512;
      a.K2 = P + rb * NP + C_KR; a.ldk2 = NP; a.cs = (const f32x2*)(ws + OFF_ROPE) + rb * 16;
      attn_unit<AT_MLA>(lds, a, qb, cc, gi, pidx, qidx, cv);
    }
  }
  {
    __syncthreads();
    const LAS int* sc = (const LAS int*)(lds + 2 * ATT_BUF + 64);
    const int k = gi >> 3, used = gi & 7;
    const int b0 = __builtin_amdgcn_readfirstlane(sc[k & 1]);
    const int b1 = (used >= 1) ? __builtin_amdgcn_readfirstlane(sc[(k + 1) & 1]) : CMU_TOTAL;
    const int tid = get_tid(), lane = tid & 63, w = tid >> 6;
    if (qidx < CMU_TOTAL) cmu_from_lds(cc, qidx, lane, w, lds + 2 * ATT_BUF + 1024 + ((gi + 1) & 1) * 8192);
    if (pidx < CMU_TOTAL) cmu_store(cc, pidx, lane, w, cv);
#pragma unroll 1
    for (int j = used; j < 16; ++j) {
      const int ci = (j < 8) ? b0 + j : b1 + (j - 8);
      if (ci < CMU_TOTAL) { float v0[16]; cmu_load(cc, ci, lane, w, v0); cmu_store(cc, ci, lane, w, v0); }
    }
    __syncthreads();
  }
  for (;;) {
    if (get_tid() == 0) s_unit[0] = atomicAdd(cc.ctr, 2);
    __syncthreads();
    const int c0 = __builtin_amdgcn_readfirstlane(s_unit[0]);
    __syncthreads();
    if (c0 >= CMU_TOTAL) break;
    const int tid = get_tid(), lane = tid & 63, w = tid >> 6;
    float v0[16], v1[16];
    cmu_load(cc, c0, lane, w, v0);
    if (c0 + 1 < CMU_TOTAL) cmu_load(cc, c0 + 1, lane, w, v1);
    cmu_store(cc, c0, lane, w, v0);
    if (c0 + 1 < CMU_TOTAL) cmu_store(cc, c0 + 1, lane, w, v1);
  }
}

__device__ __forceinline__ size_t tmp_blocked(int row, int col) {
  return (size_t)(row >> 6) * 65536 + (size_t)((((((col >> 7) * 4 + ((col >> 5) & 3)) * 4 + ((col >> 3) & 3)) * 2 + ((row >> 5) & 1)) * 64 + (((col >> 2) & 1) * 32 + (row & 31))) * 4);
}
struct OutprojSched {
  int grid, bid;
  __device__ __forceinline__ bool next(int i, pg8::Unit& u) const {
    int mt, nt;
    if (grid == 256) { if (i > 0) return false; const int xcd = bid & 7, j = bid >> 3; mt = 8 * xcd + (j >> 2); nt = j & 3; }
    else { const int t = bid + i * grid; if (t >= 256) return false; mt = t >> 2; nt = t & 3; }
    u.boff = (unsigned)nt * (256u * 1024u * 2u); u.arow0 = mt * 256; u.mvalid = 256; u.e = 0; u.mt = mt; u.nt = nt; u.slot0 = 0;
    return true;
  }
};
struct OutprojEpi {
  const bf16_t* hB; float* tmp;
  __device__ __forceinline__ void operator()(const pg8::f32x4v (&acc)[2][2][4][2], const pg8::Unit& u, int wr, int wc, int fr, int fq) const {
#pragma unroll
    for (int ai = 0; ai < 2; ++ai)
#pragma unroll
      for (int m = 0; m < 4; ++m) {
        const int row = u.mt * 256 + 128 * ai + 64 * wr + 16 * m + fr;
#pragma unroll
        for (int bj = 0; bj < 2; ++bj)
#pragma unroll
          for (int n = 0; n < 2; ++n) {
            const int col = u.nt * 256 + 128 * bj + 32 * wc + 16 * n + 4 * fq;
            const u32x2 hb = *(const u32x2*)(hB + (size_t)row * DM + col);
            const pg8::f32x4v v = acc[ai][bj][m][n];
            *(f32x4*)(tmp + tmp_blocked(row, col)) = (f32x4){DN_ALPHA * bflo(hb.x) + v[0], DN_ALPHA * bfhi(hb.x) + v[1], DN_ALPHA * bflo(hb.y) + v[2], DN_ALPHA * bfhi(hb.y) + v[3]};
          }
      }
  }
};
__device__ __forceinline__ void phase_outproj(const Params& p, int layer, LAS unsigned char* lds) {
  unsigned char* ws = p.ws;
  OutprojSched S{get_nblk(), get_bid()};
  OutprojEpi E{(const bf16_t*)(ws + OFF_HB), (float*)(ws + OFF_TMPF)};
  pg8::gemm_phase<false, false>(lds, (const bf16_t*)(ws + OFF_MIX), (const bf16_t*)(ws + OFF_WOUT) + (size_t)layer * 1024 * 1024, S, E);
}

__device__ __forceinline__ void phase_ln1_router(const Params& p, int layer, LAS unsigned char* lds) {
  unsigned char* ws = p.ws;
  const float* tmp = (const float*)(ws + OFF_TMPF);
  float* hF = (float*)(ws + OFF_HF); bf16_t* hB = (bf16_t*)(ws + OFF_HB);
  int* ctrl = (int*)(ws + OFF_CTRL); int* cnt = ctrl + CW_CNT + layer * 32;
  int* list = (int*)(ws + OFF_LIST); int* toke = (int*)(ws + OFF_TOKE); float* tokg = (float*)(ws + OFF_TOKG);
  const float* Wr = p.router_w + (size_t)layer * DM * NE; const float* rb = p.router_b + layer * NE;
  const float* g1 = p.ln1_g + layer * DM; const float* b1 = p.ln1_b + layer * DM;
  LAS float* red = (LAS float*)lds;
  LAS float* lg = (LAS float*)(lds + 32768);
  LAS float* part = (LAS float*)(lds + 136192);
  LAS float* part2 = (LAS float*)(lds + 137216);
  LAS int* lcnt = (LAS int*)(lds + 138240);
#pragma unroll 1
  for (int hs = get_bid(); hs < M_TOK / 32; hs += get_nblk()) {
    const int m0 = hs * 32, mi = hs & 1;
    const int tid = get_tid(), lane = tid & 63, w = tid >> 6, c31 = lane & 31, hi = lane >> 5;
    f32x16 acc[4];
    {
      const float* tb = tmp + (size_t)(hs >> 1) * 65536 + (size_t)(w * 32 * 64 + lane) * 4;
#pragma unroll
      for (int ni = 0; ni < 4; ++ni)
#pragma unroll
        for (int g4 = 0; g4 < 4; ++g4) {
          const f32x4 v = *(const f32x4*)(tb + (size_t)(((ni * 4 + g4) * 2 + mi) * 64) * 4);
          acc[ni][4 * g4] = v.x; acc[ni][4 * g4 + 1] = v.y; acc[ni][4 * g4 + 2] = v.z; acc[ni][4 * g4 + 3] = v.w;
        }
    }
    float mean, rstd;
    {
      float sacc = 0.f;
#pragma unroll
      for (int ni = 0; ni < 4; ++ni)
#pragma unroll
        for (int r = 0; r < 16; ++r) sacc += acc[ni][r];
      float s0, s1; pair_vals(sacc, s0, s1);
      if (hi == 0) part[c31 * 8 + w] = s0 + s1;
    }
    __syncthreads();
    {
      const f32x4 pa = *(const LAS f32x4*)(part + c31 * 8), pb = *(const LAS f32x4*)(part + c31 * 8 + 4);
      mean = ((pa.x + pa.y) + (pa.z + pa.w) + (pb.x + pb.y) + (pb.z + pb.w)) * (1.f / DM);
      float q = 0.f;
#pragma unroll
      for (int ni = 0; ni < 4; ++ni)
#pragma unroll
        for (int r = 0; r < 16; ++r) { const float d = acc[ni][r] - mean; q += d * d; }
      float q0, q1; pair_vals(q, q0, q1);
      if (hi == 0) part2[c31 * 8 + w] = q0 + q1;
    }
    __syncthreads();
    {
      const f32x4 pa = *(const LAS f32x4*)(part2 + c31 * 8), pb = *(const LAS f32x4*)(part2 + c31 * 8 + 4);
      rstd = rsqrtf(((pa.x + pa.y) + (pa.z + pa.w) + (pb.x + pb.y) + (pb.z + pb.w)) * (1.f / DM) + LN_EPS);
    }
    LAS unsigned char* wt = lds + w * 16896;
#pragma unroll
    for (int ni = 0; ni < 4; ++ni)
#pragma unroll
      for (int g4 = 0; g4 < 4; ++g4) {
        const int n = 128 * w + ni * 32 + 8 * g4 + 4 * hi;
        const f32x4 gg = *(const f32x4*)(g1 + n), bb = *(const f32x4*)(b1 + n);
        f32x4 y;
        y.x = (acc[ni][4 * g4] - mean) * rstd * gg.x + bb.x; y.y = (acc[ni][4 * g4 + 1] - mean) * rstd * gg.y + bb.y;
        y.z = (acc[ni][4 * g4 + 2] - mean) * rstd * gg.z + bb.z; y.w = (acc[ni][4 * g4 + 3] - mean) * rstd * gg.w + bb.w;
        acc[ni][4 * g4] = y.x; acc[ni][4 * g4 + 1] = y.y; acc[ni][4 * g4 + 2] = y.z; acc[ni][4 * g4 + 3] = y.w;
        *(LAS f32x4*)(wt + c31 * 528 + (ni * 32 + 8 * g4 + 4 * hi) * 4) = y;
      }
    {
      const int cl = (lane & 31) * 4;
      const size_t off0 = (size_t)(m0 + hi) * DM + 128 * w + cl;
      bf16_t* pB = hB + off0; unsigned char* p8 = ws + OFF_H8 + off0;
      const LAS unsigned char* rp = wt + hi * 528 + cl * 4;
#pragma unroll 4
      for (int it = 0; it < 16; ++it) {
        const f32x4 y = *(const LAS f32x4*)rp;
        u32x2 o; o.x = cvtpk(y.x, y.y); o.y = cvtpk(y.z, y.w);
        *(u32x2*)pB = o;
        *(unsigned*)p8 = pk4_fp8(clamp448(y.x * S8_H), clamp448(y.y * S8_H), clamp448(y.z * S8_H), clamp448(y.w * S8_H));
        rp += 2 * 528; pB += 2 * DM; p8 += 2 * DM;
      }
    }
    f32x16 D0;
#pragma unroll
    for (int r = 0; r < 16; ++r) D0[r] = 0.f;
    {
      const float* wrp = Wr + (128 * w + 4 * hi) * 32 + c31;
      float wa[16], wb[16];
#pragma unroll
      for (int r = 0; r < 16; ++r) wa[r] = wrp[(8 * (r >> 2) + (r & 3)) * 32];
#pragma unroll
      for (int ni = 0; ni < 4; ++ni) {
        __builtin_amdgcn_sched_barrier(0);
        if (ni < 3) {
#pragma unroll
          for (int r = 0; r < 16; ++r) wb[r] = wrp[((ni + 1) * 32 + 8 * (r >> 2) + (r & 3)) * 32];
        }
        __builtin_amdgcn_sched_barrier(0);
#pragma unroll
        for (int r = 0; r < 16; ++r) D0 = __builtin_amdgcn_mfma_f32_32x32x2f32(acc[ni][r], wa[r], D0, 0, 0, 0);
        __builtin_amdgcn_sched_barrier(0);
#pragma unroll
        for (int r = 0; r < 16; ++r) wa[r] = wb[r];
      }
    }
    __syncthreads();
#pragma unroll
    for (int r = 0; r < 16; ++r) red[(w * 32 + crow(r, hi)) * 32 + c31] = D0[r];
    __syncthreads();
#pragma unroll
    for (int i = 0; i < 2; ++i) {
      const int idx = tid + 512 * i;
      float sv = rb[idx & 31];
#pragma unroll
      for (int ww = 0; ww < 8; ++ww) sv += red[ww * 1024 + idx];
      lg[(idx & 31) * 32 + (idx >> 5)] = sv;
    }
    if (tid < 32) lcnt[tid] = 0;
    __syncthreads();
    float gt[4]; int li[4], rk[4];
    if (tid < 32) {
      float lv[4]; unsigned used = 0u;
#pragma unroll
      for (int k = 0; k < 4; ++k) {
        float best = -INFINITY; int bi = 0;
        for (int e = 0; e < 32; ++e) { const float v = lg[e * 32 + tid]; if (!((used >> e) & 1u) && v > best) { best = v; bi = e; } }
        used |= 1u << bi; lv[k] = best; li[k] = bi;
      }
      float sm = 0.f;
#pragma unroll
      for (int k = 0; k < 4; ++k) { gt[k] = expf(lv[k] - lv[0]); sm += gt[k]; }
      const float inv = 1.f / sm;
#pragma unroll
      for (int k = 0; k < 4; ++k) { gt[k] *= inv; rk[k] = __hip_atomic_fetch_add(&lcnt[li[k]], 1, __ATOMIC_RELAXED, __HIP_MEMORY_SCOPE_WORKGROUP); }
    }
    __syncthreads();
    if (tid < 32) { const int c = lcnt[tid]; lcnt[32 + tid] = c ? atomicAdd(&cnt[tid], c) : 0; }
    __syncthreads();
    if (tid < 32) {
      const int m = m0 + tid;
#pragma unroll
      for (int k = 0; k < 4; ++k) {
        const int ps = lcnt[32 + li[k]] + rk[k];
        list[li[k] * M_TOK + ps] = m;
        toke[m * 4 + k] = (li[k] << 16) | ps;
        tokg[m * 4 + k] = gt[k];
      }
    }
    __syncthreads();
  }
}

__device__ __forceinline__ void moe_prefix(const int* cnt, LAS int* s_start, LAS int* s_tstart, LAS int* s_cnt) {
  if (get_tid() < 64) {
    const int lane = get_tid();
    const int c = (lane < 32) ? cnt[lane] : 0;
    const int tl = (c + 255) >> 8;
    int ic = c, it = tl;
#pragma unroll
    for (int o = 1; o < 32; o <<= 1) { const int a = __shfl_up(ic, o), b = __shfl_up(it, o); if (lane >= o) { ic += a; it += b; } }
    if (lane < 32) { s_cnt[lane] = c; s_start[lane] = ic - c; s_tstart[lane] = it - tl; }
    if (lane == 31) { s_start[32] = ic; s_tstart[32] = it; }
  }
  __syncthreads();
}

struct MoeSched {
  unsigned estride; int NT, total_mt, grid, bid; const LAS int* s_start; const LAS int* s_tstart; const LAS int* s_cnt;
  __device__ __forceinline__ bool next(int i, pg8::Unit& u) const {
    int mtg, nt; bool ok;
    if (grid == 256) { const int MG = 32 / NT; const int xcd = bid & 7, j = bid >> 3; mtg = MG * (xcd + 8 * i) + j / NT; nt = j % NT; ok = (MG * (8 * i) < total_mt); }
    else { const int item = bid + i * grid; ok = (item < total_mt * NT); mtg = item / NT; nt = item % NT; }
    const bool live = ok && (mtg < total_mt);
    const int mq = live ? mtg : 0;
    int e = 0;
    while (__builtin_amdgcn_readfirstlane(s_tstart[e + 1]) <= mq) ++e;
    const int mt = mq - __builtin_amdgcn_readfirstlane(s_tstart[e]);
    const int mv = live ? min(256, __builtin_amdgcn_readfirstlane(s_cnt[e]) - mt * 256) : 0;
    const int sl = __builtin_amdgcn_readfirstlane(s_start[e]) + mt * 256;
    const unsigned bo = (unsigned)e * estride + (unsigned)nt * (256u * 1024u);
    u.boff = bo; u.arow0 = i; u.mvalid = mv; u.e = e; u.mt = mt; u.nt = nt; u.slot0 = sl;
    return ok;
  }
};
struct MoeUpEpi {
  unsigned char* act; const LAS float* btab;
  __device__ __forceinline__ void operator()(const pg8::f32x4v (&acc)[2][2][4][2], const pg8::Unit& u, int wr, int wc, int fr, int fq) const {
    constexpr float US = 1.f / (S8_H * S8_WGU);
    constexpr float KEXP = -1.702f * LOG2E;
    const LAS float* bt = btab + u.arow0 * 256 + 16 * wc + 4 * fq;
    f32x4 bg[2], bl[2];
#pragma unroll
    for (int bj = 0; bj < 2; ++bj) { bg[bj] = *(const LAS f32x4*)(bt + 64 * bj); bl[bj] = *(const LAS f32x4*)(bt + 128 + 64 * bj); }
#pragma unroll
    for (int ai = 0; ai < 2; ++ai)
#pragma unroll
      for (int m = 0; m < 4; ++m) {
        const int rl = 128 * ai + 64 * wr + 16 * m + fr;
        if (rl < u.mvalid) {
          unsigned char* orow = act + (size_t)(u.slot0 + rl) * DFF + 16 * (8 * u.nt + wc) + 4 * fq;
#pragma unroll
          for (int bj = 0; bj < 2; ++bj) {
            float o[4];
#pragma unroll
            for (int i = 0; i < 4; ++i) {
              const float gl = fminf(fmaf(acc[ai][bj][m][0][i], US, bg[bj][i]), 7.f);
              const float ln = fminf(fmaxf(fmaf(acc[ai][bj][m][1][i], US, bl[bj][i]), -7.f), 7.f);
              const float sg = __builtin_amdgcn_rcpf(1.f + __builtin_amdgcn_exp2f(KEXP * gl));
              o[i] = fminf(gl * sg * fmaf(ln, S8_ACT, S8_ACT), 448.f);
            }
            *(unsigned*)(orow + 64 * bj) = pk4_fp8(o[0], o[1], o[2], o[3]);
          }
        }
      }
  }
};
struct MoeDownEpi {
  bf16_t* yb; const LAS float* btab;
  __device__ __forceinline__ void operator()(const pg8::f32x4v (&acc)[2][2][4][2], const pg8::Unit& u, int wr, int wc, int fr, int fq) const {
    constexpr float us = 1.f / (S8_ACT * S8_WDN);
    const LAS float* bt = btab + u.e * 256 + 32 * wc + 4 * fq;
    f32x4 b4[2][2];
#pragma unroll
    for (int bj = 0; bj < 2; ++bj)
#pragma unroll
      for (int n = 0; n < 2; ++n) b4[bj][n] = *(const LAS f32x4*)(bt + 128 * bj + 16 * n);
#pragma unroll
    for (int ai = 0; ai < 2; ++ai)
#pragma unroll
      for (int m = 0; m < 4; ++m) {
        const int rl = 128 * ai + 64 * wr + 16 * m + fr;
        if (rl < u.mvalid) {
          bf16_t* orow = yb + (size_t)(u.slot0 + rl) * DM + u.nt * 256 + 32 * wc + 4 * fq;
#pragma unroll
          for (int bj = 0; bj < 2; ++bj)
#pragma unroll
            for (int n = 0; n < 2; ++n) {
              const pg8::f32x4v v = acc[ai][bj][m][n];
              u32x2 ov; ov.x = cvtpk(fmaf(v[0], us, b4[bj][n].x), fmaf(v[1], us, b4[bj][n].y)); ov.y = cvtpk(fmaf(v[2], us, b4[bj][n].z), fmaf(v[3], us, b4[bj][n].w));
              *(u32x2*)(orow + 128 * bj + 16 * n) = ov;
            }
        }
      }
  }
};
__device__ __forceinline__ void phase_moe_up(const Params& p, int layer, LAS unsigned char* lds) {
  unsigned char* ws = p.ws;
  const int* cnt = (const int*)(ws + OFF_CTRL) + CW_CNT + layer * 32;
  const int* list = (const int*)(ws + OFF_LIST);
  LAS int* s_start = (LAS int*)(lds + LDS_GEMM); LAS int* s_tstart = s_start + 40; LAS int* s_cnt = s_start + 80;
  moe_prefix(cnt, s_start, s_tstart, s_cnt);
  MoeSched S{2048u * 1024u, 8, __builtin_amdgcn_readfirstlane(s_tstart[32]), get_nblk(), get_bid(), s_start, s_tstart, s_cnt};
  {
    const int tid = get_tid();
    LAS int* rowtab = (LAS int*)(lds + LDS_ROWTAB);
    LAS float* btab = (LAS float*)(lds + LDS_BIASTAB);
    const float* bgu = p.b_gate_up + (size_t)layer * NE * 2048;
    pg8::Unit u;
    for (int i = 0; i < 12 && S.next(i, u); ++i) {
      if (tid < 256) {
        int v = 0;
        if (u.mvalid > 0) v = list[u.e * M_TOK + u.mt * 256 + min(tid, u.mvalid - 1)];
        rowtab[i * 256 + tid] = v;
      } else {
        const int c = tid - 256;
        btab[i * 256 + c] = bgu[(size_t)u.e * 2048 + (c >> 7) * 1024 + u.nt * 128 + (c & 127)];
      }
    }
    __syncthreads();
  }
  MoeUpEpi E{(unsigned char*)(ws + OFF_ACT), (const LAS float*)(lds + LDS_BIASTAB)};
  pg8::gemm_phase<true, true>(lds, (const bf16_t*)(ws + OFF_H8), (const bf16_t*)(ws + OFF_WGU + (size_t)layer * NE * 2048 * 1024), S, E);
}
struct MoeDownSched {
  MoeSched base;
  __device__ __forceinline__ bool next(int i, pg8::Unit& u) const { const bool ok = base.next(i, u); if (ok) { u.arow0 = u.slot0; u.e = i; } return ok; }
};
__device__ __forceinline__ void phase_moe_down(const Params& p, int layer, LAS unsigned char* lds) {
  unsigned char* ws = p.ws;
  const int* cnt = (const int*)(ws + OFF_CTRL) + CW_CNT + layer * 32;
  LAS int* s_start = (LAS int*)(lds + LDS_GEMM); LAS int* s_tstart = s_start + 40; LAS int* s_cnt = s_start + 80;
  moe_prefix(cnt, s_start, s_tstart, s_cnt);
  MoeDownSched S{MoeSched{1024u * 1024u, 4, __builtin_amdgcn_readfirstlane(s_tstart[32]), get_nblk(), get_bid(), s_start, s_tstart, s_cnt}};
  {
    const int tid = get_tid();
    LAS float* btab = (LAS float*)(lds + LDS_BIASTAB);
    const float* bd = p.b_down + (size_t)layer * NE * 1024;
    pg8::Unit u;
    for (int i = 0; i < 12 && S.base.next(i, u); ++i)
      if (tid < 256) btab[i * 256 + tid] = bd[(size_t)u.e * 1024 + u.nt * 256 + tid];
    __syncthreads();
  }
  MoeDownEpi E{(bf16_t*)(ws + OFF_Y), (const LAS float*)(lds + LDS_BIASTAB)};
  pg8::gemm_phase<false, true>(lds, (const bf16_t*)(ws + OFF_ACT), (const bf16_t*)(ws + OFF_WD + (size_t)layer * NE * 1024 * 1024), S, E);
}

__device__ __forceinline__ void phase_combine_ln2(const Params& p, int layer, LAS unsigned char* lds) {
  unsigned char* ws = p.ws;
  const bf16_t* yb = (const bf16_t*)(ws + OFF_Y);
  float* hF = (float*)(ws + OFF_HF); bf16_t* hB = (bf16_t*)(ws + OFF_HB);
  const int* cnt = (const int*)(ws + OFF_CTRL) + CW_CNT + layer * 32;
  const int* toke = (const int*)(ws + OFF_TOKE); const float* tokg = (const float*)(ws + OFF_TOKG);
  LAS int* s_start = (LAS int*)(lds + LDS_GEMM); LAS int* s_tstart = s_start + 40; LAS int* s_cnt = s_start + 80;
  moe_prefix(cnt, s_start, s_tstart, s_cnt);
  const float* g2 = p.ln2_g + layer * DM; const float* b2 = p.ln2_b + layer * DM;
  const bool last = (layer == DEPTH - 1);
  const int lane = get_tid() & 63, gw = get_bid() * 8 + (get_tid() >> 6), ngw = get_nblk() * 8;
  for (int m = gw; m < M_TOK; m += ngw) {
    f32x4 v[4];
#pragma unroll
    for (int j = 0; j < 4; ++j) { const u32x2 hb = *(const u32x2*)(hB + (size_t)m * DM + 4 * lane + 256 * j); v[j] = (f32x4){bflo(hb.x), bfhi(hb.x), bflo(hb.y), bfhi(hb.y)} * DN_ALPHA; }
#pragma unroll
    for (int k = 0; k < 4; ++k) {
      const int ep = toke[m * 4 + k]; const float gt = tokg[m * 4 + k];
      const int slot = s_start[ep >> 16] + (ep & 0xffff);
      const bf16_t* yr = yb + (size_t)slot * DM;
#pragma unroll
      for (int j = 0; j < 4; ++j) {
        const u32x2 a = *(const u32x2*)(yr + 4 * lane + 256 * j);
        v[j].x += gt * bflo(a.x); v[j].y += gt * bfhi(a.x); v[j].z += gt * bflo(a.y); v[j].w += gt * bfhi(a.y);
      }
    }
    ln_row(v, g2, b2, lane);
    if (last) store_row_f32_bf16(v, p.out + (size_t)m * DM, nullptr, lane);
    else store_row_f32_bf16(v, nullptr, hB + (size_t)m * DM, lane);
  }
}

#if defined(__HIP_DEVICE_COMPILE__)
#define PH(call) do { const __attribute__((address_space(4))) Params* q_ = pp; asm volatile("" : "+s"(q_)); Params p; __builtin_memcpy(&p, q_, sizeof(Params)); call; } while (0)
#else
#define PH(call) do { const Params& p = p_unused; (void)pp; call; } while (0)
#endif
__global__ void __launch_bounds__(512) fwd_kernel(Params p_unused) {
  cg::grid_group grid = cg::this_grid();
  extern __shared__ __attribute__((aligned(16))) unsigned char smem[];
  LAS unsigned char* lds = (LAS unsigned char*)smem;
  const __attribute__((address_space(4))) Params* pp = (const __attribute__((address_space(4))) Params*)__builtin_amdgcn_kernarg_segment_ptr();
  if (threadIdx.x < 4) ((volatile LAS unsigned*)(lds + LDS_MISC))[threadIdx.x] = 0u;
  __syncthreads();
#define GRID_BAR() do { XcdBarrier b_; PH(b_.bar = (unsigned*)(p.ws + OFF_CTRL) + CW_BAR); b_.x = xb_xcc_id(); b_.st = (volatile LAS unsigned*)(lds + LDS_MISC); xcd_barrier(b_); } while (0)
  { unsigned* bw; PH(bw = (unsigned*)(p.ws + OFF_CTRL) + CW_BAR); (void)xcd_barrier_post(bw, (volatile LAS unsigned*)(lds + LDS_MISC)); }
  PH(phase_convert(p));
  PH(phase_prologue_misc(p));
  grid.sync();
#pragma unroll 1
  for (int layer = 0; layer < DEPTH; ++layer) {
    PH(phase_inproj(p, layer, lds));
    GRID_BAR();
    PH(phase_mla_up(p, layer, lds));
    GRID_BAR();
    PH(phase_attention(p, layer, lds));
    GRID_BAR();
    PH(phase_outproj(p, layer, lds));
    GRID_BAR();
    PH(phase_ln1_router(p, layer, lds));
    GRID_BAR();
    PH(phase_moe_up(p, layer, lds));
    GRID_BAR();
    PH(phase_moe_down(p, layer, lds));
    GRID_BAR();
    PH(phase_combine_ln2(p, layer, lds));
    if (layer + 1 < DEPTH) GRID_BAR();
  }
}

extern "C" void kernel_launch(void* const* d_in, const int* in_sizes, int n_in, void* d_out, int out_size,
                              void* d_ws, size_t ws_size, hipStream_t stream) {
  static int grid_blocks = 0;
  if (!grid_blocks) {
    int dev = 0, cus = 0, per_cu = 0;
    (void)hipGetDevice(&dev);
    (void)hipDeviceGetAttribute(&cus, hipDeviceAttributeMultiprocessorCount, dev);
    (void)hipFuncSetAttribute((const void*)fwd_kernel, hipFuncAttributeMaxDynamicSharedMemorySize, LDS_BYTES);
    (void)hipOccupancyMaxActiveBlocksPerMultiprocessor(&per_cu, fwd_kernel, 512, LDS_BYTES);
    if (per_cu < 1) { fprintf(stderr, "kernel_launch: occupancy query returned %d\n", per_cu); per_cu = 1; }
    if (per_cu > 1) per_cu = 1;
    grid_blocks = cus * per_cu;
    if (n_in != 23 || ws_size < WS_END) { fprintf(stderr, "kernel_launch: unexpected n_in %d or ws_size %zu (< %zu)\n", n_in, ws_size, (size_t)WS_END); }
  }
  if (ws_size < WS_END) return;
  (void)hipMemsetAsync((char*)d_ws + OFF_CTRL, 0, CTRL_BYTES, stream);
  Params p{};
  p.x = (const float*)d_in[0]; p.pos = (const int*)d_in[1]; p.ln_in_g = (const float*)d_in[2]; p.ln_in_b = (const float*)d_in[3];
  p.w_in = (const float*)d_in[4]; p.b_forget = (const float*)d_in[5]; p.diff_lambda = (const float*)d_in[6]; p.diff_subln_g = (const float*)d_in[7];
  p.mla_q_norm_g = (const float*)d_in[8]; p.mla_w_uq = (const float*)d_in[9]; p.mla_kv_norm_g = (const float*)d_in[10]; p.mla_w_ukv = (const float*)d_in[11];
  p.w_out = (const float*)d_in[12]; p.ln1_g = (const float*)d_in[13]; p.ln1_b = (const float*)d_in[14]; p.router_w = (const float*)d_in[15];
  p.router_b = (const float*)d_in[16]; p.w_gate_up = (const float*)d_in[17]; p.b_gate_up = (const float*)d_in[18]; p.w_down = (const float*)d_in[19];
  p.b_down = (const float*)d_in[20]; p.ln2_g = (const float*)d_in[21]; p.ln2_b = (const float*)d_in[22];
  p.out = (float*)d_out; p.ws = (unsigned char*)d_ws;
  void* args[] = {&p};
  hipError_t e = hipLaunchCooperativeKernel((void*)fwd_kernel, dim3(grid_blocks), dim3(512), args, LDS_BYTES, stream);
  if (e != hipSuccess) fprintf(stderr, "cooperative launch failed: %s (grid %d)\n", hipGetErrorString(e), grid_blocks);
}
```

```cpp
#include <hip/hip_runtime.h>
#include <hip/hip_cooperative_groups.h>
#include <cstdio>
#include <cstdint>
namespace cg = cooperative_groups;

#define LAS __attribute__((address_space(3)))
typedef unsigned short bf16_t;
typedef short bf16x8 __attribute__((ext_vector_type(8)));
typedef short s16x4 __attribute__((ext_vector_type(4)));
typedef float f32x16 __attribute__((ext_vector_type(16)));
typedef float f32x4 __attribute__((ext_vector_type(4)));
typedef float f32x2 __attribute__((ext_vector_type(2)));
typedef unsigned u32x4 __attribute__((ext_vector_type(4)));
typedef unsigned u32x2 __attribute__((ext_vector_type(2)));
typedef __bf16 bf16x2_t __attribute__((ext_vector_type(2)));

constexpr int M_TOK = 16384, DM = 1024, SEQ = 4096, NBATCH = 4, DEPTH = 2;
constexpr int NP = 2816;
constexpr int NE = 32, DFF = 1024, TOPK = 4;
constexpr int C_SBQ = 0, C_SBK = 256, C_SBV = 512, C_DFQ = 768, C_DFK = 1024, C_DFV = 1280, C_FXQ = 1536, C_FXK = 1792, C_FXV = 2048,
              C_CQ = 2304, C_CKV = 2560, C_KR = 2688, C_FXF = 2720, C_END = 2724;
constexpr float LOG2E = 1.4426950408889634f;
constexpr float DN_ALPHA = 1.4142135623730951f;
constexpr float LN_EPS = 1e-5f, RMS_EPS = 1e-6f;
constexpr float S8_H = 16.f, S8_WGU = 64.f, S8_ACT = 8.f, S8_WDN = 128.f;

constexpr size_t MB = 1ull << 20;
constexpr size_t OFF_CTRL = 0, CTRL_BYTES = 65536;
constexpr size_t OFF_ROPE = 1 * MB;
constexpr size_t OFF_GATEF = 3 * MB;
constexpr size_t OFF_FK = 3 * MB + 512 * 1024;
constexpr size_t OFF_LIST = 4 * MB;
constexpr size_t OFF_TOKE = 6 * MB;
constexpr size_t OFF_TOKG = 6 * MB + 512 * 1024;
constexpr size_t OFF_WUQ = 7 * MB;
constexpr size_t OFF_WUKV = 7 * MB + 512 * 1024;
constexpr size_t OFF_WOUT = 8 * MB;
constexpr size_t OFF_WIN = 12 * MB;
constexpr size_t OFF_HF = 24 * MB;
constexpr size_t OFF_HB = 88 * MB;
constexpr size_t OFF_P = 120 * MB;
constexpr size_t OFF_CQN = 208 * MB;
constexpr size_t OFF_CKVN = 216 * MB;
constexpr size_t OFF_QD = 220 * MB;
constexpr size_t OFF_KVD = 232 * MB;
constexpr size_t OFF_MIX = 248 * MB;
constexpr size_t OFF_TMPF = 280 * MB;
constexpr size_t OFF_KN = 3 * MB + 768 * 1024;
constexpr size_t OFF_H8 = 220 * MB;
constexpr size_t OFF_ACT = 344 * MB;
constexpr size_t OFF_Y = 473 * MB;
constexpr size_t OFF_WGU = 602 * MB;
constexpr size_t OFF_WD = 858 * MB;
constexpr size_t WS_END = 986 * MB;
constexpr int CW_CNT = 0;
constexpr int CW_ATTQ = 128;
constexpr int CW_LAM = 160;
constexpr int CW_CONVQ = 192;
constexpr int CW_BAR = 4096;

constexpr int LDS_ROWTAB = 131072;
constexpr int LDS_GEMM = 143360;
constexpr int LDS_MISC = LDS_GEMM + 1024;
constexpr int LDS_BIASTAB = 147456;
constexpr int LDS_BYTES = 159744;

struct Params {
  const float* x; const int* pos; const float* ln_in_g; const float* ln_in_b; const float* w_in; const float* b_forget;
  const float* diff_lambda; const float* diff_subln_g; const float* mla_q_norm_g; const float* mla_w_uq; const float* mla_kv_norm_g;
  const float* mla_w_ukv; const float* w_out; const float* ln1_g; const float* ln1_b; const float* router_w; const float* router_b;
  const float* w_gate_up; const float* b_gate_up; const float* w_down; const float* b_down; const float* ln2_g; const float* ln2_b;
  float* out; unsigned char* ws;
};

__device__ __forceinline__ unsigned cvtpk(float lo, float hi) { f32x2 v = {lo, hi}; bf16x2_t b = __builtin_convertvector(v, bf16x2_t); return __builtin_bit_cast(unsigned, b); }
__device__ __forceinline__ unsigned pk4_fp8(float a, float b, float c, float d) {
  int w = __builtin_amdgcn_cvt_pk_fp8_f32(a, b, 0, false);
  w = __builtin_amdgcn_cvt_pk_fp8_f32(c, d, w, true);
  return (unsigned)w;
}
__device__ __forceinline__ float clamp448(float x) { return fminf(fmaxf(x, -448.f), 448.f); }
__device__ __forceinline__ float bf2f(unsigned short b) { return __uint_as_float(((unsigned)b) << 16); }
__device__ __forceinline__ float bflo(unsigned w) { return __uint_as_float(w << 16); }
__device__ __forceinline__ float bfhi(unsigned w) { return __uint_as_float(w & 0xffff0000u); }
__device__ __forceinline__ float wave_sum(float v) {
#pragma unroll
  for (int o = 1; o < 64; o <<= 1) v += __shfl_xor(v, o);
  return v;
}
__device__ __forceinline__ int get_bid() { int b = blockIdx.x; asm volatile("" : "+s"(b)); return b; }
__device__ __forceinline__ int get_nblk() { int g = gridDim.x; asm volatile("" : "+s"(g)); return g; }
__device__ __forceinline__ int get_tid() { int t = threadIdx.x; asm volatile("" : "+v"(t)); return t; }
__device__ __forceinline__ int crow(int r, int hi) { return (r & 3) + 8 * (r >> 2) + 4 * hi; }
__device__ __forceinline__ void pair_vals(float v, float& v0, float& v1) {
  auto rr = __builtin_amdgcn_permlane32_swap(__float_as_uint(v), __float_as_uint(v), false, false);
  v0 = __uint_as_float(rr[0]); v1 = __uint_as_float(rr[1]);
}


#define XB_TMO      128
#define XB_XCNT(j)  (256  + 64 * (j))
#define XB_XSUB(j)  (1280 + 64 * (j))
#define XB_XGEN(j)  (2304 + 64 * (j))
#define XB_TOP      3328
#define XB_TOPGEN   3392
#define XCD_BAR_WORDS 3456
#define XB_SPIN_CAP (1u << 22)
__device__ __forceinline__ unsigned xb_ld(unsigned* p)              { return __hip_atomic_load(p, __ATOMIC_RELAXED, __HIP_MEMORY_SCOPE_AGENT); }
__device__ __forceinline__ unsigned xb_add(unsigned* p, unsigned v) { return __hip_atomic_fetch_add(p, v, __ATOMIC_RELAXED, __HIP_MEMORY_SCOPE_AGENT); }
__device__ __forceinline__ unsigned xb_xcc_id() { return (unsigned)__builtin_amdgcn_s_getreg((3 << 11) | 20) & 0xFu; }
#define XB_SPIN(cond, bar) do { unsigned _sp = 0; while (cond) { __builtin_amdgcn_s_sleep(1); \
    if ((++_sp & 255u) == 0u) { if (xb_ld(&(bar)[XB_TMO])) break; if (_sp > XB_SPIN_CAP) { atomicAdd(&(bar)[XB_TMO], 1u); break; } } } } while (0)
struct XcdBarrier { unsigned* bar; unsigned x; volatile LAS unsigned* st; };
__device__ __forceinline__ XcdBarrier xcd_barrier_post(unsigned* bar, volatile LAS unsigned* st) {
  XcdBarrier b; b.bar = bar; b.x = xb_xcc_id(); b.st = st;
  if (threadIdx.x == 0) (void)xb_add(&bar[XB_XCNT(b.x)], 1u);
  return b;
}
__device__ __forceinline__ void xcd_barrier_complete(unsigned* bar, unsigned x, unsigned& nloc, unsigned& nx) {
  const unsigned G = gridDim.x * gridDim.y * gridDim.z;
  unsigned sum, cnt, mine, sp = 0u;
  for (;;) {
    sum = 0u; cnt = 0u; mine = 0u;
#pragma unroll
    for (unsigned j = 0; j < 16; ++j) { const unsigned c = xb_ld(&bar[XB_XCNT(j)]); sum += c; cnt += (c > 0u) ? 1u : 0u; mine = (j == x) ? c : mine; }
    if (sum == G) break;
    __builtin_amdgcn_s_sleep(1);
    if ((++sp & 255u) == 0u) { if (xb_ld(&bar[XB_TMO])) break; if (sp > XB_SPIN_CAP) { atomicAdd(&bar[XB_TMO], 1u); break; } }
  }
  nloc = mine > 0u ? mine : 1u; nx = cnt > 0u ? cnt : 1u;
}
__device__ __forceinline__ void xcd_barrier(const XcdBarrier& b) {
  asm volatile("s_waitcnt vmcnt(0)" ::: "memory");
  __syncthreads();
  if (threadIdx.x == 0) {
    unsigned* bar = b.bar;
    __builtin_amdgcn_s_waitcnt(0);
    unsigned nloc = b.st[0], nx = b.st[1];
    if (nloc == 0u) { xcd_barrier_complete(bar, b.x, nloc, nx); b.st[0] = nloc; b.st[1] = nx; }
    const unsigned old = xb_add(&bar[XB_XSUB(b.x)], 1u);
    const unsigned gen = old / nloc;
    if (old + 1u == (gen + 1u) * nloc) {
      __builtin_amdgcn_fence(__ATOMIC_RELEASE, "agent");
      asm volatile("s_waitcnt vmcnt(0)" ::: "memory");
      const unsigned og = xb_add(&bar[XB_TOP], 1u);
      const unsigned tg = og / nx;
      if (og + 1u == (tg + 1u) * nx) xb_add(&bar[XB_TOPGEN], 1u);
      else XB_SPIN(xb_ld(&bar[XB_TOPGEN]) == tg, bar);
      __builtin_amdgcn_fence(__ATOMIC_ACQUIRE, "agent");
      xb_add(&bar[XB_XGEN(b.x)], 1u);
      asm volatile("s_waitcnt vmcnt(0)" ::: "memory");
    } else {
      XB_SPIN(xb_ld(&bar[XB_XGEN(b.x)]) == gen, bar);
      __builtin_amdgcn_fence(__ATOMIC_ACQUIRE, "agent");
      asm volatile("s_waitcnt vmcnt(0)" ::: "memory");
    }
  }
  __syncthreads();
}

struct ConvDesc { const float* src; bf16_t* dst; const float* kscale; int K, Ndst, srcld, mode, kb, nb; };
constexpr int CV_U_IN = 16 * 11, CV_U_OUT = 16 * 4, CV_U_UQ = 4 * 2, CV_U_UKV = 2 * 2;
constexpr int CV_SMALL = 2 * (CV_U_IN + CV_U_OUT + CV_U_UQ + CV_U_UKV);
__device__ __forceinline__ bool conv_desc(const Params& p, int u, ConvDesc& d) {
  unsigned char* ws = p.ws;
  constexpr int T_IN = 2 * CV_U_IN, T_OUT = 2 * CV_U_OUT, T_UQ = 2 * CV_U_UQ;
  const float* src; bf16_t* dst; const float* ksc = nullptr; int K, Ndst, srcld, mode, q, nbn;
  int r = u;
  if (r < T_IN) { const int inst = r / CV_U_IN; q = r % CV_U_IN; src = p.w_in + (size_t)inst * 1024 * 2724; dst = (bf16_t*)(ws + OFF_WIN) + (size_t)inst * NP * 1024; K = 1024; Ndst = NP; srcld = 2724; mode = 1; nbn = 11; }
  else if ((r -= T_IN) < T_OUT) { const int inst = r / CV_U_OUT; q = r % CV_U_OUT; src = p.w_out + (size_t)inst * 1024 * 1024; dst = (bf16_t*)(ws + OFF_WOUT) + (size_t)inst * 1024 * 1024; K = 1024; Ndst = 1024; srcld = 1024; mode = 0; nbn = 4; }
  else if ((r -= T_OUT) < T_UQ) { const int inst = r / CV_U_UQ; q = r % CV_U_UQ; src = p.mla_w_uq + (size_t)inst * 256 * 384; dst = (bf16_t*)(ws + OFF_WUQ) + (size_t)inst * 384 * 256; K = 256; Ndst = 384; srcld = 384; mode = 0; nbn = 2; ksc = p.mla_q_norm_g + inst * 256; }
  else { r -= T_UQ; const int inst = r / CV_U_UKV; q = r % CV_U_UKV; src = p.mla_w_ukv + (size_t)inst * 128 * 512; dst = (bf16_t*)(ws + OFF_WUKV) + (size_t)inst * 512 * 128; K = 128; Ndst = 512; srcld = 512; mode = 0; nbn = 2; ksc = p.mla_kv_norm_g + inst * 128; }
  d.src = src; d.dst = dst; d.kscale = ksc; d.K = K; d.Ndst = Ndst; d.srcld = srcld; d.mode = mode; d.kb = q / nbn; d.nb = q % nbn;
  return u < CV_SMALL;
}
__device__ __forceinline__ void conv_load(const ConvDesc& d, float (&v)[4][8], int lane, int w) {
  const int k0 = d.kb * 64 + 8 * w;
#pragma unroll
  for (int u = 0; u < 4; ++u) {
    const int n = d.nb * 256 + u * 64 + lane;
    int sc = n; bool ok = n < d.Ndst;
    if (d.mode == 1) { if (n < 2304) sc = n; else if (n < C_FXF) sc = n + 4; else if (n < C_END) sc = 2304 + (n - C_FXF); else ok = false; }
    const float* sp = d.src + (size_t)k0 * d.srcld + sc;
#pragma unroll
    for (int j = 0; j < 8; ++j) v[u][j] = ok ? __builtin_nontemporal_load(sp + (size_t)j * d.srcld) : 0.f;
  }
}
__device__ __forceinline__ void conv_store(const ConvDesc& d, const float (&v)[4][8], int lane, int w) {
  const int k0 = d.kb * 64 + 8 * w;
#pragma unroll
  for (int u = 0; u < 4; ++u) {
    const int n = d.nb * 256 + u * 64 + lane;
    if (n < d.Ndst) {
      int dr = n;
      if (d.mode == 2) { const int j = n & 1023; dr = (j >> 4) * 32 + (j & 15) + ((n >= 1024) ? 16 : 0); }
      float g[8];
#pragma unroll
      for (int j = 0; j < 8; ++j) g[j] = d.kscale ? d.kscale[k0 + j] : 1.f;
      u32x4 o; o.x = cvtpk(v[u][0] * g[0], v[u][1] * g[1]); o.y = cvtpk(v[u][2] * g[2], v[u][3] * g[3]); o.z = cvtpk(v[u][4] * g[4], v[u][5] * g[5]); o.w = cvtpk(v[u][6] * g[6], v[u][7] * g[7]);
      *(u32x4*)(d.dst + (size_t)dr * d.K + k0) = o;
    }
  }
}
__device__ __forceinline__ void phase_convert(const Params& p) {
  const int tid = get_tid(), lane = tid & 63, w = tid >> 6;
  const int G = get_nblk();
  for (int u = get_bid(); u < CV_SMALL; u += G) {
    ConvDesc d; float va[4][8];
    conv_desc(p, u, d);
    conv_load(d, va, lane, w);
    conv_store(d, va, lane, w);
  }
}

__device__ __forceinline__ void ln_row(f32x4 (&v)[4], const float* g, const float* b, int lane) {
  float s = 0.f;
#pragma unroll
  for (int j = 0; j < 4; ++j) s += (v[j].x + v[j].y) + (v[j].z + v[j].w);
  const float mean = wave_sum(s) * (1.f / DM);
  float s2 = 0.f;
#pragma unroll
  for (int j = 0; j < 4; ++j) { v[j] = v[j] - mean; s2 += (v[j].x * v[j].x + v[j].y * v[j].y) + (v[j].z * v[j].z + v[j].w * v[j].w); }
  const float rstd = rsqrtf(wave_sum(s2) * (1.f / DM) + LN_EPS);
#pragma unroll
  for (int j = 0; j < 4; ++j) {
    const f32x4 gg = *(const f32x4*)(g + 4 * lane + 256 * j), bb = *(const f32x4*)(b + 4 * lane + 256 * j);
    v[j] = v[j] * rstd * gg + bb;
  }
}
__device__ __forceinline__ void store_row_f32_bf16(const f32x4 (&v)[4], float* of, bf16_t* ob, int lane) {
#pragma unroll
  for (int j = 0; j < 4; ++j) {
    if (of) *(f32x4*)(of + 4 * lane + 256 * j) = v[j];
    if (ob) { u32x2 w; w.x = cvtpk(v[j].x, v[j].y); w.y = cvtpk(v[j].z, v[j].w); *(u32x2*)(ob + 4 * lane + 256 * j) = w; }
  }
}

__device__ __forceinline__ void phase_prologue_misc(const Params& p) {
  unsigned char* ws = p.ws;
  const int lane = get_tid() & 63, gw = get_bid() * 8 + (get_tid() >> 6), ngw = get_nblk() * 8;
  float* hF = (float*)(ws + OFF_HF); bf16_t* hB = (bf16_t*)(ws + OFF_HB);
  for (int m = gw; m < M_TOK; m += ngw) {
    f32x4 v[4];
#pragma unroll
    for (int j = 0; j < 4; ++j) v[j] = *(const f32x4*)(p.x + (size_t)m * DM + 4 * lane + 256 * j);
    ln_row(v, p.ln_in_g, p.ln_in_b, lane);
    store_row_f32_bf16(v, nullptr, hB + (size_t)m * DM, lane);
  }
  f32x2* cs = (f32x2*)(ws + OFF_ROPE);
  const int gt = get_bid() * 512 + get_tid(), ngt = get_nblk() * 512;
  for (int i = gt; i < M_TOK * 16; i += ngt) {
    const int m = i >> 4, f = i & 15;
    const double invf = exp2(-(double)f * (13.287712379549449 / 16.0));
    double a = (double)p.pos[m] * invf;
    a = a - 6.283185307179586476925 * rint(a * 0.15915494309189533577);
    float sn, cn; __sincosf((float)a, &sn, &cn);
    cs[i] = (f32x2){cn, sn};
  }
  if (get_bid() == 0 && get_tid() < DEPTH) {
    const int l = get_tid(); const float* lp = p.diff_lambda + l * 128;
    float s1 = 0.f, s2 = 0.f;
    for (int i = 0; i < 32; ++i) { s1 += lp[i] * lp[32 + i]; s2 += lp[64 + i] * lp[96 + i]; }
    const float linit = 0.8f - 0.6f * expf(-0.3f * (float)l);
    ((float*)(ws + OFF_CTRL))[CW_LAM + l] = expf(s1) - expf(s2) + linit;
  }
}

struct GemmDesc { const bf16_t* A; int lda; const int* rowidx; int row0; int mvalid; const bf16_t* Bt; int ldb; int K; };

template <int NI>
__device__ __forceinline__ void gemm_tile(LAS unsigned char* lds, const GemmDesc& g, f32x16 (&acc)[2][NI]) {
  constexpr int BN = 64 * NI;
  constexpr int A_BYTES = 256 * 128, B_BYTES = BN * 128, STAGE = A_BYTES + B_BYTES;
  constexpr int NBL = BN / 64;
  const int tid = get_tid(), lane = tid & 63, w = tid >> 6, wm = w >> 1, wn = w & 1, c31 = lane & 31, hi = lane >> 5;
  const int lr = tid >> 3, lc = (tid & 7) ^ ((tid >> 4) & 7);
  const bf16_t* ap[4];
#pragma unroll
  for (int i = 0; i < 4; ++i) {
    const int r = lr + 64 * i;
    int row;
    if (g.rowidx) row = g.rowidx[g.row0 + (r < g.mvalid ? r : 0)]; else row = g.row0 + r;
    ap[i] = g.A + (size_t)row * g.lda + lc * 8;
  }
  const bf16_t* bp = g.Bt + (size_t)lr * g.ldb + lc * 8;
  const int wbase = w * 1024;
  const int xr = (lane >> 1) & 7;
  int roff[4];
#pragma unroll
  for (int ks = 0; ks < 4; ++ks) roff[ks] = ((2 * ks + hi) ^ xr) << 4;
  const int a_base = (wm * 64 + c31) * 128, b_base = A_BYTES + (wn * 32 * NI + c31) * 128;
#pragma unroll
  for (int mi = 0; mi < 2; ++mi)
#pragma unroll
    for (int ni = 0; ni < NI; ++ni)
#pragma unroll
      for (int r = 0; r < 16; ++r) acc[mi][ni][r] = 0.f;
  const int nk = g.K >> 6;
#define GT_STAGE(stg, ko) do { LAS unsigned char* s_ = lds + (stg) * STAGE + wbase; \
    _Pragma("unroll") for (int i = 0; i < 4; ++i) __builtin_amdgcn_global_load_lds((const unsigned*)(ap[i] + (ko)), (LAS unsigned*)(s_ + 8192 * i), 16, 0, 0); \
    _Pragma("unroll") for (int i = 0; i < NBL; ++i) __builtin_amdgcn_global_load_lds((const unsigned*)(bp + (size_t)(64 * i) * g.ldb + (ko)), (LAS unsigned*)(s_ + A_BYTES + 8192 * i), 16, 0, 0); } while (0)
  GT_STAGE(0, 0);
  __syncthreads();
  bf16x8 af[2][2], bfr[2][NI];
  for (int kt = 0; kt < nk; ++kt) {
    LAS unsigned char* cur = lds + (kt & 1) * STAGE;
    if (kt + 1 < nk) GT_STAGE((kt + 1) & 1, (kt + 1) * 64);
#pragma unroll
    for (int mi = 0; mi < 2; ++mi) af[0][mi] = *(const LAS bf16x8*)(cur + a_base + mi * 4096 + roff[0]);
#pragma unroll
    for (int ni = 0; ni < NI; ++ni) bfr[0][ni] = *(const LAS bf16x8*)(cur + b_base + ni * 4096 + roff[0]);
#pragma unroll
    for (int ks = 0; ks < 4; ++ks) {
      if (ks < 3) {
#pragma unroll
        for (int mi = 0; mi < 2; ++mi) af[(ks + 1) & 1][mi] = *(const LAS bf16x8*)(cur + a_base + mi * 4096 + roff[ks + 1]);
#pragma unroll
        for (int ni = 0; ni < NI; ++ni) bfr[(ks + 1) & 1][ni] = *(const LAS bf16x8*)(cur + b_base + ni * 4096 + roff[ks + 1]);
      }
      __builtin_amdgcn_s_setprio(1);
#pragma unroll
      for (int mi = 0; mi < 2; ++mi)
#pragma unroll
        for (int ni = 0; ni < NI; ++ni) acc[mi][ni] = __builtin_amdgcn_mfma_f32_32x32x16_bf16(bfr[ks & 1][ni], af[ks & 1][mi], acc[mi][ni], 0, 0, 0);
      __builtin_amdgcn_s_setprio(0);
    }
    __syncthreads();
  }
#undef GT_STAGE
}


namespace pg8 {
typedef float f32x4v __attribute__((ext_vector_type(4)));
constexpr int BM = 256, BK = 64, HALF = 128, HTB = HALF * BK * 2, STAGE_BYTES = 8 * HTB, KK = 1024;
typedef int v8i_t __attribute__((ext_vector_type(8)));
typedef int v4i_t __attribute__((ext_vector_type(4)));
__device__ __forceinline__ v8i_t cat8(bf16x8 a, bf16x8 b) { const v4i_t x = __builtin_bit_cast(v4i_t, a), y = __builtin_bit_cast(v4i_t, b); return __builtin_shufflevector(x, y, 0, 1, 2, 3, 4, 5, 6, 7); }
__device__ __forceinline__ int lds_byte(int r, int c) { const int st = (r >> 4) * 2 + (c >> 5), rr = r & 15, cc = c & 31, ob = rr * 64 + cc * 2; return st * 1024 + (ob ^ (((ob >> 9) & 1) << 5)); }
__device__ __forceinline__ void stage_rc(int b, int& R, int& C) { const int st = b / 1024, sb = b % 1024, swz = sb ^ (((sb >> 9) & 1) << 5); R = (st >> 1) * 16 + swz / 64; C = (st & 1) * 32 + (swz % 64) / 2; }
struct Unit { unsigned boff; int arow0; int mvalid; int e, mt, nt, slot0; };
template <bool GATHER, bool FP8, class Sched, class Epi>
__device__ __forceinline__ void gemm_phase(LAS unsigned char* lds, const bf16_t* Abuf, const bf16_t* Bbuf, const Sched& S, const Epi& E) {
  const int tid = get_tid(), wid = __builtin_amdgcn_readfirstlane(tid >> 6), lane = tid & 63, wr = wid >> 2, wc = wid & 3, fr = lane & 15, fq = lane >> 4;
  const __amdgpu_buffer_rsrc_t rsA = __builtin_amdgcn_make_buffer_rsrc((void*)Abuf, (short)0, 0x7ffffff0, 0x00020000);
  const __amdgpu_buffer_rsrc_t rsB = __builtin_amdgcn_make_buffer_rsrc((void*)Bbuf, (short)0, 0x7ffffff0, 0x00020000);
  constexpr int RS = FP8 ? KK : 2 * KK;
  constexpr int NT_K = FP8 ? 8 : 16;
  const int lrow = (wid >> 1) * 16 + (lane >> 2);
  const int cbyte = (wid & 1) * 64 + (((lane & 3) * 16) ^ (((lane >> 5) & 1) << 5));
  const unsigned vB = (unsigned)(lrow * RS + cbyte);
  const LAS int* rowtab = (const LAS int*)(lds + LDS_ROWTAB) + lrow;
#define PG8_ROWS(V, u) do { if (GATHER) { _Pragma("unroll") for (int h_ = 0; h_ < 2; ++h_) _Pragma("unroll") for (int i_ = 0; i_ < 2; ++i_) \
      V[h_][i_] = (unsigned)(rowtab[(u).arow0 * 256 + h_ * HALF + i_ * 64] * RS + cbyte); } } while (0)
#define PG8_ABASE(u) (GATHER ? 0u : (unsigned)(u).arow0 * (unsigned)RS)
  constexpr unsigned kstep = BK * 2;
  const unsigned ldsw = (unsigned)wid * 1024u;
  const int aoff = lds_byte(wr * 64 + fr, fq * 8), boff = lds_byte(wc * 32 + fr, fq * 8);
#define PG8_SA(b, h) (((b) * 2 + (h)) * HTB)
#define PG8_SB(b, h) ((4 + (b) * 2 + (h)) * HTB)
#define PG8_LOAD1(rs, ldsoff, voff, soff) __builtin_amdgcn_raw_ptr_buffer_load_lds(rs, (LAS void*)(lds + (ldsoff) + ldsw), 16, (int)(voff), (int)(soff), 0, 0)
#define PG8_STAGE_B(bufoff, soff, h) do { PG8_LOAD1(rsB, (bufoff), vB, (soff) + (unsigned)((h) * HALF * RS)); PG8_LOAD1(rsB, (bufoff) + 8192, vB, (soff) + (unsigned)(((h) * HALF + 64) * RS)); } while (0)
#define PG8_STAGE_A(bufoff, soff, h, v0, v1) do { if (GATHER) { PG8_LOAD1(rsA, (bufoff), (v0), (soff)); PG8_LOAD1(rsA, (bufoff) + 8192, (v1), (soff)); } \
    else { PG8_LOAD1(rsA, (bufoff), vB, (soff) + (unsigned)((h) * HALF * RS)); PG8_LOAD1(rsA, (bufoff) + 8192, vB, (soff) + (unsigned)(((h) * HALF + 64) * RS)); } } while (0)
#define PG8_LDA(dst, b, h) do { if (FP8) { _Pragma("unroll") for (int m = 0; m < 4; ++m) { \
      const v4i_t lo_ = *(const LAS v4i_t*)(lds + PG8_SA(b, h) + aoff + m * 2048), hi_ = *(const LAS v4i_t*)(lds + PG8_SA(b, h) + aoff + m * 2048 + 1024); \
      dst##8[m] = __builtin_shufflevector(lo_, hi_, 0, 1, 2, 3, 4, 5, 6, 7); } } \
    else { _Pragma("unroll") for (int m = 0; m < 4; ++m) _Pragma("unroll") for (int k = 0; k < 2; ++k) dst[m][k] = *(const LAS bf16x8*)(lds + PG8_SA(b, h) + aoff + m * 2048 + k * 1024); } } while (0)
#define PG8_LDB(dst, b, h) do { if (FP8) { _Pragma("unroll") for (int n = 0; n < 2; ++n) { \
      const v4i_t lo_ = *(const LAS v4i_t*)(lds + PG8_SB(b, h) + boff + n * 2048), hi_ = *(const LAS v4i_t*)(lds + PG8_SB(b, h) + boff + n * 2048 + 1024); \
      dst##8[n] = __builtin_shufflevector(lo_, hi_, 0, 1, 2, 3, 4, 5, 6, 7); } } \
    else { _Pragma("unroll") for (int n = 0; n < 2; ++n) _Pragma("unroll") for (int k = 0; k < 2; ++k) dst[n][k] = *(const LAS bf16x8*)(lds + PG8_SB(b, h) + boff + n * 2048 + k * 1024); } } while (0)
#define PG8_MMA(ai, bj, At, Bt) do { __builtin_amdgcn_s_setprio(1); _Pragma("unroll") for (int m = 0; m < 4; ++m) _Pragma("unroll") for (int n = 0; n < 2; ++n) { \
    if (FP8) asm volatile("v_mfma_scale_f32_16x16x128_f8f6f4 %0, %1, %2, %0, %3, %3 op_sel_hi:[0,0,0]" : "+v"(acc[ai][bj][m][n]) : "v"(Bt##8[n]), "v"(At##8[m]), "v"(sc1));   \
    else { _Pragma("unroll") for (int k = 0; k < 2; ++k) acc[ai][bj][m][n] = __builtin_amdgcn_mfma_f32_16x16x32_bf16(Bt[n][k], At[m][k], acc[ai][bj][m][n], 0, 0, 0); } } \
    __builtin_amdgcn_s_setprio(0); } while (0)
#define PG8_WAIT_V(n) asm volatile("s_waitcnt vmcnt(" #n ")" ::: "memory")
#define PG8_WAIT_L(n) asm volatile("s_waitcnt lgkmcnt(" #n ")" ::: "memory")
#define PG8_BAR __builtin_amdgcn_s_barrier()
#define PG8_SCHED __builtin_amdgcn_sched_barrier(0)
  Unit cur, nxt; int ui = 0;
  if (!S.next(0, cur)) return;
  f32x4v acc[2][2][4][2];
#pragma unroll
  for (int a = 0; a < 2; ++a)
#pragma unroll
    for (int b = 0; b < 2; ++b)
#pragma unroll
      for (int m = 0; m < 4; ++m)
#pragma unroll
        for (int n = 0; n < 2; ++n) acc[a][b][m][n] = (f32x4v){0.f, 0.f, 0.f, 0.f};
  unsigned sc1 = 0x7f7f7f7fu; asm volatile("" : "+v"(sc1));
  bf16x8 At[4][2], B0[2][2], B1[2][2];
  v8i_t At8[4], B08[2], B18[2];
  unsigned cV[2][2];
#pragma unroll
  for (int h = 0; h < 2; ++h)
#pragma unroll
    for (int i = 0; i < 2; ++i) cV[h][i] = 0u;
  PG8_ROWS(cV, cur);
  unsigned cA = PG8_ABASE(cur), cB = cur.boff;
  PG8_STAGE_B(PG8_SB(0, 0), cB, 0); PG8_STAGE_B(PG8_SB(0, 1), cB, 1);
  PG8_STAGE_A(PG8_SA(0, 0), cA, 0, cV[0][0], cV[0][1]); PG8_STAGE_A(PG8_SA(0, 1), cA, 1, cV[1][0], cV[1][1]);
  if (wr == 1) PG8_BAR;
  PG8_WAIT_V(2); PG8_BAR;
  PG8_STAGE_B(PG8_SB(1, 0), cB + kstep, 0); PG8_STAGE_A(PG8_SA(1, 0), cA + kstep, 0, cV[0][0], cV[0][1]); PG8_STAGE_B(PG8_SB(1, 1), cB + kstep, 1);
  PG8_WAIT_V(6); PG8_BAR;
  for (;;) {
    const bool has_next = S.next(ui + 1, nxt);
    const unsigned nB = has_next ? nxt.boff : cB;
    const unsigned nA = has_next ? PG8_ABASE(nxt) : cA;
#pragma unroll 1
    for (int t = 0; t < NT_K; t += 2) {
      const bool last = (t == NT_K - 2);
      const unsigned a1 = cA + (unsigned)(t + 1) * kstep;
      const unsigned a2 = last ? nA : cA + (unsigned)(t + 2) * kstep, b2 = last ? nB : cB + (unsigned)(t + 2) * kstep;
      const unsigned a3 = a2 + kstep, b3 = b2 + kstep;
      unsigned w00 = cV[0][0], w01 = cV[0][1], w10 = cV[1][0], w11 = cV[1][1];
      if (GATHER && last && has_next) { unsigned nV[2][2]; PG8_ROWS(nV, nxt); w00 = nV[0][0]; w01 = nV[0][1]; w10 = nV[1][0]; w11 = nV[1][1]; }
      PG8_LDB(B0, 0, 0); PG8_LDB(B1, 0, 1); PG8_SCHED; PG8_LDA(At, 0, 0); PG8_STAGE_A(PG8_SA(1, 1), a1, 1, cV[1][0], cV[1][1]);
      PG8_WAIT_V(8); PG8_WAIT_L(0); PG8_BAR; PG8_MMA(0, 0, At, B0); PG8_MMA(0, 1, At, B1); PG8_BAR; PG8_SCHED;
      PG8_LDA(At, 0, 1); PG8_STAGE_B(PG8_SB(0, 0), b2, 0); PG8_STAGE_B(PG8_SB(0, 1), b2, 1); PG8_STAGE_A(PG8_SA(0, 0), a2, 0, w00, w01);
      PG8_WAIT_V(8); PG8_WAIT_L(0); PG8_BAR; PG8_MMA(1, 0, At, B0); PG8_MMA(1, 1, At, B1); PG8_BAR; PG8_SCHED;
      PG8_LDB(B0, 1, 0); PG8_LDB(B1, 1, 1); PG8_SCHED; PG8_LDA(At, 1, 0); PG8_STAGE_A(PG8_SA(0, 1), a2, 1, w10, w11);
      PG8_WAIT_V(8); PG8_WAIT_L(0); PG8_BAR; PG8_MMA(0, 0, At, B0); PG8_MMA(0, 1, At, B1); PG8_BAR; PG8_SCHED;
      PG8_LDA(At, 1, 1); PG8_STAGE_B(PG8_SB(1, 0), b3, 0); PG8_STAGE_B(PG8_SB(1, 1), b3, 1); PG8_STAGE_A(PG8_SA(1, 0), a3, 0, w00, w01);
      PG8_WAIT_V(8); PG8_WAIT_L(0); PG8_BAR; PG8_MMA(1, 0, At, B0); PG8_MMA(1, 1, At, B1); PG8_BAR; PG8_SCHED;
    }
    if (wr == 0) PG8_BAR;
    if (FP8) asm volatile("s_nop 15\n\ts_nop 15" ::: "memory");
    E(acc, cur, wr, wc, fr, fq);
    if (!has_next) break;
#pragma unroll
    for (int a = 0; a < 2; ++a)
#pragma unroll
      for (int b = 0; b < 2; ++b)
#pragma unroll
        for (int m = 0; m < 4; ++m)
#pragma unroll
          for (int n = 0; n < 2; ++n) acc[a][b][m][n] = (f32x4v){0.f, 0.f, 0.f, 0.f};
    if (FP8) asm volatile("s_nop 7" ::: "memory");
    cur = nxt; cB = nB; cA = nA; ++ui;
    PG8_ROWS(cV, cur);
    if (wr == 1) PG8_BAR;
  }
  PG8_WAIT_V(0);
  PG8_BAR;
#undef PG8_ROWS
#undef PG8_ABASE
#undef PG8_SA
#undef PG8_SB
#undef PG8_LOAD1
#undef PG8_STAGE_A
#undef PG8_STAGE_B
#undef PG8_LDA
#undef PG8_LDB
#undef PG8_MMA
#undef PG8_WAIT_V
#undef PG8_WAIT_L
#undef PG8_BAR
#undef PG8_SCHED
}
}

struct InprojSched {
  int grid, bid;
  __device__ __forceinline__ bool next(int i, pg8::Unit& u) const {
    constexpr int NT = NP / 256;
    int mt, nt;
    if (grid == 256) { const int xcd = bid & 7, j = bid >> 3, q = j + 32 * i; if (q >= 8 * NT) return false; mt = 8 * xcd + q / NT; nt = q % NT; }
    else { const int t = bid + i * grid; if (t >= 64 * NT) return false; mt = t / NT; nt = t % NT; }
    u.boff = (unsigned)nt * (256u * 1024u * 2u); u.arow0 = mt * 256; u.mvalid = 256; u.e = 0; u.mt = mt; u.nt = nt; u.slot0 = 0;
    return true;
  }
};
struct InprojEpi {
  bf16_t* P; float* gateF; const f32x2* cs; float* ssq;
  __device__ __forceinline__ void operator()(const pg8::f32x4v (&acc)[2][2][4][2], const pg8::Unit& u, int wr, int wc, int fr, int fq) const {
    const int nt = u.nt;
    const bool rope_all = (nt == 3) || (nt == 4);
#pragma unroll
    for (int ai = 0; ai < 2; ++ai)
#pragma unroll
      for (int m = 0; m < 4; ++m) {
        const int row = u.mt * 256 + 128 * ai + 64 * wr + 16 * m + fr;
        bf16_t* prow = P + (size_t)row * NP + nt * 256 + 32 * wc + 4 * fq;
        f32x2 c4[4];
        if (rope_all || nt == 10) {
#pragma unroll
          for (int j = 0; j < 4; ++j) c4[j] = cs[(size_t)row * 16 + 4 * fq + j];
        }
        float sq = 0.f;
#pragma unroll
        for (int bj = 0; bj < 2; ++bj) {
          pg8::f32x4v v0 = acc[ai][bj][m][0], v1 = acc[ai][bj][m][1];
          if (rope_all || (nt == 10 && bj == 1 && wc == 0)) {
#pragma unroll
            for (int j = 0; j < 4; ++j) { const float x1 = v0[j], x2 = v1[j]; v0[j] = x1 * c4[j].x - x2 * c4[j].y; v1[j] = x2 * c4[j].x + x1 * c4[j].y; }
          }
          if (nt == 9 || (nt == 10 && bj == 0)) {
#pragma unroll
            for (int j = 0; j < 4; ++j) sq += v0[j] * v0[j] + v1[j] * v1[j];
          }
          u32x2 o; o.x = cvtpk(v0[0], v0[1]); o.y = cvtpk(v0[2], v0[3]);
          *(u32x2*)(prow + 128 * bj) = o;
          o.x = cvtpk(v1[0], v1[1]); o.y = cvtpk(v1[2], v1[3]);
          *(u32x2*)(prow + 128 * bj + 16) = o;
          if (nt == 10 && bj == 1 && wc == 1 && fq == 0) *(f32x4*)(gateF + (size_t)row * 4) = (f32x4){v0[0], v0[1], v0[2], v0[3]};
        }
        if (nt == 9 || nt == 10) {
          sq += __shfl_xor(sq, 16); sq += __shfl_xor(sq, 32);
          if (fq == 0) ssq[(size_t)row * 8 + (nt == 9 ? 0 : 4) + wc] = sq;
        }
      }
  }
};
__device__ __forceinline__ void phase_inproj(const Params& p, int layer, LAS unsigned char* lds) {
  unsigned char* ws = p.ws;
  InprojSched S{get_nblk(), get_bid()};
  InprojEpi E{(bf16_t*)(ws + OFF_P), (float*)(ws + OFF_GATEF), (const f32x2*)(ws + OFF_ROPE), (float*)(ws + OFF_CQN)};
  pg8::gemm_phase<false, false>(lds, (const bf16_t*)(ws + OFF_HB), (const bf16_t*)(ws + OFF_WIN) + (size_t)layer * NP * 1024, S, E);
}

__device__ __forceinline__ void rope4(bf16_t* base, const f32x2* cs4) {
  const u32x2 a = *(const u32x2*)base, b = *(const u32x2*)(base + 16);
  float x1[4] = {bflo(a.x), bfhi(a.x), bflo(a.y), bfhi(a.y)}, x2[4] = {bflo(b.x), bfhi(b.x), bflo(b.y), bfhi(b.y)};
  float y1[4], y2[4];
#pragma unroll
  for (int i = 0; i < 4; ++i) { const f32x2 c = cs4[i]; y1[i] = x1[i] * c.x - x2[i] * c.y; y2[i] = x2[i] * c.x + x1[i] * c.y; }
  u32x2 oa, ob; oa.x = cvtpk(y1[0], y1[1]); oa.y = cvtpk(y1[2], y1[3]); ob.x = cvtpk(y2[0], y2[1]); ob.y = cvtpk(y2[2], y2[3]);
  *(u32x2*)base = oa; *(u32x2*)(base + 16) = ob;
}
__device__ __forceinline__ void phase_post(const Params& p, int layer, LAS unsigned char* lds) {
  unsigned char* ws = p.ws;
  bf16_t* P = (bf16_t*)(ws + OFF_P);
  const f32x2* cs = (const f32x2*)(ws + OFF_ROPE);
  bf16_t* cqn = (bf16_t*)(ws + OFF_CQN); bf16_t* ckvn = (bf16_t*)(ws + OFF_CKVN);
  const int lane = get_tid() & 63, gw = get_bid() * 8 + (get_tid() >> 6), ngw = get_nblk() * 8;
  const float* gq = p.mla_q_norm_g + layer * 256; const float* gkv = p.mla_kv_norm_g + layer * 128;
  for (int m = gw; m < M_TOK; m += ngw) {
    bf16_t* row = P + (size_t)m * NP;
    const f32x2* csm = cs + (size_t)m * 16;
    { const int sh = lane >> 2, pg = lane & 3; rope4(row + C_DFQ + sh * 32 + 4 * pg, csm + 4 * pg); }
    if (lane < 4) rope4(row + C_KR + 4 * lane, csm + 4 * lane);
    {
      const u32x2 a = *(const u32x2*)(row + C_CQ + 4 * lane);
      float x[4] = {bflo(a.x), bfhi(a.x), bflo(a.y), bfhi(a.y)};
      const float ss = wave_sum(x[0] * x[0] + x[1] * x[1] + x[2] * x[2] + x[3] * x[3]);
      const float rs = rsqrtf(ss * (1.f / 256.f) + RMS_EPS);
      const f32x4 gg = *(const f32x4*)(gq + 4 * lane);
      u32x2 o; o.x = cvtpk(x[0] * rs * gg.x, x[1] * rs * gg.y); o.y = cvtpk(x[2] * rs * gg.z, x[3] * rs * gg.w);
      *(u32x2*)(cqn + (size_t)m * 256 + 4 * lane) = o;
    }
    {
      const unsigned a = *(const unsigned*)(row + C_CKV + 2 * lane);
      const float x0 = bflo(a), x1 = bfhi(a);
      const float ss = wave_sum(x0 * x0 + x1 * x1);
      const float rs = rsqrtf(ss * (1.f / 128.f) + RMS_EPS);
      const f32x2 gg = *(const f32x2*)(gkv + 2 * lane);
      *(unsigned*)(ckvn + (size_t)m * 128 + 2 * lane) = cvtpk(x0 * rs * gg.x, x1 * rs * gg.y);
    }
  }
  if (get_bid() < 16) {
    const int b = get_bid() >> 2, h = get_bid() & 3, tid = get_tid();
    const float* gateF = (const float*)(ws + OFF_GATEF);
    float* Fk = (float*)(ws + OFF_FK) + (size_t)get_bid() * SEQ;
    const float bf = p.b_forget[layer * 4 + h];
    LAS float* sc = (LAS float*)lds;
    float v[8]; float run = 0.f;
#pragma unroll
    for (int i = 0; i < 8; ++i) {
      const float xx = gateF[(size_t)(b * SEQ + tid * 8 + i) * 4 + h] + bf;
      const float ls = fminf(xx, 0.f) - log1pf(expf(-fabsf(xx)));
      run += ls; v[i] = run;
    }
    float inc = run;
#pragma unroll
    for (int o = 1; o < 64; o <<= 1) { const float t = __shfl_up(inc, o); if (lane >= o) inc += t; }
    __syncthreads();
    if (lane == 63) sc[tid >> 6] = inc;
    __syncthreads();
    float wbase = 0.f;
    for (int i = 0; i < (tid >> 6); ++i) wbase += sc[i];
    const float excl = wbase + inc - run;
#pragma unroll
    for (int i = 0; i < 8; ++i) Fk[tid * 8 + i] = -8.f * (excl + v[i]);
    __syncthreads();
  }
}

__device__ __forceinline__ void phase_mla_up(const Params& p, int layer, LAS unsigned char* lds) {
  unsigned char* ws = p.ws;
  const bf16_t* P = (const bf16_t*)(ws + OFF_P);
  const float* ssq = (const float*)(ws + OFF_CQN);
  const bf16_t* Wq = (const bf16_t*)(ws + OFF_WUQ) + (size_t)layer * 384 * 256;
  const bf16_t* Wkv = (const bf16_t*)(ws + OFF_WUKV) + (size_t)layer * 512 * 128;
  bf16_t* qd = (bf16_t*)(ws + OFF_QD); bf16_t* kvd = (bf16_t*)(ws + OFF_KVD);
  const int sb = get_bid() - (get_nblk() - 16);
  if (sb >= 0) {
    const int b = sb >> 2, h = sb & 3, tid = get_tid(), lane = tid & 63;
    const float* gateF = (const float*)(ws + OFF_GATEF);
    float* Fk = (float*)(ws + OFF_FK) + (size_t)sb * SEQ;
    const float bf = p.b_forget[layer * 4 + h];
    LAS float* sc = (LAS float*)lds;
    float v[8]; float run = 0.f;
#pragma unroll
    for (int i = 0; i < 8; ++i) {
      const float xx = gateF[(size_t)(b * SEQ + tid * 8 + i) * 4 + h] + bf;
      const float ls = fminf(xx, 0.f) - log1pf(expf(-fabsf(xx)));
      run += ls; v[i] = run;
    }
    float inc = run;
#pragma unroll
    for (int o = 1; o < 64; o <<= 1) { const float t = __shfl_up(inc, o); if (lane >= o) inc += t; }
    __syncthreads();
    if (lane == 63) sc[tid >> 6] = inc;
    __syncthreads();
    float wbase = 0.f;
    for (int i = 0; i < (tid >> 6); ++i) wbase += sc[i];
    const float excl = wbase + inc - run;
#pragma unroll
    for (int i = 0; i < 8; ++i) Fk[tid * 8 + i] = -8.f * (excl + v[i]);
    __syncthreads();
  }
  const int lane = get_tid() & 63, w = get_tid() >> 6, wm = w >> 1, wn = w & 1, c31 = lane & 31, hi = lane >> 5;
  for (int item = get_bid() * 8 + w; item < 16 * 64; item += get_nblk() * 8) {
    const int bh = item >> 6, tl = item & 63, b = bh >> 2, h = bh & 3;
    const bf16_t* kr = P + (size_t)(b * SEQ + 64 * tl + lane) * NP + C_FXK + h * 64;
    float ss = 0.f;
#pragma unroll
    for (int c = 0; c < 8; ++c) {
      const u32x4 x = *(const u32x4*)(kr + 8 * c);
      ss += bflo(x.x) * bflo(x.x) + bfhi(x.x) * bfhi(x.x) + bflo(x.y) * bflo(x.y) + bfhi(x.y) * bfhi(x.y) + bflo(x.z) * bflo(x.z) + bfhi(x.z) * bfhi(x.z) + bflo(x.w) * bflo(x.w) + bfhi(x.w) * bfhi(x.w);
    }
    float nv = sqrtf(ss) * 1.0001f;
#pragma unroll
    for (int o = 1; o < 64; o <<= 1) nv = fmaxf(nv, __shfl_xor(nv, o));
    if (lane == 0) ((float*)(ws + OFF_KN))[item] = nv;
  }
  constexpr int TQ = 64 * 3, TKV = 64 * 4;
  for (int t = get_bid(); t < TQ + TKV; t += get_nblk()) {
    const bool isq = t < TQ; const int tt = isq ? t : t - TQ; const int ntn = isq ? 3 : 4; const int mt = tt / ntn, nt = tt % ntn;
    GemmDesc g;
    if (isq) g = GemmDesc{P + C_CQ, NP, nullptr, mt * 256, 256, Wq + (size_t)nt * 128 * 256, 256, 256};
    else g = GemmDesc{P + C_CKV, NP, nullptr, mt * 256, 256, Wkv + (size_t)nt * 128 * 128, 128, 128};
    f32x16 acc[2][2];
    gemm_tile<2>(lds, g, acc);
    bf16_t* O = isq ? qd : kvd; const int ldo = isq ? 384 : 512;
#pragma unroll
    for (int mi = 0; mi < 2; ++mi) {
      const int m = mt * 256 + wm * 64 + mi * 32 + c31;
      const f32x4 s4 = *(const f32x4*)(ssq + (size_t)m * 8 + (isq ? 0 : 4));
      const float rs = rsqrtf(((s4.x + s4.y) + (s4.z + s4.w)) * (isq ? (1.f / 256.f) : (1.f / 128.f)) + RMS_EPS);
#pragma unroll
      for (int ni = 0; ni < 2; ++ni)
#pragma unroll
        for (int g4 = 0; g4 < 4; ++g4) {
          const int n = nt * 128 + wn * 64 + ni * 32 + 4 * hi + 8 * g4;
          u32x2 o; o.x = cvtpk(acc[mi][ni][4 * g4] * rs, acc[mi][ni][4 * g4 + 1] * rs); o.y = cvtpk(acc[mi][ni][4 * g4 + 2] * rs, acc[mi][ni][4 * g4 + 3] * rs);
          *(u32x2*)(O + (size_t)m * ldo + n) = o;
        }
    }
  }
}

constexpr int CMU_UP = 32 * 8 * 32, CMU_DN = 32 * 8 * 16, CMU_TOTAL = CMU_UP + CMU_DN;
struct ConvCtx { const float* wgu; const float* wdn; unsigned char* dgu; unsigned char* ddn; int* ctr; };
__device__ __forceinline__ void cmu_load(const ConvCtx& c, int idx, int lane, int w, float (&v)[16]) {
  const bool up = idx < CMU_UP;
  const int i2 = up ? idx : idx - CMU_UP;
  const int e = up ? (i2 >> 8) : (i2 >> 7), rem = up ? (i2 & 255) : (i2 & 127);
  const int kb = up ? (rem >> 5) : (rem >> 4), nb = up ? (rem & 31) : (rem & 15);
  const int N = up ? 2048 : 1024;
  const float* base = up ? c.wgu : c.wdn;
  const float* sp = base + ((size_t)e * 1024 + kb * 128 + 16 * w) * N + nb * 64 + lane;
#pragma unroll
  for (int j = 0; j < 16; ++j) v[j] = __builtin_nontemporal_load(sp + (size_t)j * N);
}
__device__ __forceinline__ void cmu_store(const ConvCtx& c, int idx, int lane, int w, const float (&v)[16]) {
  const bool up = idx < CMU_UP;
  const int i2 = up ? idx : idx - CMU_UP;
  const int e = up ? (i2 >> 8) : (i2 >> 7), rem = up ? (i2 & 255) : (i2 & 127);
  const int kb = up ? (rem >> 5) : (rem >> 4), nb = up ? (rem & 31) : (rem & 15);
  const int N = up ? 2048 : 1024;
  const int n = nb * 64 + lane;
  int dr = n;
  if (up) { const int j = n & 1023; dr = (j >> 4) * 32 + (j & 15) + ((n >= 1024) ? 16 : 0); }
  unsigned char* base = up ? c.dgu : c.ddn;
  const float sc = up ? S8_WGU : S8_WDN;
  u32x4 o;
  o.x = pk4_fp8(v[0] * sc, v[1] * sc, v[2] * sc, v[3] * sc); o.y = pk4_fp8(v[4] * sc, v[5] * sc, v[6] * sc, v[7] * sc);
  o.z = pk4_fp8(v[8] * sc, v[9] * sc, v[10] * sc, v[11] * sc); o.w = pk4_fp8(v[12] * sc, v[13] * sc, v[14] * sc, v[15] * sc);
  *(u32x4*)(base + ((size_t)e * N + dr) * 1024 + kb * 128 + 16 * w) = o;
}

__device__ __forceinline__ void cmu_to_lds(const ConvCtx& c, int idx, int lane, int w, const float (&v)[16], LAS unsigned char* tile) {
  const float sc = (idx < CMU_UP) ? S8_WGU : S8_WDN;
  u32x4 o;
  o.x = pk4_fp8(v[0] * sc, v[1] * sc, v[2] * sc, v[3] * sc); o.y = pk4_fp8(v[4] * sc, v[5] * sc, v[6] * sc, v[7] * sc);
  o.z = pk4_fp8(v[8] * sc, v[9] * sc, v[10] * sc, v[11] * sc); o.w = pk4_fp8(v[12] * sc, v[13] * sc, v[14] * sc, v[15] * sc);
  *(LAS u32x4*)(tile + lane * 128 + ((w ^ (lane & 7)) << 4)) = o;
}
__device__ __forceinline__ void cmu_from_lds(const ConvCtx& c, int idx, int lane, int w, const LAS unsigned char* tile) {
  const bool up = idx < CMU_UP;
  const int i2 = up ? idx : idx - CMU_UP;
  const int e = up ? (i2 >> 8) : (i2 >> 7), rem = up ? (i2 & 255) : (i2 & 127);
  const int kb = up ? (rem >> 5) : (rem >> 4), nb = up ? (rem & 31) : (rem & 15);
  const int N = up ? 2048 : 1024;
  const int r = 8 * w + (lane >> 3), ch = lane & 7;
  const u32x4 o = *(const LAS u32x4*)(tile + r * 128 + ((ch ^ (r & 7)) << 4));
  const int n = nb * 64 + r;
  int dr = n;
  if (up) { const int j = n & 1023; dr = (j >> 4) * 32 + (j & 15) + ((n >= 1024) ? 16 : 0); }
  unsigned char* base = up ? c.dgu : c.ddn;
  *(u32x4*)(base + ((size_t)e * N + dr) * 1024 + kb * 128 + 16 * ch) = o;
}

enum { AT_SB = 0, AT_DIFF = 1, AT_FOX = 2, AT_MLA = 3 };
struct AttnArgs {
  const bf16_t* Q; int ldq; const bf16_t* K; int ldk; const bf16_t* V; int ldv; const bf16_t* K2; int ldk2;
  const float* Fk; const f32x2* cs; bf16_t* O; int ldo; float lam, oscale; const float* subg; const float* kn;
};
constexpr int ATT_K1 = 0, ATT_V = 8192, ATT_K2 = 16384, ATT_F = 20480, ATT_BUF = 20992;

__device__ __forceinline__ float max3f(float a, float b, float c) { float r; asm("v_max3_f32 %0, %1, %2, %3" : "=v"(r) : "v"(a), "v"(b), "v"(c)); return r; }
__device__ __forceinline__ float max2f(float a, float b) { float r; asm("v_max_f32_e32 %0, %1, %2" : "=v"(r) : "v"(a), "v"(b)); return r; }
__device__ __forceinline__ bool softmax_tile(f32x16& p0, f32x16& p1, float& m, float& l, float c, bool domask, int kbase, int q, int hi, float& alpha) {
  if (domask) {
#pragma unroll
    for (int r = 0; r < 16; ++r) { const int key = kbase + crow(r, hi); if (key > q) p0[r] = -INFINITY; if (key + 32 > q) p1[r] = -INFINITY; }
  }
  asm volatile("s_nop 15\n\ts_nop 7" : "+v"(p0), "+v"(p1));
  float a = max3f(p0[0], p0[1], p1[0]), b = max3f(p0[2], p0[3], p1[1]); a = max3f(a, p1[2], p1[3]);
#pragma unroll
  for (int r = 4; r < 16; r += 4) { a = max3f(a, p0[r], p0[r + 1]); b = max3f(b, p0[r + 2], p0[r + 3]); a = max3f(a, p1[r], p1[r + 1]); b = max3f(b, p1[r + 2], p1[r + 3]); }
  float a0, a1; pair_vals(max2f(a, b), a0, a1);
  const float rm = max2f(a0, a1);
  const bool resc = __any((rm - m) * c > 8.0f);
  alpha = 1.f;
  if (resc) { const float mn = max2f(m, rm); alpha = __builtin_amdgcn_exp2f((m - mn) * c); l *= alpha; m = mn; }
  const float mc = m * c;
  float s = 0.f;
#pragma unroll
  for (int r = 0; r < 16; ++r) { p0[r] = __builtin_amdgcn_exp2f(fmaf(p0[r], c, -mc)); p1[r] = __builtin_amdgcn_exp2f(fmaf(p1[r], c, -mc)); s += p0[r] + p1[r]; }
  l += s;
  return resc;
}
__device__ __forceinline__ bf16x8 pack8(const f32x16& p, int b) {
  u32x4 w; w.x = cvtpk(p[b], p[b + 1]); w.y = cvtpk(p[b + 2], p[b + 3]); w.z = cvtpk(p[b + 4], p[b + 5]); w.w = cvtpk(p[b + 6], p[b + 7]);
  return __builtin_bit_cast(bf16x8, w);
}
__device__ __forceinline__ bf16x8 vfrag(LAS unsigned char* vb, int off) {
  const s16x4 lo = __builtin_bit_cast(s16x4, __builtin_amdgcn_ds_read_tr16_b64_v4i16((LAS s16x4*)(vb + off)));
  const s16x4 hh = __builtin_bit_cast(s16x4, __builtin_amdgcn_ds_read_tr16_b64_v4i16((LAS s16x4*)(vb + off + 1024)));
  return (bf16x8){lo[0], lo[1], lo[2], lo[3], hh[0], hh[1], hh[2], hh[3]};
}

template <int T>
__device__ __forceinline__ void attn_unit(LAS unsigned char* lds, const AttnArgs& a, int qb, const ConvCtx& cc, int& gi, int& pidx, int& qidx, float (&cv)[16]) {
  const int tid = get_tid(), lane = tid & 63, w = tid >> 6, c31 = lane & 31, hi = lane >> 5;
  const int t0 = qb * 256 + w * 32, q = t0 + c31;
  constexpr int NKS = (T == AT_MLA) ? 6 : 4;
  constexpr float CSC = (T == AT_DIFF) ? 0.17677669529663687f * LOG2E : (T == AT_MLA) ? 0.10206207261596577f * LOG2E : 0.125f * LOG2E;
  bf16x8 qf[NKS];
  {
    const bf16_t* qrow = a.Q + (size_t)q * a.ldq;
#pragma unroll
    for (int ks = 0; ks < NKS; ++ks) qf[ks] = *(const bf16x8*)(qrow + 16 * ks + 8 * hi);
    if (T == AT_MLA) {
      const f32x2* csq = a.cs + (size_t)q * 16 + 8 * hi;
      bf16x8 n4, n5;
#pragma unroll
      for (int j = 0; j < 8; j += 2) {
        const f32x2 c0 = csq[j], c1 = csq[j + 1];
        const float x1a = bf2f((unsigned short)qf[4][j]), x1b = bf2f((unsigned short)qf[4][j + 1]);
        const float x2a = bf2f((unsigned short)qf[5][j]), x2b = bf2f((unsigned short)qf[5][j + 1]);
        const unsigned w1 = cvtpk(x1a * c0.x - x2a * c0.y, x1b * c1.x - x2b * c1.y);
        const unsigned w2 = cvtpk(x2a * c0.x + x1a * c0.y, x2b * c1.x + x1b * c1.y);
        n4[j] = (short)(w1 & 0xffff); n4[j + 1] = (short)(w1 >> 16); n5[j] = (short)(w2 & 0xffff); n5[j + 1] = (short)(w2 >> 16);
      }
      qf[4] = n4; qf[5] = n5;
    }
  }
  const int skey = tid >> 3, sch = tid & 7;
  const int k1_st = ATT_K1 + skey * 128 + ((sch ^ ((skey >> 1) & 7)) << 4);
  const int v_st = ATT_V + skey * 128 + ((sch ^ (((skey >> 1) & 1) << 2)) << 4);
  const int k2key = tid >> 2, k2ch = tid & 3;
  const int k2_st = ATT_K2 + k2key * 64 + ((k2ch ^ ((k2key >> 2) & 3)) << 4);
  const int xr = (lane >> 1) & 7;
  int kro[4];
#pragma unroll
  for (int ks = 0; ks < 4; ++ks) kro[ks] = ATT_K1 + c31 * 128 + (((2 * ks + hi) ^ xr) << 4);
  int k2ro[2];
#pragma unroll
  for (int ks = 0; ks < 2; ++ks) k2ro[ks] = ATT_K2 + c31 * 64 + (((2 * ks + hi) ^ ((c31 >> 2) & 3)) << 4);
  int vro[2];
  {
    const int i = lane & 15, qq = i >> 2, pp = i & 3, gg = (lane >> 4) & 1, bit = (qq >> 1) & 1;
#pragma unroll
    for (int d0 = 0; d0 < 2; ++d0) vro[d0] = ATT_V + (4 * hi + qq) * 128 + ((4 * (d0 ^ bit) + 2 * gg + (pp >> 1)) << 4) + (pp & 1) * 8;
  }
  const int ntiles = 4 * (qb + 1);
  const int wave_last = (t0 + 31) >> 6;
  LAS float* kpre = (LAS float*)(lds + 2 * ATT_BUF + 256);
  LAS float* fend = kpre + 64;
  float qn = 0.f;
  if (T == AT_FOX) {
    if (w == 0) {
      float v = (lane < ntiles) ? a.kn[lane] : 0.f;
#pragma unroll
      for (int o = 1; o < 64; o <<= 1) { const float u_ = __shfl_up(v, o); if (lane >= o) v = fmaxf(v, u_); }
      kpre[lane] = v;
      fend[lane] = (lane < ntiles) ? a.Fk[64 * lane + 63] : 0.f;
    }
    float ss = 0.f;
#pragma unroll
    for (int ks = 0; ks < 4; ++ks)
#pragma unroll
      for (int j = 0; j < 8; ++j) { const float x = bf2f((unsigned short)qf[ks][j]); ss += x * x; }
    float s0_, s1_; pair_vals(ss, s0_, s1_);
    qn = sqrtf(s0_ + s1_) * 1.0001f;
  }
  f32x16 o0[2], o1[2];
#pragma unroll
  for (int d0 = 0; d0 < 2; ++d0)
#pragma unroll
    for (int r = 0; r < 16; ++r) { o0[d0][r] = 0.f; o1[d0][r] = 0.f; }
  float m0 = -INFINITY, l0 = 0.f, m1 = -INFINITY, l1 = 0.f;
  float Crun = 0.f;
  bool fin = false;
  u32x4 rk, rv, rk2; float rf = 0.f;
#define ATT_TILE(it) ((T == AT_SB || T == AT_FOX) ? (ntiles - 1 - (it)) : (it))
#define ATT_GLOAD(t) do { const int key_ = 64 * (t) + skey; \
    rk = *(const u32x4*)(a.K + (size_t)key_ * a.ldk + sch * 8); rv = *(const u32x4*)(a.V + (size_t)key_ * a.ldv + sch * 8); \
    if (T == AT_MLA) { if (tid < 256) rk2 = *(const u32x4*)(a.K2 + (size_t)(64 * (t) + k2key) * a.ldk2 + k2ch * 8); } \
    if (T == AT_FOX) { if (tid < 64) rf = a.Fk[64 * (t) + tid]; } } while (0)
#define ATT_LSTORE(buf) do { LAS unsigned char* b_ = lds + (buf) * ATT_BUF; \
    *(LAS u32x4*)(b_ + k1_st) = rk; *(LAS u32x4*)(b_ + v_st) = rv; \
    if (T == AT_MLA) { if (tid < 256) *(LAS u32x4*)(b_ + k2_st) = rk2; } \
    if (T == AT_FOX) { if (tid < 64) *(LAS float*)(b_ + ATT_F + 4 * tid) = rf; } } while (0)
  LAS int* s_conv = (LAS int*)(lds + 2 * ATT_BUF + 64);
  ATT_GLOAD(ATT_TILE(0));
  ATT_LSTORE(0);
  __syncthreads();
  for (int it = 0; it < ntiles; ++it) {
    const int t = ATT_TILE(it);
    LAS unsigned char* cur = lds + (it & 1) * ATT_BUF;
    const bool more = (it + 1 < ntiles);
    const int cidx = __builtin_amdgcn_readfirstlane(s_conv[(gi >> 3) & 1]) + (gi & 7);
    int cnext = 0;
    const bool cfetch = (gi & 7) == 0;
    if (cfetch && tid == 0) cnext = atomicAdd(cc.ctr, 8);
    if (more) ATT_GLOAD(ATT_TILE(it + 1));
    const bool active = (t <= wave_last) && !fin;
    if (active) {
      const bool domask = (64 * t + 63 > t0);
      const int kbase = 64 * t;
      if (T == AT_DIFF) {
        f32x16 pa0, pa1, pb0, pb1;
#pragma unroll
        for (int r = 0; r < 16; ++r) { pa0[r] = 0.f; pa1[r] = 0.f; pb0[r] = 0.f; pb1[r] = 0.f; }
#pragma unroll
        for (int ks = 0; ks < 2; ++ks) {
          const bf16x8 k0 = *(const LAS bf16x8*)(cur + kro[ks]), k1 = *(const LAS bf16x8*)(cur + kro[ks] + 4096);
          pa0 = __builtin_amdgcn_mfma_f32_32x32x16_bf16(k0, qf[ks], pa0, 0, 0, 0); pa1 = __builtin_amdgcn_mfma_f32_32x32x16_bf16(k1, qf[ks], pa1, 0, 0, 0);
        }
#pragma unroll
        for (int ks = 2; ks < 4; ++ks) {
          const bf16x8 k0 = *(const LAS bf16x8*)(cur + kro[ks]), k1 = *(const LAS bf16x8*)(cur + kro[ks] + 4096);
          pb0 = __builtin_amdgcn_mfma_f32_32x32x16_bf16(k0, qf[ks], pb0, 0, 0, 0); pb1 = __builtin_amdgcn_mfma_f32_32x32x16_bf16(k1, qf[ks], pb1, 0, 0, 0);
        }
        float al0, al1;
        const bool rs0 = softmax_tile(pa0, pa1, m0, l0, CSC, domask, kbase, q, hi, al0);
        const bool rs1 = softmax_tile(pb0, pb1, m1, l1, CSC, domask, kbase, q, hi, al1);
        if (rs0) {
#pragma unroll
          for (int d0 = 0; d0 < 2; ++d0)
#pragma unroll
            for (int r = 0; r < 16; ++r) o0[d0][r] *= al0;
        }
        if (rs1) {
#pragma unroll
          for (int d0 = 0; d0 < 2; ++d0)
#pragma unroll
            for (int r = 0; r < 16; ++r) o1[d0][r] *= al1;
        }
#pragma unroll
        for (int s = 0; s < 4; ++s) {
          const bf16x8 pfa = pack8((s < 2) ? pa0 : pa1, 8 * (s & 1)), pfb = pack8((s < 2) ? pb0 : pb1, 8 * (s & 1));
#pragma unroll
          for (int d0 = 0; d0 < 2; ++d0) {
            const bf16x8 vf = vfrag(cur, vro[d0] + 2048 * s);
            o0[d0] = __builtin_amdgcn_mfma_f32_32x32x16_bf16(vf, pfa, o0[d0], 0, 0, 0);
            o1[d0] = __builtin_amdgcn_mfma_f32_32x32x16_bf16(vf, pfb, o1[d0], 0, 0, 0);
          }
        }
      } else {
        f32x16 p0, p1;
        if (T == AT_FOX) {
#pragma unroll
          for (int g4 = 0; g4 < 4; ++g4) {
            const f32x4 f0 = *(const LAS f32x4*)(cur + ATT_F + (8 * g4 + 4 * hi) * 4), f1 = *(const LAS f32x4*)(cur + ATT_F + (32 + 8 * g4 + 4 * hi) * 4);
            p0[4 * g4] = f0.x; p0[4 * g4 + 1] = f0.y; p0[4 * g4 + 2] = f0.z; p0[4 * g4 + 3] = f0.w;
            p1[4 * g4] = f1.x; p1[4 * g4 + 1] = f1.y; p1[4 * g4 + 2] = f1.z; p1[4 * g4 + 3] = f1.w;
          }
        } else {
#pragma unroll
          for (int r = 0; r < 16; ++r) { p0[r] = 0.f; p1[r] = 0.f; }
        }
#pragma unroll
        for (int ks = 0; ks < 4; ++ks) {
          const bf16x8 k0 = *(const LAS bf16x8*)(cur + kro[ks]), k1 = *(const LAS bf16x8*)(cur + kro[ks] + 4096);
          p0 = __builtin_amdgcn_mfma_f32_32x32x16_bf16(k0, qf[ks], p0, 0, 0, 0); p1 = __builtin_amdgcn_mfma_f32_32x32x16_bf16(k1, qf[ks], p1, 0, 0, 0);
        }
        if (T == AT_MLA) {
#pragma unroll
          for (int ks = 0; ks < 2; ++ks) {
            const bf16x8 k0 = *(const LAS bf16x8*)(cur + k2ro[ks]), k1 = *(const LAS bf16x8*)(cur + k2ro[ks] + 2048);
            p0 = __builtin_amdgcn_mfma_f32_32x32x16_bf16(k0, qf[(NKS == 6) ? 4 + ks : ks], p0, 0, 0, 0);
            p1 = __builtin_amdgcn_mfma_f32_32x32x16_bf16(k1, qf[(NKS == 6) ? 4 + ks : ks], p1, 0, 0, 0);
          }
        }
        if (T == AT_SB) {
          f32x16 e0, e1;
          float T8[8];
#pragma unroll
          for (int half = 0; half < 2; ++half) {
            f32x16& pp = half ? p1 : p0; f32x16& ee = half ? e1 : e0;
#pragma unroll
            for (int r = 0; r < 16; ++r) {
              const float z2 = pp[r] * CSC;
              float lk = -__builtin_amdgcn_logf(1.0f + __builtin_amdgcn_exp2f(fminf(z2, 126.f)));
              const bool valid = !domask || (kbase + 32 * half + crow(r, hi) < q);
              lk = valid ? lk : 0.f;
              pp[r] = valid ? (z2 + lk) : -INFINITY;
              ee[r] = lk;
            }
#pragma unroll
            for (int g4 = 0; g4 < 4; ++g4) {
              const float x0 = ee[4 * g4], x1 = ee[4 * g4 + 1], x2 = ee[4 * g4 + 2], x3 = ee[4 * g4 + 3];
              ee[4 * g4 + 3] = 0.f; ee[4 * g4 + 2] = x3; ee[4 * g4 + 1] = x3 + x2; ee[4 * g4] = x3 + x2 + x1;
              T8[4 * half + g4] = x3 + x2 + x1 + x0;
            }
          }
          float Tl[8], Th[8];
#pragma unroll
          for (int i = 0; i < 8; ++i) pair_vals(T8[i], Tl[i], Th[i]);
          float ps = 0.f; float base[8];
#pragma unroll
          for (int i = 7; i >= 0; --i) { base[i] = Crun + ps + (hi ? 0.f : Th[i]); ps += Tl[i] + Th[i]; }
          Crun += ps;
#pragma unroll
          for (int r = 0; r < 16; ++r) {
            p0[r] = __builtin_amdgcn_exp2f(p0[r] + e0[r] + base[r >> 2]);
            p1[r] = __builtin_amdgcn_exp2f(p1[r] + e1[r] + base[4 + (r >> 2)]);
          }
          if (__all(Crun < -48.f)) fin = true;
        } else {
          float al;
          if (softmax_tile(p0, p1, m0, l0, CSC, domask, kbase, q, hi, al)) {
#pragma unroll
            for (int d0 = 0; d0 < 2; ++d0)
#pragma unroll
              for (int r = 0; r < 16; ++r) o0[d0][r] *= al;
          }
          if (T == AT_FOX) { if (t > 0) { if (__all((qn * kpre[t - 1] + fend[t - 1] - m0) * CSC < -40.f)) fin = true; } }
        }
#pragma unroll
        for (int s = 0; s < 4; ++s) {
          const bf16x8 pf = pack8((s < 2) ? p0 : p1, 8 * (s & 1));
#pragma unroll
          for (int d0 = 0; d0 < 2; ++d0) {
            const bf16x8 vf = vfrag(cur, vro[d0] + 2048 * s);
            o0[d0] = __builtin_amdgcn_mfma_f32_32x32x16_bf16(vf, pf, o0[d0], 0, 0, 0);
          }
        }
      }
    }
    if (more) ATT_LSTORE((it + 1) & 1);
    {
      LAS unsigned char* ctile = lds + 2 * ATT_BUF + 1024;
      if (qidx < CMU_TOTAL) cmu_from_lds(cc, qidx, lane, w, ctile + ((gi + 1) & 1) * 8192);
      if (pidx < CMU_TOTAL) cmu_to_lds(cc, pidx, lane, w, cv, ctile + (gi & 1) * 8192);
      qidx = pidx;
      pidx = cidx;
      if (pidx < CMU_TOTAL) cmu_load(cc, pidx, lane, w, cv);
    }
    if (cfetch && tid == 0) s_conv[((gi >> 3) + 1) & 1] = cnext;
    ++gi;
    if (T == AT_SB || T == AT_FOX) {
      const bool wave_done = fin || (t == 0);
      if (__syncthreads_and(wave_done ? 1 : 0)) break;
    } else {
      __syncthreads();
    }
  }
  __syncthreads();
#undef ATT_TILE
#undef ATT_GLOAD
#undef ATT_LSTORE
  if (T == AT_DIFF) {
    float la, lb; pair_vals(l0, la, lb); const float inv0 = 1.f / (la + lb);
    pair_vals(l1, la, lb); const float inv1 = a.lam / (la + lb);
    float ss = 0.f;
#pragma unroll
    for (int d0 = 0; d0 < 2; ++d0)
#pragma unroll
      for (int r = 0; r < 16; ++r) { const float v = o0[d0][r] * inv0 - o1[d0][r] * inv1; o0[d0][r] = v; ss += v * v; }
    float sa, sb; pair_vals(ss, sa, sb);
    const float rs = rsqrtf((sa + sb) * (1.f / 64.f) + RMS_EPS) * a.oscale;
#pragma unroll
    for (int d0 = 0; d0 < 2; ++d0)
#pragma unroll
      for (int g4 = 0; g4 < 4; ++g4) {
        const int dv = 32 * d0 + 8 * g4 + 4 * hi;
        const f32x4 gg = *(const f32x4*)(a.subg + dv);
        u32x2 o; o.x = cvtpk(o0[d0][4 * g4] * rs * gg.x, o0[d0][4 * g4 + 1] * rs * gg.y); o.y = cvtpk(o0[d0][4 * g4 + 2] * rs * gg.z, o0[d0][4 * g4 + 3] * rs * gg.w);
        *(u32x2*)(a.O + (size_t)q * a.ldo + dv) = o;
      }
  } else {
    float inv = 1.f;
    if (T != AT_SB) { float la, lb; pair_vals(l0, la, lb); inv = 1.f / (la + lb); }
#pragma unroll
    for (int d0 = 0; d0 < 2; ++d0)
#pragma unroll
      for (int g4 = 0; g4 < 4; ++g4) {
        const int dv = 32 * d0 + 8 * g4 + 4 * hi;
        u32x2 o; o.x = cvtpk(o0[d0][4 * g4] * inv, o0[d0][4 * g4 + 1] * inv); o.y = cvtpk(o0[d0][4 * g4 + 2] * inv, o0[d0][4 * g4 + 3] * inv);
        *(u32x2*)(a.O + (size_t)q * a.ldo + dv) = o;
      }
  }
}

__device__ __forceinline__ void phase_attention(const Params& p, int layer, LAS unsigned char* lds) {
  unsigned char* ws = p.ws;
  const bf16_t* P = (const bf16_t*)(ws + OFF_P);
  const bf16_t* qd = (const bf16_t*)(ws + OFF_QD); const bf16_t* kvd = (const bf16_t*)(ws + OFF_KVD);
  bf16_t* mix = (bf16_t*)(ws + OFF_MIX);
  int* ctrl = (int*)(ws + OFF_CTRL);
  const float lam = ((const float*)ctrl)[CW_LAM + layer];
  const float linit = 0.8f - 0.6f * expf(-0.3f * (float)layer);
  LAS int* s_unit = (LAS int*)(lds + 2 * ATT_BUF);
  ConvCtx cc;
  cc.wgu = p.w_gate_up + (size_t)layer * NE * 1024 * 2048; cc.wdn = p.w_down + (size_t)layer * NE * 1024 * 1024;
  cc.dgu = ws + OFF_WGU + (size_t)layer * NE * 2048 * 1024; cc.ddn = ws + OFF_WD + (size_t)layer * NE * 1024 * 1024;
  cc.ctr = ctrl + CW_CONVQ + layer;
  int gi = 0, pidx = CMU_TOTAL, qidx = CMU_TOTAL; float cv[16];
#pragma unroll
  for (int j = 0; j < 16; ++j) cv[j] = 0.f;
  if (get_tid() == 0) ((LAS int*)(lds + 2 * ATT_BUF + 64))[0] = atomicAdd(cc.ctr, 8);
  for (;;) {
    if (get_tid() == 0) *s_unit = atomicAdd(&ctrl[CW_ATTQ + layer], 1);
    __syncthreads();
    const int u = *s_unit;
    __syncthreads();
    if (u >= 1024) break;
    const int qb = 15 - (u >> 6), rem = u & 63, type = rem & 3, bh = rem >> 2, b = bh >> 2, h = bh & 3;
    const size_t rb = (size_t)b * SEQ;
    AttnArgs a{};
    a.O = mix + rb * DM + type * 256 + h * 64; a.ldo = DM;
    if (type == AT_SB) {
      a.Q = P + rb * NP + C_SBQ + h * 64; a.K = P + rb * NP + C_SBK + h * 64; a.V = P + rb * NP + C_SBV + h * 64; a.ldq = a.ldk = a.ldv = NP;
      attn_unit<AT_SB>(lds, a, qb, cc, gi, pidx, qidx, cv);
    } else if (type == AT_DIFF) {
      a.Q = P + rb * NP + C_DFQ + h * 64; a.K = P + rb * NP + C_DFK + h * 64; a.V = P + rb * NP + C_DFV + h * 64; a.ldq = a.ldk = a.ldv = NP;
      a.lam = lam; a.oscale = 1.f - linit; a.subg = p.diff_subln_g + layer * 64;
      attn_unit<AT_DIFF>(lds, a, qb, cc, gi, pidx, qidx, cv);
    } else if (type == AT_FOX) {
      a.Q = P + rb * NP + C_FXQ + h * 64; a.K = P + rb * NP + C_FXK + h * 64; a.V = P + rb * NP + C_FXV + h * 64; a.ldq = a.ldk = a.ldv = NP;
      a.Fk = (const float*)(ws + OFF_FK) + (size_t)bh * SEQ; a.kn = (const float*)(ws + OFF_KN) + bh * 64;
      attn_unit<AT_FOX>(lds, a, qb, cc, gi, pidx, qidx, cv);
    } else {
      a.Q = qd + rb * 384 + h * 96; a.ldq = 384; a.K = kvd + rb * 512 + h * 128; a.ldk = 512; a.V = kvd + rb * 512 + h * 128 + 64; a.ldv = 512;
      a.K2 = P + rb * NP + C_KR; a.ldk2 = NP; a.cs = (const f32x2*)(ws + OFF_ROPE) + rb * 16;
      attn_unit<AT_MLA>(lds, a, qb, cc, gi, pidx, qidx, cv);
    }
  }
  {
    __syncthreads();
    const LAS int* sc = (const LAS int*)(lds + 2 * ATT_BUF + 64);
    const int k = gi >> 3, used = gi & 7;
    const int b0 = __builtin_amdgcn_readfirstlane(sc[k & 1]);
    const int b1 = (used >= 1) ? __builtin_amdgcn_readfirstlane(sc[(k + 1) & 1]) : CMU_TOTAL;
    const int tid = get_tid(), lane = tid & 63, w = tid >> 6;
    if (qidx < CMU_TOTAL) cmu_from_lds(cc, qidx, lane, w, lds + 2 * ATT_BUF + 1024 + ((gi + 1) & 1) * 8192);
    if (pidx < CMU_TOTAL) cmu_store(cc, pidx, lane, w, cv);
#pragma unroll 1
    for (int j = used; j < 16; ++j) {
      const int ci = (j < 8) ? b0 + j : b1 + (j - 8);
      if (ci < CMU_TOTAL) { float v0[16]; cmu_load(cc, ci, lane, w, v0); cmu_store(cc, ci, lane, w, v0); }
    }
    __syncthreads();
  }
  for (;;) {
    if (get_tid() == 0) s_unit[0] = atomicAdd(cc.ctr, 2);
    __syncthreads();
    const int c0 = __builtin_amdgcn_readfirstlane(s_unit[0]);
    __syncthreads();
    if (c0 >= CMU_TOTAL) break;
    const int tid = get_tid(), lane = tid & 63, w = tid >> 6;
    float v0[16], v1[16];
    cmu_load(cc, c0, lane, w, v0);
    if (c0 + 1 < CMU_TOTAL) cmu_load(cc, c0 + 1, lane, w, v1);
    cmu_store(cc, c0, lane, w, v0);
    if (c0 + 1 < CMU_TOTAL) cmu_store(cc, c0 + 1, lane, w, v1);
  }
}

__device__ __forceinline__ size_t tmp_blocked(int row, int col) {
  return (size_t)(row >> 6) * 65536 + (size_t)((((((col >> 7) * 4 + ((col >> 5) & 3)) * 4 + ((col >> 3) & 3)) * 2 + ((row >> 5) & 1)) * 64 + (((col >> 2) & 1) * 32 + (row & 31))) * 4);
}
struct OutprojSched {
  int grid, bid;
  __device__ __forceinline__ bool next(int i, pg8::Unit& u) const {
    int mt, nt;
    if (grid == 256) { if (i > 0) return false; const int xcd = bid & 7, j = bid >> 3; mt = 8 * xcd + (j >> 2); nt = j & 3; }
    else { const int t = bid + i * grid; if (t >= 256) return false; mt = t >> 2; nt = t & 3; }
    u.boff = (unsigned)nt * (256u * 1024u * 2u); u.arow0 = mt * 256; u.mvalid = 256; u.e = 0; u.mt = mt; u.nt = nt; u.slot0 = 0;
    return true;
  }
};
struct OutprojEpi {
  const bf16_t* hB; float* tmp;
  __device__ __forceinline__ void operator()(const pg8::f32x4v (&acc)[2][2][4][2], const pg8::Unit& u, int wr, int wc, int fr, int fq) const {
#pragma unroll
    for (int ai = 0; ai < 2; ++ai)
#pragma unroll
      for (int m = 0; m < 4; ++m) {
        const int row = u.mt * 256 + 128 * ai + 64 * wr + 16 * m + fr;
#pragma unroll
        for (int bj = 0; bj < 2; ++bj)
#pragma unroll
          for (int n = 0; n < 2; ++n) {
            const int col = u.nt * 256 + 128 * bj + 32 * wc + 16 * n + 4 * fq;
            const u32x2 hb = *(const u32x2*)(hB + (size_t)row * DM + col);
            const pg8::f32x4v v = acc[ai][bj][m][n];
            *(f32x4*)(tmp + tmp_blocked(row, col)) = (f32x4){DN_ALPHA * bflo(hb.x) + v[0], DN_ALPHA * bfhi(hb.x) + v[1], DN_ALPHA * bflo(hb.y) + v[2], DN_ALPHA * bfhi(hb.y) + v[3]};
          }
      }
  }
};
__device__ __forceinline__ void phase_outproj(const Params& p, int layer, LAS unsigned char* lds) {
  unsigned char* ws = p.ws;
  OutprojSched S{get_nblk(), get_bid()};
  OutprojEpi E{(const bf16_t*)(ws + OFF_HB), (float*)(ws + OFF_TMPF)};
  pg8::gemm_phase<false, false>(lds, (const bf16_t*)(ws + OFF_MIX), (const bf16_t*)(ws + OFF_WOUT) + (size_t)layer * 1024 * 1024, S, E);
}

__device__ __forceinline__ void phase_ln1_router(const Params& p, int layer, LAS unsigned char* lds) {
  unsigned char* ws = p.ws;
  const float* tmp = (const float*)(ws + OFF_TMPF);
  float* hF = (float*)(ws + OFF_HF); bf16_t* hB = (bf16_t*)(ws + OFF_HB);
  int* ctrl = (int*)(ws + OFF_CTRL); int* cnt = ctrl + CW_CNT + layer * 32;
  int* list = (int*)(ws + OFF_LIST); int* toke = (int*)(ws + OFF_TOKE); float* tokg = (float*)(ws + OFF_TOKG);
  const float* Wr = p.router_w + (size_t)layer * DM * NE; const float* rb = p.router_b + layer * NE;
  const float* g1 = p.ln1_g + layer * DM; const float* b1 = p.ln1_b + layer * DM;
  LAS float* red = (LAS float*)lds;
  LAS float* lg = (LAS float*)(lds + 32768);
  LAS float* part = (LAS float*)(lds + 136192);
  LAS float* part2 = (LAS float*)(lds + 137216);
  LAS int* lcnt = (LAS int*)(lds + 138240);
#pragma unroll 1
  for (int hs = get_bid(); hs < M_TOK / 32; hs += get_nblk()) {
    const int m0 = hs * 32, mi = hs & 1;
    const int tid = get_tid(), lane = tid & 63, w = tid >> 6, c31 = lane & 31, hi = lane >> 5;
    f32x16 acc[4];
    {
      const float* tb = tmp + (size_t)(hs >> 1) * 65536 + (size_t)(w * 32 * 64 + lane) * 4;
#pragma unroll
      for (int ni = 0; ni < 4; ++ni)
#pragma unroll
        for (int g4 = 0; g4 < 4; ++g4) {
          const f32x4 v = *(const f32x4*)(tb + (size_t)(((ni * 4 + g4) * 2 + mi) * 64) * 4);
          acc[ni][4 * g4] = v.x; acc[ni][4 * g4 + 1] = v.y; acc[ni][4 * g4 + 2] = v.z; acc[ni][4 * g4 + 3] = v.w;
        }
    }
    float mean, rstd;
    {
      float sacc = 0.f;
#pragma unroll
      for (int ni = 0; ni < 4; ++ni)
#pragma unroll
        for (int r = 0; r < 16; ++r) sacc += acc[ni][r];
      float s0, s1; pair_vals(sacc, s0, s1);
      if (hi == 0) part[c31 * 8 + w] = s0 + s1;
    }
    __syncthreads();
    {
      const f32x4 pa = *(const LAS f32x4*)(part + c31 * 8), pb = *(const LAS f32x4*)(part + c31 * 8 + 4);
      mean = ((pa.x + pa.y) + (pa.z + pa.w) + (pb.x + pb.y) + (pb.z + pb.w)) * (1.f / DM);
      float q = 0.f;
#pragma unroll
      for (int ni = 0; ni < 4; ++ni)
#pragma unroll
        for (int r = 0; r < 16; ++r) { const float d = acc[ni][r] - mean; q += d * d; }
      float q0, q1; pair_vals(q, q0, q1);
      if (hi == 0) part2[c31 * 8 + w] = q0 + q1;
    }
    __syncthreads();
    {
      const f32x4 pa = *(const LAS f32x4*)(part2 + c31 * 8), pb = *(const LAS f32x4*)(part2 + c31 * 8 + 4);
      rstd = rsqrtf(((pa.x + pa.y) + (pa.z + pa.w) + (pb.x + pb.y) + (pb.z + pb.w)) * (1.f / DM) + LN_EPS);
    }
    LAS unsigned char* wt = lds + w * 16896;
#pragma unroll
    for (int ni = 0; ni < 4; ++ni)
#pragma unroll
      for (int g4 = 0; g4 < 4; ++g4) {
        const int n = 128 * w + ni * 32 + 8 * g4 + 4 * hi;
        const f32x4 gg = *(const f32x4*)(g1 + n), bb = *(const f32x4*)(b1 + n);
        f32x4 y;
        y.x = (acc[ni][4 * g4] - mean) * rstd * gg.x + bb.x; y.y = (acc[ni][4 * g4 + 1] - mean) * rstd * gg.y + bb.y;
        y.z = (acc[ni][4 * g4 + 2] - mean) * rstd * gg.z + bb.z; y.w = (acc[ni][4 * g4 + 3] - mean) * rstd * gg.w + bb.w;
        acc[ni][4 * g4] = y.x; acc[ni][4 * g4 + 1] = y.y; acc[ni][4 * g4 + 2] = y.z; acc[ni][4 * g4 + 3] = y.w;
        *(LAS f32x4*)(wt + c31 * 528 + (ni * 32 + 8 * g4 + 4 * hi) * 4) = y;
      }
    {
      const int cl = (lane & 31) * 4;
      const size_t off0 = (size_t)(m0 + hi) * DM + 128 * w + cl;
      bf16_t* pB = hB + off0; unsigned char* p8 = ws + OFF_H8 + off0;
      const LAS unsigned char* rp = wt + hi * 528 + cl * 4;
#pragma unroll 4
      for (int it = 0; it < 16; ++it) {
        const f32x4 y = *(const LAS f32x4*)rp;
        u32x2 o; o.x = cvtpk(y.x, y.y); o.y = cvtpk(y.z, y.w);
        *(u32x2*)pB = o;
        *(unsigned*)p8 = pk4_fp8(clamp448(y.x * S8_H), clamp448(y.y * S8_H), clamp448(y.z * S8_H), clamp448(y.w * S8_H));
        rp += 2 * 528; pB += 2 * DM; p8 += 2 * DM;
      }
    }
    f32x16 D0;
#pragma unroll
    for (int r = 0; r < 16; ++r) D0[r] = 0.f;
    {
      const float* wrp = Wr + (128 * w + 4 * hi) * 32 + c31;
      float wa[16], wb[16];
#pragma unroll
      for (int r = 0; r < 16; ++r) wa[r] = wrp[(8 * (r >> 2) + (r & 3)) * 32];
#pragma unroll
      for (int ni = 0; ni < 4; ++ni) {
        __builtin_amdgcn_sched_barrier(0);
        if (ni < 3) {
#pragma unroll
          for (int r = 0; r < 16; ++r) wb[r] = wrp[((ni + 1) * 32 + 8 * (r >> 2) + (r & 3)) * 32];
        }
        __builtin_amdgcn_sched_barrier(0);
#pragma unroll
        for (int r = 0; r < 16; ++r) D0 = __builtin_amdgcn_mfma_f32_32x32x2f32(acc[ni][r], wa[r], D0, 0, 0, 0);
        __builtin_amdgcn_sched_barrier(0);
#pragma unroll
        for (int r = 0; r < 16; ++r) wa[r] = wb[r];
      }
    }
    __syncthreads();
#pragma unroll
    for (int r = 0; r < 16; ++r) red[(w * 32 + crow(r, hi)) * 32 + c31] = D0[r];
    __syncthreads();
#pragma unroll
    for (int i = 0; i < 2; ++i) {
      const int idx = tid + 512 * i;
      float sv = rb[idx & 31];
#pragma unroll
      for (int ww = 0; ww < 8; ++ww) sv += red[ww * 1024 + idx];
      lg[(idx & 31) * 32 + (idx >> 5)] = sv;
    }
    if (tid < 32) lcnt[tid] = 0;
    __syncthreads();
    float gt[4]; int li[4], rk[4];
    if (tid < 32) {
      float lv[4]; unsigned used = 0u;
#pragma unroll
      for (int k = 0; k < 4; ++k) {
        float best = -INFINITY; int bi = 0;
        for (int e = 0; e < 32; ++e) { const float v = lg[e * 32 + tid]; if (!((used >> e) & 1u) && v > best) { best = v; bi = e; } }
        used |= 1u << bi; lv[k] = best; li[k] = bi;
      }
      float sm = 0.f;
#pragma unroll
      for (int k = 0; k < 4; ++k) { gt[k] = expf(lv[k] - lv[0]); sm += gt[k]; }
      const float inv = 1.f / sm;
#pragma unroll
      for (int k = 0; k < 4; ++k) { gt[k] *= inv; rk[k] = __hip_atomic_fetch_add(&lcnt[li[k]], 1, __ATOMIC_RELAXED, __HIP_MEMORY_SCOPE_WORKGROUP); }
    }
    __syncthreads();
    if (tid < 32) { const int c = lcnt[tid]; lcnt[32 + tid] = c ? atomicAdd(&cnt[tid], c) : 0; }
    __syncthreads();
    if (tid < 32) {
      const int m = m0 + tid;
#pragma unroll
      for (int k = 0; k < 4; ++k) {
        const int ps = lcnt[32 + li[k]] + rk[k];
        list[li[k] * M_TOK + ps] = m;
        toke[m * 4 + k] = (li[k] << 16) | ps;
        tokg[m * 4 + k] = gt[k];
      }
    }
    __syncthreads();
  }
}

__device__ __forceinline__ void moe_prefix(const int* cnt, LAS int* s_start, LAS int* s_tstart, LAS int* s_cnt) {
  if (get_tid() < 64) {
    const int lane = get_tid();
    const int c = (lane < 32) ? cnt[lane] : 0;
    const int tl = (c + 255) >> 8;
    int ic = c, it = tl;
#pragma unroll
    for (int o = 1; o < 32; o <<= 1) { const int a = __shfl_up(ic, o), b = __shfl_up(it, o); if (lane >= o) { ic += a; it += b; } }
    if (lane < 32) { s_cnt[lane] = c; s_start[lane] = ic - c; s_tstart[lane] = it - tl; }
    if (lane == 31) { s_start[32] = ic; s_tstart[32] = it; }
  }
  __syncthreads();
}

struct MoeSched {
  unsigned estride; int NT, total_mt, grid, bid; const LAS int* s_start; const LAS int* s_tstart; const LAS int* s_cnt;
  __device__ __forceinline__ bool next(int i, pg8::Unit& u) const {
    int mtg, nt; bool ok;
    if (grid == 256) { const int MG = 32 / NT; const int xcd = bid & 7, j = bid >> 3; mtg = MG * (xcd + 8 * i) + j / NT; nt = j % NT; ok = (MG * (8 * i) < total_mt); }
    else { const int item = bid + i * grid; ok = (item < total_mt * NT); mtg = item / NT; nt = item % NT; }
    const bool live = ok && (mtg < total_mt);
    const int mq = live ? mtg : 0;
    const int ln_ = (int)(threadIdx.x & 63);
    const int tend_ = s_tstart[(ln_ < 32 ? ln_ : 31) + 1];
    const int e = (int)__builtin_popcountll(__ballot(ln_ < 32 && tend_ <= mq));
    const int mt = mq - __builtin_amdgcn_readfirstlane(s_tstart[e]);
    const int mv = live ? min(256, __builtin_amdgcn_readfirstlane(s_cnt[e]) - mt * 256) : 0;
    const int sl = __builtin_amdgcn_readfirstlane(s_start[e]) + mt * 256;
    const unsigned bo = (unsigned)e * estride + (unsigned)nt * (256u * 1024u);
    u.boff = bo; u.arow0 = i; u.mvalid = mv; u.e = e; u.mt = mt; u.nt = nt; u.slot0 = sl;
    return ok;
  }
};
struct MoeUpEpi {
  unsigned char* act; const LAS float* btab;
  __device__ __forceinline__ void operator()(const pg8::f32x4v (&acc)[2][2][4][2], const pg8::Unit& u, int wr, int wc, int fr, int fq) const {
    constexpr float US = 1.f / (S8_H * S8_WGU);
    constexpr float KEXP = -1.702f * LOG2E;
    const LAS float* bt = btab + u.arow0 * 256 + 16 * wc + 4 * fq;
    f32x4 bg[2], bl[2];
#pragma unroll
    for (int bj = 0; bj < 2; ++bj) { bg[bj] = *(const LAS f32x4*)(bt + 64 * bj); bl[bj] = *(const LAS f32x4*)(bt + 128 + 64 * bj); }
#pragma unroll
    for (int ai = 0; ai < 2; ++ai)
#pragma unroll
      for (int m = 0; m < 4; ++m) {
        const int rl = 128 * ai + 64 * wr + 16 * m + fr;
        if (rl < u.mvalid) {
          unsigned char* orow = act + (size_t)(u.slot0 + rl) * DFF + 16 * (8 * u.nt + wc) + 4 * fq;
#pragma unroll
          for (int bj = 0; bj < 2; ++bj) {
            float o[4];
#pragma unroll
            for (int i = 0; i < 4; ++i) {
              const float gl = fminf(fmaf(acc[ai][bj][m][0][i], US, bg[bj][i]), 7.f);
              const float ln = fminf(fmaxf(fmaf(acc[ai][bj][m][1][i], US, bl[bj][i]), -7.f), 7.f);
              const float sg = __builtin_amdgcn_rcpf(1.f + __builtin_amdgcn_exp2f(KEXP * gl));
              o[i] = fminf(gl * sg * fmaf(ln, S8_ACT, S8_ACT), 448.f);
            }
            *(unsigned*)(orow + 64 * bj) = pk4_fp8(o[0], o[1], o[2], o[3]);
          }
        }
      }
  }
};
struct MoeDownEpi {
  bf16_t* yb; const LAS float* btab;
  __device__ __forceinline__ void operator()(const pg8::f32x4v (&acc)[2][2][4][2], const pg8::Unit& u, int wr, int wc, int fr, int fq) const {
    constexpr float us = 1.f / (S8_ACT * S8_WDN);
    const LAS float* bt = btab + u.e * 256 + 32 * wc + 4 * fq;
    f32x4 b4[2][2];
#pragma unroll
    for (int bj = 0; bj < 2; ++bj)
#pragma unroll
      for (int n = 0; n < 2; ++n) b4[bj][n] = *(const LAS f32x4*)(bt + 128 * bj + 16 * n);
#pragma unroll
    for (int ai = 0; ai < 2; ++ai)
#pragma unroll
      for (int m = 0; m < 4; ++m) {
        const int rl = 128 * ai + 64 * wr + 16 * m + fr;
        if (rl < u.mvalid) {
          bf16_t* orow = yb + (size_t)(u.slot0 + rl) * DM + u.nt * 256 + 32 * wc + 4 * fq;
#pragma unroll
          for (int bj = 0; bj < 2; ++bj)
#pragma unroll
            for (int n = 0; n < 2; ++n) {
              const pg8::f32x4v v = acc[ai][bj][m][n];
              u32x2 ov; ov.x = cvtpk(fmaf(v[0], us, b4[bj][n].x), fmaf(v[1], us, b4[bj][n].y)); ov.y = cvtpk(fmaf(v[2], us, b4[bj][n].z), fmaf(v[3], us, b4[bj][n].w));
              *(u32x2*)(orow + 128 * bj + 16 * n) = ov;
            }
        }
      }
  }
};
__device__ __forceinline__ void phase_moe_up(const Params& p, int layer, LAS unsigned char* lds) {
  unsigned char* ws = p.ws;
  const int* cnt = (const int*)(ws + OFF_CTRL) + CW_CNT + layer * 32;
  const int* list = (const int*)(ws + OFF_LIST);
  LAS int* s_start = (LAS int*)(lds + LDS_GEMM); LAS int* s_tstart = s_start + 40; LAS int* s_cnt = s_start + 80;
  moe_prefix(cnt, s_start, s_tstart, s_cnt);
  MoeSched S{2048u * 1024u, 8, __builtin_amdgcn_readfirstlane(s_tstart[32]), get_nblk(), get_bid(), s_start, s_tstart, s_cnt};
  {
    const int tid = get_tid();
    LAS int* rowtab = (LAS int*)(lds + LDS_ROWTAB);
    LAS float* btab = (LAS float*)(lds + LDS_BIASTAB);
    const float* bgu = p.b_gate_up + (size_t)layer * NE * 2048;
    pg8::Unit u;
    for (int i = 0; i < 12 && S.next(i, u); ++i) {
      if (tid < 256) {
        int v = 0;
        if (u.mvalid > 0) v = list[u.e * M_TOK + u.mt * 256 + min(tid, u.mvalid - 1)];
        rowtab[i * 256 + tid] = v;
      } else {
        const int c = tid - 256;
        btab[i * 256 + c] = bgu[(size_t)u.e * 2048 + (c >> 7) * 1024 + u.nt * 128 + (c & 127)];
      }
    }
    __syncthreads();
  }
  MoeUpEpi E{(unsigned char*)(ws + OFF_ACT), (const LAS float*)(lds + LDS_BIASTAB)};
  pg8::gemm_phase<true, true>(lds, (const bf16_t*)(ws + OFF_H8), (const bf16_t*)(ws + OFF_WGU + (size_t)layer * NE * 2048 * 1024), S, E);
}
struct MoeDownSched {
  MoeSched base;
  __device__ __forceinline__ bool next(int i, pg8::Unit& u) const { const bool ok = base.next(i, u); if (ok) { u.arow0 = u.slot0; u.e = i; } return ok; }
};
__device__ __forceinline__ void phase_moe_down(const Params& p, int layer, LAS unsigned char* lds) {
  unsigned char* ws = p.ws;
  const int* cnt = (const int*)(ws + OFF_CTRL) + CW_CNT + layer * 32;
  LAS int* s_start = (LAS int*)(lds + LDS_GEMM); LAS int* s_tstart = s_start + 40; LAS int* s_cnt = s_start + 80;
  moe_prefix(cnt, s_start, s_tstart, s_cnt);
  MoeDownSched S{MoeSched{1024u * 1024u, 4, __builtin_amdgcn_readfirstlane(s_tstart[32]), get_nblk(), get_bid(), s_start, s_tstart, s_cnt}};
  {
    const int tid = get_tid();
    LAS float* btab = (LAS float*)(lds + LDS_BIASTAB);
    const float* bd = p.b_down + (size_t)layer * NE * 1024;
    pg8::Unit u;
    for (int i = 0; i < 12 && S.base.next(i, u); ++i)
      if (tid < 256) btab[i * 256 + tid] = bd[(size_t)u.e * 1024 + u.nt * 256 + tid];
    __syncthreads();
  }
  MoeDownEpi E{(bf16_t*)(ws + OFF_Y), (const LAS float*)(lds + LDS_BIASTAB)};
  pg8::gemm_phase<false, true>(lds, (const bf16_t*)(ws + OFF_ACT), (const bf16_t*)(ws + OFF_WD + (size_t)layer * NE * 1024 * 1024), S, E);
}

__device__ __forceinline__ void phase_combine_ln2(const Params& p, int layer, LAS unsigned char* lds) {
  unsigned char* ws = p.ws;
  const bf16_t* yb = (const bf16_t*)(ws + OFF_Y);
  float* hF = (float*)(ws + OFF_HF); bf16_t* hB = (bf16_t*)(ws + OFF_HB);
  const int* cnt = (const int*)(ws + OFF_CTRL) + CW_CNT + layer * 32;
  const int* toke = (const int*)(ws + OFF_TOKE); const float* tokg = (const float*)(ws + OFF_TOKG);
  LAS int* s_start = (LAS int*)(lds + LDS_GEMM); LAS int* s_tstart = s_start + 40; LAS int* s_cnt = s_start + 80;
  moe_prefix(cnt, s_start, s_tstart, s_cnt);
  const float* g2 = p.ln2_g + layer * DM; const float* b2 = p.ln2_b + layer * DM;
  const bool last = (layer == DEPTH - 1);
  const int lane = get_tid() & 63, gw = get_bid() * 8 + (get_tid() >> 6), ngw = get_nblk() * 8;
  for (int m = gw; m < M_TOK; m += ngw) {
    f32x4 v[4];
#pragma unroll
    for (int j = 0; j < 4; ++j) { const u32x2 hb = *(const u32x2*)(hB + (size_t)m * DM + 4 * lane + 256 * j); v[j] = (f32x4){bflo(hb.x), bfhi(hb.x), bflo(hb.y), bfhi(hb.y)} * DN_ALPHA; }
#pragma unroll
    for (int k = 0; k < 4; ++k) {
      const int ep = toke[m * 4 + k]; const float gt = tokg[m * 4 + k];
      const int slot = s_start[ep >> 16] + (ep & 0xffff);
      const bf16_t* yr = yb + (size_t)slot * DM;
#pragma unroll
      for (int j = 0; j < 4; ++j) {
        const u32x2 a = *(const u32x2*)(yr + 4 * lane + 256 * j);
        v[j].x += gt * bflo(a.x); v[j].y += gt * bfhi(a.x); v[j].z += gt * bflo(a.y); v[j].w += gt * bfhi(a.y);
      }
    }
    ln_row(v, g2, b2, lane);
    if (last) store_row_f32_bf16(v, p.out + (size_t)m * DM, nullptr, lane);
    else store_row_f32_bf16(v, nullptr, hB + (size_t)m * DM, lane);
  }
}

#if defined(__HIP_DEVICE_COMPILE__)
#define PH(call) do { const __attribute__((address_space(4))) Params* q_ = pp; asm volatile("" : "+s"(q_)); Params p; __builtin_memcpy(&p, q_, sizeof(Params)); call; } while (0)
#else
#define PH(call) do { const Params& p = p_unused; (void)pp; call; } while (0)
#endif
__global__ void __launch_bounds__(512) fwd_kernel(Params p_unused) {
  cg::grid_group grid = cg::this_grid();
  extern __shared__ __attribute__((aligned(16))) unsigned char smem[];
  LAS unsigned char* lds = (LAS unsigned char*)smem;
  const __attribute__((address_space(4))) Params* pp = (const __attribute__((address_space(4))) Params*)__builtin_amdgcn_kernarg_segment_ptr();
  if (threadIdx.x < 4) ((volatile LAS unsigned*)(lds + LDS_MISC))[threadIdx.x] = 0u;
  __syncthreads();
#define GRID_BAR() do { XcdBarrier b_; PH(b_.bar = (unsigned*)(p.ws + OFF_CTRL) + CW_BAR); b_.x = xb_xcc_id(); b_.st = (volatile LAS unsigned*)(lds + LDS_MISC); xcd_barrier(b_); } while (0)
  { unsigned* bw; PH(bw = (unsigned*)(p.ws + OFF_CTRL) + CW_BAR); (void)xcd_barrier_post(bw, (volatile LAS unsigned*)(lds + LDS_MISC)); }
  PH(phase_convert(p));
  PH(phase_prologue_misc(p));
  grid.sync();
#pragma unroll 1
  for (int layer = 0; layer < DEPTH; ++layer) {
    PH(phase_inproj(p, layer, lds));
    GRID_BAR();
    PH(phase_mla_up(p, layer, lds));
    GRID_BAR();
    PH(phase_attention(p, layer, lds));
    GRID_BAR();
    PH(phase_outproj(p, layer, lds));
    GRID_BAR();
    PH(phase_ln1_router(p, layer, lds));
    GRID_BAR();
    PH(phase_moe_up(p, layer, lds));
    GRID_BAR();
    PH(phase_moe_down(p, layer, lds));
    GRID_BAR();
    PH(phase_combine_ln2(p, layer, lds));
    if (layer + 1 < DEPTH) GRID_BAR();
  }
}

extern "C" void kernel_launch(void* const* d_in, const int* in_sizes, int n_in, void* d_out, int out_size,
                              void* d_ws, size_t ws_size, hipStream_t stream) {
  static int grid_blocks = 0;
  if (!grid_blocks) {
    int dev = 0, cus = 0, per_cu = 0;
    (void)hipGetDevice(&dev);
    (void)hipDeviceGetAttribute(&cus, hipDeviceAttributeMultiprocessorCount, dev);
    (void)hipFuncSetAttribute((const void*)fwd_kernel, hipFuncAttributeMaxDynamicSharedMemorySize, LDS_BYTES);
    (void)hipOccupancyMaxActiveBlocksPerMultiprocessor(&per_cu, fwd_kernel, 512, LDS_BYTES);
    if (per_cu < 1) { fprintf(stderr, "kernel_launch: occupancy query returned %d\n", per_cu); per_cu = 1; }
    if (per_cu > 1) per_cu = 1;
    grid_blocks = cus * per_cu;
    if (n_in != 23 || ws_size < WS_END) { fprintf(stderr, "kernel_launch: unexpected n_in %d or ws_size %zu (< %zu)\n", n_in, ws_size, (size_t)WS_END); }
  }
  if (ws_size < WS_END) return;
  (void)hipMemsetAsync((char*)d_ws + OFF_CTRL, 0, CTRL_BYTES, stream);
  Params p{};
  p.x = (const float*)d_in[0]; p.pos = (const int*)d_in[1]; p.ln_in_g = (const float*)d_in[2]; p.ln_in_b = (const float*)d_in[3];
  p.w_in = (const float*)d_in[4]; p.b_forget = (const float*)d_in[5]; p.diff_lambda = (const float*)d_in[6]; p.diff_subln_g = (const float*)d_in[7];
  p.mla_q_norm_g = (const float*)d_in[8]; p.mla_w_uq = (const float*)d_in[9]; p.mla_kv_norm_g = (const float*)d_in[10]; p.mla_w_ukv = (const float*)d_in[11];
  p.w_out = (const float*)d_in[12]; p.ln1_g = (const float*)d_in[13]; p.ln1_b = (const float*)d_in[14]; p.router_w = (const float*)d_in[15];
  p.router_b = (const float*)d_in[16]; p.w_gate_up = (const float*)d_in[17]; p.b_gate_up = (const float*)d_in[18]; p.w_down = (const float*)d_in[19];
  p.b_down = (const float*)d_in[20]; p.ln2_g = (const float*)d_in[21]; p.ln2_b = (const float*)d_in[22];
  p.out = (float*)d_out; p.ws = (unsigned char*)d_ws;
  void* args[] = {&p};
  hipError_t e = hipLaunchCooperativeKernel((void*)fwd_kernel, dim3(grid_blocks), dim3(512), args, LDS_BYTES, stream);
  if (e != hipSuccess) fprintf(stderr, "cooperative launch failed: %s (grid %d)\n", hipGetErrorString(e), grid_blocks);
}
```

```cpp
#include <hip/hip_runtime.h>
#include <hip/hip_cooperative_groups.h>
#include <cstdio>
#include <cstdint>
namespace cg = cooperative_groups;

#define LAS __attribute__((address_space(3)))
typedef unsigned short bf16_t;
typedef short bf16x8 __attribute__((ext_vector_type(8)));
typedef short s16x4 __attribute__((ext_vector_type(4)));
typedef float f32x16 __attribute__((ext_vector_type(16)));
typedef float f32x4 __attribute__((ext_vector_type(4)));
typedef float f32x2 __attribute__((ext_vector_type(2)));
typedef unsigned u32x4 __attribute__((ext_vector_type(4)));
typedef unsigned u32x2 __attribute__((ext_vector_type(2)));
typedef __bf16 bf16x2_t __attribute__((ext_vector_type(2)));

constexpr int M_TOK = 16384, DM = 1024, SEQ = 4096, NBATCH = 4, DEPTH = 2;
constexpr int NP = 2816;
constexpr int NE = 32, DFF = 1024, TOPK = 4;
constexpr int C_SBQ = 0, C_SBK = 256, C_SBV = 512, C_DFQ = 768, C_DFK = 1024, C_DFV = 1280, C_FXQ = 1536, C_FXK = 1792, C_FXV = 2048,
              C_CQ = 2304, C_CKV = 2560, C_KR = 2688, C_FXF = 2720, C_END = 2724;
constexpr float LOG2E = 1.4426950408889634f;
constexpr float DN_ALPHA = 1.4142135623730951f;
constexpr float LN_EPS = 1e-5f, RMS_EPS = 1e-6f;
constexpr float S8_H = 16.f, S8_WGU = 64.f, S8_ACT = 8.f, S8_WDN = 128.f;

constexpr size_t MB = 1ull << 20;
constexpr size_t OFF_CTRL = 0, CTRL_BYTES = 65536;
constexpr size_t OFF_ROPE = 1 * MB;
constexpr size_t OFF_GATEF = 3 * MB;
constexpr size_t OFF_FK = 3 * MB + 512 * 1024;
constexpr size_t OFF_LIST = 4 * MB;
constexpr size_t OFF_TOKE = 6 * MB;
constexpr size_t OFF_TOKG = 6 * MB + 512 * 1024;
constexpr size_t OFF_WUQ = 7 * MB;
constexpr size_t OFF_WUKV = 7 * MB + 512 * 1024;
constexpr size_t OFF_WOUT = 8 * MB;
constexpr size_t OFF_WIN = 12 * MB;
constexpr size_t OFF_HF = 24 * MB;
constexpr size_t OFF_HB = 88 * MB;
constexpr size_t OFF_P = 120 * MB;
constexpr size_t OFF_CQN = 208 * MB;
constexpr size_t OFF_CKVN = 216 * MB;
constexpr size_t OFF_QD = 220 * MB;
constexpr size_t OFF_KVD = 232 * MB;
constexpr size_t OFF_MIX = 248 * MB;
constexpr size_t OFF_TMPF = 280 * MB;
constexpr size_t OFF_KN = 3 * MB + 768 * 1024;
constexpr size_t OFF_H8 = 220 * MB;
constexpr size_t OFF_ACT = 344 * MB;
constexpr size_t OFF_Y = 473 * MB;
constexpr size_t OFF_WGU = 602 * MB;
constexpr size_t OFF_WD = 858 * MB;
constexpr size_t WS_END = 986 * MB;
constexpr int CW_CNT = 0;
constexpr int CW_ATTQ = 128;
constexpr int CW_LAM = 160;
constexpr int CW_CONVQ = 192;
constexpr int CW_BAR = 4096;

constexpr int LDS_ROWTAB = 131072;
constexpr int LDS_GEMM = 143360;
constexpr int LDS_MISC = LDS_GEMM + 1024;
constexpr int LDS_BIASTAB = 147456;
constexpr int LDS_BYTES = 159744;

struct Params {
  const float* x; const int* pos; const float* ln_in_g; const float* ln_in_b; const float* w_in; const float* b_forget;
  const float* diff_lambda; const float* diff_subln_g; const float* mla_q_norm_g; const float* mla_w_uq; const float* mla_kv_norm_g;
  const float* mla_w_ukv; const float* w_out; const float* ln1_g; const float* ln1_b; const float* router_w; const float* router_b;
  const float* w_gate_up; const float* b_gate_up; const float* w_down; const float* b_down; const float* ln2_g; const float* ln2_b;
  float* out; unsigned char* ws;
};

__device__ __forceinline__ unsigned cvtpk(float lo, float hi) { f32x2 v = {lo, hi}; bf16x2_t b = __builtin_convertvector(v, bf16x2_t); return __builtin_bit_cast(unsigned, b); }
__device__ __forceinline__ unsigned pk4_fp8(float a, float b, float c, float d) {
  int w = __builtin_amdgcn_cvt_pk_fp8_f32(a, b, 0, false);
  w = __builtin_amdgcn_cvt_pk_fp8_f32(c, d, w, true);
  return (unsigned)w;
}
__device__ __forceinline__ float clamp448(float x) { return fminf(fmaxf(x, -448.f), 448.f); }
__device__ __forceinline__ float bf2f(unsigned short b) { return __uint_as_float(((unsigned)b) << 16); }
__device__ __forceinline__ float bflo(unsigned w) { return __uint_as_float(w << 16); }
__device__ __forceinline__ float bfhi(unsigned w) { return __uint_as_float(w & 0xffff0000u); }
__device__ __forceinline__ float wave_sum(float v) {
#pragma unroll
  for (int o = 1; o < 64; o <<= 1) v += __shfl_xor(v, o);
  return v;
}
__device__ __forceinline__ int get_bid() { int b = blockIdx.x; asm volatile("" : "+s"(b)); return b; }
__device__ __forceinline__ int get_nblk() { int g = gridDim.x; asm volatile("" : "+s"(g)); return g; }
__device__ __forceinline__ int get_tid() { int t = threadIdx.x; asm volatile("" : "+v"(t)); return t; }
__device__ __forceinline__ int crow(int r, int hi) { return (r & 3) + 8 * (r >> 2) + 4 * hi; }
__device__ __forceinline__ void pair_vals(float v, float& v0, float& v1) {
  auto rr = __builtin_amdgcn_permlane32_swap(__float_as_uint(v), __float_as_uint(v), false, false);
  v0 = __uint_as_float(rr[0]); v1 = __uint_as_float(rr[1]);
}


#define XB_TMO      128
#define XB_XCNT(j)  (256  + 64 * (j))
#define XB_XSUB(j)  (1280 + 64 * (j))
#define XB_XGEN(j)  (2304 + 64 * (j))
#define XB_TOP      3328
#define XB_TOPGEN   3392
#define XCD_BAR_WORDS 3456
#define XB_SPIN_CAP (1u << 22)
__device__ __forceinline__ unsigned xb_ld(unsigned* p)              { return __hip_atomic_load(p, __ATOMIC_RELAXED, __HIP_MEMORY_SCOPE_AGENT); }
__device__ __forceinline__ unsigned xb_add(unsigned* p, unsigned v) { return __hip_atomic_fetch_add(p, v, __ATOMIC_RELAXED, __HIP_MEMORY_SCOPE_AGENT); }
__device__ __forceinline__ unsigned xb_xcc_id() { return (unsigned)__builtin_amdgcn_s_getreg((3 << 11) | 20) & 0xFu; }
#define XB_SPIN(cond, bar) do { unsigned _sp = 0; while (cond) { __builtin_amdgcn_s_sleep(1); \
    if ((++_sp & 255u) == 0u) { if (xb_ld(&(bar)[XB_TMO])) break; if (_sp > XB_SPIN_CAP) { atomicAdd(&(bar)[XB_TMO], 1u); break; } } } } while (0)
struct XcdBarrier { unsigned* bar; unsigned x; volatile LAS unsigned* st; };
__device__ __forceinline__ XcdBarrier xcd_barrier_post(unsigned* bar, volatile LAS unsigned* st) {
  XcdBarrier b; b.bar = bar; b.x = xb_xcc_id(); b.st = st;
  if (threadIdx.x == 0) (void)xb_add(&bar[XB_XCNT(b.x)], 1u);
  return b;
}
__device__ __forceinline__ void xcd_barrier_complete(unsigned* bar, unsigned x, unsigned& nloc, unsigned& nx) {
  const unsigned G = gridDim.x * gridDim.y * gridDim.z;
  unsigned sum, cnt, mine, sp = 0u;
  for (;;) {
    sum = 0u; cnt = 0u; mine = 0u;
#pragma unroll
    for (unsigned j = 0; j < 16; ++j) { const unsigned c = xb_ld(&bar[XB_XCNT(j)]); sum += c; cnt += (c > 0u) ? 1u : 0u; mine = (j == x) ? c : mine; }
    if (sum == G) break;
    __builtin_amdgcn_s_sleep(1);
    if ((++sp & 255u) == 0u) { if (xb_ld(&bar[XB_TMO])) break; if (sp > XB_SPIN_CAP) { atomicAdd(&bar[XB_TMO], 1u); break; } }
  }
  nloc = mine > 0u ? mine : 1u; nx = cnt > 0u ? cnt : 1u;
}
__device__ __forceinline__ void xcd_barrier(const XcdBarrier& b) {
  asm volatile("s_waitcnt vmcnt(0)" ::: "memory");
  __syncthreads();
  if (threadIdx.x == 0) {
    unsigned* bar = b.bar;
    __builtin_amdgcn_s_waitcnt(0);
    unsigned nloc = b.st[0], nx = b.st[1];
    if (nloc == 0u) { xcd_barrier_complete(bar, b.x, nloc, nx); b.st[0] = nloc; b.st[1] = nx; }
    const unsigned old = xb_add(&bar[XB_XSUB(b.x)], 1u);
    const unsigned gen = old / nloc;
    if (old + 1u == (gen + 1u) * nloc) {
      __builtin_amdgcn_fence(__ATOMIC_RELEASE, "agent");
      asm volatile("s_waitcnt vmcnt(0)" ::: "memory");
      const unsigned og = xb_add(&bar[XB_TOP], 1u);
      const unsigned tg = og / nx;
      if (og + 1u == (tg + 1u) * nx) xb_add(&bar[XB_TOPGEN], 1u);
      else XB_SPIN(xb_ld(&bar[XB_TOPGEN]) == tg, bar);
      __builtin_amdgcn_fence(__ATOMIC_ACQUIRE, "agent");
      xb_add(&bar[XB_XGEN(b.x)], 1u);
      asm volatile("s_waitcnt vmcnt(0)" ::: "memory");
    } else {
      XB_SPIN(xb_ld(&bar[XB_XGEN(b.x)]) == gen, bar);
      __builtin_amdgcn_fence(__ATOMIC_ACQUIRE, "agent");
      asm volatile("s_waitcnt vmcnt(0)" ::: "memory");
    }
  }
  __syncthreads();
}

struct ConvDesc { const float* src; bf16_t* dst; const float* kscale; int K, Ndst, srcld, mode, kb, nb; };
constexpr int CV_U_IN = 16 * 11, CV_U_OUT = 16 * 4, CV_U_UQ = 4 * 2, CV_U_UKV = 2 * 2;
constexpr int CV_SMALL = 2 * (CV_U_IN + CV_U_OUT + CV_U_UQ + CV_U_UKV);
__device__ __forceinline__ bool conv_desc(const Params& p, int u, ConvDesc& d) {
  unsigned char* ws = p.ws;
  constexpr int T_IN = 2 * CV_U_IN, T_OUT = 2 * CV_U_OUT, T_UQ = 2 * CV_U_UQ;
  const float* src; bf16_t* dst; const float* ksc = nullptr; int K, Ndst, srcld, mode, q, nbn;
  int r = u;
  if (r < T_IN) { const int inst = r / CV_U_IN; q = r % CV_U_IN; src = p.w_in + (size_t)inst * 1024 * 2724; dst = (bf16_t*)(ws + OFF_WIN) + (size_t)inst * NP * 1024; K = 1024; Ndst = NP; srcld = 2724; mode = 1; nbn = 11; }
  else if ((r -= T_IN) < T_OUT) { const int inst = r / CV_U_OUT; q = r % CV_U_OUT; src = p.w_out + (size_t)inst * 1024 * 1024; dst = (bf16_t*)(ws + OFF_WOUT) + (size_t)inst * 1024 * 1024; K = 1024; Ndst = 1024; srcld = 1024; mode = 0; nbn = 4; }
  else if ((r -= T_OUT) < T_UQ) { const int inst = r / CV_U_UQ; q = r % CV_U_UQ; src = p.mla_w_uq + (size_t)inst * 256 * 384; dst = (bf16_t*)(ws + OFF_WUQ) + (size_t)inst * 384 * 256; K = 256; Ndst = 384; srcld = 384; mode = 0; nbn = 2; ksc = p.mla_q_norm_g + inst * 256; }
  else { r -= T_UQ; const int inst = r / CV_U_UKV; q = r % CV_U_UKV; src = p.mla_w_ukv + (size_t)inst * 128 * 512; dst = (bf16_t*)(ws + OFF_WUKV) + (size_t)inst * 512 * 128; K = 128; Ndst = 512; srcld = 512; mode = 0; nbn = 2; ksc = p.mla_kv_norm_g + inst * 128; }
  d.src = src; d.dst = dst; d.kscale = ksc; d.K = K; d.Ndst = Ndst; d.srcld = srcld; d.mode = mode; d.kb = q / nbn; d.nb = q % nbn;
  return u < CV_SMALL;
}
__device__ __forceinline__ void conv_load(const ConvDesc& d, float (&v)[4][8], int lane, int w) {
  const int k0 = d.kb * 64 + 8 * w;
#pragma unroll
  for (int u = 0; u < 4; ++u) {
    const int n = d.nb * 256 + u * 64 + lane;
    int sc = n; bool ok = n < d.Ndst;
    if (d.mode == 1) { if (n < 2304) sc = n; else if (n < C_FXF) sc = n + 4; else if (n < C_END) sc = 2304 + (n - C_FXF); else ok = false; }
    const float* sp = d.src + (size_t)k0 * d.srcld + sc;
#pragma unroll
    for (int j = 0; j < 8; ++j) v[u][j] = ok ? __builtin_nontemporal_load(sp + (size_t)j * d.srcld) : 0.f;
  }
}
__device__ __forceinline__ void conv_store(const ConvDesc& d, const float (&v)[4][8], int lane, int w) {
  const int k0 = d.kb * 64 + 8 * w;
#pragma unroll
  for (int u = 0; u < 4; ++u) {
    const int n = d.nb * 256 + u * 64 + lane;
    if (n < d.Ndst) {
      int dr = n;
      if (d.mode == 2) { const int j = n & 1023; dr = (j >> 4) * 32 + (j & 15) + ((n >= 1024) ? 16 : 0); }
      float g[8];
#pragma unroll
      for (int j = 0; j < 8; ++j) g[j] = d.kscale ? d.kscale[k0 + j] : 1.f;
      u32x4 o; o.x = cvtpk(v[u][0] * g[0], v[u][1] * g[1]); o.y = cvtpk(v[u][2] * g[2], v[u][3] * g[3]); o.z = cvtpk(v[u][4] * g[4], v[u][5] * g[5]); o.w = cvtpk(v[u][6] * g[6], v[u][7] * g[7]);
      *(u32x4*)(d.dst + (size_t)dr * d.K + k0) = o;
    }
  }
}
__device__ __forceinline__ void phase_convert(const Params& p) {
  const int tid = get_tid(), lane = tid & 63, w = tid >> 6;
  const int G = get_nblk();
  for (int u = get_bid(); u < CV_SMALL; u += G) {
    ConvDesc d; float va[4][8];
    conv_desc(p, u, d);
    conv_load(d, va, lane, w);
    conv_store(d, va, lane, w);
  }
}

__device__ __forceinline__ void ln_row(f32x4 (&v)[4], const float* g, const float* b, int lane) {
  float s = 0.f;
#pragma unroll
  for (int j = 0; j < 4; ++j) s += (v[j].x + v[j].y) + (v[j].z + v[j].w);
  const float mean = wave_sum(s) * (1.f / DM);
  float s2 = 0.f;
#pragma unroll
  for (int j = 0; j < 4; ++j) { v[j] = v[j] - mean; s2 += (v[j].x * v[j].x + v[j].y * v[j].y) + (v[j].z * v[j].z + v[j].w * v[j].w); }
  const float rstd = rsqrtf(wave_sum(s2) * (1.f / DM) + LN_EPS);
#pragma unroll
  for (int j = 0; j < 4; ++j) {
    const f32x4 gg = *(const f32x4*)(g + 4 * lane + 256 * j), bb = *(const f32x4*)(b + 4 * lane + 256 * j);
    v[j] = v[j] * rstd * gg + bb;
  }
}
__device__ __forceinline__ void store_row_f32_bf16(const f32x4 (&v)[4], float* of, bf16_t* ob, int lane) {
#pragma unroll
  for (int j = 0; j < 4; ++j) {
    if (of) *(f32x4*)(of + 4 * lane + 256 * j) = v[j];
    if (ob) { u32x2 w; w.x = cvtpk(v[j].x, v[j].y); w.y = cvtpk(v[j].z, v[j].w); *(u32x2*)(ob + 4 * lane + 256 * j) = w; }
  }
}

__device__ __forceinline__ void phase_prologue_misc(const Params& p) {
  unsigned char* ws = p.ws;
  const int lane = get_tid() & 63, gw = get_bid() * 8 + (get_tid() >> 6), ngw = get_nblk() * 8;
  float* hF = (float*)(ws + OFF_HF); bf16_t* hB = (bf16_t*)(ws + OFF_HB);
  for (int m = gw; m < M_TOK; m += ngw) {
    f32x4 v[4];
#pragma unroll
    for (int j = 0; j < 4; ++j) v[j] = *(const f32x4*)(p.x + (size_t)m * DM + 4 * lane + 256 * j);
    ln_row(v, p.ln_in_g, p.ln_in_b, lane);
    store_row_f32_bf16(v, nullptr, hB + (size_t)m * DM, lane);
  }
  f32x2* cs = (f32x2*)(ws + OFF_ROPE);
  const int gt = get_bid() * 512 + get_tid(), ngt = get_nblk() * 512;
  for (int i = gt; i < M_TOK * 16; i += ngt) {
    const int m = i >> 4, f = i & 15;
    const double invf = exp2(-(double)f * (13.287712379549449 / 16.0));
    double a = (double)p.pos[m] * invf;
    a = a - 6.283185307179586476925 * rint(a * 0.15915494309189533577);
    float sn, cn; __sincosf((float)a, &sn, &cn);
    cs[i] = (f32x2){cn, sn};
  }
  if (get_bid() == 0 && get_tid() < DEPTH) {
    const int l = get_tid(); const float* lp = p.diff_lambda + l * 128;
    float s1 = 0.f, s2 = 0.f;
    for (int i = 0; i < 32; ++i) { s1 += lp[i] * lp[32 + i]; s2 += lp[64 + i] * lp[96 + i]; }
    const float linit = 0.8f - 0.6f * expf(-0.3f * (float)l);
    ((float*)(ws + OFF_CTRL))[CW_LAM + l] = expf(s1) - expf(s2) + linit;
  }
}

struct GemmDesc { const bf16_t* A; int lda; const int* rowidx; int row0; int mvalid; const bf16_t* Bt; int ldb; int K; };

template <int NI>
__device__ __forceinline__ void gemm_tile(LAS unsigned char* lds, const GemmDesc& g, f32x16 (&acc)[2][NI]) {
  constexpr int BN = 64 * NI;
  constexpr int A_BYTES = 256 * 128, B_BYTES = BN * 128, STAGE = A_BYTES + B_BYTES;
  constexpr int NBL = BN / 64;
  const int tid = get_tid(), lane = tid & 63, w = tid >> 6, wm = w >> 1, wn = w & 1, c31 = lane & 31, hi = lane >> 5;
  const int lr = tid >> 3, lc = (tid & 7) ^ ((tid >> 4) & 7);
  const bf16_t* ap[4];
#pragma unroll
  for (int i = 0; i < 4; ++i) {
    const int r = lr + 64 * i;
    int row;
    if (g.rowidx) row = g.rowidx[g.row0 + (r < g.mvalid ? r : 0)]; else row = g.row0 + r;
    ap[i] = g.A + (size_t)row * g.lda + lc * 8;
  }
  const bf16_t* bp = g.Bt + (size_t)lr * g.ldb + lc * 8;
  const int wbase = w * 1024;
  const int xr = (lane >> 1) & 7;
  int roff[4];
#pragma unroll
  for (int ks = 0; ks < 4; ++ks) roff[ks] = ((2 * ks + hi) ^ xr) << 4;
  const int a_base = (wm * 64 + c31) * 128, b_base = A_BYTES + (wn * 32 * NI + c31) * 128;
#pragma unroll
  for (int mi = 0; mi < 2; ++mi)
#pragma unroll
    for (int ni = 0; ni < NI; ++ni)
#pragma unroll
      for (int r = 0; r < 16; ++r) acc[mi][ni][r] = 0.f;
  const int nk = g.K >> 6;
#define GT_STAGE(stg, ko) do { LAS unsigned char* s_ = lds + (stg) * STAGE + wbase; \
    _Pragma("unroll") for (int i = 0; i < 4; ++i) __builtin_amdgcn_global_load_lds((const unsigned*)(ap[i] + (ko)), (LAS unsigned*)(s_ + 8192 * i), 16, 0, 0); \
    _Pragma("unroll") for (int i = 0; i < NBL; ++i) __builtin_amdgcn_global_load_lds((const unsigned*)(bp + (size_t)(64 * i) * g.ldb + (ko)), (LAS unsigned*)(s_ + A_BYTES + 8192 * i), 16, 0, 0); } while (0)
  GT_STAGE(0, 0);
  __syncthreads();
  bf16x8 af[2][2], bfr[2][NI];
  for (int kt = 0; kt < nk; ++kt) {
    LAS unsigned char* cur = lds + (kt & 1) * STAGE;
    if (kt + 1 < nk) GT_STAGE((kt + 1) & 1, (kt + 1) * 64);
#pragma unroll
    for (int mi = 0; mi < 2; ++mi) af[0][mi] = *(const LAS bf16x8*)(cur + a_base + mi * 4096 + roff[0]);
#pragma unroll
    for (int ni = 0; ni < NI; ++ni) bfr[0][ni] = *(const LAS bf16x8*)(cur + b_base + ni * 4096 + roff[0]);
#pragma unroll
    for (int ks = 0; ks < 4; ++ks) {
      if (ks < 3) {
#pragma unroll
        for (int mi = 0; mi < 2; ++mi) af[(ks + 1) & 1][mi] = *(const LAS bf16x8*)(cur + a_base + mi * 4096 + roff[ks + 1]);
#pragma unroll
        for (int ni = 0; ni < NI; ++ni) bfr[(ks + 1) & 1][ni] = *(const LAS bf16x8*)(cur + b_base + ni * 4096 + roff[ks + 1]);
      }
      __builtin_amdgcn_s_setprio(1);
#pragma unroll
      for (int mi = 0; mi < 2; ++mi)
#pragma unroll
        for (int ni = 0; ni < NI; ++ni) acc[mi][ni] = __builtin_amdgcn_mfma_f32_32x32x16_bf16(bfr[ks & 1][ni], af[ks & 1][mi], acc[mi][ni], 0, 0, 0);
      __builtin_amdgcn_s_setprio(0);
    }
    __syncthreads();
  }
#undef GT_STAGE
}


namespace pg8 {
typedef float f32x4v __attribute__((ext_vector_type(4)));
constexpr int BM = 256, BK = 64, HALF = 128, HTB = HALF * BK * 2, STAGE_BYTES = 8 * HTB, KK = 1024;
typedef int v8i_t __attribute__((ext_vector_type(8)));
typedef int v4i_t __attribute__((ext_vector_type(4)));
__device__ __forceinline__ v8i_t cat8(bf16x8 a, bf16x8 b) { const v4i_t x = __builtin_bit_cast(v4i_t, a), y = __builtin_bit_cast(v4i_t, b); return __builtin_shufflevector(x, y, 0, 1, 2, 3, 4, 5, 6, 7); }
__device__ __forceinline__ int lds_byte(int r, int c) { const int st = (r >> 4) * 2 + (c >> 5), rr = r & 15, cc = c & 31, ob = rr * 64 + cc * 2; return st * 1024 + (ob ^ (((ob >> 9) & 1) << 5)); }
__device__ __forceinline__ void stage_rc(int b, int& R, int& C) { const int st = b / 1024, sb = b % 1024, swz = sb ^ (((sb >> 9) & 1) << 5); R = (st >> 1) * 16 + swz / 64; C = (st & 1) * 32 + (swz % 64) / 2; }
struct Unit { unsigned boff; int arow0; int mvalid; int e, mt, nt, slot0; };
template <bool GATHER, bool FP8, class Sched, class Epi>
__device__ __forceinline__ void gemm_phase(LAS unsigned char* lds, const bf16_t* Abuf, const bf16_t* Bbuf, const Sched& S, const Epi& E) {
  const int tid = get_tid(), wid = __builtin_amdgcn_readfirstlane(tid >> 6), lane = tid & 63, wr = wid >> 2, wc = wid & 3, fr = lane & 15, fq = lane >> 4;
  const __amdgpu_buffer_rsrc_t rsA = __builtin_amdgcn_make_buffer_rsrc((void*)Abuf, (short)0, 0x7ffffff0, 0x00020000);
  const __amdgpu_buffer_rsrc_t rsB = __builtin_amdgcn_make_buffer_rsrc((void*)Bbuf, (short)0, 0x7ffffff0, 0x00020000);
  constexpr int RS = FP8 ? KK : 2 * KK;
  constexpr int NT_K = FP8 ? 8 : 16;
  const int lrow = (wid >> 1) * 16 + (lane >> 2);
  const int cbyte = (wid & 1) * 64 + (((lane & 3) * 16) ^ (((lane >> 5) & 1) << 5));
  const unsigned vB = (unsigned)(lrow * RS + cbyte);
  const LAS int* rowtab = (const LAS int*)(lds + LDS_ROWTAB) + lrow;
#define PG8_ROWS(V, u) do { if (GATHER) { _Pragma("unroll") for (int h_ = 0; h_ < 2; ++h_) _Pragma("unroll") for (int i_ = 0; i_ < 2; ++i_) \
      V[h_][i_] = (unsigned)(rowtab[(u).arow0 * 256 + h_ * HALF + i_ * 64] * RS + cbyte); } } while (0)
#define PG8_ABASE(u) (GATHER ? 0u : (unsigned)(u).arow0 * (unsigned)RS)
  constexpr unsigned kstep = BK * 2;
  const unsigned ldsw = (unsigned)wid * 1024u;
  const int aoff = lds_byte(wr * 64 + fr, fq * 8), boff = lds_byte(wc * 32 + fr, fq * 8);
#define PG8_SA(b, h) (((b) * 2 + (h)) * HTB)
#define PG8_SB(b, h) ((4 + (b) * 2 + (h)) * HTB)
#define PG8_LOAD1(rs, ldsoff, voff, soff) __builtin_amdgcn_raw_ptr_buffer_load_lds(rs, (LAS void*)(lds + (ldsoff) + ldsw), 16, (int)(voff), (int)(soff), 0, 0)
#define PG8_STAGE_B(bufoff, soff, h) do { PG8_LOAD1(rsB, (bufoff), vB, (soff) + (unsigned)((h) * HALF * RS)); PG8_LOAD1(rsB, (bufoff) + 8192, vB, (soff) + (unsigned)(((h) * HALF + 64) * RS)); } while (0)
#define PG8_STAGE_A(bufoff, soff, h, v0, v1) do { if (GATHER) { PG8_LOAD1(rsA, (bufoff), (v0), (soff)); PG8_LOAD1(rsA, (bufoff) + 8192, (v1), (soff)); } \
    else { PG8_LOAD1(rsA, (bufoff), vB, (soff) + (unsigned)((h) * HALF * RS)); PG8_LOAD1(rsA, (bufoff) + 8192, vB, (soff) + (unsigned)(((h) * HALF + 64) * RS)); } } while (0)
#define PG8_LDA(dst, b, h) do { if (FP8) { _Pragma("unroll") for (int m = 0; m < 4; ++m) { \
      const v4i_t lo_ = *(const LAS v4i_t*)(lds + PG8_SA(b, h) + aoff + m * 2048), hi_ = *(const LAS v4i_t*)(lds + PG8_SA(b, h) + aoff + m * 2048 + 1024); \
      dst##8[m] = __builtin_shufflevector(lo_, hi_, 0, 1, 2, 3, 4, 5, 6, 7); } } \
    else { _Pragma("unroll") for (int m = 0; m < 4; ++m) _Pragma("unroll") for (int k = 0; k < 2; ++k) dst[m][k] = *(const LAS bf16x8*)(lds + PG8_SA(b, h) + aoff + m * 2048 + k * 1024); } } while (0)
#define PG8_LDB(dst, b, h) do { if (FP8) { _Pragma("unroll") for (int n = 0; n < 2; ++n) { \
      const v4i_t lo_ = *(const LAS v4i_t*)(lds + PG8_SB(b, h) + boff + n * 2048), hi_ = *(const LAS v4i_t*)(lds + PG8_SB(b, h) + boff + n * 2048 + 1024); \
      dst##8[n] = __builtin_shufflevector(lo_, hi_, 0, 1, 2, 3, 4, 5, 6, 7); } } \
    else { _Pragma("unroll") for (int n = 0; n < 2; ++n) _Pragma("unroll") for (int k = 0; k < 2; ++k) dst[n][k] = *(const LAS bf16x8*)(lds + PG8_SB(b, h) + boff + n * 2048 + k * 1024); } } while (0)
#define PG8_MMA(ai, bj, At, Bt) do { __builtin_amdgcn_s_setprio(1); _Pragma("unroll") for (int m = 0; m < 4; ++m) _Pragma("unroll") for (int n = 0; n < 2; ++n) { \
    if (FP8) asm volatile("v_mfma_scale_f32_16x16x128_f8f6f4 %0, %1, %2, %0, %3, %3 op_sel_hi:[0,0,0]" : "+v"(acc[ai][bj][m][n]) : "v"(Bt##8[n]), "v"(At##8[m]), "v"(sc1));   \
    else { _Pragma("unroll") for (int k = 0; k < 2; ++k) acc[ai][bj][m][n] = __builtin_amdgcn_mfma_f32_16x16x32_bf16(Bt[n][k], At[m][k], acc[ai][bj][m][n], 0, 0, 0); } } \
    __builtin_amdgcn_s_setprio(0); } while (0)
#define PG8_WAIT_V(n) asm volatile("s_waitcnt vmcnt(" #n ")" ::: "memory")
#define PG8_WAIT_L(n) asm volatile("s_waitcnt lgkmcnt(" #n ")" ::: "memory")
#define PG8_BAR __builtin_amdgcn_s_barrier()
#define PG8_SCHED __builtin_amdgcn_sched_barrier(0)
  Unit cur, nxt; int ui = 0;
  if (!S.next(0, cur)) return;
  f32x4v acc[2][2][4][2];
#pragma unroll
  for (int a = 0; a < 2; ++a)
#pragma unroll
    for (int b = 0; b < 2; ++b)
#pragma unroll
      for (int m = 0; m < 4; ++m)
#pragma unroll
        for (int n = 0; n < 2; ++n) acc[a][b][m][n] = (f32x4v){0.f, 0.f, 0.f, 0.f};
  unsigned sc1 = 0x7f7f7f7fu; asm volatile("" : "+v"(sc1));
  bf16x8 At[4][2], B0[2][2], B1[2][2];
  v8i_t At8[4], B08[2], B18[2];
  unsigned cV[2][2];
#pragma unroll
  for (int h = 0; h < 2; ++h)
#pragma unroll
    for (int i = 0; i < 2; ++i) cV[h][i] = 0u;
  PG8_ROWS(cV, cur);
  unsigned cA = PG8_ABASE(cur), cB = cur.boff;
  PG8_STAGE_B(PG8_SB(0, 0), cB, 0); PG8_STAGE_B(PG8_SB(0, 1), cB, 1);
  PG8_STAGE_A(PG8_SA(0, 0), cA, 0, cV[0][0], cV[0][1]); PG8_STAGE_A(PG8_SA(0, 1), cA, 1, cV[1][0], cV[1][1]);
  if (wr == 1) PG8_BAR;
  PG8_WAIT_V(2); PG8_BAR;
  PG8_STAGE_B(PG8_SB(1, 0), cB + kstep, 0); PG8_STAGE_A(PG8_SA(1, 0), cA + kstep, 0, cV[0][0], cV[0][1]); PG8_STAGE_B(PG8_SB(1, 1), cB + kstep, 1);
  PG8_WAIT_V(6); PG8_BAR;
  for (;;) {
    const bool has_next = S.next(ui + 1, nxt);
    const unsigned nB = has_next ? nxt.boff : cB;
    const unsigned nA = has_next ? PG8_ABASE(nxt) : cA;
#pragma unroll 1
    for (int t = 0; t < NT_K; t += 2) {
      const bool last = (t == NT_K - 2);
      const unsigned a1 = cA + (unsigned)(t + 1) * kstep;
      const unsigned a2 = last ? nA : cA + (unsigned)(t + 2) * kstep, b2 = last ? nB : cB + (unsigned)(t + 2) * kstep;
      const unsigned a3 = a2 + kstep, b3 = b2 + kstep;
      unsigned w00 = cV[0][0], w01 = cV[0][1], w10 = cV[1][0], w11 = cV[1][1];
      if (GATHER && last && has_next) { unsigned nV[2][2]; PG8_ROWS(nV, nxt); w00 = nV[0][0]; w01 = nV[0][1]; w10 = nV[1][0]; w11 = nV[1][1]; }
      PG8_LDB(B0, 0, 0); PG8_LDB(B1, 0, 1); PG8_SCHED; PG8_LDA(At, 0, 0); PG8_STAGE_A(PG8_SA(1, 1), a1, 1, cV[1][0], cV[1][1]);
      PG8_WAIT_V(8); PG8_WAIT_L(0); PG8_BAR; PG8_MMA(0, 0, At, B0); PG8_MMA(0, 1, At, B1); PG8_BAR; PG8_SCHED;
      PG8_LDA(At, 0, 1); PG8_STAGE_B(PG8_SB(0, 0), b2, 0); PG8_STAGE_B(PG8_SB(0, 1), b2, 1); PG8_STAGE_A(PG8_SA(0, 0), a2, 0, w00, w01);
      PG8_WAIT_V(8); PG8_WAIT_L(0); PG8_BAR; PG8_MMA(1, 0, At, B0); PG8_MMA(1, 1, At, B1); PG8_BAR; PG8_SCHED;
      PG8_LDB(B0, 1, 0); PG8_LDB(B1, 1, 1); PG8_SCHED; PG8_LDA(At, 1, 0); PG8_STAGE_A(PG8_SA(0, 1), a2, 1, w10, w11);
      PG8_WAIT_V(8); PG8_WAIT_L(0); PG8_BAR; PG8_MMA(0, 0, At, B0); PG8_MMA(0, 1, At, B1); PG8_BAR; PG8_SCHED;
      PG8_LDA(At, 1, 1); PG8_STAGE_B(PG8_SB(1, 0), b3, 0); PG8_STAGE_B(PG8_SB(1, 1), b3, 1); PG8_STAGE_A(PG8_SA(1, 0), a3, 0, w00, w01);
      PG8_WAIT_V(8); PG8_WAIT_L(0); PG8_BAR; PG8_MMA(1, 0, At, B0); PG8_MMA(1, 1, At, B1); PG8_BAR; PG8_SCHED;
    }
    if (wr == 0) PG8_BAR;
    if (FP8) asm volatile("s_nop 15\n\ts_nop 15" ::: "memory");
    E(acc, cur, wr, wc, fr, fq);
    if (!has_next) break;
#pragma unroll
    for (int a = 0; a < 2; ++a)
#pragma unroll
      for (int b = 0; b < 2; ++b)
#pragma unroll
        for (int m = 0; m < 4; ++m)
#pragma unroll
          for (int n = 0; n < 2; ++n) acc[a][b][m][n] = (f32x4v){0.f, 0.f, 0.f, 0.f};
    if (FP8) asm volatile("s_nop 7" ::: "memory");
    cur = nxt; cB = nB; cA = nA; ++ui;
    PG8_ROWS(cV, cur);
    if (wr == 1) PG8_BAR;
  }
  PG8_WAIT_V(0);
  PG8_BAR;
#undef PG8_ROWS
#undef PG8_ABASE
#undef PG8_SA
#undef PG8_SB
#undef PG8_LOAD1
#undef PG8_STAGE_A
#undef PG8_STAGE_B
#undef PG8_LDA
#undef PG8_LDB
#undef PG8_MMA
#undef PG8_WAIT_V
#undef PG8_WAIT_L
#undef PG8_BAR
#undef PG8_SCHED
}
}

struct InprojSched {
  int grid, bid;
  __device__ __forceinline__ bool next(int i, pg8::Unit& u) const {
    constexpr int NT = NP / 256;
    int mt, nt;
    if (grid == 256) { const int xcd = bid & 7, j = bid >> 3, q = j + 32 * i; if (q >= 8 * NT) return false; mt = 8 * xcd + q / NT; nt = q % NT; }
    else { const int t = bid + i * grid; if (t >= 64 * NT) return false; mt = t / NT; nt = t % NT; }
    u.boff = (unsigned)nt * (256u * 1024u * 2u); u.arow0 = mt * 256; u.mvalid = 256; u.e = 0; u.mt = mt; u.nt = nt; u.slot0 = 0;
    return true;
  }
};
struct InprojEpi {
  bf16_t* P; float* gateF; const f32x2* cs; float* ssq;
  __device__ __forceinline__ void operator()(const pg8::f32x4v (&acc)[2][2][4][2], const pg8::Unit& u, int wr, int wc, int fr, int fq) const {
    const int nt = u.nt;
    const bool rope_all = (nt == 3) || (nt == 4);
#pragma unroll
    for (int ai = 0; ai < 2; ++ai)
#pragma unroll
      for (int m = 0; m < 4; ++m) {
        const int row = u.mt * 256 + 128 * ai + 64 * wr + 16 * m + fr;
        bf16_t* prow = P + (size_t)row * NP + nt * 256 + 32 * wc + 4 * fq;
        f32x2 c4[4];
        if (rope_all || nt == 10) {
#pragma unroll
          for (int j = 0; j < 4; ++j) c4[j] = cs[(size_t)row * 16 + 4 * fq + j];
        }
        float sq = 0.f;
#pragma unroll
        for (int bj = 0; bj < 2; ++bj) {
          pg8::f32x4v v0 = acc[ai][bj][m][0], v1 = acc[ai][bj][m][1];
          if (rope_all || (nt == 10 && bj == 1 && wc == 0)) {
#pragma unroll
            for (int j = 0; j < 4; ++j) { const float x1 = v0[j], x2 = v1[j]; v0[j] = x1 * c4[j].x - x2 * c4[j].y; v1[j] = x2 * c4[j].x + x1 * c4[j].y; }
          }
          if (nt == 9 || (nt == 10 && bj == 0)) {
#pragma unroll
            for (int j = 0; j < 4; ++j) sq += v0[j] * v0[j] + v1[j] * v1[j];
          }
          u32x2 o; o.x = cvtpk(v0[0], v0[1]); o.y = cvtpk(v0[2], v0[3]);
          *(u32x2*)(prow + 128 * bj) = o;
          o.x = cvtpk(v1[0], v1[1]); o.y = cvtpk(v1[2], v1[3]);
          *(u32x2*)(prow + 128 * bj + 16) = o;
          if (nt == 10 && bj == 1 && wc == 1 && fq == 0) *(f32x4*)(gateF + (size_t)row * 4) = (f32x4){v0[0], v0[1], v0[2], v0[3]};
        }
        if (nt == 9 || nt == 10) {
          sq += __shfl_xor(sq, 16); sq += __shfl_xor(sq, 32);
          if (fq == 0) ssq[(size_t)row * 8 + (nt == 9 ? 0 : 4) + wc] = sq;
        }
      }
  }
};
__device__ __forceinline__ void phase_inproj(const Params& p, int layer, LAS unsigned char* lds) {
  unsigned char* ws = p.ws;
  InprojSched S{get_nblk(), get_bid()};
  InprojEpi E{(bf16_t*)(ws + OFF_P), (float*)(ws + OFF_GATEF), (const f32x2*)(ws + OFF_ROPE), (float*)(ws + OFF_CQN)};
  pg8::gemm_phase<false, false>(lds, (const bf16_t*)(ws + OFF_HB), (const bf16_t*)(ws + OFF_WIN) + (size_t)layer * NP * 1024, S, E);
}

__device__ __forceinline__ void rope4(bf16_t* base, const f32x2* cs4) {
  const u32x2 a = *(const u32x2*)base, b = *(const u32x2*)(base + 16);
  float x1[4] = {bflo(a.x), bfhi(a.x), bflo(a.y), bfhi(a.y)}, x2[4] = {bflo(b.x), bfhi(b.x), bflo(b.y), bfhi(b.y)};
  float y1[4], y2[4];
#pragma unroll
  for (int i = 0; i < 4; ++i) { const f32x2 c = cs4[i]; y1[i] = x1[i] * c.x - x2[i] * c.y; y2[i] = x2[i] * c.x + x1[i] * c.y; }
  u32x2 oa, ob; oa.x = cvtpk(y1[0], y1[1]); oa.y = cvtpk(y1[2], y1[3]); ob.x = cvtpk(y2[0], y2[1]); ob.y = cvtpk(y2[2], y2[3]);
  *(u32x2*)base = oa; *(u32x2*)(base + 16) = ob;
}
__device__ __forceinline__ void phase_post(const Params& p, int layer, LAS unsigned char* lds) {
  unsigned char* ws = p.ws;
  bf16_t* P = (bf16_t*)(ws + OFF_P);
  const f32x2* cs = (const f32x2*)(ws + OFF_ROPE);
  bf16_t* cqn = (bf16_t*)(ws + OFF_CQN); bf16_t* ckvn = (bf16_t*)(ws + OFF_CKVN);
  const int lane = get_tid() & 63, gw = get_bid() * 8 + (get_tid() >> 6), ngw = get_nblk() * 8;
  const float* gq = p.mla_q_norm_g + layer * 256; const float* gkv = p.mla_kv_norm_g + layer * 128;
  for (int m = gw; m < M_TOK; m += ngw) {
    bf16_t* row = P + (size_t)m * NP;
    const f32x2* csm = cs + (size_t)m * 16;
    { const int sh = lane >> 2, pg = lane & 3; rope4(row + C_DFQ + sh * 32 + 4 * pg, csm + 4 * pg); }
    if (lane < 4) rope4(row + C_KR + 4 * lane, csm + 4 * lane);
    {
      const u32x2 a = *(const u32x2*)(row + C_CQ + 4 * lane);
      float x[4] = {bflo(a.x), bfhi(a.x), bflo(a.y), bfhi(a.y)};
      const float ss = wave_sum(x[0] * x[0] + x[1] * x[1] + x[2] * x[2] + x[3] * x[3]);
      const float rs = rsqrtf(ss * (1.f / 256.f) + RMS_EPS);
      const f32x4 gg = *(const f32x4*)(gq + 4 * lane);
      u32x2 o; o.x = cvtpk(x[0] * rs * gg.x, x[1] * rs * gg.y); o.y = cvtpk(x[2] * rs * gg.z, x[3] * rs * gg.w);
      *(u32x2*)(cqn + (size_t)m * 256 + 4 * lane) = o;
    }
    {
      const unsigned a = *(const unsigned*)(row + C_CKV + 2 * lane);
      const float x0 = bflo(a), x1 = bfhi(a);
      const float ss = wave_sum(x0 * x0 + x1 * x1);
      const float rs = rsqrtf(ss * (1.f / 128.f) + RMS_EPS);
      const f32x2 gg = *(const f32x2*)(gkv + 2 * lane);
      *(unsigned*)(ckvn + (size_t)m * 128 + 2 * lane) = cvtpk(x0 * rs * gg.x, x1 * rs * gg.y);
    }
  }
  if (get_bid() < 16) {
    const int b = get_bid() >> 2, h = get_bid() & 3, tid = get_tid();
    const float* gateF = (const float*)(ws + OFF_GATEF);
    float* Fk = (float*)(ws + OFF_FK) + (size_t)get_bid() * SEQ;
    const float bf = p.b_forget[layer * 4 + h];
    LAS float* sc = (LAS float*)lds;
    float v[8]; float run = 0.f;
#pragma unroll
    for (int i = 0; i < 8; ++i) {
      const float xx = gateF[(size_t)(b * SEQ + tid * 8 + i) * 4 + h] + bf;
      const float ls = fminf(xx, 0.f) - log1pf(expf(-fabsf(xx)));
      run += ls; v[i] = run;
    }
    float inc = run;
#pragma unroll
    for (int o = 1; o < 64; o <<= 1) { const float t = __shfl_up(inc, o); if (lane >= o) inc += t; }
    __syncthreads();
    if (lane == 63) sc[tid >> 6] = inc;
    __syncthreads();
    float wbase = 0.f;
    for (int i = 0; i < (tid >> 6); ++i) wbase += sc[i];
    const float excl = wbase + inc - run;
#pragma unroll
    for (int i = 0; i < 8; ++i) Fk[tid * 8 + i] = -8.f * (excl + v[i]);
    __syncthreads();
  }
}

__device__ __forceinline__ void phase_mla_up(const Params& p, int layer, LAS unsigned char* lds) {
  unsigned char* ws = p.ws;
  const bf16_t* P = (const bf16_t*)(ws + OFF_P);
  const float* ssq = (const float*)(ws + OFF_CQN);
  const bf16_t* Wq = (const bf16_t*)(ws + OFF_WUQ) + (size_t)layer * 384 * 256;
  const bf16_t* Wkv = (const bf16_t*)(ws + OFF_WUKV) + (size_t)layer * 512 * 128;
  bf16_t* qd = (bf16_t*)(ws + OFF_QD); bf16_t* kvd = (bf16_t*)(ws + OFF_KVD);
  const int sb = get_bid() - (get_nblk() - 16);
  if (sb >= 0) {
    const int b = sb >> 2, h = sb & 3, tid = get_tid(), lane = tid & 63;
    const float* gateF = (const float*)(ws + OFF_GATEF);
    float* Fk = (float*)(ws + OFF_FK) + (size_t)sb * SEQ;
    const float bf = p.b_forget[layer * 4 + h];
    LAS float* sc = (LAS float*)lds;
    float v[8]; float run = 0.f;
#pragma unroll
    for (int i = 0; i < 8; ++i) {
      const float xx = gateF[(size_t)(b * SEQ + tid * 8 + i) * 4 + h] + bf;
      const float ls = fminf(xx, 0.f) - log1pf(expf(-fabsf(xx)));
      run += ls; v[i] = run;
    }
    float inc = run;
#pragma unroll
    for (int o = 1; o < 64; o <<= 1) { const float t = __shfl_up(inc, o); if (lane >= o) inc += t; }
    __syncthreads();
    if (lane == 63) sc[tid >> 6] = inc;
    __syncthreads();
    float wbase = 0.f;
    for (int i = 0; i < (tid >> 6); ++i) wbase += sc[i];
    const float excl = wbase + inc - run;
#pragma unroll
    for (int i = 0; i < 8; ++i) Fk[tid * 8 + i] = -8.f * (excl + v[i]);
    __syncthreads();
  }
  const int lane = get_tid() & 63, w = get_tid() >> 6, wm = w >> 1, wn = w & 1, c31 = lane & 31, hi = lane >> 5;
  for (int item = get_bid() * 8 + w; item < 16 * 64; item += get_nblk() * 8) {
    const int bh = item >> 6, tl = item & 63, b = bh >> 2, h = bh & 3;
    const bf16_t* kr = P + (size_t)(b * SEQ + 64 * tl + lane) * NP + C_FXK + h * 64;
    float ss = 0.f;
#pragma unroll
    for (int c = 0; c < 8; ++c) {
      const u32x4 x = *(const u32x4*)(kr + 8 * c);
      ss += bflo(x.x) * bflo(x.x) + bfhi(x.x) * bfhi(x.x) + bflo(x.y) * bflo(x.y) + bfhi(x.y) * bfhi(x.y) + bflo(x.z) * bflo(x.z) + bfhi(x.z) * bfhi(x.z) + bflo(x.w) * bflo(x.w) + bfhi(x.w) * bfhi(x.w);
    }
    float nv = sqrtf(ss) * 1.0001f;
#pragma unroll
    for (int o = 1; o < 64; o <<= 1) nv = fmaxf(nv, __shfl_xor(nv, o));
    if (lane == 0) ((float*)(ws + OFF_KN))[item] = nv;
  }
  constexpr int TQ = 64 * 3, TKV = 64 * 4;
  for (int t = get_bid(); t < TQ + TKV; t += get_nblk()) {
    const bool isq = t < TQ; const int tt = isq ? t : t - TQ; const int ntn = isq ? 3 : 4; const int mt = tt / ntn, nt = tt % ntn;
    GemmDesc g;
    if (isq) g = GemmDesc{P + C_CQ, NP, nullptr, mt * 256, 256, Wq + (size_t)nt * 128 * 256, 256, 256};
    else g = GemmDesc{P + C_CKV, NP, nullptr, mt * 256, 256, Wkv + (size_t)nt * 128 * 128, 128, 128};
    f32x16 acc[2][2];
    gemm_tile<2>(lds, g, acc);
    bf16_t* O = isq ? qd : kvd; const int ldo = isq ? 384 : 512;
#pragma unroll
    for (int mi = 0; mi < 2; ++mi) {
      const int m = mt * 256 + wm * 64 + mi * 32 + c31;
      const f32x4 s4 = *(const f32x4*)(ssq + (size_t)m * 8 + (isq ? 0 : 4));
      const float rs = rsqrtf(((s4.x + s4.y) + (s4.z + s4.w)) * (isq ? (1.f / 256.f) : (1.f / 128.f)) + RMS_EPS);
#pragma unroll
      for (int ni = 0; ni < 2; ++ni)
#pragma unroll
        for (int g4 = 0; g4 < 4; ++g4) {
          const int n = nt * 128 + wn * 64 + ni * 32 + 4 * hi + 8 * g4;
          u32x2 o; o.x = cvtpk(acc[mi][ni][4 * g4] * rs, acc[mi][ni][4 * g4 + 1] * rs); o.y = cvtpk(acc[mi][ni][4 * g4 + 2] * rs, acc[mi][ni][4 * g4 + 3] * rs);
          *(u32x2*)(O + (size_t)m * ldo + n) = o;
        }
    }
  }
}

constexpr int CMU_UP = 32 * 8 * 32, CMU_DN = 32 * 8 * 16, CMU_TOTAL = CMU_UP + CMU_DN;
struct ConvCtx { const float* wgu; const float* wdn; unsigned char* dgu; unsigned char* ddn; int* ctr; };
__device__ __forceinline__ void cmu_load(const ConvCtx& c, int idx, int lane, int w, float (&v)[16]) {
  const bool up = idx < CMU_UP;
  const int i2 = up ? idx : idx - CMU_UP;
  const int e = up ? (i2 >> 8) : (i2 >> 7), rem = up ? (i2 & 255) : (i2 & 127);
  const int kb = up ? (rem >> 5) : (rem >> 4), nb = up ? (rem & 31) : (rem & 15);
  const int N = up ? 2048 : 1024;
  const float* base = up ? c.wgu : c.wdn;
  const float* sp = base + ((size_t)e * 1024 + kb * 128 + 16 * w) * N + nb * 64 + lane;
#pragma unroll
  for (int j = 0; j < 16; ++j) v[j] = __builtin_nontemporal_load(sp + (size_t)j * N);
}
__device__ __forceinline__ void cmu_store(const ConvCtx& c, int idx, int lane, int w, const float (&v)[16]) {
  const bool up = idx < CMU_UP;
  const int i2 = up ? idx : idx - CMU_UP;
  const int e = up ? (i2 >> 8) : (i2 >> 7), rem = up ? (i2 & 255) : (i2 & 127);
  const int kb = up ? (rem >> 5) : (rem >> 4), nb = up ? (rem & 31) : (rem & 15);
  const int N = up ? 2048 : 1024;
  const int n = nb * 64 + lane;
  int dr = n;
  if (up) { const int j = n & 1023; dr = (j >> 4) * 32 + (j & 15) + ((n >= 1024) ? 16 : 0); }
  unsigned char* base = up ? c.dgu : c.ddn;
  const float sc = up ? S8_WGU : S8_WDN;
  u32x4 o;
  o.x = pk4_fp8(v[0] * sc, v[1] * sc, v[2] * sc, v[3] * sc); o.y = pk4_fp8(v[4] * sc, v[5] * sc, v[6] * sc, v[7] * sc);
  o.z = pk4_fp8(v[8] * sc, v[9] * sc, v[10] * sc, v[11] * sc); o.w = pk4_fp8(v[12] * sc, v[13] * sc, v[14] * sc, v[15] * sc);
  *(u32x4*)(base + ((size_t)e * N + dr) * 1024 + kb * 128 + 16 * w) = o;
}

__device__ __forceinline__ void cmu_to_lds(const ConvCtx& c, int idx, int lane, int w, const float (&v)[16], LAS unsigned char* tile) {
  const float sc = (idx < CMU_UP) ? S8_WGU : S8_WDN;
  u32x4 o;
  o.x = pk4_fp8(v[0] * sc, v[1] * sc, v[2] * sc, v[3] * sc); o.y = pk4_fp8(v[4] * sc, v[5] * sc, v[6] * sc, v[7] * sc);
  o.z = pk4_fp8(v[8] * sc, v[9] * sc, v[10] * sc, v[11] * sc); o.w = pk4_fp8(v[12] * sc, v[13] * sc, v[14] * sc, v[15] * sc);
  *(LAS u32x4*)(tile + lane * 128 + ((w ^ (lane & 7)) << 4)) = o;
}
__device__ __forceinline__ void cmu_from_lds(const ConvCtx& c, int idx, int lane, int w, const LAS unsigned char* tile) {
  const bool up = idx < CMU_UP;
  const int i2 = up ? idx : idx - CMU_UP;
  const int e = up ? (i2 >> 8) : (i2 >> 7), rem = up ? (i2 & 255) : (i2 & 127);
  const int kb = up ? (rem >> 5) : (rem >> 4), nb = up ? (rem & 31) : (rem & 15);
  const int N = up ? 2048 : 1024;
  const int r = 8 * w + (lane >> 3), ch = lane & 7;
  const u32x4 o = *(const LAS u32x4*)(tile + r * 128 + ((ch ^ (r & 7)) << 4));
  const int n = nb * 64 + r;
  int dr = n;
  if (up) { const int j = n & 1023; dr = (j >> 4) * 32 + (j & 15) + ((n >= 1024) ? 16 : 0); }
  unsigned char* base = up ? c.dgu : c.ddn;
  *(u32x4*)(base + ((size_t)e * N + dr) * 1024 + kb * 128 + 16 * ch) = o;
}

enum { AT_SB = 0, AT_DIFF = 1, AT_FOX = 2, AT_MLA = 3 };
struct AttnArgs {
  const bf16_t* Q; int ldq; const bf16_t* K; int ldk; const bf16_t* V; int ldv; const bf16_t* K2; int ldk2;
  const float* Fk; const f32x2* cs; bf16_t* O; int ldo; float lam, oscale; const float* subg; const float* kn;
};
constexpr int ATT_K1 = 0, ATT_V = 8192, ATT_K2 = 16384, ATT_F = 20480, ATT_BUF = 20992;

__device__ __forceinline__ float max3f(float a, float b, float c) { float r; asm("v_max3_f32 %0, %1, %2, %3" : "=v"(r) : "v"(a), "v"(b), "v"(c)); return r; }
__device__ __forceinline__ float max2f(float a, float b) { float r; asm("v_max_f32_e32 %0, %1, %2" : "=v"(r) : "v"(a), "v"(b)); return r; }
__device__ __forceinline__ bool softmax_tile(f32x16& p0, f32x16& p1, float& m, float& l, float c, bool domask, int kbase, int q, int hi, float& alpha) {
  if (domask) {
#pragma unroll
    for (int r = 0; r < 16; ++r) { const int key = kbase + crow(r, hi); if (key > q) p0[r] = -INFINITY; if (key + 32 > q) p1[r] = -INFINITY; }
  }
  asm volatile("s_nop 15\n\ts_nop 7" : "+v"(p0), "+v"(p1));
  float a = max3f(p0[0], p0[1], p1[0]), b = max3f(p0[2], p0[3], p1[1]); a = max3f(a, p1[2], p1[3]);
#pragma unroll
  for (int r = 4; r < 16; r += 4) { a = max3f(a, p0[r], p0[r + 1]); b = max3f(b, p0[r + 2], p0[r + 3]); a = max3f(a, p1[r], p1[r + 1]); b = max3f(b, p1[r + 2], p1[r + 3]); }
  float a0, a1; pair_vals(max2f(a, b), a0, a1);
  const float rm = max2f(a0, a1);
  const bool resc = __any((rm - m) * c > 8.0f);
  alpha = 1.f;
  if (resc) { const float mn = max2f(m, rm); alpha = __builtin_amdgcn_exp2f((m - mn) * c); l *= alpha; m = mn; }
  const float mc = m * c;
  float s = 0.f;
#pragma unroll
  for (int r = 0; r < 16; ++r) { p0[r] = __builtin_amdgcn_exp2f(fmaf(p0[r], c, -mc)); p1[r] = __builtin_amdgcn_exp2f(fmaf(p1[r], c, -mc)); s += p0[r] + p1[r]; }
  l += s;
  return resc;
}
__device__ __forceinline__ bf16x8 pack8(const f32x16& p, int b) {
  u32x4 w; w.x = cvtpk(p[b], p[b + 1]); w.y = cvtpk(p[b + 2], p[b + 3]); w.z = cvtpk(p[b + 4], p[b + 5]); w.w = cvtpk(p[b + 6], p[b + 7]);
  return __builtin_bit_cast(bf16x8, w);
}
__device__ __forceinline__ bf16x8 vfrag(LAS unsigned char* vb, int off) {
  const s16x4 lo = __builtin_bit_cast(s16x4, __builtin_amdgcn_ds_read_tr16_b64_v4i16((LAS s16x4*)(vb + off)));
  const s16x4 hh = __builtin_bit_cast(s16x4, __builtin_amdgcn_ds_read_tr16_b64_v4i16((LAS s16x4*)(vb + off + 1024)));
  return (bf16x8){lo[0], lo[1], lo[2], lo[3], hh[0], hh[1], hh[2], hh[3]};
}

template <int T>
__device__ __forceinline__ void attn_unit(LAS unsigned char* lds, const AttnArgs& a, int qb, const ConvCtx& cc, int& gi, int& pidx, int& qidx, float (&cv)[16]) {
  const int tid = get_tid(), lane = tid & 63, w = tid >> 6, c31 = lane & 31, hi = lane >> 5;
  const int t0 = qb * 256 + w * 32, q = t0 + c31;
  constexpr int NKS = (T == AT_MLA) ? 6 : 4;
  constexpr float CSC = (T == AT_DIFF) ? 0.17677669529663687f * LOG2E : (T == AT_MLA) ? 0.10206207261596577f * LOG2E : 0.125f * LOG2E;
  bf16x8 qf[NKS];
  {
    const bf16_t* qrow = a.Q + (size_t)q * a.ldq;
#pragma unroll
    for (int ks = 0; ks < NKS; ++ks) qf[ks] = *(const bf16x8*)(qrow + 16 * ks + 8 * hi);
    if (T == AT_MLA) {
      const f32x2* csq = a.cs + (size_t)q * 16 + 8 * hi;
      bf16x8 n4, n5;
#pragma unroll
      for (int j = 0; j < 8; j += 2) {
        const f32x2 c0 = csq[j], c1 = csq[j + 1];
        const float x1a = bf2f((unsigned short)qf[4][j]), x1b = bf2f((unsigned short)qf[4][j + 1]);
        const float x2a = bf2f((unsigned short)qf[5][j]), x2b = bf2f((unsigned short)qf[5][j + 1]);
        const unsigned w1 = cvtpk(x1a * c0.x - x2a * c0.y, x1b * c1.x - x2b * c1.y);
        const unsigned w2 = cvtpk(x2a * c0.x + x1a * c0.y, x2b * c1.x + x1b * c1.y);
        n4[j] = (short)(w1 & 0xffff); n4[j + 1] = (short)(w1 >> 16); n5[j] = (short)(w2 & 0xffff); n5[j + 1] = (short)(w2 >> 16);
      }
      qf[4] = n4; qf[5] = n5;
    }
  }
  const int skey = tid >> 3, sch = tid & 7;
  const int k1_st = ATT_K1 + skey * 128 + ((sch ^ ((skey >> 1) & 7)) << 4);
  const int v_st = ATT_V + skey * 128 + ((sch ^ (((skey >> 1) & 1) << 2)) << 4);
  const int k2key = tid >> 2, k2ch = tid & 3;
  const int k2_st = ATT_K2 + k2key * 64 + ((k2ch ^ ((k2key >> 2) & 3)) << 4);
  const int xr = (lane >> 1) & 7;
  int kro[4];
#pragma unroll
  for (int ks = 0; ks < 4; ++ks) kro[ks] = ATT_K1 + c31 * 128 + (((2 * ks + hi) ^ xr) << 4);
  int k2ro[2];
#pragma unroll
  for (int ks = 0; ks < 2; ++ks) k2ro[ks] = ATT_K2 + c31 * 64 + (((2 * ks + hi) ^ ((c31 >> 2) & 3)) << 4);
  int vro[2];
  {
    const int i = lane & 15, qq = i >> 2, pp = i & 3, gg = (lane >> 4) & 1, bit = (qq >> 1) & 1;
#pragma unroll
    for (int d0 = 0; d0 < 2; ++d0) vro[d0] = ATT_V + (4 * hi + qq) * 128 + ((4 * (d0 ^ bit) + 2 * gg + (pp >> 1)) << 4) + (pp & 1) * 8;
  }
  const int ntiles = 4 * (qb + 1);
  const int wave_last = (t0 + 31) >> 6;
  LAS float* kpre = (LAS float*)(lds + 2 * ATT_BUF + 256);
  LAS float* fend = kpre + 64;
  float qn = 0.f;
  if (T == AT_FOX) {
    if (w == 0) {
      float v = (lane < ntiles) ? a.kn[lane] : 0.f;
#pragma unroll
      for (int o = 1; o < 64; o <<= 1) { const float u_ = __shfl_up(v, o); if (lane >= o) v = fmaxf(v, u_); }
      kpre[lane] = v;
      fend[lane] = (lane < ntiles) ? a.Fk[64 * lane + 63] : 0.f;
    }
    float ss = 0.f;
#pragma unroll
    for (int ks = 0; ks < 4; ++ks)
#pragma unroll
      for (int j = 0; j < 8; ++j) { const float x = bf2f((unsigned short)qf[ks][j]); ss += x * x; }
    float s0_, s1_; pair_vals(ss, s0_, s1_);
    qn = sqrtf(s0_ + s1_) * 1.0001f;
  }
  f32x16 o0[2], o1[2];
#pragma unroll
  for (int d0 = 0; d0 < 2; ++d0)
#pragma unroll
    for (int r = 0; r < 16; ++r) { o0[d0][r] = 0.f; o1[d0][r] = 0.f; }
  float m0 = -INFINITY, l0 = 0.f, m1 = -INFINITY, l1 = 0.f;
  float Crun = 0.f;
  bool fin = false;
  u32x4 rk, rv, rk2; float rf = 0.f;
#define ATT_TILE(it) ((T == AT_SB || T == AT_FOX) ? (ntiles - 1 - (it)) : (it))
#define ATT_GLOAD(t) do { const int key_ = 64 * (t) + skey; \
    rk = *(const u32x4*)(a.K + (size_t)key_ * a.ldk + sch * 8); rv = *(const u32x4*)(a.V + (size_t)key_ * a.ldv + sch * 8); \
    if (T == AT_MLA) { if (tid < 256) rk2 = *(const u32x4*)(a.K2 + (size_t)(64 * (t) + k2key) * a.ldk2 + k2ch * 8); } \
    if (T == AT_FOX) { if (tid < 64) rf = a.Fk[64 * (t) + tid]; } } while (0)
#define ATT_LSTORE(buf) do { LAS unsigned char* b_ = lds + (buf) * ATT_BUF; \
    *(LAS u32x4*)(b_ + k1_st) = rk; *(LAS u32x4*)(b_ + v_st) = rv; \
    if (T == AT_MLA) { if (tid < 256) *(LAS u32x4*)(b_ + k2_st) = rk2; } \
    if (T == AT_FOX) { if (tid < 64) *(LAS float*)(b_ + ATT_F + 4 * tid) = rf; } } while (0)
  LAS int* s_conv = (LAS int*)(lds + 2 * ATT_BUF + 64);
  ATT_GLOAD(ATT_TILE(0));
  ATT_LSTORE(0);
  __syncthreads();
  for (int it = 0; it < ntiles; ++it) {
    const int t = ATT_TILE(it);
    LAS unsigned char* cur = lds + (it & 1) * ATT_BUF;
    const bool more = (it + 1 < ntiles);
    const int cidx = __builtin_amdgcn_readfirstlane(s_conv[(gi >> 3) & 1]) + (gi & 7);
    int cnext = 0;
    const bool cfetch = (gi & 7) == 0;
    if (cfetch && tid == 0) cnext = atomicAdd(cc.ctr, 8);
    if (more) ATT_GLOAD(ATT_TILE(it + 1));
    const bool active = (t <= wave_last) && !fin;
    if (active) {
      const bool domask = (64 * t + 63 > t0);
      const int kbase = 64 * t;
      if (T == AT_DIFF) {
        f32x16 pa0, pa1, pb0, pb1;
#pragma unroll
        for (int r = 0; r < 16; ++r) { pa0[r] = 0.f; pa1[r] = 0.f; pb0[r] = 0.f; pb1[r] = 0.f; }
#pragma unroll
        for (int ks = 0; ks < 2; ++ks) {
          const bf16x8 k0 = *(const LAS bf16x8*)(cur + kro[ks]), k1 = *(const LAS bf16x8*)(cur + kro[ks] + 4096);
          pa0 = __builtin_amdgcn_mfma_f32_32x32x16_bf16(k0, qf[ks], pa0, 0, 0, 0); pa1 = __builtin_amdgcn_mfma_f32_32x32x16_bf16(k1, qf[ks], pa1, 0, 0, 0);
        }
#pragma unroll
        for (int ks = 2; ks < 4; ++ks) {
          const bf16x8 k0 = *(const LAS bf16x8*)(cur + kro[ks]), k1 = *(const LAS bf16x8*)(cur + kro[ks] + 4096);
          pb0 = __builtin_amdgcn_mfma_f32_32x32x16_bf16(k0, qf[ks], pb0, 0, 0, 0); pb1 = __builtin_amdgcn_mfma_f32_32x32x16_bf16(k1, qf[ks], pb1, 0, 0, 0);
        }
        float al0, al1;
        const bool rs0 = softmax_tile(pa0, pa1, m0, l0, CSC, domask, kbase, q, hi, al0);
        const bool rs1 = softmax_tile(pb0, pb1, m1, l1, CSC, domask, kbase, q, hi, al1);
        if (rs0) {
#pragma unroll
          for (int d0 = 0; d0 < 2; ++d0)
#pragma unroll
            for (int r = 0; r < 16; ++r) o0[d0][r] *= al0;
        }
        if (rs1) {
#pragma unroll
          for (int d0 = 0; d0 < 2; ++d0)
#pragma unroll
            for (int r = 0; r < 16; ++r) o1[d0][r] *= al1;
        }
#pragma unroll
        for (int s = 0; s < 4; ++s) {
          const bf16x8 pfa = pack8((s < 2) ? pa0 : pa1, 8 * (s & 1)), pfb = pack8((s < 2) ? pb0 : pb1, 8 * (s & 1));
#pragma unroll
          for (int d0 = 0; d0 < 2; ++d0) {
            const bf16x8 vf = vfrag(cur, vro[d0] + 2048 * s);
            o0[d0] = __builtin_amdgcn_mfma_f32_32x32x16_bf16(vf, pfa, o0[d0], 0, 0, 0);
            o1[d0] = __builtin_amdgcn_mfma_f32_32x32x16_bf16(vf, pfb, o1[d0], 0, 0, 0);
          }
        }
      } else {
        f32x16 p0, p1;
        if (T == AT_FOX) {
#pragma unroll
          for (int g4 = 0; g4 < 4; ++g4) {
            const f32x4 f0 = *(const LAS f32x4*)(cur + ATT_F + (8 * g4 + 4 * hi) * 4), f1 = *(const LAS f32x4*)(cur + ATT_F + (32 + 8 * g4 + 4 * hi) * 4);
            p0[4 * g4] = f0.x; p0[4 * g4 + 1] = f0.y; p0[4 * g4 + 2] = f0.z; p0[4 * g4 + 3] = f0.w;
            p1[4 * g4] = f1.x; p1[4 * g4 + 1] = f1.y; p1[4 * g4 + 2] = f1.z; p1[4 * g4 + 3] = f1.w;
          }
        } else {
#pragma unroll
          for (int r = 0; r < 16; ++r) { p0[r] = 0.f; p1[r] = 0.f; }
        }
#pragma unroll
        for (int ks = 0; ks < 4; ++ks) {
          const bf16x8 k0 = *(const LAS bf16x8*)(cur + kro[ks]), k1 = *(const LAS bf16x8*)(cur + kro[ks] + 4096);
          p0 = __builtin_amdgcn_mfma_f32_32x32x16_bf16(k0, qf[ks], p0, 0, 0, 0); p1 = __builtin_amdgcn_mfma_f32_32x32x16_bf16(k1, qf[ks], p1, 0, 0, 0);
        }
        if (T == AT_MLA) {
#pragma unroll
          for (int ks = 0; ks < 2; ++ks) {
            const bf16x8 k0 = *(const LAS bf16x8*)(cur + k2ro[ks]), k1 = *(const LAS bf16x8*)(cur + k2ro[ks] + 2048);
            p0 = __builtin_amdgcn_mfma_f32_32x32x16_bf16(k0, qf[(NKS == 6) ? 4 + ks : ks], p0, 0, 0, 0);
            p1 = __builtin_amdgcn_mfma_f32_32x32x16_bf16(k1, qf[(NKS == 6) ? 4 + ks : ks], p1, 0, 0, 0);
          }
        }
        if (T == AT_SB) {
          f32x16 e0, e1;
          float T8[8];
#pragma unroll
          for (int half = 0; half < 2; ++half) {
            f32x16& pp = half ? p1 : p0; f32x16& ee = half ? e1 : e0;
#pragma unroll
            for (int r = 0; r < 16; ++r) {
              const float z2 = pp[r] * CSC;
              float lk = -__builtin_amdgcn_logf(1.0f + __builtin_amdgcn_exp2f(fminf(z2, 126.f)));
              const bool valid = !domask || (kbase + 32 * half + crow(r, hi) < q);
              lk = valid ? lk : 0.f;
              pp[r] = valid ? (z2 + lk) : -INFINITY;
              ee[r] = lk;
            }
#pragma unroll
            for (int g4 = 0; g4 < 4; ++g4) {
              const float x0 = ee[4 * g4], x1 = ee[4 * g4 + 1], x2 = ee[4 * g4 + 2], x3 = ee[4 * g4 + 3];
              ee[4 * g4 + 3] = 0.f; ee[4 * g4 + 2] = x3; ee[4 * g4 + 1] = x3 + x2; ee[4 * g4] = x3 + x2 + x1;
              T8[4 * half + g4] = x3 + x2 + x1 + x0;
            }
          }
          float Tl[8], Th[8];
#pragma unroll
          for (int i = 0; i < 8; ++i) pair_vals(T8[i], Tl[i], Th[i]);
          float ps = 0.f; float base[8];
#pragma unroll
          for (int i = 7; i >= 0; --i) { base[i] = Crun + ps + (hi ? 0.f : Th[i]); ps += Tl[i] + Th[i]; }
          Crun += ps;
#pragma unroll
          for (int r = 0; r < 16; ++r) {
            p0[r] = __builtin_amdgcn_exp2f(p0[r] + e0[r] + base[r >> 2]);
            p1[r] = __builtin_amdgcn_exp2f(p1[r] + e1[r] + base[4 + (r >> 2)]);
          }
          if (__all(Crun < -48.f)) fin = true;
        } else {
          float al;
          if (softmax_tile(p0, p1, m0, l0, CSC, domask, kbase, q, hi, al)) {
#pragma unroll
            for (int d0 = 0; d0 < 2; ++d0)
#pragma unroll
              for (int r = 0; r < 16; ++r) o0[d0][r] *= al;
          }
          if (T == AT_FOX) { if (t > 0) { if (__all((qn * kpre[t - 1] + fend[t - 1] - m0) * CSC < -40.f)) fin = true; } }
        }
#pragma unroll
        for (int s = 0; s < 4; ++s) {
          const bf16x8 pf = pack8((s < 2) ? p0 : p1, 8 * (s & 1));
#pragma unroll
          for (int d0 = 0; d0 < 2; ++d0) {
            const bf16x8 vf = vfrag(cur, vro[d0] + 2048 * s);
            o0[d0] = __builtin_amdgcn_mfma_f32_32x32x16_bf16(vf, pf, o0[d0], 0, 0, 0);
          }
        }
      }
    }
    if (more) ATT_LSTORE((it + 1) & 1);
    {
      LAS unsigned char* ctile = lds + 2 * ATT_BUF + 1024;
      if (qidx < CMU_TOTAL) cmu_from_lds(cc, qidx, lane, w, ctile + ((gi + 1) & 1) * 8192);
      if (pidx < CMU_TOTAL) cmu_to_lds(cc, pidx, lane, w, cv, ctile + (gi & 1) * 8192);
      qidx = pidx;
      pidx = cidx;
      if (pidx < CMU_TOTAL) cmu_load(cc, pidx, lane, w, cv);
    }
    if (cfetch && tid == 0) s_conv[((gi >> 3) + 1) & 1] = cnext;
    ++gi;
    if (T == AT_SB || T == AT_FOX) {
      const bool wave_done = fin || (t == 0);
      if (__syncthreads_and(wave_done ? 1 : 0)) break;
    } else {
      __syncthreads();
    }
  }
  __syncthreads();
#undef ATT_TILE
#undef ATT_GLOAD
#undef ATT_LSTORE
  if (T == AT_DIFF) {
    float la, lb; pair_vals(l0, la, lb); const float inv0 = 1.f / (la + lb);
    pair_vals(l1, la, lb); const float inv1 = a.lam / (la + lb);
    float ss = 0.f;
#pragma unroll
    for (int d0 = 0; d0 < 2; ++d0)
#pragma unroll
      for (int r = 0; r < 16; ++r) { const float v = o0[d0][r] * inv0 - o1[d0][r] * inv1; o0[d0][r] = v; ss += v * v; }
    float sa, sb; pair_vals(ss, sa, sb);
    const float rs = rsqrtf((sa + sb) * (1.f / 64.f) + RMS_EPS) * a.oscale;
#pragma unroll
    for (int d0 = 0; d0 < 2; ++d0)
#pragma unroll
      for (int g4 = 0; g4 < 4; ++g4) {
        const int dv = 32 * d0 + 8 * g4 + 4 * hi;
        const f32x4 gg = *(const f32x4*)(a.subg + dv);
        u32x2 o; o.x = cvtpk(o0[d0][4 * g4] * rs * gg.x, o0[d0][4 * g4 + 1] * rs * gg.y); o.y = cvtpk(o0[d0][4 * g4 + 2] * rs * gg.z, o0[d0][4 * g4 + 3] * rs * gg.w);
        *(u32x2*)(a.O + (size_t)q * a.ldo + dv) = o;
      }
  } else {
    float inv = 1.f;
    if (T != AT_SB) { float la, lb; pair_vals(l0, la, lb); inv = 1.f / (la + lb); }
#pragma unroll
    for (int d0 = 0; d0 < 2; ++d0)
#pragma unroll
      for (int g4 = 0; g4 < 4; ++g4) {
        const int dv = 32 * d0 + 8 * g4 + 4 * hi;
        u32x2 o; o.x = cvtpk(o0[d0][4 * g4] * inv, o0[d0][4 * g4 + 1] * inv); o.y = cvtpk(o0[d0][4 * g4 + 2] * inv, o0[d0][4 * g4 + 3] * inv);
        *(u32x2*)(a.O + (size_t)q * a.ldo + dv) = o;
      }
  }
}

__device__ __forceinline__ void phase_attention(const Params& p, int layer, LAS unsigned char* lds) {
  unsigned char* ws = p.ws;
  const bf16_t* P = (const bf16_t*)(ws + OFF_P);
  const bf16_t* qd = (const bf16_t*)(ws + OFF_QD); const bf16_t* kvd = (const bf16_t*)(ws + OFF_KVD);
  bf16_t* mix = (bf16_t*)(ws + OFF_MIX);
  int* ctrl = (int*)(ws + OFF_CTRL);
  const float lam = ((const float*)ctrl)[CW_LAM + layer];
  const float linit = 0.8f - 0.6f * expf(-0.3f * (float)layer);
  LAS int* s_unit = (LAS int*)(lds + 2 * ATT_BUF);
  ConvCtx cc;
  cc.wgu = p.w_gate_up + (size_t)layer * NE * 1024 * 2048; cc.wdn = p.w_down + (size_t)layer * NE * 1024 * 1024;
  cc.dgu = ws + OFF_WGU + (size_t)layer * NE * 2048 * 1024; cc.ddn = ws + OFF_WD + (size_t)layer * NE * 1024 * 1024;
  cc.ctr = ctrl + CW_CONVQ + layer;
  int gi = 0, pidx = CMU_TOTAL, qidx = CMU_TOTAL; float cv[16];
#pragma unroll
  for (int j = 0; j < 16; ++j) cv[j] = 0.f;
  if (get_tid() == 0) ((LAS int*)(lds + 2 * ATT_BUF + 64))[0] = atomicAdd(cc.ctr, 8);
  for (;;) {
    if (get_tid() == 0) *s_unit = atomicAdd(&ctrl[CW_ATTQ + layer], 1);
    __syncthreads();
    const int u = *s_unit;
    __syncthreads();
    if (u >= 1024) break;
    const int qb = 15 - (u >> 6), rem = u & 63, type = rem & 3, bh = rem >> 2, b = bh >> 2, h = bh & 3;
    const size_t rb = (size_t)b * SEQ;
    AttnArgs a{};
    a.O = mix + rb * DM + type * 256 + h * 64; a.ldo = DM;
    if (type == AT_SB) {
      a.Q = P + rb * NP + C_SBQ + h * 64; a.K = P + rb * NP + C_SBK + h * 64; a.V = P + rb * NP + C_SBV + h * 64; a.ldq = a.ldk = a.ldv = NP;
      attn_unit<AT_SB>(lds, a, qb, cc, gi, pidx, qidx, cv);
    } else if (type == AT_DIFF) {
      a.Q = P + rb * NP + C_DFQ + h * 64; a.K = P + rb * NP + C_DFK + h * 64; a.V = P + rb * NP + C_DFV + h * 64; a.ldq = a.ldk = a.ldv = NP;
      a.lam = lam; a.oscale = 1.f - linit; a.subg = p.diff_subln_g + layer * 64;
      attn_unit<AT_DIFF>(lds, a, qb, cc, gi, pidx, qidx, cv);
    } else if (type == AT_FOX) {
      a.Q = P + rb * NP + C_FXQ + h * 64; a.K = P + rb * NP + C_FXK + h * 64; a.V = P + rb * NP + C_FXV + h * 64; a.ldq = a.ldk = a.ldv = NP;
      a.Fk = (const float*)(ws + OFF_FK) + (size_t)bh * SEQ; a.kn = (const float*)(ws + OFF_KN) + bh * 64;
      attn_unit<AT_FOX>(lds, a, qb, cc, gi, pidx, qidx, cv);
    } else {
      a.Q = qd + rb * 384 + h * 96; a.ldq = 384; a.K = kvd + rb * 512 + h * 128; a.ldk = 512; a.V = kvd + rb * 512 + h * 128 + 64; a.ldv = 512;
      a.K2 = P + rb * NP + C_KR; a.ldk2 = NP; a.cs = (const f32x2*)(ws + OFF_ROPE) + rb * 16;
      attn_unit<AT_MLA>(lds, a, qb, cc, gi, pidx, qidx, cv);
    }
  }
  {
    __syncthreads();
    const LAS int* sc = (const LAS int*)(lds + 2 * ATT_BUF + 64);
    const int k = gi >> 3, used = gi & 7;
    const int b0 = __builtin_amdgcn_readfirstlane(sc[k & 1]);
    const int b1 = (used >= 1) ? __builtin_amdgcn_readfirstlane(sc[(k + 1) & 1]) : CMU_TOTAL;
    const int tid = get_tid(), lane = tid & 63, w = tid >> 6;
    if (qidx < CMU_TOTAL) cmu_from_lds(cc, qidx, lane, w, lds + 2 * ATT_BUF + 1024 + ((gi + 1) & 1) * 8192);
    if (pidx < CMU_TOTAL) cmu_store(cc, pidx, lane, w, cv);
#pragma unroll 1
    for (int j = used; j < 16; ++j) {
      const int ci = (j < 8) ? b0 + j : b1 + (j - 8);
      if (ci < CMU_TOTAL) { float v0[16]; cmu_load(cc, ci, lane, w, v0); cmu_store(cc, ci, lane, w, v0); }
    }
    __syncthreads();
  }
  for (;;) {
    if (get_tid() == 0) s_unit[0] = atomicAdd(cc.ctr, 2);
    __syncthreads();
    const int c0 = __builtin_amdgcn_readfirstlane(s_unit[0]);
    __syncthreads();
    if (c0 >= CMU_TOTAL) break;
    const int tid = get_tid(), lane = tid & 63, w = tid >> 6;
    float v0[16], v1[16];
    cmu_load(cc, c0, lane, w, v0);
    if (c0 + 1 < CMU_TOTAL) cmu_load(cc, c0 + 1, lane, w, v1);
    cmu_store(cc, c0, lane, w, v0);
    if (c0 + 1 < CMU_TOTAL) cmu_store(cc, c0 + 1, lane, w, v1);
  }
}

__device__ __forceinline__ size_t tmp_blocked(int row, int col) {
  return (size_t)(row >> 6) * 65536 + (size_t)((((((col >> 7) * 4 + ((col >> 5) & 3)) * 4 + ((col >> 3) & 3)) * 2 + ((row >> 5) & 1)) * 64 + (((col >> 2) & 1) * 32 + (row & 31))) * 4);
}
struct OutprojSched {
  int grid, bid;
  __device__ __forceinline__ bool next(int i, pg8::Unit& u) const {
    int mt, nt;
    if (grid == 256) { if (i > 0) return false; const int xcd = bid & 7, j = bid >> 3; mt = 8 * xcd + (j >> 2); nt = j & 3; }
    else { const int t = bid + i * grid; if (t >= 256) return false; mt = t >> 2; nt = t & 3; }
    u.boff = (unsigned)nt * (256u * 1024u * 2u); u.arow0 = mt * 256; u.mvalid = 256; u.e = 0; u.mt = mt; u.nt = nt; u.slot0 = 0;
    return true;
  }
};
struct OutprojEpi {
  const bf16_t* hB; float* tmp;
  __device__ __forceinline__ void operator()(const pg8::f32x4v (&acc)[2][2][4][2], const pg8::Unit& u, int wr, int wc, int fr, int fq) const {
#pragma unroll
    for (int ai = 0; ai < 2; ++ai)
#pragma unroll
      for (int m = 0; m < 4; ++m) {
        const int row = u.mt * 256 + 128 * ai + 64 * wr + 16 * m + fr;
#pragma unroll
        for (int bj = 0; bj < 2; ++bj)
#pragma unroll
          for (int n = 0; n < 2; ++n) {
            const int col = u.nt * 256 + 128 * bj + 32 * wc + 16 * n + 4 * fq;
            const u32x2 hb = *(const u32x2*)(hB + (size_t)row * DM + col);
            const pg8::f32x4v v = acc[ai][bj][m][n];
            *(f32x4*)(tmp + tmp_blocked(row, col)) = (f32x4){DN_ALPHA * bflo(hb.x) + v[0], DN_ALPHA * bfhi(hb.x) + v[1], DN_ALPHA * bflo(hb.y) + v[2], DN_ALPHA * bfhi(hb.y) + v[3]};
          }
      }
  }
};
__device__ __forceinline__ void phase_outproj(const Params& p, int layer, LAS unsigned char* lds) {
  unsigned char* ws = p.ws;
  OutprojSched S{get_nblk(), get_bid()};
  OutprojEpi E{(const bf16_t*)(ws + OFF_HB), (float*)(ws + OFF_TMPF)};
  pg8::gemm_phase<false, false>(lds, (const bf16_t*)(ws + OFF_MIX), (const bf16_t*)(ws + OFF_WOUT) + (size_t)layer * 1024 * 1024, S, E);
}

__device__ __forceinline__ void phase_ln1_router(const Params& p, int layer, LAS unsigned char* lds) {
  unsigned char* ws = p.ws;
  const float* tmp = (const float*)(ws + OFF_TMPF);
  float* hF = (float*)(ws + OFF_HF); bf16_t* hB = (bf16_t*)(ws + OFF_HB);
  int* ctrl = (int*)(ws + OFF_CTRL); int* cnt = ctrl + CW_CNT + layer * 32;
  int* list = (int*)(ws + OFF_LIST); int* toke = (int*)(ws + OFF_TOKE); float* tokg = (float*)(ws + OFF_TOKG);
  const float* Wr = p.router_w + (size_t)layer * DM * NE; const float* rb = p.router_b + layer * NE;
  const float* g1 = p.ln1_g + layer * DM; const float* b1 = p.ln1_b + layer * DM;
  LAS float* red = (LAS float*)lds;
  LAS float* lg = (LAS float*)(lds + 32768);
  LAS float* part = (LAS float*)(lds + 136192);
  LAS float* part2 = (LAS float*)(lds + 137216);
  LAS int* lcnt = (LAS int*)(lds + 138240);
#pragma unroll 1
  for (int hs = get_bid(); hs < M_TOK / 32; hs += get_nblk()) {
    const int m0 = hs * 32, mi = hs & 1;
    const int tid = get_tid(), lane = tid & 63, w = tid >> 6, c31 = lane & 31, hi = lane >> 5;
    f32x16 acc[4];
    {
      const float* tb = tmp + (size_t)(hs >> 1) * 65536 + (size_t)(w * 32 * 64 + lane) * 4;
#pragma unroll
      for (int ni = 0; ni < 4; ++ni)
#pragma unroll
        for (int g4 = 0; g4 < 4; ++g4) {
          const f32x4 v = *(const f32x4*)(tb + (size_t)(((ni * 4 + g4) * 2 + mi) * 64) * 4);
          acc[ni][4 * g4] = v.x; acc[ni][4 * g4 + 1] = v.y; acc[ni][4 * g4 + 2] = v.z; acc[ni][4 * g4 + 3] = v.w;
        }
    }
    float mean, rstd;
    {
      float sacc = 0.f;
#pragma unroll
      for (int ni = 0; ni < 4; ++ni)
#pragma unroll
        for (int r = 0; r < 16; ++r) sacc += acc[ni][r];
      float s0, s1; pair_vals(sacc, s0, s1);
      if (hi == 0) part[c31 * 8 + w] = s0 + s1;
    }
    __syncthreads();
    {
      const f32x4 pa = *(const LAS f32x4*)(part + c31 * 8), pb = *(const LAS f32x4*)(part + c31 * 8 + 4);
      mean = ((pa.x + pa.y) + (pa.z + pa.w) + (pb.x + pb.y) + (pb.z + pb.w)) * (1.f / DM);
      float q = 0.f;
#pragma unroll
      for (int ni = 0; ni < 4; ++ni)
#pragma unroll
        for (int r = 0; r < 16; ++r) { const float d = acc[ni][r] - mean; q += d * d; }
      float q0, q1; pair_vals(q, q0, q1);
      if (hi == 0) part2[c31 * 8 + w] = q0 + q1;
    }
    __syncthreads();
    {
      const f32x4 pa = *(const LAS f32x4*)(part2 + c31 * 8), pb = *(const LAS f32x4*)(part2 + c31 * 8 + 4);
      rstd = rsqrtf(((pa.x + pa.y) + (pa.z + pa.w) + (pb.x + pb.y) + (pb.z + pb.w)) * (1.f / DM) + LN_EPS);
    }
    LAS unsigned char* wt = lds + w * 16896;
#pragma unroll
    for (int ni = 0; ni < 4; ++ni)
#pragma unroll
      for (int g4 = 0; g4 < 4; ++g4) {
        const int n = 128 * w + ni * 32 + 8 * g4 + 4 * hi;
        const f32x4 gg = *(const f32x4*)(g1 + n), bb = *(const f32x4*)(b1 + n);
        f32x4 y;
        y.x = (acc[ni][4 * g4] - mean) * rstd * gg.x + bb.x; y.y = (acc[ni][4 * g4 + 1] - mean) * rstd * gg.y + bb.y;
        y.z = (acc[ni][4 * g4 + 2] - mean) * rstd * gg.z + bb.z; y.w = (acc[ni][4 * g4 + 3] - mean) * rstd * gg.w + bb.w;
        acc[ni][4 * g4] = y.x; acc[ni][4 * g4 + 1] = y.y; acc[ni][4 * g4 + 2] = y.z; acc[ni][4 * g4 + 3] = y.w;
        *(LAS f32x4*)(wt + c31 * 528 + (ni * 32 + 8 * g4 + 4 * hi) * 4) = y;
      }
    {
      const int cl = (lane & 31) * 4;
      const size_t off0 = (size_t)(m0 + hi) * DM + 128 * w + cl;
      bf16_t* pB = hB + off0; unsigned char* p8 = ws + OFF_H8 + off0;
      const LAS unsigned char* rp = wt + hi * 528 + cl * 4;
#pragma unroll 4
      for (int it = 0; it < 16; ++it) {
        const f32x4 y = *(const LAS f32x4*)rp;
        u32x2 o; o.x = cvtpk(y.x, y.y); o.y = cvtpk(y.z, y.w);
        *(u32x2*)pB = o;
        *(unsigned*)p8 = pk4_fp8(clamp448(y.x * S8_H), clamp448(y.y * S8_H), clamp448(y.z * S8_H), clamp448(y.w * S8_H));
        rp += 2 * 528; pB += 2 * DM; p8 += 2 * DM;
      }
    }
    f32x16 D0;
#pragma unroll
    for (int r = 0; r < 16; ++r) D0[r] = 0.f;
    {
      const float* wrp = Wr + (128 * w + 4 * hi) * 32 + c31;
      float wa[16], wb[16];
#pragma unroll
      for (int r = 0; r < 16; ++r) wa[r] = wrp[(8 * (r >> 2) + (r & 3)) * 32];
#pragma unroll
      for (int ni = 0; ni < 4; ++ni) {
        __builtin_amdgcn_sched_barrier(0);
        if (ni < 3) {
#pragma unroll
          for (int r = 0; r < 16; ++r) wb[r] = wrp[((ni + 1) * 32 + 8 * (r >> 2) + (r & 3)) * 32];
        }
        __builtin_amdgcn_sched_barrier(0);
#pragma unroll
        for (int r = 0; r < 16; ++r) D0 = __builtin_amdgcn_mfma_f32_32x32x2f32(acc[ni][r], wa[r], D0, 0, 0, 0);
        __builtin_amdgcn_sched_barrier(0);
#pragma unroll
        for (int r = 0; r < 16; ++r) wa[r] = wb[r];
      }
    }
    __syncthreads();
#pragma unroll
    for (int r = 0; r < 16; ++r) red[(w * 32 + crow(r, hi)) * 32 + c31] = D0[r];
    __syncthreads();
#pragma unroll
    for (int i = 0; i < 2; ++i) {
      const int idx = tid + 512 * i;
      float sv = rb[idx & 31];
#pragma unroll
      for (int ww = 0; ww < 8; ++ww) sv += red[ww * 1024 + idx];
      lg[(idx & 31) * 32 + (idx >> 5)] = sv;
    }
    if (tid < 32) lcnt[tid] = 0;
    __syncthreads();
    float gt[4]; int li[4], rk[4];
    if (tid < 32) {
      float lv[4]; unsigned used = 0u;
#pragma unroll
      for (int k = 0; k < 4; ++k) {
        float best = -INFINITY; int bi = 0;
        for (int e = 0; e < 32; ++e) { const float v = lg[e * 32 + tid]; if (!((used >> e) & 1u) && v > best) { best = v; bi = e; } }
        used |= 1u << bi; lv[k] = best; li[k] = bi;
      }
      float sm = 0.f;
#pragma unroll
      for (int k = 0; k < 4; ++k) { gt[k] = expf(lv[k] - lv[0]); sm += gt[k]; }
      const float inv = 1.f / sm;
#pragma unroll
      for (int k = 0; k < 4; ++k) { gt[k] *= inv; rk[k] = __hip_atomic_fetch_add(&lcnt[li[k]], 1, __ATOMIC_RELAXED, __HIP_MEMORY_SCOPE_WORKGROUP); }
    }
    __syncthreads();
    if (tid < 32) { const int c = lcnt[tid]; lcnt[32 + tid] = c ? atomicAdd(&cnt[tid], c) : 0; }
    __syncthreads();
    if (tid < 32) {
      const int m = m0 + tid;
#pragma unroll
      for (int k = 0; k < 4; ++k) {
        const int ps = lcnt[32 + li[k]] + rk[k];
        list[li[k] * M_TOK + ps] = m;
        toke[m * 4 + k] = (li[k] << 16) | ps;
        tokg[m * 4 + k] = gt[k];
      }
    }
    __syncthreads();
  }
}

__device__ __forceinline__ void moe_prefix(const int* cnt, LAS int* s_start, LAS int* s_tstart, LAS int* s_cnt) {
  if (get_tid() < 64) {
    const int lane = get_tid();
    const int c = (lane < 32) ? cnt[lane] : 0;
    const int tl = (c + 255) >> 8;
    int ic = c, it = tl;
#pragma unroll
    for (int o = 1; o < 32; o <<= 1) { const int a = __shfl_up(ic, o), b = __shfl_up(it, o); if (lane >= o) { ic += a; it += b; } }
    if (lane < 32) { s_cnt[lane] = c; s_start[lane] = ic - c; s_tstart[lane] = it - tl; }
    if (lane == 31) { s_start[32] = ic; s_tstart[32] = it; }
  }
  __syncthreads();
}

struct MoeSched {
  unsigned estride; int NT, total_mt, grid, bid; const LAS int* s_start; const LAS int* s_tstart; const LAS int* s_cnt;
  __device__ __forceinline__ bool next(int i, pg8::Unit& u) const {
    int mtg, nt; bool ok;
    if (grid == 256) { const int MG = 32 / NT; const int xcd = bid & 7, j = bid >> 3; mtg = MG * (xcd + 8 * i) + j / NT; nt = j % NT; ok = (MG * (8 * i) < total_mt); }
    else { const int item = bid + i * grid; ok = (item < total_mt * NT); mtg = item / NT; nt = item % NT; }
    const bool live = ok && (mtg < total_mt);
    const int mq = live ? mtg : 0;
    const int ln_ = (int)(threadIdx.x & 63);
    const int tend_ = s_tstart[(ln_ < 32 ? ln_ : 31) + 1];
    const int e = (int)__builtin_popcountll(__ballot(ln_ < 32 && tend_ <= mq));
    const int mt = mq - __builtin_amdgcn_readfirstlane(s_tstart[e]);
    const int mv = live ? min(256, __builtin_amdgcn_readfirstlane(s_cnt[e]) - mt * 256) : 0;
    const int sl = __builtin_amdgcn_readfirstlane(s_start[e]) + mt * 256;
    const unsigned bo = (unsigned)e * estride + (unsigned)nt * (256u * 1024u);
    u.boff = bo; u.arow0 = i; u.mvalid = mv; u.e = e; u.mt = mt; u.nt = nt; u.slot0 = sl;
    return ok;
  }
};
struct MoeUpEpi {
  unsigned char* act; const LAS float* btab;
  __device__ __forceinline__ void operator()(const pg8::f32x4v (&acc)[2][2][4][2], const pg8::Unit& u, int wr, int wc, int fr, int fq) const {
    constexpr float US = 1.f / (S8_H * S8_WGU);
    constexpr float KEXP = -1.702f * LOG2E;
    const LAS float* bt = btab + u.arow0 * 256 + 16 * wc + 4 * fq;
    f32x4 bg[2], bl[2];
#pragma unroll
    for (int bj = 0; bj < 2; ++bj) { bg[bj] = *(const LAS f32x4*)(bt + 64 * bj); bl[bj] = *(const LAS f32x4*)(bt + 128 + 64 * bj); }
#pragma unroll
    for (int ai = 0; ai < 2; ++ai)
#pragma unroll
      for (int m = 0; m < 4; ++m) {
        const int rl = 128 * ai + 64 * wr + 16 * m + fr;
        if (rl < u.mvalid) {
          unsigned char* orow = act + (size_t)(u.slot0 + rl) * DFF + 16 * (8 * u.nt + wc) + 4 * fq;
#pragma unroll
          for (int bj = 0; bj < 2; ++bj) {
            float o[4];
#pragma unroll
            for (int i = 0; i < 4; ++i) {
              const float gl = fminf(fmaf(acc[ai][bj][m][0][i], US, bg[bj][i]), 7.f);
              const float ln = fminf(fmaxf(fmaf(acc[ai][bj][m][1][i], US, bl[bj][i]), -7.f), 7.f);
              const float sg = __builtin_amdgcn_rcpf(1.f + __builtin_amdgcn_exp2f(KEXP * gl));
              o[i] = fminf(gl * sg * fmaf(ln, S8_ACT, S8_ACT), 448.f);
            }
            *(unsigned*)(orow + 64 * bj) = pk4_fp8(o[0], o[1], o[2], o[3]);
          }
        }
      }
  }
};
struct MoeDownEpi {
  bf16_t* yb; const LAS float* btab;
  __device__ __forceinline__ void operator()(const pg8::f32x4v (&acc)[2][2][4][2], const pg8::Unit& u, int wr, int wc, int fr, int fq) const {
    constexpr float us = 1.f / (S8_ACT * S8_WDN);
    const LAS float* bt = btab + u.e * 256 + 32 * wc + 4 * fq;
    f32x4 b4[2][2];
#pragma unroll
    for (int bj = 0; bj < 2; ++bj)
#pragma unroll
      for (int n = 0; n < 2; ++n) b4[bj][n] = *(const LAS f32x4*)(bt + 128 * bj + 16 * n);
#pragma unroll
    for (int ai = 0; ai < 2; ++ai)
#pragma unroll
      for (int m = 0; m < 4; ++m) {
        const int rl = 128 * ai + 64 * wr + 16 * m + fr;
        if (rl < u.mvalid) {
          bf16_t* orow = yb + (size_t)(u.slot0 + rl) * DM + u.nt * 256 + 32 * wc + 4 * fq;
#pragma unroll
          for (int bj = 0; bj < 2; ++bj)
#pragma unroll
            for (int n = 0; n < 2; ++n) {
              const pg8::f32x4v v = acc[ai][bj][m][n];
              u32x2 ov; ov.x = cvtpk(fmaf(v[0], us, b4[bj][n].x), fmaf(v[1], us, b4[bj][n].y)); ov.y = cvtpk(fmaf(v[2], us, b4[bj][n].z), fmaf(v[3], us, b4[bj][n].w));
              *(u32x2*)(orow + 128 * bj + 16 * n) = ov;
            }
        }
      }
  }
};
__device__ __forceinline__ void phase_moe_up(const Params& p, int layer, LAS unsigned char* lds) {
  unsigned char* ws = p.ws;
  const int* cnt = (const int*)(ws + OFF_CTRL) + CW_CNT + layer * 32;
  const int* list = (const int*)(ws + OFF_LIST);
  LAS int* s_start = (LAS int*)(lds + LDS_GEMM); LAS int* s_tstart = s_start + 40; LAS int* s_cnt = s_start + 80;
  moe_prefix(cnt, s_start, s_tstart, s_cnt);
  MoeSched S{2048u * 1024u, 8, __builtin_amdgcn_readfirstlane(s_tstart[32]), get_nblk(), get_bid(), s_start, s_tstart, s_cnt};
  {
    const int tid = get_tid();
    LAS int* rowtab = (LAS int*)(lds + LDS_ROWTAB);
    LAS float* btab = (LAS float*)(lds + LDS_BIASTAB);
    const float* bgu = p.b_gate_up + (size_t)layer * NE * 2048;
    unsigned vals[12]; bool okv[12];
#pragma unroll
    for (int i = 0; i < 12; ++i) {
      pg8::Unit u;
      okv[i] = S.next(i, u);
      vals[i] = 0u;
      if (okv[i]) {
        if (tid < 256) { if (u.mvalid > 0) vals[i] = (unsigned)list[u.e * M_TOK + u.mt * 256 + min(tid, u.mvalid - 1)]; }
        else { const int c = tid - 256; vals[i] = __float_as_uint(bgu[(size_t)u.e * 2048 + (c >> 7) * 1024 + u.nt * 128 + (c & 127)]); }
      }
    }
#pragma unroll
    for (int i = 0; i < 12; ++i) {
      if (okv[i]) { if (tid < 256) rowtab[i * 256 + tid] = (int)vals[i]; else btab[i * 256 + (tid - 256)] = __uint_as_float(vals[i]); }
    }
    __syncthreads();
  }
  MoeUpEpi E{(unsigned char*)(ws + OFF_ACT), (const LAS float*)(lds + LDS_BIASTAB)};
  pg8::gemm_phase<true, true>(lds, (const bf16_t*)(ws + OFF_H8), (const bf16_t*)(ws + OFF_WGU + (size_t)layer * NE * 2048 * 1024), S, E);
}
struct MoeDownSched {
  MoeSched base;
  __device__ __forceinline__ bool next(int i, pg8::Unit& u) const { const bool ok = base.next(i, u); if (ok) { u.arow0 = u.slot0; u.e = i; } return ok; }
};
__device__ __forceinline__ void phase_moe_down(const Params& p, int layer, LAS unsigned char* lds) {
  unsigned char* ws = p.ws;
  const int* cnt = (const int*)(ws + OFF_CTRL) + CW_CNT + layer * 32;
  LAS int* s_start = (LAS int*)(lds + LDS_GEMM); LAS int* s_tstart = s_start + 40; LAS int* s_cnt = s_start + 80;
  moe_prefix(cnt, s_start, s_tstart, s_cnt);
  MoeDownSched S{MoeSched{1024u * 1024u, 4, __builtin_amdgcn_readfirstlane(s_tstart[32]), get_nblk(), get_bid(), s_start, s_tstart, s_cnt}};
  {
    const int tid = get_tid();
    LAS float* btab = (LAS float*)(lds + LDS_BIASTAB);
    const float* bd = p.b_down + (size_t)layer * NE * 1024;
    float vals[12]; bool okv[12];
#pragma unroll
    for (int i = 0; i < 12; ++i) {
      pg8::Unit u;
      okv[i] = S.base.next(i, u);
      vals[i] = 0.f;
      if (okv[i] && tid < 256) vals[i] = bd[(size_t)u.e * 1024 + u.nt * 256 + tid];
    }
#pragma unroll
    for (int i = 0; i < 12; ++i)
      if (okv[i] && tid < 256) btab[i * 256 + tid] = vals[i];
    __syncthreads();
  }
  MoeDownEpi E{(bf16_t*)(ws + OFF_Y), (const LAS float*)(lds + LDS_BIASTAB)};
  pg8::gemm_phase<false, true>(lds, (const bf16_t*)(ws + OFF_ACT), (const bf16_t*)(ws + OFF_WD + (size_t)layer * NE * 1024 * 1024), S, E);
}

__device__ __forceinline__ void phase_combine_ln2(const Params& p, int layer, LAS unsigned char* lds) {
  unsigned char* ws = p.ws;
  const bf16_t* yb = (const bf16_t*)(ws + OFF_Y);
  float* hF = (float*)(ws + OFF_HF); bf16_t* hB = (bf16_t*)(ws + OFF_HB);
  const int* cnt = (const int*)(ws + OFF_CTRL) + CW_CNT + layer * 32;
  const int* toke = (const int*)(ws + OFF_TOKE); const float* tokg = (const float*)(ws + OFF_TOKG);
  LAS int* s_start = (LAS int*)(lds + LDS_GEMM); LAS int* s_tstart = s_start + 40; LAS int* s_cnt = s_start + 80;
  moe_prefix(cnt, s_start, s_tstart, s_cnt);
  const float* g2 = p.ln2_g + layer * DM; const float* b2 = p.ln2_b + layer * DM;
  const bool last = (layer == DEPTH - 1);
  const int lane = get_tid() & 63, gw = get_bid() * 8 + (get_tid() >> 6), ngw = get_nblk() * 8;
  for (int m = gw; m < M_TOK; m += ngw) {
    f32x4 v[4];
#pragma unroll
    for (int j = 0; j < 4; ++j) { const u32x2 hb = *(const u32x2*)(hB + (size_t)m * DM + 4 * lane + 256 * j); v[j] = (f32x4){bflo(hb.x), bfhi(hb.x), bflo(hb.y), bfhi(hb.y)} * DN_ALPHA; }
#pragma unroll
    for (int k = 0; k < 4; ++k) {
      const int ep = toke[m * 4 + k]; const float gt = tokg[m * 4 + k];
      const int slot = s_start[ep >> 16] + (ep & 0xffff);
      const bf16_t* yr = yb + (size_t)slot * DM;
#pragma unroll
      for (int j = 0; j < 4; ++j) {
        const u32x2 a = *(const u32x2*)(yr + 4 * lane + 256 * j);
        v[j].x += gt * bflo(a.x); v[j].y += gt * bfhi(a.x); v[j].z += gt * bflo(a.y); v[j].w += gt * bfhi(a.y);
      }
    }
    ln_row(v, g2, b2, lane);
    if (last) store_row_f32_bf16(v, p.out + (size_t)m * DM, nullptr, lane);
    else store_row_f32_bf16(v, nullptr, hB + (size_t)m * DM, lane);
  }
}

#if defined(__HIP_DEVICE_COMPILE__)
#define PH(call) do { const __attribute__((address_space(4))) Params* q_ = pp; asm volatile("" : "+s"(q_)); Params p; __builtin_memcpy(&p, q_, sizeof(Params)); call; } while (0)
#else
#define PH(call) do { const Params& p = p_unused; (void)pp; call; } while (0)
#endif
__global__ void __launch_bounds__(512) fwd_kernel(Params p_unused) {
  cg::grid_group grid = cg::this_grid();
  extern __shared__ __attribute__((aligned(16))) unsigned char smem[];
  LAS unsigned char* lds = (LAS unsigned char*)smem;
  const __attribute__((address_space(4))) Params* pp = (const __attribute__((address_space(4))) Params*)__builtin_amdgcn_kernarg_segment_ptr();
  if (threadIdx.x < 4) ((volatile LAS unsigned*)(lds + LDS_MISC))[threadIdx.x] = 0u;
  __syncthreads();
#define GRID_BAR() do { XcdBarrier b_; PH(b_.bar = (unsigned*)(p.ws + OFF_CTRL) + CW_BAR); b_.x = xb_xcc_id(); b_.st = (volatile LAS unsigned*)(lds + LDS_MISC); xcd_barrier(b_); } while (0)
  { unsigned* bw; PH(bw = (unsigned*)(p.ws + OFF_CTRL) + CW_BAR); (void)xcd_barrier_post(bw, (volatile LAS unsigned*)(lds + LDS_MISC)); }
  PH(phase_convert(p));
  PH(phase_prologue_misc(p));
  grid.sync();
#pragma unroll 1
  for (int layer = 0; layer < DEPTH; ++layer) {
    PH(phase_inproj(p, layer, lds));
    GRID_BAR();
    PH(phase_mla_up(p, layer, lds));
    GRID_BAR();
    PH(phase_attention(p, layer, lds));
    GRID_BAR();
    PH(phase_outproj(p, layer, lds));
    GRID_BAR();
    PH(phase_ln1_router(p, layer, lds));
    GRID_BAR();
    PH(phase_moe_up(p, layer, lds));
    GRID_BAR();
    PH(phase_moe_down(p, layer, lds));
    GRID_BAR();
    PH(phase_combine_ln2(p, layer, lds));
    if (layer + 1 < DEPTH) GRID_BAR();
  }
}

extern "C" void kernel_launch(void* const* d_in, const int* in_sizes, int n_in, void* d_out, int out_size,
                              void* d_ws, size_t ws_size, hipStream_t stream) {
  static int grid_blocks = 0;
  if (!grid_blocks) {
    int dev = 0, cus = 0, per_cu = 0;
    (void)hipGetDevice(&dev);
    (void)hipDeviceGetAttribute(&cus, hipDeviceAttributeMultiprocessorCount, dev);
    (void)hipFuncSetAttribute((const void*)fwd_kernel, hipFuncAttributeMaxDynamicSharedMemorySize, LDS_BYTES);
    (void)hipOccupancyMaxActiveBlocksPerMultiprocessor(&per_cu, fwd_kernel, 512, LDS_BYTES);
    if (per_cu < 1) { fprintf(stderr, "kernel_launch: occupancy query returned %d\n", per_cu); per_cu = 1; }
    if (per_cu > 1) per_cu = 1;
    grid_blocks = cus * per_cu;
    if (n_in != 23 || ws_size < WS_END) { fprintf(stderr, "kernel_launch: unexpected n_in %d or ws_size %zu (< %zu)\n", n_in, ws_size, (size_t)WS_END); }
  }
  if (ws_size < WS_END) return;
  (void)hipMemsetAsync((char*)d_ws + OFF_CTRL, 0, CTRL_BYTES, stream);
  Params p{};
  p.x = (const float*)d_in[0]; p.pos = (const int*)d_in[1]; p.ln_in_g = (const float*)d_in[2]; p.ln_in_b = (const float*)d_in[3];
  p.w_in = (const float*)d_in[4]; p.b_forget = (const float*)d_in[5]; p.diff_lambda = (const float*)d_in[6]; p.diff_subln_g = (const float*)d_in[7];
  p.mla_q_norm_g = (const float*)d_in[8]; p.mla_w_uq = (const float*)d_in[9]; p.mla_kv_norm_g = (const float*)d_in[10]; p.mla_w_ukv = (const float*)d_in[11];
  p.w_out = (const float*)d_in[12]; p.ln1_g = (const float*)d_in[13]; p.ln1_b = (const float*)d_in[14]; p.router_w = (const float*)d_in[15];
  p.router_b = (const float*)d_in[16]; p.w_gate_up = (const float*)d_in[17]; p.b_gate_up = (const float*)d_in[18]; p.w_down = (const float*)d_in[19];
  p.b_down = (const float*)d_in[20]; p.ln2_g = (const float*)d_in[21]; p.ln2_b = (const float*)d_in[22];
  p.out = (float*)d_out; p.ws = (unsigned char*)d_ws;
  void* args[] = {&p};
  hipError_t e = hipLaunchCooperativeKernel((void*)fwd_kernel, dim3(grid_blocks), dim3(512), args, LDS_BYTES, stream);
  if (e != hipSuccess) fprintf(stderr, "cooperative launch failed: %s (grid %d)\n", hipGetErrorString(e), grid_blocks);
}
```

```cpp
#include <hip/hip_runtime.h>
#include <hip/hip_cooperative_groups.h>
#include <cstdio>
#include <cstdint>
namespace cg = cooperative_groups;

#define LAS __attribute__((address_space(3)))
typedef unsigned short bf16_t;
typedef short bf16x8 __attribute__((ext_vector_type(8)));
typedef short s16x4 __attribute__((ext_vector_type(4)));
typedef float f32x16 __attribute__((ext_vector_type(16)));
typedef float f32x4 __attribute__((ext_vector_type(4)));
typedef float f32x2 __attribute__((ext_vector_type(2)));
typedef unsigned u32x4 __attribute__((ext_vector_type(4)));
typedef unsigned u32x2 __attribute__((ext_vector_type(2)));
typedef __bf16 bf16x2_t __attribute__((ext_vector_type(2)));

constexpr int M_TOK = 16384, DM = 1024, SEQ = 4096, NBATCH = 4, DEPTH = 2;
constexpr int NP = 2816;
constexpr int NE = 32, DFF = 1024, TOPK = 4;
constexpr int C_SBQ = 0, C_SBK = 256, C_SBV = 512, C_DFQ = 768, C_DFK = 1024, C_DFV = 1280, C_FXQ = 1536, C_FXK = 1792, C_FXV = 2048,
              C_CQ = 2304, C_CKV = 2560, C_KR = 2688, C_FXF = 2720, C_END = 2724;
constexpr float LOG2E = 1.4426950408889634f;
constexpr float DN_ALPHA = 1.4142135623730951f;
constexpr float LN_EPS = 1e-5f, RMS_EPS = 1e-6f;
constexpr float S8_H = 16.f, S8_WGU = 64.f, S8_ACT = 8.f, S8_WDN = 128.f;

constexpr size_t MB = 1ull << 20;
constexpr size_t OFF_CTRL = 0, CTRL_BYTES = 65536;
constexpr size_t OFF_ROPE = 1 * MB;
constexpr size_t OFF_GATEF = 3 * MB;
constexpr size_t OFF_FK = 3 * MB + 512 * 1024;
constexpr size_t OFF_LIST = 4 * MB;
constexpr size_t OFF_TOKE = 6 * MB;
constexpr size_t OFF_TOKG = 6 * MB + 512 * 1024;
constexpr size_t OFF_WUQ = 7 * MB;
constexpr size_t OFF_WUKV = 7 * MB + 512 * 1024;
constexpr size_t OFF_WOUT = 8 * MB;
constexpr size_t OFF_WIN = 12 * MB;
constexpr size_t OFF_HF = 24 * MB;
constexpr size_t OFF_HB = 88 * MB;
constexpr size_t OFF_P = 120 * MB;
constexpr size_t OFF_CQN = 208 * MB;
constexpr size_t OFF_CKVN = 216 * MB;
constexpr size_t OFF_QD = 220 * MB;
constexpr size_t OFF_KVD = 232 * MB;
constexpr size_t OFF_MIX = 248 * MB;
constexpr size_t OFF_TMPF = 280 * MB;
constexpr size_t OFF_KN = 3 * MB + 768 * 1024;
constexpr size_t OFF_H8 = 220 * MB;
constexpr size_t OFF_ACT = 344 * MB;
constexpr size_t OFF_Y = 473 * MB;
constexpr size_t OFF_WGU = 602 * MB;
constexpr size_t OFF_WD = 858 * MB;
constexpr size_t WS_END = 986 * MB;
constexpr int CW_CNT = 0;
constexpr int CW_ATTQ = 128;
constexpr int CW_LAM = 160;
constexpr int CW_CONVQ = 192;
constexpr int CW_BAR = 4096;

constexpr int LDS_ROWTAB = 131072;
constexpr int LDS_GEMM = 143360;
constexpr int LDS_MISC = LDS_GEMM + 1024;
constexpr int LDS_BIASTAB = 147456;
constexpr int LDS_BYTES = 159744;

struct Params {
  const float* x; const int* pos; const float* ln_in_g; const float* ln_in_b; const float* w_in; const float* b_forget;
  const float* diff_lambda; const float* diff_subln_g; const float* mla_q_norm_g; const float* mla_w_uq; const float* mla_kv_norm_g;
  const float* mla_w_ukv; const float* w_out; const float* ln1_g; const float* ln1_b; const float* router_w; const float* router_b;
  const float* w_gate_up; const float* b_gate_up; const float* w_down; const float* b_down; const float* ln2_g; const float* ln2_b;
  float* out; unsigned char* ws;
};

__device__ __forceinline__ unsigned cvtpk(float lo, float hi) { f32x2 v = {lo, hi}; bf16x2_t b = __builtin_convertvector(v, bf16x2_t); return __builtin_bit_cast(unsigned, b); }
__device__ __forceinline__ unsigned pk4_fp8(float a, float b, float c, float d) {
  int w = __builtin_amdgcn_cvt_pk_fp8_f32(a, b, 0, false);
  w = __builtin_amdgcn_cvt_pk_fp8_f32(c, d, w, true);
  return (unsigned)w;
}
__device__ __forceinline__ float clamp448(float x) { return fminf(fmaxf(x, -448.f), 448.f); }
__device__ __forceinline__ float bf2f(unsigned short b) { return __uint_as_float(((unsigned)b) << 16); }
__device__ __forceinline__ float bflo(unsigned w) { return __uint_as_float(w << 16); }
__device__ __forceinline__ float bfhi(unsigned w) { return __uint_as_float(w & 0xffff0000u); }
__device__ __forceinline__ float wave_sum(float v) {
#pragma unroll
  for (int o = 1; o < 64; o <<= 1) v += __shfl_xor(v, o);
  return v;
}
__device__ __forceinline__ int get_bid() { int b = blockIdx.x; asm volatile("" : "+s"(b)); return b; }
__device__ __forceinline__ int get_nblk() { int g = gridDim.x; asm volatile("" : "+s"(g)); return g; }
__device__ __forceinline__ int get_tid() { int t = threadIdx.x; asm volatile("" : "+v"(t)); return t; }
__device__ __forceinline__ int crow(int r, int hi) { return (r & 3) + 8 * (r >> 2) + 4 * hi; }
__device__ __forceinline__ void pair_vals(float v, float& v0, float& v1) {
  auto rr = __builtin_amdgcn_permlane32_swap(__float_as_uint(v), __float_as_uint(v), false, false);
  v0 = __uint_as_float(rr[0]); v1 = __uint_as_float(rr[1]);
}


#define XB_TMO      128
#define XB_XCNT(j)  (256  + 64 * (j))
#define XB_XSUB(j)  (1280 + 64 * (j))
#define XB_XGEN(j)  (2304 + 64 * (j))
#define XB_TOP      3328
#define XB_TOPGEN   3392
#define XCD_BAR_WORDS 3456
#define XB_SPIN_CAP (1u << 22)
__device__ __forceinline__ unsigned xb_ld(unsigned* p)              { return __hip_atomic_load(p, __ATOMIC_RELAXED, __HIP_MEMORY_SCOPE_AGENT); }
__device__ __forceinline__ unsigned xb_add(unsigned* p, unsigned v) { return __hip_atomic_fetch_add(p, v, __ATOMIC_RELAXED, __HIP_MEMORY_SCOPE_AGENT); }
__device__ __forceinline__ unsigned xb_xcc_id() { return (unsigned)__builtin_amdgcn_s_getreg((3 << 11) | 20) & 0xFu; }
#define XB_SPIN(cond, bar) do { unsigned _sp = 0; while (cond) { __builtin_amdgcn_s_sleep(1); \
    if ((++_sp & 255u) == 0u) { if (xb_ld(&(bar)[XB_TMO])) break; if (_sp > XB_SPIN_CAP) { atomicAdd(&(bar)[XB_TMO], 1u); break; } } } } while (0)
struct XcdBarrier { unsigned* bar; unsigned x; volatile LAS unsigned* st; };
__device__ __forceinline__ XcdBarrier xcd_barrier_post(unsigned* bar, volatile LAS unsigned* st) {
  XcdBarrier b; b.bar = bar; b.x = xb_xcc_id(); b.st = st;
  if (threadIdx.x == 0) (void)xb_add(&bar[XB_XCNT(b.x)], 1u);
  return b;
}
__device__ __forceinline__ void xcd_barrier_complete(unsigned* bar, unsigned x, unsigned& nloc, unsigned& nx) {
  const unsigned G = gridDim.x * gridDim.y * gridDim.z;
  unsigned sum, cnt, mine, sp = 0u;
  for (;;) {
    sum = 0u; cnt = 0u; mine = 0u;
#pragma unroll
    for (unsigned j = 0; j < 16; ++j) { const unsigned c = xb_ld(&bar[XB_XCNT(j)]); sum += c; cnt += (c > 0u) ? 1u : 0u; mine = (j == x) ? c : mine; }
    if (sum == G) break;
    __builtin_amdgcn_s_sleep(1);
    if ((++sp & 255u) == 0u) { if (xb_ld(&bar[XB_TMO])) break; if (sp > XB_SPIN_CAP) { atomicAdd(&bar[XB_TMO], 1u); break; } }
  }
  nloc = mine > 0u ? mine : 1u; nx = cnt > 0u ? cnt : 1u;
}
__device__ __forceinline__ void xcd_barrier(const XcdBarrier& b) {
  asm volatile("s_waitcnt vmcnt(0)" ::: "memory");
  __syncthreads();
  if (threadIdx.x == 0) {
    unsigned* bar = b.bar;
    __builtin_amdgcn_s_waitcnt(0);
    unsigned nloc = b.st[0], nx = b.st[1];
    if (nloc == 0u) { xcd_barrier_complete(bar, b.x, nloc, nx); b.st[0] = nloc; b.st[1] = nx; }
    const unsigned old = xb_add(&bar[XB_XSUB(b.x)], 1u);
    const unsigned gen = old / nloc;
    if (old + 1u == (gen + 1u) * nloc) {
      __builtin_amdgcn_fence(__ATOMIC_RELEASE, "agent");
      asm volatile("s_waitcnt vmcnt(0)" ::: "memory");
      const unsigned og = xb_add(&bar[XB_TOP], 1u);
      const unsigned tg = og / nx;
      if (og + 1u == (tg + 1u) * nx) xb_add(&bar[XB_TOPGEN], 1u);
      else XB_SPIN(xb_ld(&bar[XB_TOPGEN]) == tg, bar);
      __builtin_amdgcn_fence(__ATOMIC_ACQUIRE, "agent");
      xb_add(&bar[XB_XGEN(b.x)], 1u);
      asm volatile("s_waitcnt vmcnt(0)" ::: "memory");
    } else {
      XB_SPIN(xb_ld(&bar[XB_XGEN(b.x)]) == gen, bar);
      __builtin_amdgcn_fence(__ATOMIC_ACQUIRE, "agent");
      asm volatile("s_waitcnt vmcnt(0)" ::: "memory");
    }
  }
  __syncthreads();
}

struct ConvDesc { const float* src; bf16_t* dst; const float* kscale; int K, Ndst, srcld, mode, kb, nb; };
constexpr int CV_U_IN = 16 * 11, CV_U_OUT = 16 * 4, CV_U_UQ = 4 * 2, CV_U_UKV = 2 * 2;
constexpr int CV_SMALL = 2 * (CV_U_IN + CV_U_OUT + CV_U_UQ + CV_U_UKV);
__device__ __forceinline__ bool conv_desc(const Params& p, int u, ConvDesc& d) {
  unsigned char* ws = p.ws;
  constexpr int T_IN = 2 * CV_U_IN, T_OUT = 2 * CV_U_OUT, T_UQ = 2 * CV_U_UQ;
  const float* src; bf16_t* dst; const float* ksc = nullptr; int K, Ndst, srcld, mode, q, nbn;
  int r = u;
  if (r < T_IN) { const int inst = r / CV_U_IN; q = r % CV_U_IN; src = p.w_in + (size_t)inst * 1024 * 2724; dst = (bf16_t*)(ws + OFF_WIN) + (size_t)inst * NP * 1024; K = 1024; Ndst = NP; srcld = 2724; mode = 1; nbn = 11; }
  else if ((r -= T_IN) < T_OUT) { const int inst = r / CV_U_OUT; q = r % CV_U_OUT; src = p.w_out + (size_t)inst * 1024 * 1024; dst = (bf16_t*)(ws + OFF_WOUT) + (size_t)inst * 1024 * 1024; K = 1024; Ndst = 1024; srcld = 1024; mode = 0; nbn = 4; }
  else if ((r -= T_OUT) < T_UQ) { const int inst = r / CV_U_UQ; q = r % CV_U_UQ; src = p.mla_w_uq + (size_t)inst * 256 * 384; dst = (bf16_t*)(ws + OFF_WUQ) + (size_t)inst * 384 * 256; K = 256; Ndst = 384; srcld = 384; mode = 0; nbn = 2; ksc = p.mla_q_norm_g + inst * 256; }
  else { r -= T_UQ; const int inst = r / CV_U_UKV; q = r % CV_U_UKV; src = p.mla_w_ukv + (size_t)inst * 128 * 512; dst = (bf16_t*)(ws + OFF_WUKV) + (size_t)inst * 512 * 128; K = 128; Ndst = 512; srcld = 512; mode = 0; nbn = 2; ksc = p.mla_kv_norm_g + inst * 128; }
  d.src = src; d.dst = dst; d.kscale = ksc; d.K = K; d.Ndst = Ndst; d.srcld = srcld; d.mode = mode; d.kb = q / nbn; d.nb = q % nbn;
  return u < CV_SMALL;
}
__device__ __forceinline__ void conv_load(const ConvDesc& d, float (&v)[4][8], int lane, int w) {
  const int k0 = d.kb * 64 + 8 * w;
#pragma unroll
  for (int u = 0; u < 4; ++u) {
    const int n = d.nb * 256 + u * 64 + lane;
    int sc = n; bool ok = n < d.Ndst;
    if (d.mode == 1) { if (n < 2304) sc = n; else if (n < C_FXF) sc = n + 4; else if (n < C_END) sc = 2304 + (n - C_FXF); else ok = false; }
    const float* sp = d.src + (size_t)k0 * d.srcld + sc;
#pragma unroll
    for (int j = 0; j < 8; ++j) v[u][j] = ok ? __builtin_nontemporal_load(sp + (size_t)j * d.srcld) : 0.f;
  }
}
__device__ __forceinline__ void conv_store(const ConvDesc& d, const float (&v)[4][8], int lane, int w) {
  const int k0 = d.kb * 64 + 8 * w;
#pragma unroll
  for (int u = 0; u < 4; ++u) {
    const int n = d.nb * 256 + u * 64 + lane;
    if (n < d.Ndst) {
      int dr = n;
      if (d.mode == 2) { const int j = n & 1023; dr = (j >> 4) * 32 + (j & 15) + ((n >= 1024) ? 16 : 0); }
      float g[8];
#pragma unroll
      for (int j = 0; j < 8; ++j) g[j] = d.kscale ? d.kscale[k0 + j] : 1.f;
      u32x4 o; o.x = cvtpk(v[u][0] * g[0], v[u][1] * g[1]); o.y = cvtpk(v[u][2] * g[2], v[u][3] * g[3]); o.z = cvtpk(v[u][4] * g[4], v[u][5] * g[5]); o.w = cvtpk(v[u][6] * g[6], v[u][7] * g[7]);
      *(u32x4*)(d.dst + (size_t)dr * d.K + k0) = o;
    }
  }
}
__device__ __forceinline__ void phase_convert(const Params& p) {
  const int tid = get_tid(), lane = tid & 63, w = tid >> 6;
  const int G = get_nblk();
  for (int u = get_bid(); u < CV_SMALL; u += G) {
    ConvDesc d; float va[4][8];
    conv_desc(p, u, d);
    conv_load(d, va, lane, w);
    conv_store(d, va, lane, w);
  }
}

__device__ __forceinline__ void ln_row(f32x4 (&v)[4], const float* g, const float* b, int lane) {
  float s = 0.f;
#pragma unroll
  for (int j = 0; j < 4; ++j) s += (v[j].x + v[j].y) + (v[j].z + v[j].w);
  const float mean = wave_sum(s) * (1.f / DM);
  float s2 = 0.f;
#pragma unroll
  for (int j = 0; j < 4; ++j) { v[j] = v[j] - mean; s2 += (v[j].x * v[j].x + v[j].y * v[j].y) + (v[j].z * v[j].z + v[j].w * v[j].w); }
  const float rstd = rsqrtf(wave_sum(s2) * (1.f / DM) + LN_EPS);
#pragma unroll
  for (int j = 0; j < 4; ++j) {
    const f32x4 gg = *(const f32x4*)(g + 4 * lane + 256 * j), bb = *(const f32x4*)(b + 4 * lane + 256 * j);
    v[j] = v[j] * rstd * gg + bb;
  }
}
__device__ __forceinline__ void store_row_f32_bf16(const f32x4 (&v)[4], float* of, bf16_t* ob, int lane) {
#pragma unroll
  for (int j = 0; j < 4; ++j) {
    if (of) *(f32x4*)(of + 4 * lane + 256 * j) = v[j];
    if (ob) { u32x2 w; w.x = cvtpk(v[j].x, v[j].y); w.y = cvtpk(v[j].z, v[j].w); *(u32x2*)(ob + 4 * lane + 256 * j) = w; }
  }
}

__device__ __forceinline__ void phase_prologue_misc(const Params& p) {
  unsigned char* ws = p.ws;
  const int lane = get_tid() & 63, gw = get_bid() * 8 + (get_tid() >> 6), ngw = get_nblk() * 8;
  float* hF = (float*)(ws + OFF_HF); bf16_t* hB = (bf16_t*)(ws + OFF_HB);
  for (int m = gw; m < M_TOK; m += ngw) {
    f32x4 v[4];
#pragma unroll
    for (int j = 0; j < 4; ++j) v[j] = *(const f32x4*)(p.x + (size_t)m * DM + 4 * lane + 256 * j);
    ln_row(v, p.ln_in_g, p.ln_in_b, lane);
    store_row_f32_bf16(v, nullptr, hB + (size_t)m * DM, lane);
  }
  f32x2* cs = (f32x2*)(ws + OFF_ROPE);
  const int gt = get_bid() * 512 + get_tid(), ngt = get_nblk() * 512;
  for (int i = gt; i < M_TOK * 16; i += ngt) {
    const int m = i >> 4, f = i & 15;
    const double invf = exp2(-(double)f * (13.287712379549449 / 16.0));
    double a = (double)p.pos[m] * invf;
    a = a - 6.283185307179586476925 * rint(a * 0.15915494309189533577);
    float sn, cn; __sincosf((float)a, &sn, &cn);
    cs[i] = (f32x2){cn, sn};
  }
  if (get_bid() == 0 && get_tid() < DEPTH) {
    const int l = get_tid(); const float* lp = p.diff_lambda + l * 128;
    float s1 = 0.f, s2 = 0.f;
    for (int i = 0; i < 32; ++i) { s1 += lp[i] * lp[32 + i]; s2 += lp[64 + i] * lp[96 + i]; }
    const float linit = 0.8f - 0.6f * expf(-0.3f * (float)l);
    ((float*)(ws + OFF_CTRL))[CW_LAM + l] = expf(s1) - expf(s2) + linit;
  }
}

struct GemmDesc { const bf16_t* A; int lda; const int* rowidx; int row0; int mvalid; const bf16_t* Bt; int ldb; int K; };

template <int NI>
__device__ __forceinline__ void gemm_tile(LAS unsigned char* lds, const GemmDesc& g, f32x16 (&acc)[2][NI]) {
  constexpr int BN = 64 * NI;
  constexpr int A_BYTES = 256 * 128, B_BYTES = BN * 128, STAGE = A_BYTES + B_BYTES;
  constexpr int NBL = BN / 64;
  const int tid = get_tid(), lane = tid & 63, w = tid >> 6, wm = w >> 1, wn = w & 1, c31 = lane & 31, hi = lane >> 5;
  const int lr = tid >> 3, lc = (tid & 7) ^ ((tid >> 4) & 7);
  const bf16_t* ap[4];
#pragma unroll
  for (int i = 0; i < 4; ++i) {
    const int r = lr + 64 * i;
    int row;
    if (g.rowidx) row = g.rowidx[g.row0 + (r < g.mvalid ? r : 0)]; else row = g.row0 + r;
    ap[i] = g.A + (size_t)row * g.lda + lc * 8;
  }
  const bf16_t* bp = g.Bt + (size_t)lr * g.ldb + lc * 8;
  const int wbase = w * 1024;
  const int xr = (lane >> 1) & 7;
  int roff[4];
#pragma unroll
  for (int ks = 0; ks < 4; ++ks) roff[ks] = ((2 * ks + hi) ^ xr) << 4;
  const int a_base = (wm * 64 + c31) * 128, b_base = A_BYTES + (wn * 32 * NI + c31) * 128;
#pragma unroll
  for (int mi = 0; mi < 2; ++mi)
#pragma unroll
    for (int ni = 0; ni < NI; ++ni)
#pragma unroll
      for (int r = 0; r < 16; ++r) acc[mi][ni][r] = 0.f;
  const int nk = g.K >> 6;
#define GT_STAGE(stg, ko) do { LAS unsigned char* s_ = lds + (stg) * STAGE + wbase; \
    _Pragma("unroll") for (int i = 0; i < 4; ++i) __builtin_amdgcn_global_load_lds((const unsigned*)(ap[i] + (ko)), (LAS unsigned*)(s_ + 8192 * i), 16, 0, 0); \
    _Pragma("unroll") for (int i = 0; i < NBL; ++i) __builtin_amdgcn_global_load_lds((const unsigned*)(bp + (size_t)(64 * i) * g.ldb + (ko)), (LAS unsigned*)(s_ + A_BYTES + 8192 * i), 16, 0, 0); } while (0)
  GT_STAGE(0, 0);
  __syncthreads();
  bf16x8 af[2][2], bfr[2][NI];
  for (int kt = 0; kt < nk; ++kt) {
    LAS unsigned char* cur = lds + (kt & 1) * STAGE;
    if (kt + 1 < nk) GT_STAGE((kt + 1) & 1, (kt + 1) * 64);
#pragma unroll
    for (int mi = 0; mi < 2; ++mi) af[0][mi] = *(const LAS bf16x8*)(cur + a_base + mi * 4096 + roff[0]);
#pragma unroll
    for (int ni = 0; ni < NI; ++ni) bfr[0][ni] = *(const LAS bf16x8*)(cur + b_base + ni * 4096 + roff[0]);
#pragma unroll
    for (int ks = 0; ks < 4; ++ks) {
      if (ks < 3) {
#pragma unroll
        for (int mi = 0; mi < 2; ++mi) af[(ks + 1) & 1][mi] = *(const LAS bf16x8*)(cur + a_base + mi * 4096 + roff[ks + 1]);
#pragma unroll
        for (int ni = 0; ni < NI; ++ni) bfr[(ks + 1) & 1][ni] = *(const LAS bf16x8*)(cur + b_base + ni * 4096 + roff[ks + 1]);
      }
      __builtin_amdgcn_s_setprio(1);
#pragma unroll
      for (int mi = 0; mi < 2; ++mi)
#pragma unroll
        for (int ni = 0; ni < NI; ++ni) acc[mi][ni] = __builtin_amdgcn_mfma_f32_32x32x16_bf16(bfr[ks & 1][ni], af[ks & 1][mi], acc[mi][ni], 0, 0, 0);
      __builtin_amdgcn_s_setprio(0);
    }
    __syncthreads();
  }
#undef GT_STAGE
}


namespace pg8 {
typedef float f32x4v __attribute__((ext_vector_type(4)));
constexpr int BM = 256, BK = 64, HALF = 128, HTB = HALF * BK * 2, STAGE_BYTES = 8 * HTB, KK = 1024;
typedef int v8i_t __attribute__((ext_vector_type(8)));
typedef int v4i_t __attribute__((ext_vector_type(4)));
__device__ __forceinline__ v8i_t cat8(bf16x8 a, bf16x8 b) { const v4i_t x = __builtin_bit_cast(v4i_t, a), y = __builtin_bit_cast(v4i_t, b); return __builtin_shufflevector(x, y, 0, 1, 2, 3, 4, 5, 6, 7); }
__device__ __forceinline__ int lds_byte(int r, int c) { const int st = (r >> 4) * 2 + (c >> 5), rr = r & 15, cc = c & 31, ob = rr * 64 + cc * 2; return st * 1024 + (ob ^ (((ob >> 9) & 1) << 5)); }
__device__ __forceinline__ void stage_rc(int b, int& R, int& C) { const int st = b / 1024, sb = b % 1024, swz = sb ^ (((sb >> 9) & 1) << 5); R = (st >> 1) * 16 + swz / 64; C = (st & 1) * 32 + (swz % 64) / 2; }
struct Unit { unsigned boff; int arow0; int mvalid; int e, mt, nt, slot0; };
template <bool GATHER, bool FP8, class Sched, class Epi>
__device__ __forceinline__ void gemm_phase(LAS unsigned char* lds, const bf16_t* Abuf, const bf16_t* Bbuf, const Sched& S, const Epi& E) {
  const int tid = get_tid(), wid = __builtin_amdgcn_readfirstlane(tid >> 6), lane = tid & 63, wr = wid >> 2, wc = wid & 3, fr = lane & 15, fq = lane >> 4;
  const __amdgpu_buffer_rsrc_t rsA = __builtin_amdgcn_make_buffer_rsrc((void*)Abuf, (short)0, 0x7ffffff0, 0x00020000);
  const __amdgpu_buffer_rsrc_t rsB = __builtin_amdgcn_make_buffer_rsrc((void*)Bbuf, (short)0, 0x7ffffff0, 0x00020000);
  constexpr int RS = FP8 ? KK : 2 * KK;
  constexpr int NT_K = FP8 ? 8 : 16;
  const int lrow = (wid >> 1) * 16 + (lane >> 2);
  const int cbyte = (wid & 1) * 64 + (((lane & 3) * 16) ^ (((lane >> 5) & 1) << 5));
  const unsigned vB = (unsigned)(lrow * RS + cbyte);
  const int lrowP = (lrow & 32) + 8 * ((lrow & 15) >> 2) + 4 * ((lrow >> 4) & 1) + (lrow & 3);
  const unsigned vBb = Epi::PERMB ? (unsigned)(lrowP * RS + cbyte) : vB;
  const LAS int* rowtab = (const LAS int*)(lds + LDS_ROWTAB) + lrow;
#define PG8_ROWS(V, u) do { if (GATHER) { _Pragma("unroll") for (int h_ = 0; h_ < 2; ++h_) _Pragma("unroll") for (int i_ = 0; i_ < 2; ++i_) \
      V[h_][i_] = (unsigned)(rowtab[(u).arow0 * 256 + h_ * HALF + i_ * 64] * RS + cbyte); } } while (0)
#define PG8_ABASE(u) (GATHER ? 0u : (unsigned)(u).arow0 * (unsigned)RS)
  constexpr unsigned kstep = BK * 2;
  const unsigned ldsw = (unsigned)wid * 1024u;
  const int aoff = lds_byte(wr * 64 + fr, fq * 8), boff = lds_byte(wc * 32 + fr, fq * 8);
#define PG8_SA(b, h) (((b) * 2 + (h)) * HTB)
#define PG8_SB(b, h) ((4 + (b) * 2 + (h)) * HTB)
#define PG8_LOAD1(rs, ldsoff, voff, soff) __builtin_amdgcn_raw_ptr_buffer_load_lds(rs, (LAS void*)(lds + (ldsoff) + ldsw), 16, (int)(voff), (int)(soff), 0, 0)
#define PG8_STAGE_B(bufoff, soff, h) do { PG8_LOAD1(rsB, (bufoff), vBb, (soff) + (unsigned)((h) * HALF * RS)); PG8_LOAD1(rsB, (bufoff) + 8192, vBb, (soff) + (unsigned)(((h) * HALF + 64) * RS)); } while (0)
#define PG8_STAGE_A(bufoff, soff, h, v0, v1) do { if (GATHER) { PG8_LOAD1(rsA, (bufoff), (v0), (soff)); PG8_LOAD1(rsA, (bufoff) + 8192, (v1), (soff)); } \
    else { PG8_LOAD1(rsA, (bufoff), vB, (soff) + (unsigned)((h) * HALF * RS)); PG8_LOAD1(rsA, (bufoff) + 8192, vB, (soff) + (unsigned)(((h) * HALF + 64) * RS)); } } while (0)
#define PG8_LDA(dst, b, h) do { if (FP8) { _Pragma("unroll") for (int m = 0; m < 4; ++m) { \
      const v4i_t lo_ = *(const LAS v4i_t*)(lds + PG8_SA(b, h) + aoff + m * 2048), hi_ = *(const LAS v4i_t*)(lds + PG8_SA(b, h) + aoff + m * 2048 + 1024); \
      dst##8[m] = __builtin_shufflevector(lo_, hi_, 0, 1, 2, 3, 4, 5, 6, 7); } } \
    else { _Pragma("unroll") for (int m = 0; m < 4; ++m) _Pragma("unroll") for (int k = 0; k < 2; ++k) dst[m][k] = *(const LAS bf16x8*)(lds + PG8_SA(b, h) + aoff + m * 2048 + k * 1024); } } while (0)
#define PG8_LDB(dst, b, h) do { if (FP8) { _Pragma("unroll") for (int n = 0; n < 2; ++n) { \
      const v4i_t lo_ = *(const LAS v4i_t*)(lds + PG8_SB(b, h) + boff + n * 2048), hi_ = *(const LAS v4i_t*)(lds + PG8_SB(b, h) + boff + n * 2048 + 1024); \
      dst##8[n] = __builtin_shufflevector(lo_, hi_, 0, 1, 2, 3, 4, 5, 6, 7); } } \
    else { _Pragma("unroll") for (int n = 0; n < 2; ++n) _Pragma("unroll") for (int k = 0; k < 2; ++k) dst[n][k] = *(const LAS bf16x8*)(lds + PG8_SB(b, h) + boff + n * 2048 + k * 1024); } } while (0)
#define PG8_MMA(ai, bj, At, Bt) do { __builtin_amdgcn_s_setprio(1); _Pragma("unroll") for (int m = 0; m < 4; ++m) _Pragma("unroll") for (int n = 0; n < 2; ++n) { \
    if (FP8) asm volatile("v_mfma_scale_f32_16x16x128_f8f6f4 %0, %1, %2, %0, %3, %3 op_sel_hi:[0,0,0]" : "+v"(acc[ai][bj][m][n]) : "v"(Bt##8[n]), "v"(At##8[m]), "v"(sc1));   \
    else { _Pragma("unroll") for (int k = 0; k < 2; ++k) acc[ai][bj][m][n] = __builtin_amdgcn_mfma_f32_16x16x32_bf16(Bt[n][k], At[m][k], acc[ai][bj][m][n], 0, 0, 0); } } \
    __builtin_amdgcn_s_setprio(0); } while (0)
#define PG8_WAIT_V(n) asm volatile("s_waitcnt vmcnt(" #n ")" ::: "memory")
#define PG8_WAIT_L(n) asm volatile("s_waitcnt lgkmcnt(" #n ")" ::: "memory")
#define PG8_BAR __builtin_amdgcn_s_barrier()
#define PG8_SCHED __builtin_amdgcn_sched_barrier(0)
  Unit cur, nxt; int ui = 0;
  if (!S.next(0, cur)) return;
  f32x4v acc[2][2][4][2];
#pragma unroll
  for (int a = 0; a < 2; ++a)
#pragma unroll
    for (int b = 0; b < 2; ++b)
#pragma unroll
      for (int m = 0; m < 4; ++m)
#pragma unroll
        for (int n = 0; n < 2; ++n) acc[a][b][m][n] = (f32x4v){0.f, 0.f, 0.f, 0.f};
  unsigned sc1 = 0x7f7f7f7fu; asm volatile("" : "+v"(sc1));
  bf16x8 At[4][2], B0[2][2], B1[2][2];
  v8i_t At8[4], B08[2], B18[2];
  unsigned cV[2][2];
#pragma unroll
  for (int h = 0; h < 2; ++h)
#pragma unroll
    for (int i = 0; i < 2; ++i) cV[h][i] = 0u;
  PG8_ROWS(cV, cur);
  unsigned cA = PG8_ABASE(cur), cB = cur.boff;
  PG8_STAGE_B(PG8_SB(0, 0), cB, 0); PG8_STAGE_B(PG8_SB(0, 1), cB, 1);
  PG8_STAGE_A(PG8_SA(0, 0), cA, 0, cV[0][0], cV[0][1]); PG8_STAGE_A(PG8_SA(0, 1), cA, 1, cV[1][0], cV[1][1]);
  if (wr == 1) PG8_BAR;
  PG8_WAIT_V(2); PG8_BAR;
  PG8_STAGE_B(PG8_SB(1, 0), cB + kstep, 0); PG8_STAGE_A(PG8_SA(1, 0), cA + kstep, 0, cV[0][0], cV[0][1]); PG8_STAGE_B(PG8_SB(1, 1), cB + kstep, 1);
  PG8_WAIT_V(6); PG8_BAR;
  for (;;) {
    const bool has_next = S.next(ui + 1, nxt);
    const unsigned nB = has_next ? nxt.boff : cB;
    const unsigned nA = has_next ? PG8_ABASE(nxt) : cA;
#pragma unroll 1
    for (int t = 0; t < NT_K; t += 2) {
      const bool last = (t == NT_K - 2);
      const unsigned a1 = cA + (unsigned)(t + 1) * kstep;
      const unsigned a2 = last ? nA : cA + (unsigned)(t + 2) * kstep, b2 = last ? nB : cB + (unsigned)(t + 2) * kstep;
      const unsigned a3 = a2 + kstep, b3 = b2 + kstep;
      unsigned w00 = cV[0][0], w01 = cV[0][1], w10 = cV[1][0], w11 = cV[1][1];
      if (GATHER && last && has_next) { unsigned nV[2][2]; PG8_ROWS(nV, nxt); w00 = nV[0][0]; w01 = nV[0][1]; w10 = nV[1][0]; w11 = nV[1][1]; }
      PG8_LDB(B0, 0, 0); PG8_LDB(B1, 0, 1); PG8_SCHED; PG8_LDA(At, 0, 0); PG8_STAGE_A(PG8_SA(1, 1), a1, 1, cV[1][0], cV[1][1]);
      PG8_WAIT_V(8); PG8_WAIT_L(0); PG8_BAR; PG8_MMA(0, 0, At, B0); PG8_MMA(0, 1, At, B1); PG8_BAR; PG8_SCHED;
      PG8_LDA(At, 0, 1); PG8_STAGE_B(PG8_SB(0, 0), b2, 0); PG8_STAGE_B(PG8_SB(0, 1), b2, 1); PG8_STAGE_A(PG8_SA(0, 0), a2, 0, w00, w01);
      PG8_WAIT_V(8); PG8_WAIT_L(0); PG8_BAR; PG8_MMA(1, 0, At, B0); PG8_MMA(1, 1, At, B1); PG8_BAR; PG8_SCHED;
      PG8_LDB(B0, 1, 0); PG8_LDB(B1, 1, 1); PG8_SCHED; PG8_LDA(At, 1, 0); PG8_STAGE_A(PG8_SA(0, 1), a2, 1, w10, w11);
      PG8_WAIT_V(8); PG8_WAIT_L(0); PG8_BAR; PG8_MMA(0, 0, At, B0); PG8_MMA(0, 1, At, B1); PG8_BAR; PG8_SCHED;
      PG8_LDA(At, 1, 1); PG8_STAGE_B(PG8_SB(1, 0), b3, 0); PG8_STAGE_B(PG8_SB(1, 1), b3, 1); PG8_STAGE_A(PG8_SA(1, 0), a3, 0, w00, w01);
      PG8_WAIT_V(8); PG8_WAIT_L(0); PG8_BAR; PG8_MMA(1, 0, At, B0); PG8_MMA(1, 1, At, B1); PG8_BAR; PG8_SCHED;
    }
    if (wr == 0) PG8_BAR;
    if (FP8) asm volatile("s_nop 15\n\ts_nop 15" ::: "memory");
    E(acc, cur, wr, wc, fr, fq);
    if (!has_next) break;
#pragma unroll
    for (int a = 0; a < 2; ++a)
#pragma unroll
      for (int b = 0; b < 2; ++b)
#pragma unroll
        for (int m = 0; m < 4; ++m)
#pragma unroll
          for (int n = 0; n < 2; ++n) acc[a][b][m][n] = (f32x4v){0.f, 0.f, 0.f, 0.f};
    if (FP8) asm volatile("s_nop 7" ::: "memory");
    cur = nxt; cB = nB; cA = nA; ++ui;
    PG8_ROWS(cV, cur);
    if (wr == 1) PG8_BAR;
  }
  PG8_WAIT_V(0);
  PG8_BAR;
#undef PG8_ROWS
#undef PG8_ABASE
#undef PG8_SA
#undef PG8_SB
#undef PG8_LOAD1
#undef PG8_STAGE_A
#undef PG8_STAGE_B
#undef PG8_LDA
#undef PG8_LDB
#undef PG8_MMA
#undef PG8_WAIT_V
#undef PG8_WAIT_L
#undef PG8_BAR
#undef PG8_SCHED
}
}

struct InprojSched {
  int grid, bid;
  __device__ __forceinline__ bool next(int i, pg8::Unit& u) const {
    constexpr int NT = NP / 256;
    int mt, nt;
    if (grid == 256) { const int xcd = bid & 7, j = bid >> 3, q = j + 32 * i; if (q >= 8 * NT) return false; mt = 8 * xcd + q / NT; nt = q % NT; }
    else { const int t = bid + i * grid; if (t >= 64 * NT) return false; mt = t / NT; nt = t % NT; }
    u.boff = (unsigned)nt * (256u * 1024u * 2u); u.arow0 = mt * 256; u.mvalid = 256; u.e = 0; u.mt = mt; u.nt = nt; u.slot0 = 0;
    return true;
  }
};
struct InprojEpi {
  static constexpr bool PERMB = false;
  bf16_t* P; float* gateF; const f32x2* cs; float* ssq;
  __device__ __forceinline__ void operator()(const pg8::f32x4v (&acc)[2][2][4][2], const pg8::Unit& u, int wr, int wc, int fr, int fq) const {
    const int nt = u.nt;
    const bool rope_all = (nt == 3) || (nt == 4);
#pragma unroll
    for (int ai = 0; ai < 2; ++ai)
#pragma unroll
      for (int m = 0; m < 4; ++m) {
        const int row = u.mt * 256 + 128 * ai + 64 * wr + 16 * m + fr;
        bf16_t* prow = P + (size_t)row * NP + nt * 256 + 32 * wc + 4 * fq;
        f32x2 c4[4];
        if (rope_all || nt == 10) {
#pragma unroll
          for (int j = 0; j < 4; ++j) c4[j] = cs[(size_t)row * 16 + 4 * fq + j];
        }
        float sq = 0.f;
#pragma unroll
        for (int bj = 0; bj < 2; ++bj) {
          pg8::f32x4v v0 = acc[ai][bj][m][0], v1 = acc[ai][bj][m][1];
          if (rope_all || (nt == 10 && bj == 1 && wc == 0)) {
#pragma unroll
            for (int j = 0; j < 4; ++j) { const float x1 = v0[j], x2 = v1[j]; v0[j] = x1 * c4[j].x - x2 * c4[j].y; v1[j] = x2 * c4[j].x + x1 * c4[j].y; }
          }
          if (nt == 9 || (nt == 10 && bj == 0)) {
#pragma unroll
            for (int j = 0; j < 4; ++j) sq += v0[j] * v0[j] + v1[j] * v1[j];
          }
          u32x2 o; o.x = cvtpk(v0[0], v0[1]); o.y = cvtpk(v0[2], v0[3]);
          *(u32x2*)(prow + 128 * bj) = o;
          o.x = cvtpk(v1[0], v1[1]); o.y = cvtpk(v1[2], v1[3]);
          *(u32x2*)(prow + 128 * bj + 16) = o;
          if (nt == 10 && bj == 1 && wc == 1 && fq == 0) *(f32x4*)(gateF + (size_t)row * 4) = (f32x4){v0[0], v0[1], v0[2], v0[3]};
        }
        if (nt == 9 || nt == 10) {
          sq += __shfl_xor(sq, 16); sq += __shfl_xor(sq, 32);
          if (fq == 0) ssq[(size_t)row * 8 + (nt == 9 ? 0 : 4) + wc] = sq;
        }
      }
  }
};
__device__ __forceinline__ void phase_inproj(const Params& p, int layer, LAS unsigned char* lds) {
  unsigned char* ws = p.ws;
  InprojSched S{get_nblk(), get_bid()};
  InprojEpi E{(bf16_t*)(ws + OFF_P), (float*)(ws + OFF_GATEF), (const f32x2*)(ws + OFF_ROPE), (float*)(ws + OFF_CQN)};
  pg8::gemm_phase<false, false>(lds, (const bf16_t*)(ws + OFF_HB), (const bf16_t*)(ws + OFF_WIN) + (size_t)layer * NP * 1024, S, E);
}

__device__ __forceinline__ void rope4(bf16_t* base, const f32x2* cs4) {
  const u32x2 a = *(const u32x2*)base, b = *(const u32x2*)(base + 16);
  float x1[4] = {bflo(a.x), bfhi(a.x), bflo(a.y), bfhi(a.y)}, x2[4] = {bflo(b.x), bfhi(b.x), bflo(b.y), bfhi(b.y)};
  float y1[4], y2[4];
#pragma unroll
  for (int i = 0; i < 4; ++i) { const f32x2 c = cs4[i]; y1[i] = x1[i] * c.x - x2[i] * c.y; y2[i] = x2[i] * c.x + x1[i] * c.y; }
  u32x2 oa, ob; oa.x = cvtpk(y1[0], y1[1]); oa.y = cvtpk(y1[2], y1[3]); ob.x = cvtpk(y2[0], y2[1]); ob.y = cvtpk(y2[2], y2[3]);
  *(u32x2*)base = oa; *(u32x2*)(base + 16) = ob;
}
__device__ __forceinline__ void phase_post(const Params& p, int layer, LAS unsigned char* lds) {
  unsigned char* ws = p.ws;
  bf16_t* P = (bf16_t*)(ws + OFF_P);
  const f32x2* cs = (const f32x2*)(ws + OFF_ROPE);
  bf16_t* cqn = (bf16_t*)(ws + OFF_CQN); bf16_t* ckvn = (bf16_t*)(ws + OFF_CKVN);
  const int lane = get_tid() & 63, gw = get_bid() * 8 + (get_tid() >> 6), ngw = get_nblk() * 8;
  const float* gq = p.mla_q_norm_g + layer * 256; const float* gkv = p.mla_kv_norm_g + layer * 128;
  for (int m = gw; m < M_TOK; m += ngw) {
    bf16_t* row = P + (size_t)m * NP;
    const f32x2* csm = cs + (size_t)m * 16;
    { const int sh = lane >> 2, pg = lane & 3; rope4(row + C_DFQ + sh * 32 + 4 * pg, csm + 4 * pg); }
    if (lane < 4) rope4(row + C_KR + 4 * lane, csm + 4 * lane);
    {
      const u32x2 a = *(const u32x2*)(row + C_CQ + 4 * lane);
      float x[4] = {bflo(a.x), bfhi(a.x), bflo(a.y), bfhi(a.y)};
      const float ss = wave_sum(x[0] * x[0] + x[1] * x[1] + x[2] * x[2] + x[3] * x[3]);
      const float rs = rsqrtf(ss * (1.f / 256.f) + RMS_EPS);
      const f32x4 gg = *(const f32x4*)(gq + 4 * lane);
      u32x2 o; o.x = cvtpk(x[0] * rs * gg.x, x[1] * rs * gg.y); o.y = cvtpk(x[2] * rs * gg.z, x[3] * rs * gg.w);
      *(u32x2*)(cqn + (size_t)m * 256 + 4 * lane) = o;
    }
    {
      const unsigned a = *(const unsigned*)(row + C_CKV + 2 * lane);
      const float x0 = bflo(a), x1 = bfhi(a);
      const float ss = wave_sum(x0 * x0 + x1 * x1);
      const float rs = rsqrtf(ss * (1.f / 128.f) + RMS_EPS);
      const f32x2 gg = *(const f32x2*)(gkv + 2 * lane);
      *(unsigned*)(ckvn + (size_t)m * 128 + 2 * lane) = cvtpk(x0 * rs * gg.x, x1 * rs * gg.y);
    }
  }
  if (get_bid() < 16) {
    const int b = get_bid() >> 2, h = get_bid() & 3, tid = get_tid();
    const float* gateF = (const float*)(ws + OFF_GATEF);
    float* Fk = (float*)(ws + OFF_FK) + (size_t)get_bid() * SEQ;
    const float bf = p.b_forget[layer * 4 + h];
    LAS float* sc = (LAS float*)lds;
    float v[8]; float run = 0.f;
#pragma unroll
    for (int i = 0; i < 8; ++i) {
      const float xx = gateF[(size_t)(b * SEQ + tid * 8 + i) * 4 + h] + bf;
      const float ls = fminf(xx, 0.f) - log1pf(expf(-fabsf(xx)));
      run += ls; v[i] = run;
    }
    float inc = run;
#pragma unroll
    for (int o = 1; o < 64; o <<= 1) { const float t = __shfl_up(inc, o); if (lane >= o) inc += t; }
    __syncthreads();
    if (lane == 63) sc[tid >> 6] = inc;
    __syncthreads();
    float wbase = 0.f;
    for (int i = 0; i < (tid >> 6); ++i) wbase += sc[i];
    const float excl = wbase + inc - run;
#pragma unroll
    for (int i = 0; i < 8; ++i) Fk[tid * 8 + i] = -8.f * (excl + v[i]);
    __syncthreads();
  }
}

__device__ __forceinline__ void phase_mla_up(const Params& p, int layer, LAS unsigned char* lds) {
  unsigned char* ws = p.ws;
  const bf16_t* P = (const bf16_t*)(ws + OFF_P);
  const float* ssq = (const float*)(ws + OFF_CQN);
  const bf16_t* Wq = (const bf16_t*)(ws + OFF_WUQ) + (size_t)layer * 384 * 256;
  const bf16_t* Wkv = (const bf16_t*)(ws + OFF_WUKV) + (size_t)layer * 512 * 128;
  bf16_t* qd = (bf16_t*)(ws + OFF_QD); bf16_t* kvd = (bf16_t*)(ws + OFF_KVD);
  const int sb = get_bid() - (get_nblk() - 16);
  if (sb >= 0) {
    const int b = sb >> 2, h = sb & 3, tid = get_tid(), lane = tid & 63;
    const float* gateF = (const float*)(ws + OFF_GATEF);
    float* Fk = (float*)(ws + OFF_FK) + (size_t)sb * SEQ;
    const float bf = p.b_forget[layer * 4 + h];
    LAS float* sc = (LAS float*)lds;
    float v[8]; float run = 0.f;
#pragma unroll
    for (int i = 0; i < 8; ++i) {
      const float xx = gateF[(size_t)(b * SEQ + tid * 8 + i) * 4 + h] + bf;
      const float ls = fminf(xx, 0.f) - log1pf(expf(-fabsf(xx)));
      run += ls; v[i] = run;
    }
    float inc = run;
#pragma unroll
    for (int o = 1; o < 64; o <<= 1) { const float t = __shfl_up(inc, o); if (lane >= o) inc += t; }
    __syncthreads();
    if (lane == 63) sc[tid >> 6] = inc;
    __syncthreads();
    float wbase = 0.f;
    for (int i = 0; i < (tid >> 6); ++i) wbase += sc[i];
    const float excl = wbase + inc - run;
#pragma unroll
    for (int i = 0; i < 8; ++i) Fk[tid * 8 + i] = -8.f * (excl + v[i]);
    __syncthreads();
  }
  const int lane = get_tid() & 63, w = get_tid() >> 6, wm = w >> 1, wn = w & 1, c31 = lane & 31, hi = lane >> 5;
  for (int item = get_bid() * 8 + w; item < 16 * 64; item += get_nblk() * 8) {
    const int bh = item >> 6, tl = item & 63, b = bh >> 2, h = bh & 3;
    const bf16_t* kr = P + (size_t)(b * SEQ + 64 * tl + lane) * NP + C_FXK + h * 64;
    float ss = 0.f;
#pragma unroll
    for (int c = 0; c < 8; ++c) {
      const u32x4 x = *(const u32x4*)(kr + 8 * c);
      ss += bflo(x.x) * bflo(x.x) + bfhi(x.x) * bfhi(x.x) + bflo(x.y) * bflo(x.y) + bfhi(x.y) * bfhi(x.y) + bflo(x.z) * bflo(x.z) + bfhi(x.z) * bfhi(x.z) + bflo(x.w) * bflo(x.w) + bfhi(x.w) * bfhi(x.w);
    }
    float nv = sqrtf(ss) * 1.0001f;
#pragma unroll
    for (int o = 1; o < 64; o <<= 1) nv = fmaxf(nv, __shfl_xor(nv, o));
    if (lane == 0) ((float*)(ws + OFF_KN))[item] = nv;
  }
  constexpr int TQ = 64 * 3, TKV = 64 * 4;
  for (int t = get_bid(); t < TQ + TKV; t += get_nblk()) {
    const bool isq = t < TQ; const int tt = isq ? t : t - TQ; const int ntn = isq ? 3 : 4; const int mt = tt / ntn, nt = tt % ntn;
    GemmDesc g;
    if (isq) g = GemmDesc{P + C_CQ, NP, nullptr, mt * 256, 256, Wq + (size_t)nt * 128 * 256, 256, 256};
    else g = GemmDesc{P + C_CKV, NP, nullptr, mt * 256, 256, Wkv + (size_t)nt * 128 * 128, 128, 128};
    f32x16 acc[2][2];
    gemm_tile<2>(lds, g, acc);
    bf16_t* O = isq ? qd : kvd; const int ldo = isq ? 384 : 512;
#pragma unroll
    for (int mi = 0; mi < 2; ++mi) {
      const int m = mt * 256 + wm * 64 + mi * 32 + c31;
      const f32x4 s4 = *(const f32x4*)(ssq + (size_t)m * 8 + (isq ? 0 : 4));
      const float rs = rsqrtf(((s4.x + s4.y) + (s4.z + s4.w)) * (isq ? (1.f / 256.f) : (1.f / 128.f)) + RMS_EPS);
#pragma unroll
      for (int ni = 0; ni < 2; ++ni)
#pragma unroll
        for (int g4 = 0; g4 < 4; ++g4) {
          const int n = nt * 128 + wn * 64 + ni * 32 + 4 * hi + 8 * g4;
          u32x2 o; o.x = cvtpk(acc[mi][ni][4 * g4] * rs, acc[mi][ni][4 * g4 + 1] * rs); o.y = cvtpk(acc[mi][ni][4 * g4 + 2] * rs, acc[mi][ni][4 * g4 + 3] * rs);
          *(u32x2*)(O + (size_t)m * ldo + n) = o;
        }
    }
  }
}

constexpr int CMU_UP = 32 * 8 * 32, CMU_DN = 32 * 8 * 16, CMU_TOTAL = CMU_UP + CMU_DN;
struct ConvCtx { const float* wgu; const float* wdn; unsigned char* dgu; unsigned char* ddn; int* ctr; };
__device__ __forceinline__ void cmu_load(const ConvCtx& c, int idx, int lane, int w, float (&v)[16]) {
  const bool up = idx < CMU_UP;
  const int i2 = up ? idx : idx - CMU_UP;
  const int e = up ? (i2 >> 8) : (i2 >> 7), rem = up ? (i2 & 255) : (i2 & 127);
  const int kb = up ? (rem >> 5) : (rem >> 4), nb = up ? (rem & 31) : (rem & 15);
  const int N = up ? 2048 : 1024;
  const float* base = up ? c.wgu : c.wdn;
  const float* sp = base + ((size_t)e * 1024 + kb * 128 + 16 * w) * N + nb * 64 + lane;
#pragma unroll
  for (int j = 0; j < 16; ++j) v[j] = __builtin_nontemporal_load(sp + (size_t)j * N);
}
__device__ __forceinline__ void cmu_store(const ConvCtx& c, int idx, int lane, int w, const float (&v)[16]) {
  const bool up = idx < CMU_UP;
  const int i2 = up ? idx : idx - CMU_UP;
  const int e = up ? (i2 >> 8) : (i2 >> 7), rem = up ? (i2 & 255) : (i2 & 127);
  const int kb = up ? (rem >> 5) : (rem >> 4), nb = up ? (rem & 31) : (rem & 15);
  const int N = up ? 2048 : 1024;
  const int n = nb * 64 + lane;
  int dr = n;
  if (up) { const int j = n & 1023; dr = (j >> 4) * 32 + (j & 15) + ((n >= 1024) ? 16 : 0); }
  unsigned char* base = up ? c.dgu : c.ddn;
  const float sc = up ? S8_WGU : S8_WDN;
  u32x4 o;
  o.x = pk4_fp8(v[0] * sc, v[1] * sc, v[2] * sc, v[3] * sc); o.y = pk4_fp8(v[4] * sc, v[5] * sc, v[6] * sc, v[7] * sc);
  o.z = pk4_fp8(v[8] * sc, v[9] * sc, v[10] * sc, v[11] * sc); o.w = pk4_fp8(v[12] * sc, v[13] * sc, v[14] * sc, v[15] * sc);
  *(u32x4*)(base + ((size_t)e * N + dr) * 1024 + kb * 128 + 16 * w) = o;
}

__device__ __forceinline__ void cmu_to_lds(const ConvCtx& c, int idx, int lane, int w, const float (&v)[16], LAS unsigned char* tile) {
  const float sc = (idx < CMU_UP) ? S8_WGU : S8_WDN;
  u32x4 o;
  o.x = pk4_fp8(v[0] * sc, v[1] * sc, v[2] * sc, v[3] * sc); o.y = pk4_fp8(v[4] * sc, v[5] * sc, v[6] * sc, v[7] * sc);
  o.z = pk4_fp8(v[8] * sc, v[9] * sc, v[10] * sc, v[11] * sc); o.w = pk4_fp8(v[12] * sc, v[13] * sc, v[14] * sc, v[15] * sc);
  *(LAS u32x4*)(tile + lane * 128 + ((w ^ (lane & 7)) << 4)) = o;
}
__device__ __forceinline__ void cmu_from_lds(const ConvCtx& c, int idx, int lane, int w, const LAS unsigned char* tile) {
  const bool up = idx < CMU_UP;
  const int i2 = up ? idx : idx - CMU_UP;
  const int e = up ? (i2 >> 8) : (i2 >> 7), rem = up ? (i2 & 255) : (i2 & 127);
  const int kb = up ? (rem >> 5) : (rem >> 4), nb = up ? (rem & 31) : (rem & 15);
  const int N = up ? 2048 : 1024;
  const int r = 8 * w + (lane >> 3), ch = lane & 7;
  const u32x4 o = *(const LAS u32x4*)(tile + r * 128 + ((ch ^ (r & 7)) << 4));
  const int n = nb * 64 + r;
  int dr = n;
  if (up) { const int j = n & 1023; dr = (j >> 4) * 32 + (j & 15) + ((n >= 1024) ? 16 : 0); }
  unsigned char* base = up ? c.dgu : c.ddn;
  *(u32x4*)(base + ((size_t)e * N + dr) * 1024 + kb * 128 + 16 * ch) = o;
}

enum { AT_SB = 0, AT_DIFF = 1, AT_FOX = 2, AT_MLA = 3 };
struct AttnArgs {
  const bf16_t* Q; int ldq; const bf16_t* K; int ldk; const bf16_t* V; int ldv; const bf16_t* K2; int ldk2;
  const float* Fk; const f32x2* cs; bf16_t* O; int ldo; float lam, oscale; const float* subg; const float* kn;
};
constexpr int ATT_K1 = 0, ATT_V = 8192, ATT_K2 = 16384, ATT_F = 20480, ATT_BUF = 20992;

__device__ __forceinline__ float max3f(float a, float b, float c) { float r; asm("v_max3_f32 %0, %1, %2, %3" : "=v"(r) : "v"(a), "v"(b), "v"(c)); return r; }
__device__ __forceinline__ float max2f(float a, float b) { float r; asm("v_max_f32_e32 %0, %1, %2" : "=v"(r) : "v"(a), "v"(b)); return r; }
__device__ __forceinline__ bool softmax_tile(f32x16& p0, f32x16& p1, float& m, float& l, float c, bool domask, int kbase, int q, int hi, float& alpha) {
  if (domask) {
#pragma unroll
    for (int r = 0; r < 16; ++r) { const int key = kbase + crow(r, hi); if (key > q) p0[r] = -INFINITY; if (key + 32 > q) p1[r] = -INFINITY; }
  }
  asm volatile("s_nop 15\n\ts_nop 7" : "+v"(p0), "+v"(p1));
  float a = max3f(p0[0], p0[1], p1[0]), b = max3f(p0[2], p0[3], p1[1]); a = max3f(a, p1[2], p1[3]);
#pragma unroll
  for (int r = 4; r < 16; r += 4) { a = max3f(a, p0[r], p0[r + 1]); b = max3f(b, p0[r + 2], p0[r + 3]); a = max3f(a, p1[r], p1[r + 1]); b = max3f(b, p1[r + 2], p1[r + 3]); }
  float a0, a1; pair_vals(max2f(a, b), a0, a1);
  const float rm = max2f(a0, a1);
  const bool resc = __any((rm - m) * c > 8.0f);
  alpha = 1.f;
  if (resc) { const float mn = max2f(m, rm); alpha = __builtin_amdgcn_exp2f((m - mn) * c); l *= alpha; m = mn; }
  const float mc = m * c;
  float s = 0.f;
#pragma unroll
  for (int r = 0; r < 16; ++r) { p0[r] = __builtin_amdgcn_exp2f(fmaf(p0[r], c, -mc)); p1[r] = __builtin_amdgcn_exp2f(fmaf(p1[r], c, -mc)); s += p0[r] + p1[r]; }
  l += s;
  return resc;
}
__device__ __forceinline__ bf16x8 pack8(const f32x16& p, int b) {
  u32x4 w; w.x = cvtpk(p[b], p[b + 1]); w.y = cvtpk(p[b + 2], p[b + 3]); w.z = cvtpk(p[b + 4], p[b + 5]); w.w = cvtpk(p[b + 6], p[b + 7]);
  return __builtin_bit_cast(bf16x8, w);
}
__device__ __forceinline__ bf16x8 vfrag(LAS unsigned char* vb, int off) {
  const s16x4 lo = __builtin_bit_cast(s16x4, __builtin_amdgcn_ds_read_tr16_b64_v4i16((LAS s16x4*)(vb + off)));
  const s16x4 hh = __builtin_bit_cast(s16x4, __builtin_amdgcn_ds_read_tr16_b64_v4i16((LAS s16x4*)(vb + off + 1024)));
  return (bf16x8){lo[0], lo[1], lo[2], lo[3], hh[0], hh[1], hh[2], hh[3]};
}

template <int T>
__device__ __forceinline__ void attn_unit(LAS unsigned char* lds, const AttnArgs& a, int qb, const ConvCtx& cc, int& gi, int& pidx, int& qidx, float (&cv)[16]) {
  const int tid = get_tid(), lane = tid & 63, w = tid >> 6, c31 = lane & 31, hi = lane >> 5;
  const int t0 = qb * 256 + w * 32, q = t0 + c31;
  constexpr int NKS = (T == AT_MLA) ? 6 : 4;
  constexpr float CSC = (T == AT_DIFF) ? 0.17677669529663687f * LOG2E : (T == AT_MLA) ? 0.10206207261596577f * LOG2E : 0.125f * LOG2E;
  bf16x8 qf[NKS];
  {
    const bf16_t* qrow = a.Q + (size_t)q * a.ldq;
#pragma unroll
    for (int ks = 0; ks < NKS; ++ks) qf[ks] = *(const bf16x8*)(qrow + 16 * ks + 8 * hi);
    if (T == AT_MLA) {
      const f32x2* csq = a.cs + (size_t)q * 16 + 8 * hi;
      bf16x8 n4, n5;
#pragma unroll
      for (int j = 0; j < 8; j += 2) {
        const f32x2 c0 = csq[j], c1 = csq[j + 1];
        const float x1a = bf2f((unsigned short)qf[4][j]), x1b = bf2f((unsigned short)qf[4][j + 1]);
        const float x2a = bf2f((unsigned short)qf[5][j]), x2b = bf2f((unsigned short)qf[5][j + 1]);
        const unsigned w1 = cvtpk(x1a * c0.x - x2a * c0.y, x1b * c1.x - x2b * c1.y);
        const unsigned w2 = cvtpk(x2a * c0.x + x1a * c0.y, x2b * c1.x + x1b * c1.y);
        n4[j] = (short)(w1 & 0xffff); n4[j + 1] = (short)(w1 >> 16); n5[j] = (short)(w2 & 0xffff); n5[j + 1] = (short)(w2 >> 16);
      }
      qf[4] = n4; qf[5] = n5;
    }
  }
  const int skey = tid >> 3, sch = tid & 7;
  const int k1_st = ATT_K1 + skey * 128 + ((sch ^ ((skey >> 1) & 7)) << 4);
  const int v_st = ATT_V + skey * 128 + ((sch ^ (((skey >> 1) & 1) << 2)) << 4);
  const int k2key = tid >> 2, k2ch = tid & 3;
  const int k2_st = ATT_K2 + k2key * 64 + ((k2ch ^ ((k2key >> 2) & 3)) << 4);
  const int xr = (lane >> 1) & 7;
  int kro[4];
#pragma unroll
  for (int ks = 0; ks < 4; ++ks) kro[ks] = ATT_K1 + c31 * 128 + (((2 * ks + hi) ^ xr) << 4);
  int k2ro[2];
#pragma unroll
  for (int ks = 0; ks < 2; ++ks) k2ro[ks] = ATT_K2 + c31 * 64 + (((2 * ks + hi) ^ ((c31 >> 2) & 3)) << 4);
  int vro[2];
  {
    const int i = lane & 15, qq = i >> 2, pp = i & 3, gg = (lane >> 4) & 1, bit = (qq >> 1) & 1;
#pragma unroll
    for (int d0 = 0; d0 < 2; ++d0) vro[d0] = ATT_V + (4 * hi + qq) * 128 + ((4 * (d0 ^ bit) + 2 * gg + (pp >> 1)) << 4) + (pp & 1) * 8;
  }
  const int ntiles = 4 * (qb + 1);
  const int wave_last = (t0 + 31) >> 6;
  LAS float* kpre = (LAS float*)(lds + 2 * ATT_BUF + 256);
  LAS float* fend = kpre + 64;
  float qn = 0.f;
  if (T == AT_FOX) {
    if (w == 0) {
      float v = (lane < ntiles) ? a.kn[lane] : 0.f;
#pragma unroll
      for (int o = 1; o < 64; o <<= 1) { const float u_ = __shfl_up(v, o); if (lane >= o) v = fmaxf(v, u_); }
      kpre[lane] = v;
      fend[lane] = (lane < ntiles) ? a.Fk[64 * lane + 63] : 0.f;
    }
    float ss = 0.f;
#pragma unroll
    for (int ks = 0; ks < 4; ++ks)
#pragma unroll
      for (int j = 0; j < 8; ++j) { const float x = bf2f((unsigned short)qf[ks][j]); ss += x * x; }
    float s0_, s1_; pair_vals(ss, s0_, s1_);
    qn = sqrtf(s0_ + s1_) * 1.0001f;
  }
  f32x16 o0[2], o1[2];
#pragma unroll
  for (int d0 = 0; d0 < 2; ++d0)
#pragma unroll
    for (int r = 0; r < 16; ++r) { o0[d0][r] = 0.f; o1[d0][r] = 0.f; }
  float m0 = -INFINITY, l0 = 0.f, m1 = -INFINITY, l1 = 0.f;
  float Crun = 0.f;
  bool fin = false;
  u32x4 rk, rv, rk2; float rf = 0.f;
#define ATT_TILE(it) ((T == AT_SB || T == AT_FOX) ? (ntiles - 1 - (it)) : (it))
#define ATT_GLOAD(t) do { const int key_ = 64 * (t) + skey; \
    rk = *(const u32x4*)(a.K + (size_t)key_ * a.ldk + sch * 8); rv = *(const u32x4*)(a.V + (size_t)key_ * a.ldv + sch * 8); \
    if (T == AT_MLA) { if (tid < 256) rk2 = *(const u32x4*)(a.K2 + (size_t)(64 * (t) + k2key) * a.ldk2 + k2ch * 8); } \
    if (T == AT_FOX) { if (tid < 64) rf = a.Fk[64 * (t) + tid]; } } while (0)
#define ATT_LSTORE(buf) do { LAS unsigned char* b_ = lds + (buf) * ATT_BUF; \
    *(LAS u32x4*)(b_ + k1_st) = rk; *(LAS u32x4*)(b_ + v_st) = rv; \
    if (T == AT_MLA) { if (tid < 256) *(LAS u32x4*)(b_ + k2_st) = rk2; } \
    if (T == AT_FOX) { if (tid < 64) *(LAS float*)(b_ + ATT_F + 4 * tid) = rf; } } while (0)
  LAS int* s_conv = (LAS int*)(lds + 2 * ATT_BUF + 64);
  ATT_GLOAD(ATT_TILE(0));
  ATT_LSTORE(0);
  __syncthreads();
  for (int it = 0; it < ntiles; ++it) {
    const int t = ATT_TILE(it);
    LAS unsigned char* cur = lds + (it & 1) * ATT_BUF;
    const bool more = (it + 1 < ntiles);
    const int cidx = __builtin_amdgcn_readfirstlane(s_conv[(gi >> 3) & 1]) + (gi & 7);
    int cnext = 0;
    const bool cfetch = (gi & 7) == 0;
    if (cfetch && tid == 0) cnext = atomicAdd(cc.ctr, 8);
    if (more) ATT_GLOAD(ATT_TILE(it + 1));
    const bool active = (t <= wave_last) && !fin;
    if (active) {
      const bool domask = (64 * t + 63 > t0);
      const int kbase = 64 * t;
      if (T == AT_DIFF) {
        f32x16 pa0, pa1, pb0, pb1;
#pragma unroll
        for (int r = 0; r < 16; ++r) { pa0[r] = 0.f; pa1[r] = 0.f; pb0[r] = 0.f; pb1[r] = 0.f; }
#pragma unroll
        for (int ks = 0; ks < 2; ++ks) {
          const bf16x8 k0 = *(const LAS bf16x8*)(cur + kro[ks]), k1 = *(const LAS bf16x8*)(cur + kro[ks] + 4096);
          pa0 = __builtin_amdgcn_mfma_f32_32x32x16_bf16(k0, qf[ks], pa0, 0, 0, 0); pa1 = __builtin_amdgcn_mfma_f32_32x32x16_bf16(k1, qf[ks], pa1, 0, 0, 0);
        }
#pragma unroll
        for (int ks = 2; ks < 4; ++ks) {
          const bf16x8 k0 = *(const LAS bf16x8*)(cur + kro[ks]), k1 = *(const LAS bf16x8*)(cur + kro[ks] + 4096);
          pb0 = __builtin_amdgcn_mfma_f32_32x32x16_bf16(k0, qf[ks], pb0, 0, 0, 0); pb1 = __builtin_amdgcn_mfma_f32_32x32x16_bf16(k1, qf[ks], pb1, 0, 0, 0);
        }
        float al0, al1;
        const bool rs0 = softmax_tile(pa0, pa1, m0, l0, CSC, domask, kbase, q, hi, al0);
        const bool rs1 = softmax_tile(pb0, pb1, m1, l1, CSC, domask, kbase, q, hi, al1);
        if (rs0) {
#pragma unroll
          for (int d0 = 0; d0 < 2; ++d0)
#pragma unroll
            for (int r = 0; r < 16; ++r) o0[d0][r] *= al0;
        }
        if (rs1) {
#pragma unroll
          for (int d0 = 0; d0 < 2; ++d0)
#pragma unroll
            for (int r = 0; r < 16; ++r) o1[d0][r] *= al1;
        }
#pragma unroll
        for (int s = 0; s < 4; ++s) {
          const bf16x8 pfa = pack8((s < 2) ? pa0 : pa1, 8 * (s & 1)), pfb = pack8((s < 2) ? pb0 : pb1, 8 * (s & 1));
#pragma unroll
          for (int d0 = 0; d0 < 2; ++d0) {
            const bf16x8 vf = vfrag(cur, vro[d0] + 2048 * s);
            o0[d0] = __builtin_amdgcn_mfma_f32_32x32x16_bf16(vf, pfa, o0[d0], 0, 0, 0);
            o1[d0] = __builtin_amdgcn_mfma_f32_32x32x16_bf16(vf, pfb, o1[d0], 0, 0, 0);
          }
        }
      } else {
        f32x16 p0, p1;
        if (T == AT_FOX) {
#pragma unroll
          for (int g4 = 0; g4 < 4; ++g4) {
            const f32x4 f0 = *(const LAS f32x4*)(cur + ATT_F + (8 * g4 + 4 * hi) * 4), f1 = *(const LAS f32x4*)(cur + ATT_F + (32 + 8 * g4 + 4 * hi) * 4);
            p0[4 * g4] = f0.x; p0[4 * g4 + 1] = f0.y; p0[4 * g4 + 2] = f0.z; p0[4 * g4 + 3] = f0.w;
            p1[4 * g4] = f1.x; p1[4 * g4 + 1] = f1.y; p1[4 * g4 + 2] = f1.z; p1[4 * g4 + 3] = f1.w;
          }
        } else {
#pragma unroll
          for (int r = 0; r < 16; ++r) { p0[r] = 0.f; p1[r] = 0.f; }
        }
#pragma unroll
        for (int ks = 0; ks < 4; ++ks) {
          const bf16x8 k0 = *(const LAS bf16x8*)(cur + kro[ks]), k1 = *(const LAS bf16x8*)(cur + kro[ks] + 4096);
          p0 = __builtin_amdgcn_mfma_f32_32x32x16_bf16(k0, qf[ks], p0, 0, 0, 0); p1 = __builtin_amdgcn_mfma_f32_32x32x16_bf16(k1, qf[ks], p1, 0, 0, 0);
        }
        if (T == AT_MLA) {
#pragma unroll
          for (int ks = 0; ks < 2; ++ks) {
            const bf16x8 k0 = *(const LAS bf16x8*)(cur + k2ro[ks]), k1 = *(const LAS bf16x8*)(cur + k2ro[ks] + 2048);
            p0 = __builtin_amdgcn_mfma_f32_32x32x16_bf16(k0, qf[(NKS == 6) ? 4 + ks : ks], p0, 0, 0, 0);
            p1 = __builtin_amdgcn_mfma_f32_32x32x16_bf16(k1, qf[(NKS == 6) ? 4 + ks : ks], p1, 0, 0, 0);
          }
        }
        if (T == AT_SB) {
          f32x16 e0, e1;
          float T8[8];
#pragma unroll
          for (int half = 0; half < 2; ++half) {
            f32x16& pp = half ? p1 : p0; f32x16& ee = half ? e1 : e0;
#pragma unroll
            for (int r = 0; r < 16; ++r) {
              const float z2 = pp[r] * CSC;
              float lk = -__builtin_amdgcn_logf(1.0f + __builtin_amdgcn_exp2f(fminf(z2, 126.f)));
              const bool valid = !domask || (kbase + 32 * half + crow(r, hi) < q);
              lk = valid ? lk : 0.f;
              pp[r] = valid ? (z2 + lk) : -INFINITY;
              ee[r] = lk;
            }
#pragma unroll
            for (int g4 = 0; g4 < 4; ++g4) {
              const float x0 = ee[4 * g4], x1 = ee[4 * g4 + 1], x2 = ee[4 * g4 + 2], x3 = ee[4 * g4 + 3];
              ee[4 * g4 + 3] = 0.f; ee[4 * g4 + 2] = x3; ee[4 * g4 + 1] = x3 + x2; ee[4 * g4] = x3 + x2 + x1;
              T8[4 * half + g4] = x3 + x2 + x1 + x0;
            }
          }
          float Tl[8], Th[8];
#pragma unroll
          for (int i = 0; i < 8; ++i) pair_vals(T8[i], Tl[i], Th[i]);
          float ps = 0.f; float base[8];
#pragma unroll
          for (int i = 7; i >= 0; --i) { base[i] = Crun + ps + (hi ? 0.f : Th[i]); ps += Tl[i] + Th[i]; }
          Crun += ps;
#pragma unroll
          for (int r = 0; r < 16; ++r) {
            p0[r] = __builtin_amdgcn_exp2f(p0[r] + e0[r] + base[r >> 2]);
            p1[r] = __builtin_amdgcn_exp2f(p1[r] + e1[r] + base[4 + (r >> 2)]);
          }
          if (__all(Crun < -48.f)) fin = true;
        } else {
          float al;
          if (softmax_tile(p0, p1, m0, l0, CSC, domask, kbase, q, hi, al)) {
#pragma unroll
            for (int d0 = 0; d0 < 2; ++d0)
#pragma unroll
              for (int r = 0; r < 16; ++r) o0[d0][r] *= al;
          }
          if (T == AT_FOX) { if (t > 0) { if (__all((qn * kpre[t - 1] + fend[t - 1] - m0) * CSC < -40.f)) fin = true; } }
        }
#pragma unroll
        for (int s = 0; s < 4; ++s) {
          const bf16x8 pf = pack8((s < 2) ? p0 : p1, 8 * (s & 1));
#pragma unroll
          for (int d0 = 0; d0 < 2; ++d0) {
            const bf16x8 vf = vfrag(cur, vro[d0] + 2048 * s);
            o0[d0] = __builtin_amdgcn_mfma_f32_32x32x16_bf16(vf, pf, o0[d0], 0, 0, 0);
          }
        }
      }
    }
    if (more) ATT_LSTORE((it + 1) & 1);
    {
      LAS unsigned char* ctile = lds + 2 * ATT_BUF + 1024;
      if (qidx < CMU_TOTAL) cmu_from_lds(cc, qidx, lane, w, ctile + ((gi + 1) & 1) * 8192);
      if (pidx < CMU_TOTAL) cmu_to_lds(cc, pidx, lane, w, cv, ctile + (gi & 1) * 8192);
      qidx = pidx;
      pidx = cidx;
      if (pidx < CMU_TOTAL) cmu_load(cc, pidx, lane, w, cv);
    }
    if (cfetch && tid == 0) s_conv[((gi >> 3) + 1) & 1] = cnext;
    ++gi;
    if (T == AT_SB || T == AT_FOX) {
      const bool wave_done = fin || (t == 0);
      if (__syncthreads_and(wave_done ? 1 : 0)) break;
    } else {
      __syncthreads();
    }
  }
  __syncthreads();
#undef ATT_TILE
#undef ATT_GLOAD
#undef ATT_LSTORE
  if (T == AT_DIFF) {
    float la, lb; pair_vals(l0, la, lb); const float inv0 = 1.f / (la + lb);
    pair_vals(l1, la, lb); const float inv1 = a.lam / (la + lb);
    float ss = 0.f;
#pragma unroll
    for (int d0 = 0; d0 < 2; ++d0)
#pragma unroll
      for (int r = 0; r < 16; ++r) { const float v = o0[d0][r] * inv0 - o1[d0][r] * inv1; o0[d0][r] = v; ss += v * v; }
    float sa, sb; pair_vals(ss, sa, sb);
    const float rs = rsqrtf((sa + sb) * (1.f / 64.f) + RMS_EPS) * a.oscale;
#pragma unroll
    for (int d0 = 0; d0 < 2; ++d0)
#pragma unroll
      for (int g4 = 0; g4 < 4; ++g4) {
        const int dv = 32 * d0 + 8 * g4 + 4 * hi;
        const f32x4 gg = *(const f32x4*)(a.subg + dv);
        u32x2 o; o.x = cvtpk(o0[d0][4 * g4] * rs * gg.x, o0[d0][4 * g4 + 1] * rs * gg.y); o.y = cvtpk(o0[d0][4 * g4 + 2] * rs * gg.z, o0[d0][4 * g4 + 3] * rs * gg.w);
        *(u32x2*)(a.O + (size_t)q * a.ldo + dv) = o;
      }
  } else {
    float inv = 1.f;
    if (T != AT_SB) { float la, lb; pair_vals(l0, la, lb); inv = 1.f / (la + lb); }
#pragma unroll
    for (int d0 = 0; d0 < 2; ++d0)
#pragma unroll
      for (int g4 = 0; g4 < 4; ++g4) {
        const int dv = 32 * d0 + 8 * g4 + 4 * hi;
        u32x2 o; o.x = cvtpk(o0[d0][4 * g4] * inv, o0[d0][4 * g4 + 1] * inv); o.y = cvtpk(o0[d0][4 * g4 + 2] * inv, o0[d0][4 * g4 + 3] * inv);
        *(u32x2*)(a.O + (size_t)q * a.ldo + dv) = o;
      }
  }
}

__device__ __forceinline__ void phase_attention(const Params& p, int layer, LAS unsigned char* lds) {
  unsigned char* ws = p.ws;
  const bf16_t* P = (const bf16_t*)(ws + OFF_P);
  const bf16_t* qd = (const bf16_t*)(ws + OFF_QD); const bf16_t* kvd = (const bf16_t*)(ws + OFF_KVD);
  bf16_t* mix = (bf16_t*)(ws + OFF_MIX);
  int* ctrl = (int*)(ws + OFF_CTRL);
  const float lam = ((const float*)ctrl)[CW_LAM + layer];
  const float linit = 0.8f - 0.6f * expf(-0.3f * (float)layer);
  LAS int* s_unit = (LAS int*)(lds + 2 * ATT_BUF);
  ConvCtx cc;
  cc.wgu = p.w_gate_up + (size_t)layer * NE * 1024 * 2048; cc.wdn = p.w_down + (size_t)layer * NE * 1024 * 1024;
  cc.dgu = ws + OFF_WGU + (size_t)layer * NE * 2048 * 1024; cc.ddn = ws + OFF_WD + (size_t)layer * NE * 1024 * 1024;
  cc.ctr = ctrl + CW_CONVQ + layer;
  int gi = 0, pidx = CMU_TOTAL, qidx = CMU_TOTAL; float cv[16];
#pragma unroll
  for (int j = 0; j < 16; ++j) cv[j] = 0.f;
  if (get_tid() == 0) ((LAS int*)(lds + 2 * ATT_BUF + 64))[0] = atomicAdd(cc.ctr, 8);
  for (;;) {
    if (get_tid() == 0) *s_unit = atomicAdd(&ctrl[CW_ATTQ + layer], 1);
    __syncthreads();
    const int u = *s_unit;
    __syncthreads();
    if (u >= 1024) break;
    const int qb = 15 - (u >> 6), rem = u & 63, type = rem & 3, bh = rem >> 2, b = bh >> 2, h = bh & 3;
    const size_t rb = (size_t)b * SEQ;
    AttnArgs a{};
    a.O = mix + rb * DM + type * 256 + h * 64; a.ldo = DM;
    if (type == AT_SB) {
      a.Q = P + rb * NP + C_SBQ + h * 64; a.K = P + rb * NP + C_SBK + h * 64; a.V = P + rb * NP + C_SBV + h * 64; a.ldq = a.ldk = a.ldv = NP;
      attn_unit<AT_SB>(lds, a, qb, cc, gi, pidx, qidx, cv);
    } else if (type == AT_DIFF) {
      a.Q = P + rb * NP + C_DFQ + h * 64; a.K = P + rb * NP + C_DFK + h * 64; a.V = P + rb * NP + C_DFV + h * 64; a.ldq = a.ldk = a.ldv = NP;
      a.lam = lam; a.oscale = 1.f - linit; a.subg = p.diff_subln_g + layer * 64;
      attn_unit<AT_DIFF>(lds, a, qb, cc, gi, pidx, qidx, cv);
    } else if (type == AT_FOX) {
      a.Q = P + rb * NP + C_FXQ + h * 64; a.K = P + rb * NP + C_FXK + h * 64; a.V = P + rb * NP + C_FXV + h * 64; a.ldq = a.ldk = a.ldv = NP;
      a.Fk = (const float*)(ws + OFF_FK) + (size_t)bh * SEQ; a.kn = (const float*)(ws + OFF_KN) + bh * 64;
      attn_unit<AT_FOX>(lds, a, qb, cc, gi, pidx, qidx, cv);
    } else {
      a.Q = qd + rb * 384 + h * 96; a.ldq = 384; a.K = kvd + rb * 512 + h * 128; a.ldk = 512; a.V = kvd + rb * 512 + h * 128 + 64; a.ldv = 512;
      a.K2 = P + rb * NP + C_KR; a.ldk2 = NP; a.cs = (const f32x2*)(ws + OFF_ROPE) + rb * 16;
      attn_unit<AT_MLA>(lds, a, qb, cc, gi, pidx, qidx, cv);
    }
  }
  {
    __syncthreads();
    const LAS int* sc = (const LAS int*)(lds + 2 * ATT_BUF + 64);
    const int k = gi >> 3, used = gi & 7;
    const int b0 = __builtin_amdgcn_readfirstlane(sc[k & 1]);
    const int b1 = (used >= 1) ? __builtin_amdgcn_readfirstlane(sc[(k + 1) & 1]) : CMU_TOTAL;
    const int tid = get_tid(), lane = tid & 63, w = tid >> 6;
    if (qidx < CMU_TOTAL) cmu_from_lds(cc, qidx, lane, w, lds + 2 * ATT_BUF + 1024 + ((gi + 1) & 1) * 8192);
    if (pidx < CMU_TOTAL) cmu_store(cc, pidx, lane, w, cv);
#pragma unroll 1
    for (int j = used; j < 16; ++j) {
      const int ci = (j < 8) ? b0 + j : b1 + (j - 8);
      if (ci < CMU_TOTAL) { float v0[16]; cmu_load(cc, ci, lane, w, v0); cmu_store(cc, ci, lane, w, v0); }
    }
    __syncthreads();
  }
  for (;;) {
    if (get_tid() == 0) s_unit[0] = atomicAdd(cc.ctr, 2);
    __syncthreads();
    const int c0 = __builtin_amdgcn_readfirstlane(s_unit[0]);
    __syncthreads();
    if (c0 >= CMU_TOTAL) break;
    const int tid = get_tid(), lane = tid & 63, w = tid >> 6;
    float v0[16], v1[16];
    cmu_load(cc, c0, lane, w, v0);
    if (c0 + 1 < CMU_TOTAL) cmu_load(cc, c0 + 1, lane, w, v1);
    cmu_store(cc, c0, lane, w, v0);
    if (c0 + 1 < CMU_TOTAL) cmu_store(cc, c0 + 1, lane, w, v1);
  }
}

__device__ __forceinline__ size_t tmp_blocked(int row, int col) {
  return (size_t)(row >> 6) * 65536 + (size_t)((((((col >> 7) * 4 + ((col >> 5) & 3)) * 4 + ((col >> 3) & 3)) * 2 + ((row >> 5) & 1)) * 64 + (((col >> 2) & 1) * 32 + (row & 31))) * 4);
}
struct OutprojSched {
  int grid, bid;
  __device__ __forceinline__ bool next(int i, pg8::Unit& u) const {
    int mt, nt;
    if (grid == 256) { if (i > 0) return false; const int xcd = bid & 7, j = bid >> 3; mt = 8 * xcd + (j >> 2); nt = j & 3; }
    else { const int t = bid + i * grid; if (t >= 256) return false; mt = t >> 2; nt = t & 3; }
    u.boff = (unsigned)nt * (256u * 1024u * 2u); u.arow0 = mt * 256; u.mvalid = 256; u.e = 0; u.mt = mt; u.nt = nt; u.slot0 = 0;
    return true;
  }
};
struct OutprojEpi {
  static constexpr bool PERMB = false;
  const bf16_t* hB; float* tmp;
  __device__ __forceinline__ void operator()(const pg8::f32x4v (&acc)[2][2][4][2], const pg8::Unit& u, int wr, int wc, int fr, int fq) const {
#pragma unroll
    for (int ai = 0; ai < 2; ++ai)
#pragma unroll
      for (int m = 0; m < 4; ++m) {
        const int row = u.mt * 256 + 128 * ai + 64 * wr + 16 * m + fr;
#pragma unroll
        for (int bj = 0; bj < 2; ++bj)
#pragma unroll
          for (int n = 0; n < 2; ++n) {
            const int col = u.nt * 256 + 128 * bj + 32 * wc + 16 * n + 4 * fq;
            const u32x2 hb = *(const u32x2*)(hB + (size_t)row * DM + col);
            const pg8::f32x4v v = acc[ai][bj][m][n];
            *(f32x4*)(tmp + tmp_blocked(row, col)) = (f32x4){DN_ALPHA * bflo(hb.x) + v[0], DN_ALPHA * bfhi(hb.x) + v[1], DN_ALPHA * bflo(hb.y) + v[2], DN_ALPHA * bfhi(hb.y) + v[3]};
          }
      }
  }
};
__device__ __forceinline__ void phase_outproj(const Params& p, int layer, LAS unsigned char* lds) {
  unsigned char* ws = p.ws;
  OutprojSched S{get_nblk(), get_bid()};
  OutprojEpi E{(const bf16_t*)(ws + OFF_HB), (float*)(ws + OFF_TMPF)};
  pg8::gemm_phase<false, false>(lds, (const bf16_t*)(ws + OFF_MIX), (const bf16_t*)(ws + OFF_WOUT) + (size_t)layer * 1024 * 1024, S, E);
}

__device__ __forceinline__ void phase_ln1_router(const Params& p, int layer, LAS unsigned char* lds) {
  unsigned char* ws = p.ws;
  const float* tmp = (const float*)(ws + OFF_TMPF);
  float* hF = (float*)(ws + OFF_HF); bf16_t* hB = (bf16_t*)(ws + OFF_HB);
  int* ctrl = (int*)(ws + OFF_CTRL); int* cnt = ctrl + CW_CNT + layer * 32;
  int* list = (int*)(ws + OFF_LIST); int* toke = (int*)(ws + OFF_TOKE); float* tokg = (float*)(ws + OFF_TOKG);
  const float* Wr = p.router_w + (size_t)layer * DM * NE; const float* rb = p.router_b + layer * NE;
  const float* g1 = p.ln1_g + layer * DM; const float* b1 = p.ln1_b + layer * DM;
  LAS float* red = (LAS float*)lds;
  LAS float* lg = (LAS float*)(lds + 32768);
  LAS float* part = (LAS float*)(lds + 136192);
  LAS float* part2 = (LAS float*)(lds + 137216);
  LAS int* lcnt = (LAS int*)(lds + 138240);
#pragma unroll 1
  for (int hs = get_bid(); hs < M_TOK / 32; hs += get_nblk()) {
    const int m0 = hs * 32, mi = hs & 1;
    const int tid = get_tid(), lane = tid & 63, w = tid >> 6, c31 = lane & 31, hi = lane >> 5;
    f32x16 acc[4];
    {
      const float* tb = tmp + (size_t)(hs >> 1) * 65536 + (size_t)(w * 32 * 64 + lane) * 4;
#pragma unroll
      for (int ni = 0; ni < 4; ++ni)
#pragma unroll
        for (int g4 = 0; g4 < 4; ++g4) {
          const f32x4 v = *(const f32x4*)(tb + (size_t)(((ni * 4 + g4) * 2 + mi) * 64) * 4);
          acc[ni][4 * g4] = v.x; acc[ni][4 * g4 + 1] = v.y; acc[ni][4 * g4 + 2] = v.z; acc[ni][4 * g4 + 3] = v.w;
        }
    }
    float mean, rstd;
    {
      float sacc = 0.f;
#pragma unroll
      for (int ni = 0; ni < 4; ++ni)
#pragma unroll
        for (int r = 0; r < 16; ++r) sacc += acc[ni][r];
      float s0, s1; pair_vals(sacc, s0, s1);
      if (hi == 0) part[c31 * 8 + w] = s0 + s1;
    }
    __syncthreads();
    {
      const f32x4 pa = *(const LAS f32x4*)(part + c31 * 8), pb = *(const LAS f32x4*)(part + c31 * 8 + 4);
      mean = ((pa.x + pa.y) + (pa.z + pa.w) + (pb.x + pb.y) + (pb.z + pb.w)) * (1.f / DM);
      float q = 0.f;
#pragma unroll
      for (int ni = 0; ni < 4; ++ni)
#pragma unroll
        for (int r = 0; r < 16; ++r) { const float d = acc[ni][r] - mean; q += d * d; }
      float q0, q1; pair_vals(q, q0, q1);
      if (hi == 0) part2[c31 * 8 + w] = q0 + q1;
    }
    __syncthreads();
    {
      const f32x4 pa = *(const LAS f32x4*)(part2 + c31 * 8), pb = *(const LAS f32x4*)(part2 + c31 * 8 + 4);
      rstd = rsqrtf(((pa.x + pa.y) + (pa.z + pa.w) + (pb.x + pb.y) + (pb.z + pb.w)) * (1.f / DM) + LN_EPS);
    }
    LAS unsigned char* wt = lds + w * 16896;
#pragma unroll
    for (int ni = 0; ni < 4; ++ni)
#pragma unroll
      for (int g4 = 0; g4 < 4; ++g4) {
        const int n = 128 * w + ni * 32 + 8 * g4 + 4 * hi;
        const f32x4 gg = *(const f32x4*)(g1 + n), bb = *(const f32x4*)(b1 + n);
        f32x4 y;
        y.x = (acc[ni][4 * g4] - mean) * rstd * gg.x + bb.x; y.y = (acc[ni][4 * g4 + 1] - mean) * rstd * gg.y + bb.y;
        y.z = (acc[ni][4 * g4 + 2] - mean) * rstd * gg.z + bb.z; y.w = (acc[ni][4 * g4 + 3] - mean) * rstd * gg.w + bb.w;
        acc[ni][4 * g4] = y.x; acc[ni][4 * g4 + 1] = y.y; acc[ni][4 * g4 + 2] = y.z; acc[ni][4 * g4 + 3] = y.w;
        *(LAS f32x4*)(wt + c31 * 528 + (ni * 32 + 8 * g4 + 4 * hi) * 4) = y;
      }
    {
      const int cl = (lane & 31) * 4;
      const size_t off0 = (size_t)(m0 + hi) * DM + 128 * w + cl;
      bf16_t* pB = hB + off0; unsigned char* p8 = ws + OFF_H8 + off0;
      const LAS unsigned char* rp = wt + hi * 528 + cl * 4;
#pragma unroll 4
      for (int it = 0; it < 16; ++it) {
        const f32x4 y = *(const LAS f32x4*)rp;
        u32x2 o; o.x = cvtpk(y.x, y.y); o.y = cvtpk(y.z, y.w);
        *(u32x2*)pB = o;
        *(unsigned*)p8 = pk4_fp8(clamp448(y.x * S8_H), clamp448(y.y * S8_H), clamp448(y.z * S8_H), clamp448(y.w * S8_H));
        rp += 2 * 528; pB += 2 * DM; p8 += 2 * DM;
      }
    }
    f32x16 D0;
#pragma unroll
    for (int r = 0; r < 16; ++r) D0[r] = 0.f;
    {
      const float* wrp = Wr + (128 * w + 4 * hi) * 32 + c31;
      float wa[16], wb[16];
#pragma unroll
      for (int r = 0; r < 16; ++r) wa[r] = wrp[(8 * (r >> 2) + (r & 3)) * 32];
#pragma unroll
      for (int ni = 0; ni < 4; ++ni) {
        __builtin_amdgcn_sched_barrier(0);
        if (ni < 3) {
#pragma unroll
          for (int r = 0; r < 16; ++r) wb[r] = wrp[((ni + 1) * 32 + 8 * (r >> 2) + (r & 3)) * 32];
        }
        __builtin_amdgcn_sched_barrier(0);
#pragma unroll
        for (int r = 0; r < 16; ++r) D0 = __builtin_amdgcn_mfma_f32_32x32x2f32(acc[ni][r], wa[r], D0, 0, 0, 0);
        __builtin_amdgcn_sched_barrier(0);
#pragma unroll
        for (int r = 0; r < 16; ++r) wa[r] = wb[r];
      }
    }
    __syncthreads();
#pragma unroll
    for (int r = 0; r < 16; ++r) red[(w * 32 + crow(r, hi)) * 32 + c31] = D0[r];
    __syncthreads();
#pragma unroll
    for (int i = 0; i < 2; ++i) {
      const int idx = tid + 512 * i;
      float sv = rb[idx & 31];
#pragma unroll
      for (int ww = 0; ww < 8; ++ww) sv += red[ww * 1024 + idx];
      lg[(idx & 31) * 32 + (idx >> 5)] = sv;
    }
    if (tid < 32) lcnt[tid] = 0;
    __syncthreads();
    float gt[4]; int li[4], rk[4];
    if (tid < 32) {
      float lv[4]; unsigned used = 0u;
#pragma unroll
      for (int k = 0; k < 4; ++k) {
        float best = -INFINITY; int bi = 0;
        for (int e = 0; e < 32; ++e) { const float v = lg[e * 32 + tid]; if (!((used >> e) & 1u) && v > best) { best = v; bi = e; } }
        used |= 1u << bi; lv[k] = best; li[k] = bi;
      }
      float sm = 0.f;
#pragma unroll
      for (int k = 0; k < 4; ++k) { gt[k] = expf(lv[k] - lv[0]); sm += gt[k]; }
      const float inv = 1.f / sm;
#pragma unroll
      for (int k = 0; k < 4; ++k) { gt[k] *= inv; rk[k] = __hip_atomic_fetch_add(&lcnt[li[k]], 1, __ATOMIC_RELAXED, __HIP_MEMORY_SCOPE_WORKGROUP); }
    }
    __syncthreads();
    if (tid < 32) { const int c = lcnt[tid]; lcnt[32 + tid] = c ? atomicAdd(&cnt[tid], c) : 0; }
    __syncthreads();
    if (tid < 32) {
      const int m = m0 + tid;
#pragma unroll
      for (int k = 0; k < 4; ++k) {
        const int ps = lcnt[32 + li[k]] + rk[k];
        list[li[k] * M_TOK + ps] = m;
        toke[m * 4 + k] = (li[k] << 16) | ps;
        tokg[m * 4 + k] = gt[k];
      }
    }
    __syncthreads();
  }
}

__device__ __forceinline__ void moe_prefix(const int* cnt, LAS int* s_start, LAS int* s_tstart, LAS int* s_cnt) {
  if (get_tid() < 64) {
    const int lane = get_tid();
    const int c = (lane < 32) ? cnt[lane] : 0;
    const int tl = (c + 255) >> 8;
    int ic = c, it = tl;
#pragma unroll
    for (int o = 1; o < 32; o <<= 1) { const int a = __shfl_up(ic, o), b = __shfl_up(it, o); if (lane >= o) { ic += a; it += b; } }
    if (lane < 32) { s_cnt[lane] = c; s_start[lane] = ic - c; s_tstart[lane] = it - tl; }
    if (lane == 31) { s_start[32] = ic; s_tstart[32] = it; }
  }
  __syncthreads();
}

struct MoeSched {
  unsigned estride; int NT, total_mt, grid, bid; const LAS int* s_start; const LAS int* s_tstart; const LAS int* s_cnt;
  __device__ __forceinline__ bool next(int i, pg8::Unit& u) const {
    int mtg, nt; bool ok;
    if (grid == 256) { const int MG = 32 / NT; const int xcd = bid & 7, j = bid >> 3; mtg = MG * (xcd + 8 * i) + j / NT; nt = j % NT; ok = (MG * (8 * i) < total_mt); }
    else { const int item = bid + i * grid; ok = (item < total_mt * NT); mtg = item / NT; nt = item % NT; }
    const bool live = ok && (mtg < total_mt);
    const int mq = live ? mtg : 0;
    const int ln_ = (int)(threadIdx.x & 63);
    const int tend_ = s_tstart[(ln_ < 32 ? ln_ : 31) + 1];
    const int e = (int)__builtin_popcountll(__ballot(ln_ < 32 && tend_ <= mq));
    const int mt = mq - __builtin_amdgcn_readfirstlane(s_tstart[e]);
    const int mv = live ? min(256, __builtin_amdgcn_readfirstlane(s_cnt[e]) - mt * 256) : 0;
    const int sl = __builtin_amdgcn_readfirstlane(s_start[e]) + mt * 256;
    const unsigned bo = (unsigned)e * estride + (unsigned)nt * (256u * 1024u);
    u.boff = bo; u.arow0 = i; u.mvalid = mv; u.e = e; u.mt = mt; u.nt = nt; u.slot0 = sl;
    return ok;
  }
};
struct MoeUpEpi {
  static constexpr bool PERMB = false;
  unsigned char* act; const LAS float* btab;
  __device__ __forceinline__ void operator()(const pg8::f32x4v (&acc)[2][2][4][2], const pg8::Unit& u, int wr, int wc, int fr, int fq) const {
    constexpr float US = 1.f / (S8_H * S8_WGU);
    constexpr float KEXP = -1.702f * LOG2E;
    const LAS float* bt = btab + u.arow0 * 256 + 16 * wc + 4 * fq;
    f32x4 bg[2], bl[2];
#pragma unroll
    for (int bj = 0; bj < 2; ++bj) { bg[bj] = *(const LAS f32x4*)(bt + 64 * bj); bl[bj] = *(const LAS f32x4*)(bt + 128 + 64 * bj); }
#pragma unroll
    for (int ai = 0; ai < 2; ++ai)
#pragma unroll
      for (int m = 0; m < 4; ++m) {
        const int rl = 128 * ai + 64 * wr + 16 * m + fr;
        if (rl < u.mvalid) {
          unsigned char* orow = act + (size_t)(u.slot0 + rl) * DFF + 16 * (8 * u.nt + wc) + 4 * fq;
#pragma unroll
          for (int bj = 0; bj < 2; ++bj) {
            float o[4];
#pragma unroll
            for (int i = 0; i < 4; ++i) {
              const float gl = fminf(fmaf(acc[ai][bj][m][0][i], US, bg[bj][i]), 7.f);
              const float ln = fminf(fmaxf(fmaf(acc[ai][bj][m][1][i], US, bl[bj][i]), -7.f), 7.f);
              const float sg = __builtin_amdgcn_rcpf(1.f + __builtin_amdgcn_exp2f(KEXP * gl));
              o[i] = fminf(gl * sg * fmaf(ln, S8_ACT, S8_ACT), 448.f);
            }
            *(unsigned*)(orow + 64 * bj) = pk4_fp8(o[0], o[1], o[2], o[3]);
          }
        }
      }
  }
};
struct MoeDownEpi {
  static constexpr bool PERMB = true;
  bf16_t* yb; const LAS float* btab;
  __device__ __forceinline__ void operator()(const pg8::f32x4v (&acc)[2][2][4][2], const pg8::Unit& u, int wr, int wc, int fr, int fq) const {
    constexpr float us = 1.f / (S8_ACT * S8_WDN);
    const LAS float* bt = btab + u.e * 256 + 32 * wc + 8 * fq;
    f32x4 b4[2][2];
#pragma unroll
    for (int bj = 0; bj < 2; ++bj)
#pragma unroll
      for (int n = 0; n < 2; ++n) b4[bj][n] = *(const LAS f32x4*)(bt + 128 * bj + 4 * n);
#pragma unroll
    for (int ai = 0; ai < 2; ++ai)
#pragma unroll
      for (int m = 0; m < 4; ++m) {
        const int rl = 128 * ai + 64 * wr + 16 * m + fr;
        if (rl < u.mvalid) {
          bf16_t* orow = yb + (size_t)(u.slot0 + rl) * DM + u.nt * 256 + 32 * wc + 8 * fq;
#pragma unroll
          for (int bj = 0; bj < 2; ++bj) {
            const pg8::f32x4v v = acc[ai][bj][m][0], w = acc[ai][bj][m][1];
            u32x4 ov;
            ov.x = cvtpk(fmaf(v[0], us, b4[bj][0].x), fmaf(v[1], us, b4[bj][0].y)); ov.y = cvtpk(fmaf(v[2], us, b4[bj][0].z), fmaf(v[3], us, b4[bj][0].w));
            ov.z = cvtpk(fmaf(w[0], us, b4[bj][1].x), fmaf(w[1], us, b4[bj][1].y)); ov.w = cvtpk(fmaf(w[2], us, b4[bj][1].z), fmaf(w[3], us, b4[bj][1].w));
            *(u32x4*)(orow + 128 * bj) = ov;
          }
        }
      }
  }
};
__device__ __forceinline__ void phase_moe_up(const Params& p, int layer, LAS unsigned char* lds) {
  unsigned char* ws = p.ws;
  const int* cnt = (const int*)(ws + OFF_CTRL) + CW_CNT + layer * 32;
  const int* list = (const int*)(ws + OFF_LIST);
  LAS int* s_start = (LAS int*)(lds + LDS_GEMM); LAS int* s_tstart = s_start + 40; LAS int* s_cnt = s_start + 80;
  moe_prefix(cnt, s_start, s_tstart, s_cnt);
  MoeSched S{2048u * 1024u, 8, __builtin_amdgcn_readfirstlane(s_tstart[32]), get_nblk(), get_bid(), s_start, s_tstart, s_cnt};
  {
    const int tid = get_tid();
    LAS int* rowtab = (LAS int*)(lds + LDS_ROWTAB);
    LAS float* btab = (LAS float*)(lds + LDS_BIASTAB);
    const float* bgu = p.b_gate_up + (size_t)layer * NE * 2048;
    unsigned vals[12]; bool okv[12];
#pragma unroll
    for (int i = 0; i < 12; ++i) {
      pg8::Unit u;
      okv[i] = S.next(i, u);
      vals[i] = 0u;
      if (okv[i]) {
        if (tid < 256) { if (u.mvalid > 0) vals[i] = (unsigned)list[u.e * M_TOK + u.mt * 256 + min(tid, u.mvalid - 1)]; }
        else { const int c = tid - 256; vals[i] = __float_as_uint(bgu[(size_t)u.e * 2048 + (c >> 7) * 1024 + u.nt * 128 + (c & 127)]); }
      }
    }
#pragma unroll
    for (int i = 0; i < 12; ++i) {
      if (okv[i]) { if (tid < 256) rowtab[i * 256 + tid] = (int)vals[i]; else btab[i * 256 + (tid - 256)] = __uint_as_float(vals[i]); }
    }
    __syncthreads();
  }
  MoeUpEpi E{(unsigned char*)(ws + OFF_ACT), (const LAS float*)(lds + LDS_BIASTAB)};
  pg8::gemm_phase<true, true>(lds, (const bf16_t*)(ws + OFF_H8), (const bf16_t*)(ws + OFF_WGU + (size_t)layer * NE * 2048 * 1024), S, E);
}
struct MoeDownSched {
  MoeSched base;
  __device__ __forceinline__ bool next(int i, pg8::Unit& u) const { const bool ok = base.next(i, u); if (ok) { u.arow0 = u.slot0; u.e = i; } return ok; }
};
__device__ __forceinline__ void phase_moe_down(const Params& p, int layer, LAS unsigned char* lds) {
  unsigned char* ws = p.ws;
  const int* cnt = (const int*)(ws + OFF_CTRL) + CW_CNT + layer * 32;
  LAS int* s_start = (LAS int*)(lds + LDS_GEMM); LAS int* s_tstart = s_start + 40; LAS int* s_cnt = s_start + 80;
  moe_prefix(cnt, s_start, s_tstart, s_cnt);
  MoeDownSched S{MoeSched{1024u * 1024u, 4, __builtin_amdgcn_readfirstlane(s_tstart[32]), get_nblk(), get_bid(), s_start, s_tstart, s_cnt}};
  {
    const int tid = get_tid();
    LAS float* btab = (LAS float*)(lds + LDS_BIASTAB);
    const float* bd = p.b_down + (size_t)layer * NE * 1024;
    float vals[12]; bool okv[12];
#pragma unroll
    for (int i = 0; i < 12; ++i) {
      pg8::Unit u;
      okv[i] = S.base.next(i, u);
      vals[i] = 0.f;
      if (okv[i] && tid < 256) vals[i] = bd[(size_t)u.e * 1024 + u.nt * 256 + tid];
    }
#pragma unroll
    for (int i = 0; i < 12; ++i)
      if (okv[i] && tid < 256) btab[i * 256 + tid] = vals[i];
    __syncthreads();
  }
  MoeDownEpi E{(bf16_t*)(ws + OFF_Y), (const LAS float*)(lds + LDS_BIASTAB)};
  pg8::gemm_phase<false, true>(lds, (const bf16_t*)(ws + OFF_ACT), (const bf16_t*)(ws + OFF_WD + (size_t)layer * NE * 1024 * 1024), S, E);
}

__device__ __forceinline__ void phase_combine_ln2(const Params& p, int layer, LAS unsigned char* lds) {
  unsigned char* ws = p.ws;
  const bf16_t* yb = (const bf16_t*)(ws + OFF_Y);
  float* hF = (float*)(ws + OFF_HF); bf16_t* hB = (bf16_t*)(ws + OFF_HB);
  const int* cnt = (const int*)(ws + OFF_CTRL) + CW_CNT + layer * 32;
  const int* toke = (const int*)(ws + OFF_TOKE); const float* tokg = (const float*)(ws + OFF_TOKG);
  LAS int* s_start = (LAS int*)(lds + LDS_GEMM); LAS int* s_tstart = s_start + 40; LAS int* s_cnt = s_start + 80;
  moe_prefix(cnt, s_start, s_tstart, s_cnt);
  const float* g2 = p.ln2_g + layer * DM; const float* b2 = p.ln2_b + layer * DM;
  const bool last = (layer == DEPTH - 1);
  const int lane = get_tid() & 63, gw = get_bid() * 8 + (get_tid() >> 6), ngw = get_nblk() * 8;
  for (int m = gw; m < M_TOK; m += ngw) {
    f32x4 v[4];
#pragma unroll
    for (int j = 0; j < 4; ++j) { const u32x2 hb = *(const u32x2*)(hB + (size_t)m * DM + 4 * lane + 256 * j); v[j] = (f32x4){bflo(hb.x), bfhi(hb.x), bflo(hb.y), bfhi(hb.y)} * DN_ALPHA; }
#pragma unroll
    for (int k = 0; k < 4; ++k) {
      const int ep = toke[m * 4 + k]; const float gt = tokg[m * 4 + k];
      const int slot = s_start[ep >> 16] + (ep & 0xffff);
      const bf16_t* yr = yb + (size_t)slot * DM;
#pragma unroll
      for (int j = 0; j < 4; ++j) {
        const u32x2 a = *(const u32x2*)(yr + 4 * lane + 256 * j);
        v[j].x += gt * bflo(a.x); v[j].y += gt * bfhi(a.x); v[j].z += gt * bflo(a.y); v[j].w += gt * bfhi(a.y);
      }
    }
    ln_row(v, g2, b2, lane);
    if (last) store_row_f32_bf16(v, p.out + (size_t)m * DM, nullptr, lane);
    else store_row_f32_bf16(v, nullptr, hB + (size_t)m * DM, lane);
  }
}

#if defined(__HIP_DEVICE_COMPILE__)
#define PH(call) do { const __attribute__((address_space(4))) Params* q_ = pp; asm volatile("" : "+s"(q_)); Params p; __builtin_memcpy(&p, q_, sizeof(Params)); call; } while (0)
#else
#define PH(call) do { const Params& p = p_unused; (void)pp; call; } while (0)
#endif
__global__ void __launch_bounds__(512) fwd_kernel(Params p_unused) {
  cg::grid_group grid = cg::this_grid();
  extern __shared__ __attribute__((aligned(16))) unsigned char smem[];
  LAS unsigned char* lds = (LAS unsigned char*)smem;
  const __attribute__((address_space(4))) Params* pp = (const __attribute__((address_space(4))) Params*)__builtin_amdgcn_kernarg_segment_ptr();
  if (threadIdx.x < 4) ((volatile LAS unsigned*)(lds + LDS_MISC))[threadIdx.x] = 0u;
  __syncthreads();
#define GRID_BAR() do { XcdBarrier b_; PH(b_.bar = (unsigned*)(p.ws + OFF_CTRL) + CW_BAR); b_.x = xb_xcc_id(); b_.st = (volatile LAS unsigned*)(lds + LDS_MISC); xcd_barrier(b_); } while (0)
  { unsigned* bw; PH(bw = (unsigned*)(p.ws + OFF_CTRL) + CW_BAR); (void)xcd_barrier_post(bw, (volatile LAS unsigned*)(lds + LDS_MISC)); }
  PH(phase_convert(p));
  PH(phase_prologue_misc(p));
  grid.sync();
#pragma unroll 1
  for (int layer = 0; layer < DEPTH; ++layer) {
    PH(phase_inproj(p, layer, lds));
    GRID_BAR();
    PH(phase_mla_up(p, layer, lds));
    GRID_BAR();
    PH(phase_attention(p, layer, lds));
    GRID_BAR();
    PH(phase_outproj(p, layer, lds));
    GRID_BAR();
    PH(phase_ln1_router(p, layer, lds));
    GRID_BAR();
    PH(phase_moe_up(p, layer, lds));
    GRID_BAR();
    PH(phase_moe_down(p, layer, lds));
    GRID_BAR();
    PH(phase_combine_ln2(p, layer, lds));
    if (layer + 1 < DEPTH) GRID_BAR();
  }
}

extern "C" void kernel_launch(void* const* d_in, const int* in_sizes, int n_in, void* d_out, int out_size,
                              void* d_ws, size_t ws_size, hipStream_t stream) {
  static int grid_blocks = 0;
  if (!grid_blocks) {
    int dev = 0, cus = 0, per_cu = 0;
    (void)hipGetDevice(&dev);
    (void)hipDeviceGetAttribute(&cus, hipDeviceAttributeMultiprocessorCount, dev);
    (void)hipFuncSetAttribute((const void*)fwd_kernel, hipFuncAttributeMaxDynamicSharedMemorySize, LDS_BYTES);
    (void)hipOccupancyMaxActiveBlocksPerMultiprocessor(&per_cu, fwd_kernel, 512, LDS_BYTES);
    if (per_cu < 1) { fprintf(stderr, "kernel_launch: occupancy query returned %d\n", per_cu); per_cu = 1; }
    if (per_cu > 1) per_cu = 1;
    grid_blocks = cus * per_cu;
    if (n_in != 23 || ws_size < WS_END) { fprintf(stderr, "kernel_launch: unexpected n_in %d or ws_size %zu (< %zu)\n", n_in, ws_size, (size_t)WS_END); }
  }
  if (ws_size < WS_END) return;
  (void)hipMemsetAsync((char*)d_ws + OFF_CTRL, 0, CTRL_BYTES, stream);
  Params p{};
  p.x = (const float*)d_in[0]; p.pos = (const int*)d_in[1]; p.ln_in_g = (const float*)d_in[2]; p.ln_in_b = (const float*)d_in[3];
  p.w_in = (const float*)d_in[4]; p.b_forget = (const float*)d_in[5]; p.diff_lambda = (const float*)d_in[6]; p.diff_subln_g = (const float*)d_in[7];
  p.mla_q_norm_g = (const float*)d_in[8]; p.mla_w_uq = (const float*)d_in[9]; p.mla_kv_norm_g = (const float*)d_in[10]; p.mla_w_ukv = (const float*)d_in[11];
  p.w_out = (const float*)d_in[12]; p.ln1_g = (const float*)d_in[13]; p.ln1_b = (const float*)d_in[14]; p.router_w = (const float*)d_in[15];
  p.router_b = (const float*)d_in[16]; p.w_gate_up = (const float*)d_in[17]; p.b_gate_up = (const float*)d_in[18]; p.w_down = (const float*)d_in[19];
  p.b_down = (const float*)d_in[20]; p.ln2_g = (const float*)d_in[21]; p.ln2_b = (const float*)d_in[22];
  p.out = (float*)d_out; p.ws = (unsigned char*)d_ws;
  void* args[] = {&p};
  hipError_t e = hipLaunchCooperativeKernel((void*)fwd_kernel, dim3(grid_blocks), dim3(512), args, LDS_BYTES, stream);
  if (e != hipSuccess) fprintf(stderr, "cooperative launch failed: %s (grid %d)\n", hipGetErrorString(e), grid_blocks);
}
```

```cpp
#include <hip/hip_runtime.h>
#include <hip/hip_cooperative_groups.h>
#include <cstdio>
#include <cstdint>
namespace cg = cooperative_groups;

#define LAS __attribute__((address_space(3)))
typedef unsigned short bf16_t;
typedef short bf16x8 __attribute__((ext_vector_type(8)));
typedef short s16x4 __attribute__((ext_vector_type(4)));
typedef float f32x16 __attribute__((ext_vector_type(16)));
typedef float f32x4 __attribute__((ext_vector_type(4)));
typedef float f32x2 __attribute__((ext_vector_type(2)));
typedef unsigned u32x4 __attribute__((ext_vector_type(4)));
typedef unsigned u32x2 __attribute__((ext_vector_type(2)));
typedef __bf16 bf16x2_t __attribute__((ext_vector_type(2)));

constexpr int M_TOK = 16384, DM = 1024, SEQ = 4096, NBATCH = 4, DEPTH = 2;
constexpr int NP = 2816;
constexpr int NE = 32, DFF = 1024, TOPK = 4;
constexpr int C_SBQ = 0, C_SBK = 256, C_SBV = 512, C_DFQ = 768, C_DFK = 1024, C_DFV = 1280, C_FXQ = 1536, C_FXK = 1792, C_FXV = 2048,
              C_CQ = 2304, C_CKV = 2560, C_KR = 2688, C_FXF = 2720, C_END = 2724;
constexpr float LOG2E = 1.4426950408889634f;
constexpr float DN_ALPHA = 1.4142135623730951f;
constexpr float LN_EPS = 1e-5f, RMS_EPS = 1e-6f;
constexpr float S8_H = 16.f, S8_WGU = 64.f, S8_ACT = 8.f, S8_WDN = 128.f;

constexpr size_t MB = 1ull << 20;
constexpr size_t OFF_CTRL = 0, CTRL_BYTES = 65536;
constexpr size_t OFF_ROPE = 1 * MB;
constexpr size_t OFF_GATEF = 3 * MB;
constexpr size_t OFF_FK = 3 * MB + 512 * 1024;
constexpr size_t OFF_LIST = 4 * MB;
constexpr size_t OFF_TOKE = 6 * MB;
constexpr size_t OFF_TOKG = 6 * MB + 512 * 1024;
constexpr size_t OFF_WUQ = 7 * MB;
constexpr size_t OFF_WUKV = 7 * MB + 512 * 1024;
constexpr size_t OFF_WOUT = 8 * MB;
constexpr size_t OFF_WIN = 12 * MB;
constexpr size_t OFF_HF = 24 * MB;
constexpr size_t OFF_HB = 88 * MB;
constexpr size_t OFF_P = 120 * MB;
constexpr size_t OFF_CQN = 208 * MB;
constexpr size_t OFF_CKVN = 216 * MB;
constexpr size_t OFF_QD = 220 * MB;
constexpr size_t OFF_KVD = 232 * MB;
constexpr size_t OFF_MIX = 248 * MB;
constexpr size_t OFF_TMPF = 280 * MB;
constexpr size_t OFF_KN = 3 * MB + 768 * 1024;
constexpr size_t OFF_H8 = 220 * MB;
constexpr size_t OFF_ACT = 344 * MB;
constexpr size_t OFF_Y = 473 * MB;
constexpr size_t OFF_WGU = 602 * MB;
constexpr size_t OFF_WD = 858 * MB;
constexpr size_t WS_END = 986 * MB;
constexpr int CW_CNT = 0;
constexpr int CW_ATTQ = 128;
constexpr int CW_LAM = 160;
constexpr int CW_CONVQ = 192;
constexpr int CW_BAR = 4096;

constexpr int LDS_ROWTAB = 131072;
constexpr int LDS_GEMM = 143360;
constexpr int LDS_MISC = LDS_GEMM + 1024;
constexpr int LDS_BIASTAB = 147456;
constexpr int LDS_BYTES = 159744;

struct Params {
  const float* x; const int* pos; const float* ln_in_g; const float* ln_in_b; const float* w_in; const float* b_forget;
  const float* diff_lambda; const float* diff_subln_g; const float* mla_q_norm_g; const float* mla_w_uq; const float* mla_kv_norm_g;
  const float* mla_w_ukv; const float* w_out; const float* ln1_g; const float* ln1_b; const float* router_w; const float* router_b;
  const float* w_gate_up; const float* b_gate_up; const float* w_down; const float* b_down; const float* ln2_g; const float* ln2_b;
  float* out; unsigned char* ws;
};

__device__ __forceinline__ unsigned cvtpk(float lo, float hi) { f32x2 v = {lo, hi}; bf16x2_t b = __builtin_convertvector(v, bf16x2_t); return __builtin_bit_cast(unsigned, b); }
__device__ __forceinline__ unsigned pk4_fp8(float a, float b, float c, float d) {
  int w = __builtin_amdgcn_cvt_pk_fp8_f32(a, b, 0, false);
  w = __builtin_amdgcn_cvt_pk_fp8_f32(c, d, w, true);
  return (unsigned)w;
}
__device__ __forceinline__ float clamp448(float x) { return fminf(fmaxf(x, -448.f), 448.f); }
__device__ __forceinline__ float bf2f(unsigned short b) { return __uint_as_float(((unsigned)b) << 16); }
__device__ __forceinline__ float bflo(unsigned w) { return __uint_as_float(w << 16); }
__device__ __forceinline__ float bfhi(unsigned w) { return __uint_as_float(w & 0xffff0000u); }
__device__ __forceinline__ float wave_sum(float v) {
#pragma unroll
  for (int o = 1; o < 64; o <<= 1) v += __shfl_xor(v, o);
  return v;
}
__device__ __forceinline__ int get_bid() { int b = blockIdx.x; asm volatile("" : "+s"(b)); return b; }
__device__ __forceinline__ int get_nblk() { int g = gridDim.x; asm volatile("" : "+s"(g)); return g; }
__device__ __forceinline__ int get_tid() { int t = threadIdx.x; asm volatile("" : "+v"(t)); return t; }
__device__ __forceinline__ int crow(int r, int hi) { return (r & 3) + 8 * (r >> 2) + 4 * hi; }
__device__ __forceinline__ void pair_vals(float v, float& v0, float& v1) {
  auto rr = __builtin_amdgcn_permlane32_swap(__float_as_uint(v), __float_as_uint(v), false, false);
  v0 = __uint_as_float(rr[0]); v1 = __uint_as_float(rr[1]);
}


#define XB_TMO      128
#define XB_XCNT(j)  (256  + 64 * (j))
#define XB_XSUB(j)  (1280 + 64 * (j))
#define XB_XGEN(j)  (2304 + 64 * (j))
#define XB_TOP      3328
#define XB_TOPGEN   3392
#define XCD_BAR_WORDS 3456
#define XB_SPIN_CAP (1u << 22)
__device__ __forceinline__ unsigned xb_ld(unsigned* p)              { return __hip_atomic_load(p, __ATOMIC_RELAXED, __HIP_MEMORY_SCOPE_AGENT); }
__device__ __forceinline__ unsigned xb_add(unsigned* p, unsigned v) { return __hip_atomic_fetch_add(p, v, __ATOMIC_RELAXED, __HIP_MEMORY_SCOPE_AGENT); }
__device__ __forceinline__ unsigned xb_xcc_id() { return (unsigned)__builtin_amdgcn_s_getreg((3 << 11) | 20) & 0xFu; }
#define XB_SPIN(cond, bar) do { unsigned _sp = 0; while (cond) { __builtin_amdgcn_s_sleep(1); \
    if ((++_sp & 255u) == 0u) { if (xb_ld(&(bar)[XB_TMO])) break; if (_sp > XB_SPIN_CAP) { atomicAdd(&(bar)[XB_TMO], 1u); break; } } } } while (0)
struct XcdBarrier { unsigned* bar; unsigned x; volatile LAS unsigned* st; };
__device__ __forceinline__ XcdBarrier xcd_barrier_post(unsigned* bar, volatile LAS unsigned* st) {
  XcdBarrier b; b.bar = bar; b.x = xb_xcc_id(); b.st = st;
  if (threadIdx.x == 0) (void)xb_add(&bar[XB_XCNT(b.x)], 1u);
  return b;
}
__device__ __forceinline__ void xcd_barrier_complete(unsigned* bar, unsigned x, unsigned& nloc, unsigned& nx) {
  const unsigned G = gridDim.x * gridDim.y * gridDim.z;
  unsigned sum, cnt, mine, sp = 0u;
  for (;;) {
    sum = 0u; cnt = 0u; mine = 0u;
#pragma unroll
    for (unsigned j = 0; j < 16; ++j) { const unsigned c = xb_ld(&bar[XB_XCNT(j)]); sum += c; cnt += (c > 0u) ? 1u : 0u; mine = (j == x) ? c : mine; }
    if (sum == G) break;
    __builtin_amdgcn_s_sleep(1);
    if ((++sp & 255u) == 0u) { if (xb_ld(&bar[XB_TMO])) break; if (sp > XB_SPIN_CAP) { atomicAdd(&bar[XB_TMO], 1u); break; } }
  }
  nloc = mine > 0u ? mine : 1u; nx = cnt > 0u ? cnt : 1u;
}
__device__ __forceinline__ void xcd_barrier(const XcdBarrier& b) {
  asm volatile("s_waitcnt vmcnt(0)" ::: "memory");
  __syncthreads();
  if (threadIdx.x == 0) {
    unsigned* bar = b.bar;
    __builtin_amdgcn_s_waitcnt(0);
    unsigned nloc = b.st[0], nx = b.st[1];
    if (nloc == 0u) { xcd_barrier_complete(bar, b.x, nloc, nx); b.st[0] = nloc; b.st[1] = nx; }
    const unsigned old = xb_add(&bar[XB_XSUB(b.x)], 1u);
    const unsigned gen = old / nloc;
    if (old + 1u == (gen + 1u) * nloc) {
      __builtin_amdgcn_fence(__ATOMIC_RELEASE, "agent");
      asm volatile("s_waitcnt vmcnt(0)" ::: "memory");
      const unsigned og = xb_add(&bar[XB_TOP], 1u);
      const unsigned tg = og / nx;
      if (og + 1u == (tg + 1u) * nx) xb_add(&bar[XB_TOPGEN], 1u);
      else XB_SPIN(xb_ld(&bar[XB_TOPGEN]) == tg, bar);
      __builtin_amdgcn_fence(__ATOMIC_ACQUIRE, "agent");
      xb_add(&bar[XB_XGEN(b.x)], 1u);
      asm volatile("s_waitcnt vmcnt(0)" ::: "memory");
    } else {
      XB_SPIN(xb_ld(&bar[XB_XGEN(b.x)]) == gen, bar);
      __builtin_amdgcn_fence(__ATOMIC_ACQUIRE, "agent");
      asm volatile("s_waitcnt vmcnt(0)" ::: "memory");
    }
  }
  __syncthreads();
}

struct ConvDesc { const float* src; bf16_t* dst; const float* kscale; int K, Ndst, srcld, mode, kb, nb; };
constexpr int CV_U_IN = 16 * 11, CV_U_OUT = 16 * 4, CV_U_UQ = 4 * 2, CV_U_UKV = 2 * 2;
constexpr int CV_SMALL = 2 * (CV_U_IN + CV_U_OUT + CV_U_UQ + CV_U_UKV);
__device__ __forceinline__ bool conv_desc(const Params& p, int u, ConvDesc& d) {
  unsigned char* ws = p.ws;
  constexpr int T_IN = 2 * CV_U_IN, T_OUT = 2 * CV_U_OUT, T_UQ = 2 * CV_U_UQ;
  const float* src; bf16_t* dst; const float* ksc = nullptr; int K, Ndst, srcld, mode, q, nbn;
  int r = u;
  if (r < T_IN) { const int inst = r / CV_U_IN; q = r % CV_U_IN; src = p.w_in + (size_t)inst * 1024 * 2724; dst = (bf16_t*)(ws + OFF_WIN) + (size_t)inst * NP * 1024; K = 1024; Ndst = NP; srcld = 2724; mode = 1; nbn = 11; }
  else if ((r -= T_IN) < T_OUT) { const int inst = r / CV_U_OUT; q = r % CV_U_OUT; src = p.w_out + (size_t)inst * 1024 * 1024; dst = (bf16_t*)(ws + OFF_WOUT) + (size_t)inst * 1024 * 1024; K = 1024; Ndst = 1024; srcld = 1024; mode = 0; nbn = 4; }
  else if ((r -= T_OUT) < T_UQ) { const int inst = r / CV_U_UQ; q = r % CV_U_UQ; src = p.mla_w_uq + (size_t)inst * 256 * 384; dst = (bf16_t*)(ws + OFF_WUQ) + (size_t)inst * 384 * 256; K = 256; Ndst = 384; srcld = 384; mode = 0; nbn = 2; ksc = p.mla_q_norm_g + inst * 256; }
  else { r -= T_UQ; const int inst = r / CV_U_UKV; q = r % CV_U_UKV; src = p.mla_w_ukv + (size_t)inst * 128 * 512; dst = (bf16_t*)(ws + OFF_WUKV) + (size_t)inst * 512 * 128; K = 128; Ndst = 512; srcld = 512; mode = 0; nbn = 2; ksc = p.mla_kv_norm_g + inst * 128; }
  d.src = src; d.dst = dst; d.kscale = ksc; d.K = K; d.Ndst = Ndst; d.srcld = srcld; d.mode = mode; d.kb = q / nbn; d.nb = q % nbn;
  return u < CV_SMALL;
}
__device__ __forceinline__ void conv_load(const ConvDesc& d, float (&v)[4][8], int lane, int w) {
  const int k0 = d.kb * 64 + 8 * w;
#pragma unroll
  for (int u = 0; u < 4; ++u) {
    const int n = d.nb * 256 + u * 64 + lane;
    int sc = n; bool ok = n < d.Ndst;
    if (d.mode == 1) { if (n < 2304) sc = n; else if (n < C_FXF) sc = n + 4; else if (n < C_END) sc = 2304 + (n - C_FXF); else ok = false; }
    const float* sp = d.src + (size_t)k0 * d.srcld + sc;
#pragma unroll
    for (int j = 0; j < 8; ++j) v[u][j] = ok ? __builtin_nontemporal_load(sp + (size_t)j * d.srcld) : 0.f;
  }
}
__device__ __forceinline__ void conv_store(const ConvDesc& d, const float (&v)[4][8], int lane, int w) {
  const int k0 = d.kb * 64 + 8 * w;
#pragma unroll
  for (int u = 0; u < 4; ++u) {
    const int n = d.nb * 256 + u * 64 + lane;
    if (n < d.Ndst) {
      int dr = n;
      if (d.mode == 2) { const int j = n & 1023; dr = (j >> 4) * 32 + (j & 15) + ((n >= 1024) ? 16 : 0); }
      float g[8];
#pragma unroll
      for (int j = 0; j < 8; ++j) g[j] = d.kscale ? d.kscale[k0 + j] : 1.f;
      u32x4 o; o.x = cvtpk(v[u][0] * g[0], v[u][1] * g[1]); o.y = cvtpk(v[u][2] * g[2], v[u][3] * g[3]); o.z = cvtpk(v[u][4] * g[4], v[u][5] * g[5]); o.w = cvtpk(v[u][6] * g[6], v[u][7] * g[7]);
      *(u32x4*)(d.dst + (size_t)dr * d.K + k0) = o;
    }
  }
}
__device__ __forceinline__ void phase_convert(const Params& p) {
  const int tid = get_tid(), lane = tid & 63, w = tid >> 6;
  const int G = get_nblk();
  for (int u = get_bid(); u < CV_SMALL; u += G) {
    ConvDesc d; float va[4][8];
    conv_desc(p, u, d);
    conv_load(d, va, lane, w);
    conv_store(d, va, lane, w);
  }
}

__device__ __forceinline__ void ln_row(f32x4 (&v)[4], const float* g, const float* b, int lane) {
  float s = 0.f;
#pragma unroll
  for (int j = 0; j < 4; ++j) s += (v[j].x + v[j].y) + (v[j].z + v[j].w);
  const float mean = wave_sum(s) * (1.f / DM);
  float s2 = 0.f;
#pragma unroll
  for (int j = 0; j < 4; ++j) { v[j] = v[j] - mean; s2 += (v[j].x * v[j].x + v[j].y * v[j].y) + (v[j].z * v[j].z + v[j].w * v[j].w); }
  const float rstd = rsqrtf(wave_sum(s2) * (1.f / DM) + LN_EPS);
#pragma unroll
  for (int j = 0; j < 4; ++j) {
    const f32x4 gg = *(const f32x4*)(g + 4 * lane + 256 * j), bb = *(const f32x4*)(b + 4 * lane + 256 * j);
    v[j] = v[j] * rstd * gg + bb;
  }
}
__device__ __forceinline__ void store_row_f32_bf16(const f32x4 (&v)[4], float* of, bf16_t* ob, int lane) {
#pragma unroll
  for (int j = 0; j < 4; ++j) {
    if (of) *(f32x4*)(of + 4 * lane + 256 * j) = v[j];
    if (ob) { u32x2 w; w.x = cvtpk(v[j].x, v[j].y); w.y = cvtpk(v[j].z, v[j].w); *(u32x2*)(ob + 4 * lane + 256 * j) = w; }
  }
}

__device__ __forceinline__ void phase_prologue_misc(const Params& p) {
  unsigned char* ws = p.ws;
  const int lane = get_tid() & 63, gw = get_bid() * 8 + (get_tid() >> 6), ngw = get_nblk() * 8;
  float* hF = (float*)(ws + OFF_HF); bf16_t* hB = (bf16_t*)(ws + OFF_HB);
  for (int m = gw; m < M_TOK; m += ngw) {
    f32x4 v[4];
#pragma unroll
    for (int j = 0; j < 4; ++j) v[j] = *(const f32x4*)(p.x + (size_t)m * DM + 4 * lane + 256 * j);
    ln_row(v, p.ln_in_g, p.ln_in_b, lane);
    store_row_f32_bf16(v, nullptr, hB + (size_t)m * DM, lane);
  }
  f32x2* cs = (f32x2*)(ws + OFF_ROPE);
  const int gt = get_bid() * 512 + get_tid(), ngt = get_nblk() * 512;
  for (int i = gt; i < M_TOK * 16; i += ngt) {
    const int m = i >> 4, f = i & 15;
    const double invf = exp2(-(double)f * (13.287712379549449 / 16.0));
    double a = (double)p.pos[m] * invf;
    a = a - 6.283185307179586476925 * rint(a * 0.15915494309189533577);
    float sn, cn; __sincosf((float)a, &sn, &cn);
    cs[i] = (f32x2){cn, sn};
  }
  if (get_bid() == 0 && get_tid() < DEPTH) {
    const int l = get_tid(); const float* lp = p.diff_lambda + l * 128;
    float s1 = 0.f, s2 = 0.f;
    for (int i = 0; i < 32; ++i) { s1 += lp[i] * lp[32 + i]; s2 += lp[64 + i] * lp[96 + i]; }
    const float linit = 0.8f - 0.6f * expf(-0.3f * (float)l);
    ((float*)(ws + OFF_CTRL))[CW_LAM + l] = expf(s1) - expf(s2) + linit;
  }
}

struct GemmDesc { const bf16_t* A; int lda; const int* rowidx; int row0; int mvalid; const bf16_t* Bt; int ldb; int K; };

template <int NI>
__device__ __forceinline__ void gemm_tile(LAS unsigned char* lds, const GemmDesc& g, f32x16 (&acc)[2][NI]) {
  constexpr int BN = 64 * NI;
  constexpr int A_BYTES = 256 * 128, B_BYTES = BN * 128, STAGE = A_BYTES + B_BYTES;
  constexpr int NBL = BN / 64;
  const int tid = get_tid(), lane = tid & 63, w = tid >> 6, wm = w >> 1, wn = w & 1, c31 = lane & 31, hi = lane >> 5;
  const int lr = tid >> 3, lc = (tid & 7) ^ ((tid >> 4) & 7);
  const bf16_t* ap[4];
#pragma unroll
  for (int i = 0; i < 4; ++i) {
    const int r = lr + 64 * i;
    int row;
    if (g.rowidx) row = g.rowidx[g.row0 + (r < g.mvalid ? r : 0)]; else row = g.row0 + r;
    ap[i] = g.A + (size_t)row * g.lda + lc * 8;
  }
  const bf16_t* bp = g.Bt + (size_t)lr * g.ldb + lc * 8;
  const int wbase = w * 1024;
  const int xr = (lane >> 1) & 7;
  int roff[4];
#pragma unroll
  for (int ks = 0; ks < 4; ++ks) roff[ks] = ((2 * ks + hi) ^ xr) << 4;
  const int a_base = (wm * 64 + c31) * 128, b_base = A_BYTES + (wn * 32 * NI + c31) * 128;
#pragma unroll
  for (int mi = 0; mi < 2; ++mi)
#pragma unroll
    for (int ni = 0; ni < NI; ++ni)
#pragma unroll
      for (int r = 0; r < 16; ++r) acc[mi][ni][r] = 0.f;
  const int nk = g.K >> 6;
#define GT_STAGE(stg, ko) do { LAS unsigned char* s_ = lds + (stg) * STAGE + wbase; \
    _Pragma("unroll") for (int i = 0; i < 4; ++i) __builtin_amdgcn_global_load_lds((const unsigned*)(ap[i] + (ko)), (LAS unsigned*)(s_ + 8192 * i), 16, 0, 0); \
    _Pragma("unroll") for (int i = 0; i < NBL; ++i) __builtin_amdgcn_global_load_lds((const unsigned*)(bp + (size_t)(64 * i) * g.ldb + (ko)), (LAS unsigned*)(s_ + A_BYTES + 8192 * i), 16, 0, 0); } while (0)
  GT_STAGE(0, 0);
  __syncthreads();
  bf16x8 af[2][2], bfr[2][NI];
  for (int kt = 0; kt < nk; ++kt) {
    LAS unsigned char* cur = lds + (kt & 1) * STAGE;
    if (kt + 1 < nk) GT_STAGE((kt + 1) & 1, (kt + 1) * 64);
#pragma unroll
    for (int mi = 0; mi < 2; ++mi) af[0][mi] = *(const LAS bf16x8*)(cur + a_base + mi * 4096 + roff[0]);
#pragma unroll
    for (int ni = 0; ni < NI; ++ni) bfr[0][ni] = *(const LAS bf16x8*)(cur + b_base + ni * 4096 + roff[0]);
#pragma unroll
    for (int ks = 0; ks < 4; ++ks) {
      if (ks < 3) {
#pragma unroll
        for (int mi = 0; mi < 2; ++mi) af[(ks + 1) & 1][mi] = *(const LAS bf16x8*)(cur + a_base + mi * 4096 + roff[ks + 1]);
#pragma unroll
        for (int ni = 0; ni < NI; ++ni) bfr[(ks + 1) & 1][ni] = *(const LAS bf16x8*)(cur + b_base + ni * 4096 + roff[ks + 1]);
      }
      __builtin_amdgcn_s_setprio(1);
#pragma unroll
      for (int mi = 0; mi < 2; ++mi)
#pragma unroll
        for (int ni = 0; ni < NI; ++ni) acc[mi][ni] = __builtin_amdgcn_mfma_f32_32x32x16_bf16(bfr[ks & 1][ni], af[ks & 1][mi], acc[mi][ni], 0, 0, 0);
      __builtin_amdgcn_s_setprio(0);
    }
    __syncthreads();
  }
#undef GT_STAGE
}


namespace pg8 {
typedef float f32x4v __attribute__((ext_vector_type(4)));
constexpr int BM = 256, BK = 64, HALF = 128, HTB = HALF * BK * 2, STAGE_BYTES = 8 * HTB, KK = 1024;
typedef int v8i_t __attribute__((ext_vector_type(8)));
typedef int v4i_t __attribute__((ext_vector_type(4)));
__device__ __forceinline__ v8i_t cat8(bf16x8 a, bf16x8 b) { const v4i_t x = __builtin_bit_cast(v4i_t, a), y = __builtin_bit_cast(v4i_t, b); return __builtin_shufflevector(x, y, 0, 1, 2, 3, 4, 5, 6, 7); }
__device__ __forceinline__ int lds_byte(int r, int c) { const int st = (r >> 4) * 2 + (c >> 5), rr = r & 15, cc = c & 31, ob = rr * 64 + cc * 2; return st * 1024 + (ob ^ (((ob >> 9) & 1) << 5)); }
__device__ __forceinline__ void stage_rc(int b, int& R, int& C) { const int st = b / 1024, sb = b % 1024, swz = sb ^ (((sb >> 9) & 1) << 5); R = (st >> 1) * 16 + swz / 64; C = (st & 1) * 32 + (swz % 64) / 2; }
struct Unit { unsigned boff; int arow0; int mvalid; int e, mt, nt, slot0; };
template <bool GATHER, bool FP8, class Sched, class Epi>
__device__ __forceinline__ void gemm_phase(LAS unsigned char* lds, const bf16_t* Abuf, const bf16_t* Bbuf, const Sched& S, const Epi& E) {
  const int tid = get_tid(), wid = __builtin_amdgcn_readfirstlane(tid >> 6), lane = tid & 63, wr = wid >> 2, wc = wid & 3, fr = lane & 15, fq = lane >> 4;
  const __amdgpu_buffer_rsrc_t rsA = __builtin_amdgcn_make_buffer_rsrc((void*)Abuf, (short)0, 0x7ffffff0, 0x00020000);
  const __amdgpu_buffer_rsrc_t rsB = __builtin_amdgcn_make_buffer_rsrc((void*)Bbuf, (short)0, 0x7ffffff0, 0x00020000);
  constexpr int RS = FP8 ? KK : 2 * KK;
  constexpr int NT_K = FP8 ? 8 : 16;
  const int lrow = (wid >> 1) * 16 + (lane >> 2);
  const int cbyte = (wid & 1) * 64 + (((lane & 3) * 16) ^ (((lane >> 5) & 1) << 5));
  const unsigned vB = (unsigned)(lrow * RS + cbyte);
  const unsigned vBb = (unsigned)(Epi::blane(lrow) * RS + cbyte);
  const LAS int* rowtab = (const LAS int*)(lds + LDS_ROWTAB) + lrow;
#define PG8_ROWS(V, u) do { if (GATHER) { _Pragma("unroll") for (int h_ = 0; h_ < 2; ++h_) _Pragma("unroll") for (int i_ = 0; i_ < 2; ++i_) \
      V[h_][i_] = (unsigned)(rowtab[(u).arow0 * 256 + h_ * HALF + i_ * 64] * RS + cbyte); } } while (0)
#define PG8_ABASE(u) (GATHER ? 0u : (unsigned)(u).arow0 * (unsigned)RS)
  constexpr unsigned kstep = BK * 2;
  const unsigned ldsw = (unsigned)wid * 1024u;
  const int aoff = lds_byte(wr * 64 + fr, fq * 8), boff = lds_byte(wc * 32 + fr, fq * 8);
#define PG8_SA(b, h) (((b) * 2 + (h)) * HTB)
#define PG8_SB(b, h) ((4 + (b) * 2 + (h)) * HTB)
#define PG8_LOAD1(rs, ldsoff, voff, soff) __builtin_amdgcn_raw_ptr_buffer_load_lds(rs, (LAS void*)(lds + (ldsoff) + ldsw), 16, (int)(voff), (int)(soff), 0, 0)
#define PG8_STAGE_B(bufoff, soff, h) do { PG8_LOAD1(rsB, (bufoff), vBb, (soff) + (unsigned)(Epi::bpiece((h), 0) * RS)); PG8_LOAD1(rsB, (bufoff) + 8192, vBb, (soff) + (unsigned)(Epi::bpiece((h), 1) * RS)); } while (0)
#define PG8_STAGE_A(bufoff, soff, h, v0, v1) do { if (GATHER) { PG8_LOAD1(rsA, (bufoff), (v0), (soff)); PG8_LOAD1(rsA, (bufoff) + 8192, (v1), (soff)); } \
    else { PG8_LOAD1(rsA, (bufoff), vB, (soff) + (unsigned)((h) * HALF * RS)); PG8_LOAD1(rsA, (bufoff) + 8192, vB, (soff) + (unsigned)(((h) * HALF + 64) * RS)); } } while (0)
#define PG8_LDA(dst, b, h) do { if (FP8) { _Pragma("unroll") for (int m = 0; m < 4; ++m) { \
      const v4i_t lo_ = *(const LAS v4i_t*)(lds + PG8_SA(b, h) + aoff + m * 2048), hi_ = *(const LAS v4i_t*)(lds + PG8_SA(b, h) + aoff + m * 2048 + 1024); \
      dst##8[m] = __builtin_shufflevector(lo_, hi_, 0, 1, 2, 3, 4, 5, 6, 7); } } \
    else { _Pragma("unroll") for (int m = 0; m < 4; ++m) _Pragma("unroll") for (int k = 0; k < 2; ++k) dst[m][k] = *(const LAS bf16x8*)(lds + PG8_SA(b, h) + aoff + m * 2048 + k * 1024); } } while (0)
#define PG8_LDB(dst, b, h) do { if (FP8) { _Pragma("unroll") for (int n = 0; n < 2; ++n) { \
      const v4i_t lo_ = *(const LAS v4i_t*)(lds + PG8_SB(b, h) + boff + n * 2048), hi_ = *(const LAS v4i_t*)(lds + PG8_SB(b, h) + boff + n * 2048 + 1024); \
      dst##8[n] = __builtin_shufflevector(lo_, hi_, 0, 1, 2, 3, 4, 5, 6, 7); } } \
    else { _Pragma("unroll") for (int n = 0; n < 2; ++n) _Pragma("unroll") for (int k = 0; k < 2; ++k) dst[n][k] = *(const LAS bf16x8*)(lds + PG8_SB(b, h) + boff + n * 2048 + k * 1024); } } while (0)
#define PG8_MMA(ai, bj, At, Bt) do { __builtin_amdgcn_s_setprio(1); _Pragma("unroll") for (int m = 0; m < 4; ++m) _Pragma("unroll") for (int n = 0; n < 2; ++n) { \
    if (FP8) asm volatile("v_mfma_scale_f32_16x16x128_f8f6f4 %0, %1, %2, %0, %3, %3 op_sel_hi:[0,0,0]" : "+v"(acc[ai][bj][m][n]) : "v"(Bt##8[n]), "v"(At##8[m]), "v"(sc1));   \
    else { _Pragma("unroll") for (int k = 0; k < 2; ++k) acc[ai][bj][m][n] = __builtin_amdgcn_mfma_f32_16x16x32_bf16(Bt[n][k], At[m][k], acc[ai][bj][m][n], 0, 0, 0); } } \
    __builtin_amdgcn_s_setprio(0); } while (0)
#define PG8_WAIT_V(n) asm volatile("s_waitcnt vmcnt(" #n ")" ::: "memory")
#define PG8_WAIT_L(n) asm volatile("s_waitcnt lgkmcnt(" #n ")" ::: "memory")
#define PG8_BAR __builtin_amdgcn_s_barrier()
#define PG8_SCHED __builtin_amdgcn_sched_barrier(0)
  Unit cur, nxt; int ui = 0;
  if (!S.next(0, cur)) return;
  f32x4v acc[2][2][4][2];
#pragma unroll
  for (int a = 0; a < 2; ++a)
#pragma unroll
    for (int b = 0; b < 2; ++b)
#pragma unroll
      for (int m = 0; m < 4; ++m)
#pragma unroll
        for (int n = 0; n < 2; ++n) acc[a][b][m][n] = (f32x4v){0.f, 0.f, 0.f, 0.f};
  unsigned sc1 = 0x7f7f7f7fu; asm volatile("" : "+v"(sc1));
  bf16x8 At[4][2], B0[2][2], B1[2][2];
  v8i_t At8[4], B08[2], B18[2];
  unsigned cV[2][2];
#pragma unroll
  for (int h = 0; h < 2; ++h)
#pragma unroll
    for (int i = 0; i < 2; ++i) cV[h][i] = 0u;
  PG8_ROWS(cV, cur);
  unsigned cA = PG8_ABASE(cur), cB = cur.boff;
  PG8_STAGE_B(PG8_SB(0, 0), cB, 0); PG8_STAGE_B(PG8_SB(0, 1), cB, 1);
  PG8_STAGE_A(PG8_SA(0, 0), cA, 0, cV[0][0], cV[0][1]); PG8_STAGE_A(PG8_SA(0, 1), cA, 1, cV[1][0], cV[1][1]);
  if (wr == 1) PG8_BAR;
  PG8_WAIT_V(2); PG8_BAR;
  PG8_STAGE_B(PG8_SB(1, 0), cB + kstep, 0); PG8_STAGE_A(PG8_SA(1, 0), cA + kstep, 0, cV[0][0], cV[0][1]); PG8_STAGE_B(PG8_SB(1, 1), cB + kstep, 1);
  PG8_WAIT_V(6); PG8_BAR;
  for (;;) {
    const bool has_next = S.next(ui + 1, nxt);
    const unsigned nB = has_next ? nxt.boff : cB;
    const unsigned nA = has_next ? PG8_ABASE(nxt) : cA;
#pragma unroll 1
    for (int t = 0; t < NT_K; t += 2) {
      const bool last = (t == NT_K - 2);
      const unsigned a1 = cA + (unsigned)(t + 1) * kstep;
      const unsigned a2 = last ? nA : cA + (unsigned)(t + 2) * kstep, b2 = last ? nB : cB + (unsigned)(t + 2) * kstep;
      const unsigned a3 = a2 + kstep, b3 = b2 + kstep;
      unsigned w00 = cV[0][0], w01 = cV[0][1], w10 = cV[1][0], w11 = cV[1][1];
      if (GATHER && last && has_next) { unsigned nV[2][2]; PG8_ROWS(nV, nxt); w00 = nV[0][0]; w01 = nV[0][1]; w10 = nV[1][0]; w11 = nV[1][1]; }
      PG8_LDB(B0, 0, 0); PG8_LDB(B1, 0, 1); PG8_SCHED; PG8_LDA(At, 0, 0); PG8_STAGE_A(PG8_SA(1, 1), a1, 1, cV[1][0], cV[1][1]);
      PG8_WAIT_V(8); PG8_WAIT_L(0); PG8_BAR; PG8_MMA(0, 0, At, B0); PG8_MMA(0, 1, At, B1); PG8_BAR; PG8_SCHED;
      PG8_LDA(At, 0, 1); PG8_STAGE_B(PG8_SB(0, 0), b2, 0); PG8_STAGE_B(PG8_SB(0, 1), b2, 1); PG8_STAGE_A(PG8_SA(0, 0), a2, 0, w00, w01);
      PG8_WAIT_V(8); PG8_WAIT_L(0); PG8_BAR; PG8_MMA(1, 0, At, B0); PG8_MMA(1, 1, At, B1); PG8_BAR; PG8_SCHED;
      PG8_LDB(B0, 1, 0); PG8_LDB(B1, 1, 1); PG8_SCHED; PG8_LDA(At, 1, 0); PG8_STAGE_A(PG8_SA(0, 1), a2, 1, w10, w11);
      PG8_WAIT_V(8); PG8_WAIT_L(0); PG8_BAR; PG8_MMA(0, 0, At, B0); PG8_MMA(0, 1, At, B1); PG8_BAR; PG8_SCHED;
      PG8_LDA(At, 1, 1); PG8_STAGE_B(PG8_SB(1, 0), b3, 0); PG8_STAGE_B(PG8_SB(1, 1), b3, 1); PG8_STAGE_A(PG8_SA(1, 0), a3, 0, w00, w01);
      PG8_WAIT_V(8); PG8_WAIT_L(0); PG8_BAR; PG8_MMA(1, 0, At, B0); PG8_MMA(1, 1, At, B1); PG8_BAR; PG8_SCHED;
    }
    if (wr == 0) PG8_BAR;
    if (FP8) asm volatile("s_nop 15\n\ts_nop 15" ::: "memory");
    E(acc, cur, wr, wc, fr, fq);
    if (!has_next) break;
#pragma unroll
    for (int a = 0; a < 2; ++a)
#pragma unroll
      for (int b = 0; b < 2; ++b)
#pragma unroll
        for (int m = 0; m < 4; ++m)
#pragma unroll
          for (int n = 0; n < 2; ++n) acc[a][b][m][n] = (f32x4v){0.f, 0.f, 0.f, 0.f};
    if (FP8) asm volatile("s_nop 7" ::: "memory");
    cur = nxt; cB = nB; cA = nA; ++ui;
    PG8_ROWS(cV, cur);
    if (wr == 1) PG8_BAR;
  }
  PG8_WAIT_V(0);
  PG8_BAR;
#undef PG8_ROWS
#undef PG8_ABASE
#undef PG8_SA
#undef PG8_SB
#undef PG8_LOAD1
#undef PG8_STAGE_A
#undef PG8_STAGE_B
#undef PG8_LDA
#undef PG8_LDB
#undef PG8_MMA
#undef PG8_WAIT_V
#undef PG8_WAIT_L
#undef PG8_BAR
#undef PG8_SCHED
}
}

struct InprojSched {
  int grid, bid;
  __device__ __forceinline__ bool next(int i, pg8::Unit& u) const {
    constexpr int NT = NP / 256;
    int mt, nt;
    if (grid == 256) { const int xcd = bid & 7, j = bid >> 3, q = j + 32 * i; if (q >= 8 * NT) return false; mt = 8 * xcd + q / NT; nt = q % NT; }
    else { const int t = bid + i * grid; if (t >= 64 * NT) return false; mt = t / NT; nt = t % NT; }
    u.boff = (unsigned)nt * (256u * 1024u * 2u); u.arow0 = mt * 256; u.mvalid = 256; u.e = 0; u.mt = mt; u.nt = nt; u.slot0 = 0;
    return true;
  }
};
struct InprojEpi {
  static __device__ __forceinline__ int blane(int lrow) { return lrow; }
  static constexpr __device__ int bpiece(int h, int i) { return 128 * h + 64 * i; }
  bf16_t* P; float* gateF; const f32x2* cs; float* ssq;
  __device__ __forceinline__ void operator()(const pg8::f32x4v (&acc)[2][2][4][2], const pg8::Unit& u, int wr, int wc, int fr, int fq) const {
    const int nt = u.nt;
    const bool rope_all = (nt == 3) || (nt == 4);
#pragma unroll
    for (int ai = 0; ai < 2; ++ai)
#pragma unroll
      for (int m = 0; m < 4; ++m) {
        const int row = u.mt * 256 + 128 * ai + 64 * wr + 16 * m + fr;
        bf16_t* prow = P + (size_t)row * NP + nt * 256 + 32 * wc + 4 * fq;
        f32x2 c4[4];
        if (rope_all || nt == 10) {
#pragma unroll
          for (int j = 0; j < 4; ++j) c4[j] = cs[(size_t)row * 16 + 4 * fq + j];
        }
        float sq = 0.f;
#pragma unroll
        for (int bj = 0; bj < 2; ++bj) {
          pg8::f32x4v v0 = acc[ai][bj][m][0], v1 = acc[ai][bj][m][1];
          if (rope_all || (nt == 10 && bj == 1 && wc == 0)) {
#pragma unroll
            for (int j = 0; j < 4; ++j) { const float x1 = v0[j], x2 = v1[j]; v0[j] = x1 * c4[j].x - x2 * c4[j].y; v1[j] = x2 * c4[j].x + x1 * c4[j].y; }
          }
          if (nt == 9 || (nt == 10 && bj == 0)) {
#pragma unroll
            for (int j = 0; j < 4; ++j) sq += v0[j] * v0[j] + v1[j] * v1[j];
          }
          u32x2 o; o.x = cvtpk(v0[0], v0[1]); o.y = cvtpk(v0[2], v0[3]);
          *(u32x2*)(prow + 128 * bj) = o;
          o.x = cvtpk(v1[0], v1[1]); o.y = cvtpk(v1[2], v1[3]);
          *(u32x2*)(prow + 128 * bj + 16) = o;
          if (nt == 10 && bj == 1 && wc == 1 && fq == 0) *(f32x4*)(gateF + (size_t)row * 4) = (f32x4){v0[0], v0[1], v0[2], v0[3]};
        }
        if (nt == 9 || nt == 10) {
          sq += __shfl_xor(sq, 16); sq += __shfl_xor(sq, 32);
          if (fq == 0) ssq[(size_t)row * 8 + (nt == 9 ? 0 : 4) + wc] = sq;
        }
      }
  }
};
__device__ __forceinline__ void phase_inproj(const Params& p, int layer, LAS unsigned char* lds) {
  unsigned char* ws = p.ws;
  InprojSched S{get_nblk(), get_bid()};
  InprojEpi E{(bf16_t*)(ws + OFF_P), (float*)(ws + OFF_GATEF), (const f32x2*)(ws + OFF_ROPE), (float*)(ws + OFF_CQN)};
  pg8::gemm_phase<false, false>(lds, (const bf16_t*)(ws + OFF_HB), (const bf16_t*)(ws + OFF_WIN) + (size_t)layer * NP * 1024, S, E);
}

__device__ __forceinline__ void rope4(bf16_t* base, const f32x2* cs4) {
  const u32x2 a = *(const u32x2*)base, b = *(const u32x2*)(base + 16);
  float x1[4] = {bflo(a.x), bfhi(a.x), bflo(a.y), bfhi(a.y)}, x2[4] = {bflo(b.x), bfhi(b.x), bflo(b.y), bfhi(b.y)};
  float y1[4], y2[4];
#pragma unroll
  for (int i = 0; i < 4; ++i) { const f32x2 c = cs4[i]; y1[i] = x1[i] * c.x - x2[i] * c.y; y2[i] = x2[i] * c.x + x1[i] * c.y; }
  u32x2 oa, ob; oa.x = cvtpk(y1[0], y1[1]); oa.y = cvtpk(y1[2], y1[3]); ob.x = cvtpk(y2[0], y2[1]); ob.y = cvtpk(y2[2], y2[3]);
  *(u32x2*)base = oa; *(u32x2*)(base + 16) = ob;
}
__device__ __forceinline__ void phase_post(const Params& p, int layer, LAS unsigned char* lds) {
  unsigned char* ws = p.ws;
  bf16_t* P = (bf16_t*)(ws + OFF_P);
  const f32x2* cs = (const f32x2*)(ws + OFF_ROPE);
  bf16_t* cqn = (bf16_t*)(ws + OFF_CQN); bf16_t* ckvn = (bf16_t*)(ws + OFF_CKVN);
  const int lane = get_tid() & 63, gw = get_bid() * 8 + (get_tid() >> 6), ngw = get_nblk() * 8;
  const float* gq = p.mla_q_norm_g + layer * 256; const float* gkv = p.mla_kv_norm_g + layer * 128;
  for (int m = gw; m < M_TOK; m += ngw) {
    bf16_t* row = P + (size_t)m * NP;
    const f32x2* csm = cs + (size_t)m * 16;
    { const int sh = lane >> 2, pg = lane & 3; rope4(row + C_DFQ + sh * 32 + 4 * pg, csm + 4 * pg); }
    if (lane < 4) rope4(row + C_KR + 4 * lane, csm + 4 * lane);
    {
      const u32x2 a = *(const u32x2*)(row + C_CQ + 4 * lane);
      float x[4] = {bflo(a.x), bfhi(a.x), bflo(a.y), bfhi(a.y)};
      const float ss = wave_sum(x[0] * x[0] + x[1] * x[1] + x[2] * x[2] + x[3] * x[3]);
      const float rs = rsqrtf(ss * (1.f / 256.f) + RMS_EPS);
      const f32x4 gg = *(const f32x4*)(gq + 4 * lane);
      u32x2 o; o.x = cvtpk(x[0] * rs * gg.x, x[1] * rs * gg.y); o.y = cvtpk(x[2] * rs * gg.z, x[3] * rs * gg.w);
      *(u32x2*)(cqn + (size_t)m * 256 + 4 * lane) = o;
    }
    {
      const unsigned a = *(const unsigned*)(row + C_CKV + 2 * lane);
      const float x0 = bflo(a), x1 = bfhi(a);
      const float ss = wave_sum(x0 * x0 + x1 * x1);
      const float rs = rsqrtf(ss * (1.f / 128.f) + RMS_EPS);
      const f32x2 gg = *(const f32x2*)(gkv + 2 * lane);
      *(unsigned*)(ckvn + (size_t)m * 128 + 2 * lane) = cvtpk(x0 * rs * gg.x, x1 * rs * gg.y);
    }
  }
  if (get_bid() < 16) {
    const int b = get_bid() >> 2, h = get_bid() & 3, tid = get_tid();
    const float* gateF = (const float*)(ws + OFF_GATEF);
    float* Fk = (float*)(ws + OFF_FK) + (size_t)get_bid() * SEQ;
    const float bf = p.b_forget[layer * 4 + h];
    LAS float* sc = (LAS float*)lds;
    float v[8]; float run = 0.f;
#pragma unroll
    for (int i = 0; i < 8; ++i) {
      const float xx = gateF[(size_t)(b * SEQ + tid * 8 + i) * 4 + h] + bf;
      const float ls = fminf(xx, 0.f) - log1pf(expf(-fabsf(xx)));
      run += ls; v[i] = run;
    }
    float inc = run;
#pragma unroll
    for (int o = 1; o < 64; o <<= 1) { const float t = __shfl_up(inc, o); if (lane >= o) inc += t; }
    __syncthreads();
    if (lane == 63) sc[tid >> 6] = inc;
    __syncthreads();
    float wbase = 0.f;
    for (int i = 0; i < (tid >> 6); ++i) wbase += sc[i];
    const float excl = wbase + inc - run;
#pragma unroll
    for (int i = 0; i < 8; ++i) Fk[tid * 8 + i] = -8.f * (excl + v[i]);
    __syncthreads();
  }
}

__device__ __forceinline__ void phase_mla_up(const Params& p, int layer, LAS unsigned char* lds) {
  unsigned char* ws = p.ws;
  const bf16_t* P = (const bf16_t*)(ws + OFF_P);
  const float* ssq = (const float*)(ws + OFF_CQN);
  const bf16_t* Wq = (const bf16_t*)(ws + OFF_WUQ) + (size_t)layer * 384 * 256;
  const bf16_t* Wkv = (const bf16_t*)(ws + OFF_WUKV) + (size_t)layer * 512 * 128;
  bf16_t* qd = (bf16_t*)(ws + OFF_QD); bf16_t* kvd = (bf16_t*)(ws + OFF_KVD);
  const int sb = get_bid() - (get_nblk() - 16);
  if (sb >= 0) {
    const int b = sb >> 2, h = sb & 3, tid = get_tid(), lane = tid & 63;
    const float* gateF = (const float*)(ws + OFF_GATEF);
    float* Fk = (float*)(ws + OFF_FK) + (size_t)sb * SEQ;
    const float bf = p.b_forget[layer * 4 + h];
    LAS float* sc = (LAS float*)lds;
    float v[8]; float run = 0.f;
#pragma unroll
    for (int i = 0; i < 8; ++i) {
      const float xx = gateF[(size_t)(b * SEQ + tid * 8 + i) * 4 + h] + bf;
      const float ls = fminf(xx, 0.f) - log1pf(expf(-fabsf(xx)));
      run += ls; v[i] = run;
    }
    float inc = run;
#pragma unroll
    for (int o = 1; o < 64; o <<= 1) { const float t = __shfl_up(inc, o); if (lane >= o) inc += t; }
    __syncthreads();
    if (lane == 63) sc[tid >> 6] = inc;
    __syncthreads();
    float wbase = 0.f;
    for (int i = 0; i < (tid >> 6); ++i) wbase += sc[i];
    const float excl = wbase + inc - run;
#pragma unroll
    for (int i = 0; i < 8; ++i) Fk[tid * 8 + i] = -8.f * (excl + v[i]);
    __syncthreads();
  }
  const int lane = get_tid() & 63, w = get_tid() >> 6, wm = w >> 1, wn = w & 1, c31 = lane & 31, hi = lane >> 5;
  for (int item = get_bid() * 8 + w; item < 16 * 64; item += get_nblk() * 8) {
    const int bh = item >> 6, tl = item & 63, b = bh >> 2, h = bh & 3;
    const bf16_t* kr = P + (size_t)(b * SEQ + 64 * tl + lane) * NP + C_FXK + h * 64;
    float ss = 0.f;
#pragma unroll
    for (int c = 0; c < 8; ++c) {
      const u32x4 x = *(const u32x4*)(kr + 8 * c);
      ss += bflo(x.x) * bflo(x.x) + bfhi(x.x) * bfhi(x.x) + bflo(x.y) * bflo(x.y) + bfhi(x.y) * bfhi(x.y) + bflo(x.z) * bflo(x.z) + bfhi(x.z) * bfhi(x.z) + bflo(x.w) * bflo(x.w) + bfhi(x.w) * bfhi(x.w);
    }
    float nv = sqrtf(ss) * 1.0001f;
#pragma unroll
    for (int o = 1; o < 64; o <<= 1) nv = fmaxf(nv, __shfl_xor(nv, o));
    if (lane == 0) ((float*)(ws + OFF_KN))[item] = nv;
  }
  constexpr int TQ = 64 * 3, TKV = 64 * 4;
  for (int t = get_bid(); t < TQ + TKV; t += get_nblk()) {
    const bool isq = t < TQ; const int tt = isq ? t : t - TQ; const int ntn = isq ? 3 : 4; const int mt = tt / ntn, nt = tt % ntn;
    GemmDesc g;
    if (isq) g = GemmDesc{P + C_CQ, NP, nullptr, mt * 256, 256, Wq + (size_t)nt * 128 * 256, 256, 256};
    else g = GemmDesc{P + C_CKV, NP, nullptr, mt * 256, 256, Wkv + (size_t)nt * 128 * 128, 128, 128};
    f32x16 acc[2][2];
    gemm_tile<2>(lds, g, acc);
    bf16_t* O = isq ? qd : kvd; const int ldo = isq ? 384 : 512;
#pragma unroll
    for (int mi = 0; mi < 2; ++mi) {
      const int m = mt * 256 + wm * 64 + mi * 32 + c31;
      const f32x4 s4 = *(const f32x4*)(ssq + (size_t)m * 8 + (isq ? 0 : 4));
      const float rs = rsqrtf(((s4.x + s4.y) + (s4.z + s4.w)) * (isq ? (1.f / 256.f) : (1.f / 128.f)) + RMS_EPS);
#pragma unroll
      for (int ni = 0; ni < 2; ++ni)
#pragma unroll
        for (int g4 = 0; g4 < 4; ++g4) {
          const int n = nt * 128 + wn * 64 + ni * 32 + 4 * hi + 8 * g4;
          u32x2 o; o.x = cvtpk(acc[mi][ni][4 * g4] * rs, acc[mi][ni][4 * g4 + 1] * rs); o.y = cvtpk(acc[mi][ni][4 * g4 + 2] * rs, acc[mi][ni][4 * g4 + 3] * rs);
          *(u32x2*)(O + (size_t)m * ldo + n) = o;
        }
    }
  }
}

constexpr int CMU_UP = 32 * 8 * 32, CMU_DN = 32 * 8 * 16, CMU_TOTAL = CMU_UP + CMU_DN;
struct ConvCtx { const float* wgu; const float* wdn; unsigned char* dgu; unsigned char* ddn; int* ctr; };
__device__ __forceinline__ void cmu_load(const ConvCtx& c, int idx, int lane, int w, float (&v)[16]) {
  const bool up = idx < CMU_UP;
  const int i2 = up ? idx : idx - CMU_UP;
  const int e = up ? (i2 >> 8) : (i2 >> 7), rem = up ? (i2 & 255) : (i2 & 127);
  const int kb = up ? (rem >> 5) : (rem >> 4), nb = up ? (rem & 31) : (rem & 15);
  const int N = up ? 2048 : 1024;
  const float* base = up ? c.wgu : c.wdn;
  const float* sp = base + ((size_t)e * 1024 + kb * 128 + 16 * w) * N + nb * 64 + lane;
#pragma unroll
  for (int j = 0; j < 16; ++j) v[j] = __builtin_nontemporal_load(sp + (size_t)j * N);
}
__device__ __forceinline__ void cmu_store(const ConvCtx& c, int idx, int lane, int w, const float (&v)[16]) {
  const bool up = idx < CMU_UP;
  const int i2 = up ? idx : idx - CMU_UP;
  const int e = up ? (i2 >> 8) : (i2 >> 7), rem = up ? (i2 & 255) : (i2 & 127);
  const int kb = up ? (rem >> 5) : (rem >> 4), nb = up ? (rem & 31) : (rem & 15);
  const int N = up ? 2048 : 1024;
  const int n = nb * 64 + lane;
  int dr = n;
  if (up) { const int j = n & 1023; dr = (j >> 4) * 32 + (j & 15) + ((n >= 1024) ? 16 : 0); }
  unsigned char* base = up ? c.dgu : c.ddn;
  const float sc = up ? S8_WGU : S8_WDN;
  u32x4 o;
  o.x = pk4_fp8(v[0] * sc, v[1] * sc, v[2] * sc, v[3] * sc); o.y = pk4_fp8(v[4] * sc, v[5] * sc, v[6] * sc, v[7] * sc);
  o.z = pk4_fp8(v[8] * sc, v[9] * sc, v[10] * sc, v[11] * sc); o.w = pk4_fp8(v[12] * sc, v[13] * sc, v[14] * sc, v[15] * sc);
  *(u32x4*)(base + ((size_t)e * N + dr) * 1024 + kb * 128 + 16 * w) = o;
}

__device__ __forceinline__ void cmu_to_lds(const ConvCtx& c, int idx, int lane, int w, const float (&v)[16], LAS unsigned char* tile) {
  const float sc = (idx < CMU_UP) ? S8_WGU : S8_WDN;
  u32x4 o;
  o.x = pk4_fp8(v[0] * sc, v[1] * sc, v[2] * sc, v[3] * sc); o.y = pk4_fp8(v[4] * sc, v[5] * sc, v[6] * sc, v[7] * sc);
  o.z = pk4_fp8(v[8] * sc, v[9] * sc, v[10] * sc, v[11] * sc); o.w = pk4_fp8(v[12] * sc, v[13] * sc, v[14] * sc, v[15] * sc);
  *(LAS u32x4*)(tile + lane * 128 + ((w ^ (lane & 7)) << 4)) = o;
}
__device__ __forceinline__ void cmu_from_lds(const ConvCtx& c, int idx, int lane, int w, const LAS unsigned char* tile) {
  const bool up = idx < CMU_UP;
  const int i2 = up ? idx : idx - CMU_UP;
  const int e = up ? (i2 >> 8) : (i2 >> 7), rem = up ? (i2 & 255) : (i2 & 127);
  const int kb = up ? (rem >> 5) : (rem >> 4), nb = up ? (rem & 31) : (rem & 15);
  const int N = up ? 2048 : 1024;
  const int r = 8 * w + (lane >> 3), ch = lane & 7;
  const u32x4 o = *(const LAS u32x4*)(tile + r * 128 + ((ch ^ (r & 7)) << 4));
  const int n = nb * 64 + r;
  int dr = n;
  if (up) { const int j = n & 1023; dr = (j >> 4) * 32 + (j & 15) + ((n >= 1024) ? 16 : 0); }
  unsigned char* base = up ? c.dgu : c.ddn;
  *(u32x4*)(base + ((size_t)e * N + dr) * 1024 + kb * 128 + 16 * ch) = o;
}

enum { AT_SB = 0, AT_DIFF = 1, AT_FOX = 2, AT_MLA = 3 };
struct AttnArgs {
  const bf16_t* Q; int ldq; const bf16_t* K; int ldk; const bf16_t* V; int ldv; const bf16_t* K2; int ldk2;
  const float* Fk; const f32x2* cs; bf16_t* O; int ldo; float lam, oscale; const float* subg; const float* kn;
};
constexpr int ATT_K1 = 0, ATT_V = 8192, ATT_K2 = 16384, ATT_F = 20480, ATT_BUF = 20992;

__device__ __forceinline__ float max3f(float a, float b, float c) { float r; asm("v_max3_f32 %0, %1, %2, %3" : "=v"(r) : "v"(a), "v"(b), "v"(c)); return r; }
__device__ __forceinline__ float max2f(float a, float b) { float r; asm("v_max_f32_e32 %0, %1, %2" : "=v"(r) : "v"(a), "v"(b)); return r; }
__device__ __forceinline__ bool softmax_tile(f32x16& p0, f32x16& p1, float& m, float& l, float c, bool domask, int kbase, int q, int hi, float& alpha) {
  if (domask) {
#pragma unroll
    for (int r = 0; r < 16; ++r) { const int key = kbase + crow(r, hi); if (key > q) p0[r] = -INFINITY; if (key + 32 > q) p1[r] = -INFINITY; }
  }
  asm volatile("s_nop 15\n\ts_nop 7" : "+v"(p0), "+v"(p1));
  float a = max3f(p0[0], p0[1], p1[0]), b = max3f(p0[2], p0[3], p1[1]); a = max3f(a, p1[2], p1[3]);
#pragma unroll
  for (int r = 4; r < 16; r += 4) { a = max3f(a, p0[r], p0[r + 1]); b = max3f(b, p0[r + 2], p0[r + 3]); a = max3f(a, p1[r], p1[r + 1]); b = max3f(b, p1[r + 2], p1[r + 3]); }
  float a0, a1; pair_vals(max2f(a, b), a0, a1);
  const float rm = max2f(a0, a1);
  const bool resc = __any((rm - m) * c > 8.0f);
  alpha = 1.f;
  if (resc) { const float mn = max2f(m, rm); alpha = __builtin_amdgcn_exp2f((m - mn) * c); l *= alpha; m = mn; }
  const float mc = m * c;
  float s = 0.f;
#pragma unroll
  for (int r = 0; r < 16; ++r) { p0[r] = __builtin_amdgcn_exp2f(fmaf(p0[r], c, -mc)); p1[r] = __builtin_amdgcn_exp2f(fmaf(p1[r], c, -mc)); s += p0[r] + p1[r]; }
  l += s;
  return resc;
}
__device__ __forceinline__ bf16x8 pack8(const f32x16& p, int b) {
  u32x4 w; w.x = cvtpk(p[b], p[b + 1]); w.y = cvtpk(p[b + 2], p[b + 3]); w.z = cvtpk(p[b + 4], p[b + 5]); w.w = cvtpk(p[b + 6], p[b + 7]);
  return __builtin_bit_cast(bf16x8, w);
}
__device__ __forceinline__ bf16x8 vfrag(LAS unsigned char* vb, int off) {
  const s16x4 lo = __builtin_bit_cast(s16x4, __builtin_amdgcn_ds_read_tr16_b64_v4i16((LAS s16x4*)(vb + off)));
  const s16x4 hh = __builtin_bit_cast(s16x4, __builtin_amdgcn_ds_read_tr16_b64_v4i16((LAS s16x4*)(vb + off + 1024)));
  return (bf16x8){lo[0], lo[1], lo[2], lo[3], hh[0], hh[1], hh[2], hh[3]};
}

template <int T>
__device__ __forceinline__ void attn_unit(LAS unsigned char* lds, const AttnArgs& a, int qb, const ConvCtx& cc, int& gi, int& pidx, int& qidx, float (&cv)[16]) {
  const int tid = get_tid(), lane = tid & 63, w = tid >> 6, c31 = lane & 31, hi = lane >> 5;
  const int t0 = qb * 256 + w * 32, q = t0 + c31;
  constexpr int NKS = (T == AT_MLA) ? 6 : 4;
  constexpr float CSC = (T == AT_DIFF) ? 0.17677669529663687f * LOG2E : (T == AT_MLA) ? 0.10206207261596577f * LOG2E : 0.125f * LOG2E;
  bf16x8 qf[NKS];
  {
    const bf16_t* qrow = a.Q + (size_t)q * a.ldq;
#pragma unroll
    for (int ks = 0; ks < NKS; ++ks) qf[ks] = *(const bf16x8*)(qrow + 16 * ks + 8 * hi);
    if (T == AT_MLA) {
      const f32x2* csq = a.cs + (size_t)q * 16 + 8 * hi;
      bf16x8 n4, n5;
#pragma unroll
      for (int j = 0; j < 8; j += 2) {
        const f32x2 c0 = csq[j], c1 = csq[j + 1];
        const float x1a = bf2f((unsigned short)qf[4][j]), x1b = bf2f((unsigned short)qf[4][j + 1]);
        const float x2a = bf2f((unsigned short)qf[5][j]), x2b = bf2f((unsigned short)qf[5][j + 1]);
        const unsigned w1 = cvtpk(x1a * c0.x - x2a * c0.y, x1b * c1.x - x2b * c1.y);
        const unsigned w2 = cvtpk(x2a * c0.x + x1a * c0.y, x2b * c1.x + x1b * c1.y);
        n4[j] = (short)(w1 & 0xffff); n4[j + 1] = (short)(w1 >> 16); n5[j] = (short)(w2 & 0xffff); n5[j + 1] = (short)(w2 >> 16);
      }
      qf[4] = n4; qf[5] = n5;
    }
  }
  const int skey = tid >> 3, sch = tid & 7;
  const int k1_st = ATT_K1 + skey * 128 + ((sch ^ ((skey >> 1) & 7)) << 4);
  const int v_st = ATT_V + skey * 128 + ((sch ^ (((skey >> 1) & 1) << 2)) << 4);
  const int k2key = tid >> 2, k2ch = tid & 3;
  const int k2_st = ATT_K2 + k2key * 64 + ((k2ch ^ ((k2key >> 2) & 3)) << 4);
  const int xr = (lane >> 1) & 7;
  int kro[4];
#pragma unroll
  for (int ks = 0; ks < 4; ++ks) kro[ks] = ATT_K1 + c31 * 128 + (((2 * ks + hi) ^ xr) << 4);
  int k2ro[2];
#pragma unroll
  for (int ks = 0; ks < 2; ++ks) k2ro[ks] = ATT_K2 + c31 * 64 + (((2 * ks + hi) ^ ((c31 >> 2) & 3)) << 4);
  int vro[2];
  {
    const int i = lane & 15, qq = i >> 2, pp = i & 3, gg = (lane >> 4) & 1, bit = (qq >> 1) & 1;
#pragma unroll
    for (int d0 = 0; d0 < 2; ++d0) vro[d0] = ATT_V + (4 * hi + qq) * 128 + ((4 * (d0 ^ bit) + 2 * gg + (pp >> 1)) << 4) + (pp & 1) * 8;
  }
  const int ntiles = 4 * (qb + 1);
  const int wave_last = (t0 + 31) >> 6;
  LAS float* kpre = (LAS float*)(lds + 2 * ATT_BUF + 256);
  LAS float* fend = kpre + 64;
  float qn = 0.f;
  if (T == AT_FOX) {
    if (w == 0) {
      float v = (lane < ntiles) ? a.kn[lane] : 0.f;
#pragma unroll
      for (int o = 1; o < 64; o <<= 1) { const float u_ = __shfl_up(v, o); if (lane >= o) v = fmaxf(v, u_); }
      kpre[lane] = v;
      fend[lane] = (lane < ntiles) ? a.Fk[64 * lane + 63] : 0.f;
    }
    float ss = 0.f;
#pragma unroll
    for (int ks = 0; ks < 4; ++ks)
#pragma unroll
      for (int j = 0; j < 8; ++j) { const float x = bf2f((unsigned short)qf[ks][j]); ss += x * x; }
    float s0_, s1_; pair_vals(ss, s0_, s1_);
    qn = sqrtf(s0_ + s1_) * 1.0001f;
  }
  f32x16 o0[2], o1[2];
#pragma unroll
  for (int d0 = 0; d0 < 2; ++d0)
#pragma unroll
    for (int r = 0; r < 16; ++r) { o0[d0][r] = 0.f; o1[d0][r] = 0.f; }
  float m0 = -INFINITY, l0 = 0.f, m1 = -INFINITY, l1 = 0.f;
  float Crun = 0.f;
  bool fin = false;
  u32x4 rk, rv, rk2; float rf = 0.f;
#define ATT_TILE(it) ((T == AT_SB || T == AT_FOX) ? (ntiles - 1 - (it)) : (it))
#define ATT_GLOAD(t) do { const int key_ = 64 * (t) + skey; \
    rk = *(const u32x4*)(a.K + (size_t)key_ * a.ldk + sch * 8); rv = *(const u32x4*)(a.V + (size_t)key_ * a.ldv + sch * 8); \
    if (T == AT_MLA) { if (tid < 256) rk2 = *(const u32x4*)(a.K2 + (size_t)(64 * (t) + k2key) * a.ldk2 + k2ch * 8); } \
    if (T == AT_FOX) { if (tid < 64) rf = a.Fk[64 * (t) + tid]; } } while (0)
#define ATT_LSTORE(buf) do { LAS unsigned char* b_ = lds + (buf) * ATT_BUF; \
    *(LAS u32x4*)(b_ + k1_st) = rk; *(LAS u32x4*)(b_ + v_st) = rv; \
    if (T == AT_MLA) { if (tid < 256) *(LAS u32x4*)(b_ + k2_st) = rk2; } \
    if (T == AT_FOX) { if (tid < 64) *(LAS float*)(b_ + ATT_F + 4 * tid) = rf; } } while (0)
  LAS int* s_conv = (LAS int*)(lds + 2 * ATT_BUF + 64);
  ATT_GLOAD(ATT_TILE(0));
  ATT_LSTORE(0);
  __syncthreads();
  for (int it = 0; it < ntiles; ++it) {
    const int t = ATT_TILE(it);
    LAS unsigned char* cur = lds + (it & 1) * ATT_BUF;
    const bool more = (it + 1 < ntiles);
    const int cidx = __builtin_amdgcn_readfirstlane(s_conv[(gi >> 3) & 1]) + (gi & 7);
    int cnext = 0;
    const bool cfetch = (gi & 7) == 0;
    if (cfetch && tid == 0) cnext = atomicAdd(cc.ctr, 8);
    if (more) ATT_GLOAD(ATT_TILE(it + 1));
    const bool active = (t <= wave_last) && !fin;
    if (active) {
      const bool domask = (64 * t + 63 > t0);
      const int kbase = 64 * t;
      if (T == AT_DIFF) {
        f32x16 pa0, pa1, pb0, pb1;
#pragma unroll
        for (int r = 0; r < 16; ++r) { pa0[r] = 0.f; pa1[r] = 0.f; pb0[r] = 0.f; pb1[r] = 0.f; }
#pragma unroll
        for (int ks = 0; ks < 2; ++ks) {
          const bf16x8 k0 = *(const LAS bf16x8*)(cur + kro[ks]), k1 = *(const LAS bf16x8*)(cur + kro[ks] + 4096);
          pa0 = __builtin_amdgcn_mfma_f32_32x32x16_bf16(k0, qf[ks], pa0, 0, 0, 0); pa1 = __builtin_amdgcn_mfma_f32_32x32x16_bf16(k1, qf[ks], pa1, 0, 0, 0);
        }
#pragma unroll
        for (int ks = 2; ks < 4; ++ks) {
          const bf16x8 k0 = *(const LAS bf16x8*)(cur + kro[ks]), k1 = *(const LAS bf16x8*)(cur + kro[ks] + 4096);
          pb0 = __builtin_amdgcn_mfma_f32_32x32x16_bf16(k0, qf[ks], pb0, 0, 0, 0); pb1 = __builtin_amdgcn_mfma_f32_32x32x16_bf16(k1, qf[ks], pb1, 0, 0, 0);
        }
        float al0, al1;
        const bool rs0 = softmax_tile(pa0, pa1, m0, l0, CSC, domask, kbase, q, hi, al0);
        const bool rs1 = softmax_tile(pb0, pb1, m1, l1, CSC, domask, kbase, q, hi, al1);
        if (rs0) {
#pragma unroll
          for (int d0 = 0; d0 < 2; ++d0)
#pragma unroll
            for (int r = 0; r < 16; ++r) o0[d0][r] *= al0;
        }
        if (rs1) {
#pragma unroll
          for (int d0 = 0; d0 < 2; ++d0)
#pragma unroll
            for (int r = 0; r < 16; ++r) o1[d0][r] *= al1;
        }
#pragma unroll
        for (int s = 0; s < 4; ++s) {
          const bf16x8 pfa = pack8((s < 2) ? pa0 : pa1, 8 * (s & 1)), pfb = pack8((s < 2) ? pb0 : pb1, 8 * (s & 1));
#pragma unroll
          for (int d0 = 0; d0 < 2; ++d0) {
            const bf16x8 vf = vfrag(cur, vro[d0] + 2048 * s);
            o0[d0] = __builtin_amdgcn_mfma_f32_32x32x16_bf16(vf, pfa, o0[d0], 0, 0, 0);
            o1[d0] = __builtin_amdgcn_mfma_f32_32x32x16_bf16(vf, pfb, o1[d0], 0, 0, 0);
          }
        }
      } else {
        f32x16 p0, p1;
        if (T == AT_FOX) {
#pragma unroll
          for (int g4 = 0; g4 < 4; ++g4) {
            const f32x4 f0 = *(const LAS f32x4*)(cur + ATT_F + (8 * g4 + 4 * hi) * 4), f1 = *(const LAS f32x4*)(cur + ATT_F + (32 + 8 * g4 + 4 * hi) * 4);
            p0[4 * g4] = f0.x; p0[4 * g4 + 1] = f0.y; p0[4 * g4 + 2] = f0.z; p0[4 * g4 + 3] = f0.w;
            p1[4 * g4] = f1.x; p1[4 * g4 + 1] = f1.y; p1[4 * g4 + 2] = f1.z; p1[4 * g4 + 3] = f1.w;
          }
        } else {
#pragma unroll
          for (int r = 0; r < 16; ++r) { p0[r] = 0.f; p1[r] = 0.f; }
        }
#pragma unroll
        for (int ks = 0; ks < 4; ++ks) {
          const bf16x8 k0 = *(const LAS bf16x8*)(cur + kro[ks]), k1 = *(const LAS bf16x8*)(cur + kro[ks] + 4096);
          p0 = __builtin_amdgcn_mfma_f32_32x32x16_bf16(k0, qf[ks], p0, 0, 0, 0); p1 = __builtin_amdgcn_mfma_f32_32x32x16_bf16(k1, qf[ks], p1, 0, 0, 0);
        }
        if (T == AT_MLA) {
#pragma unroll
          for (int ks = 0; ks < 2; ++ks) {
            const bf16x8 k0 = *(const LAS bf16x8*)(cur + k2ro[ks]), k1 = *(const LAS bf16x8*)(cur + k2ro[ks] + 2048);
            p0 = __builtin_amdgcn_mfma_f32_32x32x16_bf16(k0, qf[(NKS == 6) ? 4 + ks : ks], p0, 0, 0, 0);
            p1 = __builtin_amdgcn_mfma_f32_32x32x16_bf16(k1, qf[(NKS == 6) ? 4 + ks : ks], p1, 0, 0, 0);
          }
        }
        if (T == AT_SB) {
          f32x16 e0, e1;
          float T8[8];
#pragma unroll
          for (int half = 0; half < 2; ++half) {
            f32x16& pp = half ? p1 : p0; f32x16& ee = half ? e1 : e0;
#pragma unroll
            for (int r = 0; r < 16; ++r) {
              const float z2 = pp[r] * CSC;
              float lk = -__builtin_amdgcn_logf(1.0f + __builtin_amdgcn_exp2f(fminf(z2, 126.f)));
              const bool valid = !domask || (kbase + 32 * half + crow(r, hi) < q);
              lk = valid ? lk : 0.f;
              pp[r] = valid ? (z2 + lk) : -INFINITY;
              ee[r] = lk;
            }
#pragma unroll
            for (int g4 = 0; g4 < 4; ++g4) {
              const float x0 = ee[4 * g4], x1 = ee[4 * g4 + 1], x2 = ee[4 * g4 + 2], x3 = ee[4 * g4 + 3];
              ee[4 * g4 + 3] = 0.f; ee[4 * g4 + 2] = x3; ee[4 * g4 + 1] = x3 + x2; ee[4 * g4] = x3 + x2 + x1;
              T8[4 * half + g4] = x3 + x2 + x1 + x0;
            }
          }
          float Tl[8], Th[8];
#pragma unroll
          for (int i = 0; i < 8; ++i) pair_vals(T8[i], Tl[i], Th[i]);
          float ps = 0.f; float base[8];
#pragma unroll
          for (int i = 7; i >= 0; --i) { base[i] = Crun + ps + (hi ? 0.f : Th[i]); ps += Tl[i] + Th[i]; }
          Crun += ps;
#pragma unroll
          for (int r = 0; r < 16; ++r) {
            p0[r] = __builtin_amdgcn_exp2f(p0[r] + e0[r] + base[r >> 2]);
            p1[r] = __builtin_amdgcn_exp2f(p1[r] + e1[r] + base[4 + (r >> 2)]);
          }
          if (__all(Crun < -48.f)) fin = true;
        } else {
          float al;
          if (softmax_tile(p0, p1, m0, l0, CSC, domask, kbase, q, hi, al)) {
#pragma unroll
            for (int d0 = 0; d0 < 2; ++d0)
#pragma unroll
              for (int r = 0; r < 16; ++r) o0[d0][r] *= al;
          }
          if (T == AT_FOX) { if (t > 0) { if (__all((qn * kpre[t - 1] + fend[t - 1] - m0) * CSC < -40.f)) fin = true; } }
        }
#pragma unroll
        for (int s = 0; s < 4; ++s) {
          const bf16x8 pf = pack8((s < 2) ? p0 : p1, 8 * (s & 1));
#pragma unroll
          for (int d0 = 0; d0 < 2; ++d0) {
            const bf16x8 vf = vfrag(cur, vro[d0] + 2048 * s);
            o0[d0] = __builtin_amdgcn_mfma_f32_32x32x16_bf16(vf, pf, o0[d0], 0, 0, 0);
          }
        }
      }
    }
    if (more) ATT_LSTORE((it + 1) & 1);
    {
      LAS unsigned char* ctile = lds + 2 * ATT_BUF + 1024;
      if (qidx < CMU_TOTAL) cmu_from_lds(cc, qidx, lane, w, ctile + ((gi + 1) & 1) * 8192);
      if (pidx < CMU_TOTAL) cmu_to_lds(cc, pidx, lane, w, cv, ctile + (gi & 1) * 8192);
      qidx = pidx;
      pidx = cidx;
      if (pidx < CMU_TOTAL) cmu_load(cc, pidx, lane, w, cv);
    }
    if (cfetch && tid == 0) s_conv[((gi >> 3) + 1) & 1] = cnext;
    ++gi;
    if (T == AT_SB || T == AT_FOX) {
      const bool wave_done = fin || (t == 0);
      if (__syncthreads_and(wave_done ? 1 : 0)) break;
    } else {
      __syncthreads();
    }
  }
  __syncthreads();
#undef ATT_TILE
#undef ATT_GLOAD
#undef ATT_LSTORE
  if (T == AT_DIFF) {
    float la, lb; pair_vals(l0, la, lb); const float inv0 = 1.f / (la + lb);
    pair_vals(l1, la, lb); const float inv1 = a.lam / (la + lb);
    float ss = 0.f;
#pragma unroll
    for (int d0 = 0; d0 < 2; ++d0)
#pragma unroll
      for (int r = 0; r < 16; ++r) { const float v = o0[d0][r] * inv0 - o1[d0][r] * inv1; o0[d0][r] = v; ss += v * v; }
    float sa, sb; pair_vals(ss, sa, sb);
    const float rs = rsqrtf((sa + sb) * (1.f / 64.f) + RMS_EPS) * a.oscale;
#pragma unroll
    for (int d0 = 0; d0 < 2; ++d0)
#pragma unroll
      for (int g4 = 0; g4 < 4; ++g4) {
        const int dv = 32 * d0 + 8 * g4 + 4 * hi;
        const f32x4 gg = *(const f32x4*)(a.subg + dv);
        u32x2 o; o.x = cvtpk(o0[d0][4 * g4] * rs * gg.x, o0[d0][4 * g4 + 1] * rs * gg.y); o.y = cvtpk(o0[d0][4 * g4 + 2] * rs * gg.z, o0[d0][4 * g4 + 3] * rs * gg.w);
        *(u32x2*)(a.O + (size_t)q * a.ldo + dv) = o;
      }
  } else {
    float inv = 1.f;
    if (T != AT_SB) { float la, lb; pair_vals(l0, la, lb); inv = 1.f / (la + lb); }
#pragma unroll
    for (int d0 = 0; d0 < 2; ++d0)
#pragma unroll
      for (int g4 = 0; g4 < 4; ++g4) {
        const int dv = 32 * d0 + 8 * g4 + 4 * hi;
        u32x2 o; o.x = cvtpk(o0[d0][4 * g4] * inv, o0[d0][4 * g4 + 1] * inv); o.y = cvtpk(o0[d0][4 * g4 + 2] * inv, o0[d0][4 * g4 + 3] * inv);
        *(u32x2*)(a.O + (size_t)q * a.ldo + dv) = o;
      }
  }
}

__device__ __forceinline__ void phase_attention(const Params& p, int layer, LAS unsigned char* lds) {
  unsigned char* ws = p.ws;
  const bf16_t* P = (const bf16_t*)(ws + OFF_P);
  const bf16_t* qd = (const bf16_t*)(ws + OFF_QD); const bf16_t* kvd = (const bf16_t*)(ws + OFF_KVD);
  bf16_t* mix = (bf16_t*)(ws + OFF_MIX);
  int* ctrl = (int*)(ws + OFF_CTRL);
  const float lam = ((const float*)ctrl)[CW_LAM + layer];
  const float linit = 0.8f - 0.6f * expf(-0.3f * (float)layer);
  LAS int* s_unit = (LAS int*)(lds + 2 * ATT_BUF);
  ConvCtx cc;
  cc.wgu = p.w_gate_up + (size_t)layer * NE * 1024 * 2048; cc.wdn = p.w_down + (size_t)layer * NE * 1024 * 1024;
  cc.dgu = ws + OFF_WGU + (size_t)layer * NE * 2048 * 1024; cc.ddn = ws + OFF_WD + (size_t)layer * NE * 1024 * 1024;
  cc.ctr = ctrl + CW_CONVQ + layer;
  int gi = 0, pidx = CMU_TOTAL, qidx = CMU_TOTAL; float cv[16];
#pragma unroll
  for (int j = 0; j < 16; ++j) cv[j] = 0.f;
  if (get_tid() == 0) ((LAS int*)(lds + 2 * ATT_BUF + 64))[0] = atomicAdd(cc.ctr, 8);
  for (;;) {
    if (get_tid() == 0) *s_unit = atomicAdd(&ctrl[CW_ATTQ + layer], 1);
    __syncthreads();
    const int u = *s_unit;
    __syncthreads();
    if (u >= 1024) break;
    const int qb = 15 - (u >> 6), rem = u & 63, type = rem & 3, bh = rem >> 2, b = bh >> 2, h = bh & 3;
    const size_t rb = (size_t)b * SEQ;
    AttnArgs a{};
    a.O = mix + rb * DM + type * 256 + h * 64; a.ldo = DM;
    if (type == AT_SB) {
      a.Q = P + rb * NP + C_SBQ + h * 64; a.K = P + rb * NP + C_SBK + h * 64; a.V = P + rb * NP + C_SBV + h * 64; a.ldq = a.ldk = a.ldv = NP;
      attn_unit<AT_SB>(lds, a, qb, cc, gi, pidx, qidx, cv);
    } else if (type == AT_DIFF) {
      a.Q = P + rb * NP + C_DFQ + h * 64; a.K = P + rb * NP + C_DFK + h * 64; a.V = P + rb * NP + C_DFV + h * 64; a.ldq = a.ldk = a.ldv = NP;
      a.lam = lam; a.oscale = 1.f - linit; a.subg = p.diff_subln_g + layer * 64;
      attn_unit<AT_DIFF>(lds, a, qb, cc, gi, pidx, qidx, cv);
    } else if (type == AT_FOX) {
      a.Q = P + rb * NP + C_FXQ + h * 64; a.K = P + rb * NP + C_FXK + h * 64; a.V = P + rb * NP + C_FXV + h * 64; a.ldq = a.ldk = a.ldv = NP;
      a.Fk = (const float*)(ws + OFF_FK) + (size_t)bh * SEQ; a.kn = (const float*)(ws + OFF_KN) + bh * 64;
      attn_unit<AT_FOX>(lds, a, qb, cc, gi, pidx, qidx, cv);
    } else {
      a.Q = qd + rb * 384 + h * 96; a.ldq = 384; a.K = kvd + rb * 512 + h * 128; a.ldk = 512; a.V = kvd + rb * 512 + h * 128 + 64; a.ldv = 512;
      a.K2 = P + rb * NP + C_KR; a.ldk2 = NP; a.cs = (const f32x2*)(ws + OFF_ROPE) + rb * 16;
      attn_unit<AT_MLA>(lds, a, qb, cc, gi, pidx, qidx, cv);
    }
  }
  {
    __syncthreads();
    const LAS int* sc = (const LAS int*)(lds + 2 * ATT_BUF + 64);
    const int k = gi >> 3, used = gi & 7;
    const int b0 = __builtin_amdgcn_readfirstlane(sc[k & 1]);
    const int b1 = (used >= 1) ? __builtin_amdgcn_readfirstlane(sc[(k + 1) & 1]) : CMU_TOTAL;
    const int tid = get_tid(), lane = tid & 63, w = tid >> 6;
    if (qidx < CMU_TOTAL) cmu_from_lds(cc, qidx, lane, w, lds + 2 * ATT_BUF + 1024 + ((gi + 1) & 1) * 8192);
    if (pidx < CMU_TOTAL) cmu_store(cc, pidx, lane, w, cv);
#pragma unroll 1
    for (int j = used; j < 16; ++j) {
      const int ci = (j < 8) ? b0 + j : b1 + (j - 8);
      if (ci < CMU_TOTAL) { float v0[16]; cmu_load(cc, ci, lane, w, v0); cmu_store(cc, ci, lane, w, v0); }
    }
    __syncthreads();
  }
  for (;;) {
    if (get_tid() == 0) s_unit[0] = atomicAdd(cc.ctr, 2);
    __syncthreads();
    const int c0 = __builtin_amdgcn_readfirstlane(s_unit[0]);
    __syncthreads();
    if (c0 >= CMU_TOTAL) break;
    const int tid = get_tid(), lane = tid & 63, w = tid >> 6;
    float v0[16], v1[16];
    cmu_load(cc, c0, lane, w, v0);
    if (c0 + 1 < CMU_TOTAL) cmu_load(cc, c0 + 1, lane, w, v1);
    cmu_store(cc, c0, lane, w, v0);
    if (c0 + 1 < CMU_TOTAL) cmu_store(cc, c0 + 1, lane, w, v1);
  }
}

__device__ __forceinline__ size_t tmp_blocked(int row, int col) {
  return (size_t)(row >> 6) * 65536 + (size_t)((((((col >> 7) * 4 + ((col >> 5) & 3)) * 4 + ((col >> 3) & 3)) * 2 + ((row >> 5) & 1)) * 64 + (((col >> 2) & 1) * 32 + (row & 31))) * 4);
}
struct OutprojSched {
  int grid, bid;
  __device__ __forceinline__ bool next(int i, pg8::Unit& u) const {
    int mt, nt;
    if (grid == 256) { if (i > 0) return false; const int xcd = bid & 7, j = bid >> 3; mt = 8 * xcd + (j >> 2); nt = j & 3; }
    else { const int t = bid + i * grid; if (t >= 256) return false; mt = t >> 2; nt = t & 3; }
    u.boff = (unsigned)nt * (256u * 1024u * 2u); u.arow0 = mt * 256; u.mvalid = 256; u.e = 0; u.mt = mt; u.nt = nt; u.slot0 = 0;
    return true;
  }
};
struct OutprojEpi {
  static __device__ __forceinline__ int blane(int lrow) { return lrow; }
  static constexpr __device__ int bpiece(int h, int i) { return 128 * h + 64 * i; }
  const bf16_t* hB; float* tmp;
  __device__ __forceinline__ void operator()(const pg8::f32x4v (&acc)[2][2][4][2], const pg8::Unit& u, int wr, int wc, int fr, int fq) const {
#pragma unroll
    for (int ai = 0; ai < 2; ++ai)
#pragma unroll
      for (int m = 0; m < 4; ++m) {
        const int row = u.mt * 256 + 128 * ai + 64 * wr + 16 * m + fr;
#pragma unroll
        for (int bj = 0; bj < 2; ++bj)
#pragma unroll
          for (int n = 0; n < 2; ++n) {
            const int col = u.nt * 256 + 128 * bj + 32 * wc + 16 * n + 4 * fq;
            const u32x2 hb = *(const u32x2*)(hB + (size_t)row * DM + col);
            const pg8::f32x4v v = acc[ai][bj][m][n];
            *(f32x4*)(tmp + tmp_blocked(row, col)) = (f32x4){DN_ALPHA * bflo(hb.x) + v[0], DN_ALPHA * bfhi(hb.x) + v[1], DN_ALPHA * bflo(hb.y) + v[2], DN_ALPHA * bfhi(hb.y) + v[3]};
          }
      }
  }
};
__device__ __forceinline__ void phase_outproj(const Params& p, int layer, LAS unsigned char* lds) {
  unsigned char* ws = p.ws;
  OutprojSched S{get_nblk(), get_bid()};
  OutprojEpi E{(const bf16_t*)(ws + OFF_HB), (float*)(ws + OFF_TMPF)};
  pg8::gemm_phase<false, false>(lds, (const bf16_t*)(ws + OFF_MIX), (const bf16_t*)(ws + OFF_WOUT) + (size_t)layer * 1024 * 1024, S, E);
}

__device__ __forceinline__ void phase_ln1_router(const Params& p, int layer, LAS unsigned char* lds) {
  unsigned char* ws = p.ws;
  const float* tmp = (const float*)(ws + OFF_TMPF);
  float* hF = (float*)(ws + OFF_HF); bf16_t* hB = (bf16_t*)(ws + OFF_HB);
  int* ctrl = (int*)(ws + OFF_CTRL); int* cnt = ctrl + CW_CNT + layer * 32;
  int* list = (int*)(ws + OFF_LIST); int* toke = (int*)(ws + OFF_TOKE); float* tokg = (float*)(ws + OFF_TOKG);
  const float* Wr = p.router_w + (size_t)layer * DM * NE; const float* rb = p.router_b + layer * NE;
  const float* g1 = p.ln1_g + layer * DM; const float* b1 = p.ln1_b + layer * DM;
  LAS float* red = (LAS float*)lds;
  LAS float* lg = (LAS float*)(lds + 32768);
  LAS float* part = (LAS float*)(lds + 136192);
  LAS float* part2 = (LAS float*)(lds + 137216);
  LAS int* lcnt = (LAS int*)(lds + 138240);
#pragma unroll 1
  for (int hs = get_bid(); hs < M_TOK / 32; hs += get_nblk()) {
    const int m0 = hs * 32, mi = hs & 1;
    const int tid = get_tid(), lane = tid & 63, w = tid >> 6, c31 = lane & 31, hi = lane >> 5;
    f32x16 acc[4];
    {
      const float* tb = tmp + (size_t)(hs >> 1) * 65536 + (size_t)(w * 32 * 64 + lane) * 4;
#pragma unroll
      for (int ni = 0; ni < 4; ++ni)
#pragma unroll
        for (int g4 = 0; g4 < 4; ++g4) {
          const f32x4 v = *(const f32x4*)(tb + (size_t)(((ni * 4 + g4) * 2 + mi) * 64) * 4);
          acc[ni][4 * g4] = v.x; acc[ni][4 * g4 + 1] = v.y; acc[ni][4 * g4 + 2] = v.z; acc[ni][4 * g4 + 3] = v.w;
        }
    }
    float mean, rstd;
    {
      float sacc = 0.f;
#pragma unroll
      for (int ni = 0; ni < 4; ++ni)
#pragma unroll
        for (int r = 0; r < 16; ++r) sacc += acc[ni][r];
      float s0, s1; pair_vals(sacc, s0, s1);
      if (hi == 0) part[c31 * 8 + w] = s0 + s1;
    }
    __syncthreads();
    {
      const f32x4 pa = *(const LAS f32x4*)(part + c31 * 8), pb = *(const LAS f32x4*)(part + c31 * 8 + 4);
      mean = ((pa.x + pa.y) + (pa.z + pa.w) + (pb.x + pb.y) + (pb.z + pb.w)) * (1.f / DM);
      float q = 0.f;
#pragma unroll
      for (int ni = 0; ni < 4; ++ni)
#pragma unroll
        for (int r = 0; r < 16; ++r) { const float d = acc[ni][r] - mean; q += d * d; }
      float q0, q1; pair_vals(q, q0, q1);
      if (hi == 0) part2[c31 * 8 + w] = q0 + q1;
    }
    __syncthreads();
    {
      const f32x4 pa = *(const LAS f32x4*)(part2 + c31 * 8), pb = *(const LAS f32x4*)(part2 + c31 * 8 + 4);
      rstd = rsqrtf(((pa.x + pa.y) + (pa.z + pa.w) + (pb.x + pb.y) + (pb.z + pb.w)) * (1.f / DM) + LN_EPS);
    }
    LAS unsigned char* wt = lds + w * 16896;
#pragma unroll
    for (int ni = 0; ni < 4; ++ni)
#pragma unroll
      for (int g4 = 0; g4 < 4; ++g4) {
        const int n = 128 * w + ni * 32 + 8 * g4 + 4 * hi;
        const f32x4 gg = *(const f32x4*)(g1 + n), bb = *(const f32x4*)(b1 + n);
        f32x4 y;
        y.x = (acc[ni][4 * g4] - mean) * rstd * gg.x + bb.x; y.y = (acc[ni][4 * g4 + 1] - mean) * rstd * gg.y + bb.y;
        y.z = (acc[ni][4 * g4 + 2] - mean) * rstd * gg.z + bb.z; y.w = (acc[ni][4 * g4 + 3] - mean) * rstd * gg.w + bb.w;
        acc[ni][4 * g4] = y.x; acc[ni][4 * g4 + 1] = y.y; acc[ni][4 * g4 + 2] = y.z; acc[ni][4 * g4 + 3] = y.w;
        *(LAS f32x4*)(wt + c31 * 528 + (ni * 32 + 8 * g4 + 4 * hi) * 4) = y;
      }
    {
      const int cl = (lane & 31) * 4;
      const size_t off0 = (size_t)(m0 + hi) * DM + 128 * w + cl;
      bf16_t* pB = hB + off0; unsigned char* p8 = ws + OFF_H8 + off0;
      const LAS unsigned char* rp = wt + hi * 528 + cl * 4;
#pragma unroll 4
      for (int it = 0; it < 16; ++it) {
        const f32x4 y = *(const LAS f32x4*)rp;
        u32x2 o; o.x = cvtpk(y.x, y.y); o.y = cvtpk(y.z, y.w);
        *(u32x2*)pB = o;
        *(unsigned*)p8 = pk4_fp8(clamp448(y.x * S8_H), clamp448(y.y * S8_H), clamp448(y.z * S8_H), clamp448(y.w * S8_H));
        rp += 2 * 528; pB += 2 * DM; p8 += 2 * DM;
      }
    }
    f32x16 D0;
#pragma unroll
    for (int r = 0; r < 16; ++r) D0[r] = 0.f;
    {
      const float* wrp = Wr + (128 * w + 4 * hi) * 32 + c31;
      float wa[16], wb[16];
#pragma unroll
      for (int r = 0; r < 16; ++r) wa[r] = wrp[(8 * (r >> 2) + (r & 3)) * 32];
#pragma unroll
      for (int ni = 0; ni < 4; ++ni) {
        __builtin_amdgcn_sched_barrier(0);
        if (ni < 3) {
#pragma unroll
          for (int r = 0; r < 16; ++r) wb[r] = wrp[((ni + 1) * 32 + 8 * (r >> 2) + (r & 3)) * 32];
        }
        __builtin_amdgcn_sched_barrier(0);
#pragma unroll
        for (int r = 0; r < 16; ++r) D0 = __builtin_amdgcn_mfma_f32_32x32x2f32(acc[ni][r], wa[r], D0, 0, 0, 0);
        __builtin_amdgcn_sched_barrier(0);
#pragma unroll
        for (int r = 0; r < 16; ++r) wa[r] = wb[r];
      }
    }
    __syncthreads();
#pragma unroll
    for (int r = 0; r < 16; ++r) red[(w * 32 + crow(r, hi)) * 32 + c31] = D0[r];
    __syncthreads();
#pragma unroll
    for (int i = 0; i < 2; ++i) {
      const int idx = tid + 512 * i;
      float sv = rb[idx & 31];
#pragma unroll
      for (int ww = 0; ww < 8; ++ww) sv += red[ww * 1024 + idx];
      lg[(idx & 31) * 32 + (idx >> 5)] = sv;
    }
    if (tid < 32) lcnt[tid] = 0;
    __syncthreads();
    float gt[4]; int li[4], rk[4];
    if (tid < 32) {
      float lv[4]; unsigned used = 0u;
#pragma unroll
      for (int k = 0; k < 4; ++k) {
        float best = -INFINITY; int bi = 0;
        for (int e = 0; e < 32; ++e) { const float v = lg[e * 32 + tid]; if (!((used >> e) & 1u) && v > best) { best = v; bi = e; } }
        used |= 1u << bi; lv[k] = best; li[k] = bi;
      }
      float sm = 0.f;
#pragma unroll
      for (int k = 0; k < 4; ++k) { gt[k] = expf(lv[k] - lv[0]); sm += gt[k]; }
      const float inv = 1.f / sm;
#pragma unroll
      for (int k = 0; k < 4; ++k) { gt[k] *= inv; rk[k] = __hip_atomic_fetch_add(&lcnt[li[k]], 1, __ATOMIC_RELAXED, __HIP_MEMORY_SCOPE_WORKGROUP); }
    }
    __syncthreads();
    if (tid < 32) { const int c = lcnt[tid]; lcnt[32 + tid] = c ? atomicAdd(&cnt[tid], c) : 0; }
    __syncthreads();
    if (tid < 32) {
      const int m = m0 + tid;
#pragma unroll
      for (int k = 0; k < 4; ++k) {
        const int ps = lcnt[32 + li[k]] + rk[k];
        list[li[k] * M_TOK + ps] = m;
        toke[m * 4 + k] = (li[k] << 16) | ps;
        tokg[m * 4 + k] = gt[k];
      }
    }
    __syncthreads();
  }
}

__device__ __forceinline__ void moe_prefix(const int* cnt, LAS int* s_start, LAS int* s_tstart, LAS int* s_cnt) {
  if (get_tid() < 64) {
    const int lane = get_tid();
    const int c = (lane < 32) ? cnt[lane] : 0;
    const int tl = (c + 255) >> 8;
    int ic = c, it = tl;
#pragma unroll
    for (int o = 1; o < 32; o <<= 1) { const int a = __shfl_up(ic, o), b = __shfl_up(it, o); if (lane >= o) { ic += a; it += b; } }
    if (lane < 32) { s_cnt[lane] = c; s_start[lane] = ic - c; s_tstart[lane] = it - tl; }
    if (lane == 31) { s_start[32] = ic; s_tstart[32] = it; }
  }
  __syncthreads();
}

struct MoeSched {
  unsigned estride; int NT, total_mt, grid, bid; const LAS int* s_start; const LAS int* s_tstart; const LAS int* s_cnt;
  __device__ __forceinline__ bool next(int i, pg8::Unit& u) const {
    int mtg, nt; bool ok;
    if (grid == 256) { const int MG = 32 / NT; const int xcd = bid & 7, j = bid >> 3; mtg = MG * (xcd + 8 * i) + j / NT; nt = j % NT; ok = (MG * (8 * i) < total_mt); }
    else { const int item = bid + i * grid; ok = (item < total_mt * NT); mtg = item / NT; nt = item % NT; }
    const bool live = ok && (mtg < total_mt);
    const int mq = live ? mtg : 0;
    const int ln_ = (int)(threadIdx.x & 63);
    const int tend_ = s_tstart[(ln_ < 32 ? ln_ : 31) + 1];
    const int e = (int)__builtin_popcountll(__ballot(ln_ < 32 && tend_ <= mq));
    const int mt = mq - __builtin_amdgcn_readfirstlane(s_tstart[e]);
    const int mv = live ? min(256, __builtin_amdgcn_readfirstlane(s_cnt[e]) - mt * 256) : 0;
    const int sl = __builtin_amdgcn_readfirstlane(s_start[e]) + mt * 256;
    const unsigned bo = (unsigned)e * estride + (unsigned)nt * (256u * 1024u);
    u.boff = bo; u.arow0 = i; u.mvalid = mv; u.e = e; u.mt = mt; u.nt = nt; u.slot0 = sl;
    return ok;
  }
};
struct MoeUpEpi {
  static __device__ __forceinline__ int blane(int lrow) { return 64 * (lrow >> 5) + (lrow & 31); }
  static constexpr __device__ int bpiece(int h, int i) { return 128 * i + 32 * h; }
  unsigned char* act; const LAS float* btab;
  __device__ __forceinline__ void operator()(const pg8::f32x4v (&acc)[2][2][4][2], const pg8::Unit& u, int wr, int wc, int fr, int fq) const {
    constexpr float US = 1.f / (S8_H * S8_WGU);
    constexpr float KEXP = -1.702f * LOG2E;
    const LAS float* bt = btab + u.arow0 * 256 + 32 * wc + 4 * fq;
    f32x4 bg[2], bl[2];
#pragma unroll
    for (int bj = 0; bj < 2; ++bj) { bg[bj] = *(const LAS f32x4*)(bt + 16 * bj); bl[bj] = *(const LAS f32x4*)(bt + 128 + 16 * bj); }
#pragma unroll
    for (int ai = 0; ai < 2; ++ai) {
      const int rbase = 128 * ai + 64 * wr;
      if (rbase < u.mvalid) {
        unsigned V[4][2];
#pragma unroll
        for (int m = 0; m < 4; ++m)
#pragma unroll
          for (int bj = 0; bj < 2; ++bj) {
            const f32x4 gx = acc[ai][bj][m][0] * US + bg[bj], lx = acc[ai][bj][m][1] * US + bl[bj];
            f32x4 gl, ln, ex;
#pragma unroll
            for (int i = 0; i < 4; ++i) { gl[i] = fminf(gx[i], 7.f); ln[i] = __builtin_amdgcn_fmed3f(lx[i], -7.f, 7.f); }
            const f32x4 ea = gl * KEXP;
#pragma unroll
            for (int i = 0; i < 4; ++i) ex[i] = __builtin_amdgcn_exp2f(ea[i]);
            const f32x4 den = ex + 1.f;
            f32x4 sg;
#pragma unroll
            for (int i = 0; i < 4; ++i) sg[i] = __builtin_amdgcn_rcpf(den[i]);
            const f32x4 o = (gl * sg) * (ln * S8_ACT + S8_ACT);
            V[m][bj] = pk4_fp8(o[0], o[1], o[2], o[3]);
          }
#pragma unroll
        for (int m1 = 0; m1 < 2; ++m1) {
          unsigned r0 = V[2 * m1][0], r1 = V[2 * m1][1], r2 = V[2 * m1 + 1][0], r3 = V[2 * m1 + 1][1];
          { auto t = __builtin_amdgcn_permlane32_swap(r0, r2, false, false); r0 = t[0]; r2 = t[1]; }
          { auto t = __builtin_amdgcn_permlane32_swap(r1, r3, false, false); r1 = t[0]; r3 = t[1]; }
          { auto t = __builtin_amdgcn_permlane16_swap(r0, r1, false, false); r0 = t[0]; r1 = t[1]; }
          { auto t = __builtin_amdgcn_permlane16_swap(r2, r3, false, false); r2 = t[0]; r3 = t[1]; }
          const int rl = rbase + 16 * (2 * m1 + (fq >> 1)) + fr;
          if (rl < u.mvalid) { u32x4 ov; ov.x = r0; ov.y = r1; ov.z = r2; ov.w = r3; *(u32x4*)(act + (size_t)(u.slot0 + rl) * DFF + 128 * u.nt + 32 * wc + 16 * (fq & 1)) = ov; }
        }
      }
    }
  }
};
struct MoeDownEpi {
  static __device__ __forceinline__ int blane(int lrow) { return (lrow & 32) + 8 * ((lrow & 15) >> 2) + 4 * ((lrow >> 4) & 1) + (lrow & 3); }
  static constexpr __device__ int bpiece(int h, int i) { return 128 * h + 64 * i; }
  bf16_t* yb; const LAS float* btab;
  __device__ __forceinline__ void operator()(const pg8::f32x4v (&acc)[2][2][4][2], const pg8::Unit& u, int wr, int wc, int fr, int fq) const {
    constexpr float us = 1.f / (S8_ACT * S8_WDN);
    const LAS float* bt = btab + u.e * 256 + 32 * wc + 8 * fq;
    f32x4 b4[2][2];
#pragma unroll
    for (int bj = 0; bj < 2; ++bj)
#pragma unroll
      for (int n = 0; n < 2; ++n) b4[bj][n] = *(const LAS f32x4*)(bt + 128 * bj + 4 * n);
#pragma unroll
    for (int ai = 0; ai < 2; ++ai)
#pragma unroll
      for (int m = 0; m < 4; ++m) {
        const int rl = 128 * ai + 64 * wr + 16 * m + fr;
        if (rl < u.mvalid) {
          bf16_t* orow = yb + (size_t)(u.slot0 + rl) * DM + u.nt * 256 + 32 * wc + 8 * fq;
#pragma unroll
          for (int bj = 0; bj < 2; ++bj) {
            const pg8::f32x4v v = acc[ai][bj][m][0], w = acc[ai][bj][m][1];
            u32x4 ov;
            ov.x = cvtpk(fmaf(v[0], us, b4[bj][0].x), fmaf(v[1], us, b4[bj][0].y)); ov.y = cvtpk(fmaf(v[2], us, b4[bj][0].z), fmaf(v[3], us, b4[bj][0].w));
            ov.z = cvtpk(fmaf(w[0], us, b4[bj][1].x), fmaf(w[1], us, b4[bj][1].y)); ov.w = cvtpk(fmaf(w[2], us, b4[bj][1].z), fmaf(w[3], us, b4[bj][1].w));
            *(u32x4*)(orow + 128 * bj) = ov;
          }
        }
      }
  }
};
__device__ __forceinline__ void phase_moe_up(const Params& p, int layer, LAS unsigned char* lds) {
  unsigned char* ws = p.ws;
  const int* cnt = (const int*)(ws + OFF_CTRL) + CW_CNT + layer * 32;
  const int* list = (const int*)(ws + OFF_LIST);
  LAS int* s_start = (LAS int*)(lds + LDS_GEMM); LAS int* s_tstart = s_start + 40; LAS int* s_cnt = s_start + 80;
  moe_prefix(cnt, s_start, s_tstart, s_cnt);
  MoeSched S{2048u * 1024u, 8, __builtin_amdgcn_readfirstlane(s_tstart[32]), get_nblk(), get_bid(), s_start, s_tstart, s_cnt};
  {
    const int tid = get_tid();
    LAS int* rowtab = (LAS int*)(lds + LDS_ROWTAB);
    LAS float* btab = (LAS float*)(lds + LDS_BIASTAB);
    const float* bgu = p.b_gate_up + (size_t)layer * NE * 2048;
    unsigned vals[12]; bool okv[12];
#pragma unroll
    for (int i = 0; i < 12; ++i) {
      pg8::Unit u;
      okv[i] = S.next(i, u);
      vals[i] = 0u;
      if (okv[i]) {
        if (tid < 256) { if (u.mvalid > 0) vals[i] = (unsigned)list[u.e * M_TOK + u.mt * 256 + min(tid, u.mvalid - 1)]; }
        else { const int c = tid - 256; vals[i] = __float_as_uint(bgu[(size_t)u.e * 2048 + (c >> 7) * 1024 + u.nt * 128 + (c & 127)]); }
      }
    }
#pragma unroll
    for (int i = 0; i < 12; ++i) {
      if (okv[i]) { if (tid < 256) rowtab[i * 256 + tid] = (int)vals[i]; else btab[i * 256 + (tid - 256)] = __uint_as_float(vals[i]); }
    }
    __syncthreads();
  }
  MoeUpEpi E{(unsigned char*)(ws + OFF_ACT), (const LAS float*)(lds + LDS_BIASTAB)};
  pg8::gemm_phase<true, true>(lds, (const bf16_t*)(ws + OFF_H8), (const bf16_t*)(ws + OFF_WGU + (size_t)layer * NE * 2048 * 1024), S, E);
}
struct MoeDownSched {
  MoeSched base;
  __device__ __forceinline__ bool next(int i, pg8::Unit& u) const { const bool ok = base.next(i, u); if (ok) { u.arow0 = u.slot0; u.e = i; } return ok; }
};
__device__ __forceinline__ void phase_moe_down(const Params& p, int layer, LAS unsigned char* lds) {
  unsigned char* ws = p.ws;
  const int* cnt = (const int*)(ws + OFF_CTRL) + CW_CNT + layer * 32;
  LAS int* s_start = (LAS int*)(lds + LDS_GEMM); LAS int* s_tstart = s_start + 40; LAS int* s_cnt = s_start + 80;
  moe_prefix(cnt, s_start, s_tstart, s_cnt);
  MoeDownSched S{MoeSched{1024u * 1024u, 4, __builtin_amdgcn_readfirstlane(s_tstart[32]), get_nblk(), get_bid(), s_start, s_tstart, s_cnt}};
  {
    const int tid = get_tid();
    LAS float* btab = (LAS float*)(lds + LDS_BIASTAB);
    const float* bd = p.b_down + (size_t)layer * NE * 1024;
    float vals[12]; bool okv[12];
#pragma unroll
    for (int i = 0; i < 12; ++i) {
      pg8::Unit u;
      okv[i] = S.base.next(i, u);
      vals[i] = 0.f;
      if (okv[i] && tid < 256) vals[i] = bd[(size_t)u.e * 1024 + u.nt * 256 + tid];
    }
#pragma unroll
    for (int i = 0; i < 12; ++i)
      if (okv[i] && tid < 256) btab[i * 256 + tid] = vals[i];
    __syncthreads();
  }
  MoeDownEpi E{(bf16_t*)(ws + OFF_Y), (const LAS float*)(lds + LDS_BIASTAB)};
  pg8::gemm_phase<false, true>(lds, (const bf16_t*)(ws + OFF_ACT), (const bf16_t*)(ws + OFF_WD + (size_t)layer * NE * 1024 * 1024), S, E);
}

__device__ __forceinline__ void phase_combine_ln2(const Params& p, int layer, LAS unsigned char* lds) {
  unsigned char* ws = p.ws;
  const bf16_t* yb = (const bf16_t*)(ws + OFF_Y);
  float* hF = (float*)(ws + OFF_HF); bf16_t* hB = (bf16_t*)(ws + OFF_HB);
  const int* cnt = (const int*)(ws + OFF_CTRL) + CW_CNT + layer * 32;
  const int* toke = (const int*)(ws + OFF_TOKE); const float* tokg = (const float*)(ws + OFF_TOKG);
  LAS int* s_start = (LAS int*)(lds + LDS_GEMM); LAS int* s_tstart = s_start + 40; LAS int* s_cnt = s_start + 80;
  moe_prefix(cnt, s_start, s_tstart, s_cnt);
  const float* g2 = p.ln2_g + layer * DM; const float* b2 = p.ln2_b + layer * DM;
  const bool last = (layer == DEPTH - 1);
  const int lane = get_tid() & 63, gw = get_bid() * 8 + (get_tid() >> 6), ngw = get_nblk() * 8;
  for (int m = gw; m < M_TOK; m += ngw) {
    f32x4 v[4];
#pragma unroll
    for (int j = 0; j < 4; ++j) { const u32x2 hb = *(const u32x2*)(hB + (size_t)m * DM + 4 * lane + 256 * j); v[j] = (f32x4){bflo(hb.x), bfhi(hb.x), bflo(hb.y), bfhi(hb.y)} * DN_ALPHA; }
#pragma unroll
    for (int k = 0; k < 4; ++k) {
      const int ep = toke[m * 4 + k]; const float gt = tokg[m * 4 + k];
      const int slot = s_start[ep >> 16] + (ep & 0xffff);
      const bf16_t* yr = yb + (size_t)slot * DM;
#pragma unroll
      for (int j = 0; j < 4; ++j) {
        const u32x2 a = *(const u32x2*)(yr + 4 * lane + 256 * j);
        v[j].x += gt * bflo(a.x); v[j].y += gt * bfhi(a.x); v[j].z += gt * bflo(a.y); v[j].w += gt * bfhi(a.y);
      }
    }
    ln_row(v, g2, b2, lane);
    if (last) store_row_f32_bf16(v, p.out + (size_t)m * DM, nullptr, lane);
    else store_row_f32_bf16(v, nullptr, hB + (size_t)m * DM, lane);
  }
}

#if defined(__HIP_DEVICE_COMPILE__)
#define PH(call) do { const __attribute__((address_space(4))) Params* q_ = pp; asm volatile("" : "+s"(q_)); Params p; __builtin_memcpy(&p, q_, sizeof(Params)); call; } while (0)
#else
#define PH(call) do { const Params& p = p_unused; (void)pp; call; } while (0)
#endif
__global__ void __launch_bounds__(512) fwd_kernel(Params p_unused) {
  cg::grid_group grid = cg::this_grid();
  extern __shared__ __attribute__((aligned(16))) unsigned char smem[];
  LAS unsigned char* lds = (LAS unsigned char*)smem;
  const __attribute__((address_space(4))) Params* pp = (const __attribute__((address_space(4))) Params*)__builtin_amdgcn_kernarg_segment_ptr();
  if (threadIdx.x < 4) ((volatile LAS unsigned*)(lds + LDS_MISC))[threadIdx.x] = 0u;
  __syncthreads();
#define GRID_BAR() do { XcdBarrier b_; PH(b_.bar = (unsigned*)(p.ws + OFF_CTRL) + CW_BAR); b_.x = xb_xcc_id(); b_.st = (volatile LAS unsigned*)(lds + LDS_MISC); xcd_barrier(b_); } while (0)
  { unsigned* bw; PH(bw = (unsigned*)(p.ws + OFF_CTRL) + CW_BAR); (void)xcd_barrier_post(bw, (volatile LAS unsigned*)(lds + LDS_MISC)); }
  PH(phase_convert(p));
  PH(phase_prologue_misc(p));
  grid.sync();
#pragma unroll 1
  for (int layer = 0; layer < DEPTH; ++layer) {
    PH(phase_inproj(p, layer, lds));
    GRID_BAR();
    PH(phase_mla_up(p, layer, lds));
    GRID_BAR();
    PH(phase_attention(p, layer, lds));
    GRID_BAR();
    PH(phase_outproj(p, layer, lds));
    GRID_BAR();
    PH(phase_ln1_router(p, layer, lds));
    GRID_BAR();
    PH(phase_moe_up(p, layer, lds));
    GRID_BAR();
    PH(phase_moe_down(p, layer, lds));
    GRID_BAR();
    PH(phase_combine_ln2(p, layer, lds));
    if (layer + 1 < DEPTH) GRID_BAR();
  }
}

extern "C" void kernel_launch(void* const* d_in, const int* in_sizes, int n_in, void* d_out, int out_size,
                              void* d_ws, size_t ws_size, hipStream_t stream) {
  static int grid_blocks = 0;
  if (!grid_blocks) {
    int dev = 0, cus = 0, per_cu = 0;
    (void)hipGetDevice(&dev);
    (void)hipDeviceGetAttribute(&cus, hipDeviceAttributeMultiprocessorCount, dev);
    (void)hipFuncSetAttribute((const void*)fwd_kernel, hipFuncAttributeMaxDynamicSharedMemorySize, LDS_BYTES);
    (void)hipOccupancyMaxActiveBlocksPerMultiprocessor(&per_cu, fwd_kernel, 512, LDS_BYTES);
    if (per_cu < 1) { fprintf(stderr, "kernel_launch: occupancy query returned %d\n", per_cu); per_cu = 1; }
    if (per_cu > 1) per_cu = 1;
    grid_blocks = cus * per_cu;
    if (n_in != 23 || ws_size < WS_END) { fprintf(stderr, "kernel_launch: unexpected n_in %d or ws_size %zu (< %zu)\n", n_in, ws_size, (size_t)WS_END); }
  }
  if (ws_size < WS_END) return;
  (void)hipMemsetAsync((char*)d_ws + OFF_CTRL, 0, CTRL_BYTES, stream);
  Params p{};
  p.x = (const float*)d_in[0]; p.pos = (const int*)d_in[1]; p.ln_in_g = (const float*)d_in[2]; p.ln_in_b = (const float*)d_in[3];
  p.w_in = (const float*)d_in[4]; p.b_forget = (const float*)d_in[5]; p.diff_lambda = (const float*)d_in[6]; p.diff_subln_g = (const float*)d_in[7];
  p.mla_q_norm_g = (const float*)d_in[8]; p.mla_w_uq = (const float*)d_in[9]; p.mla_kv_norm_g = (const float*)d_in[10]; p.mla_w_ukv = (const float*)d_in[11];
  p.w_out = (const float*)d_in[12]; p.ln1_g = (const float*)d_in[13]; p.ln1_b = (const float*)d_in[14]; p.router_w = (const float*)d_in[15];
  p.router_b = (const float*)d_in[16]; p.w_gate_up = (const float*)d_in[17]; p.b_gate_up = (const float*)d_in[18]; p.w_down = (const float*)d_in[19];
  p.b_down = (const float*)d_in[20]; p.ln2_g = (const float*)d_in[21]; p.ln2_b = (const float*)d_in[22];
  p.out = (float*)d_out; p.ws = (unsigned char*)d_ws;
  void* args[] = {&p};
  hipError_t e = hipLaunchCooperativeKernel((void*)fwd_kernel, dim3(grid_blocks), dim3(512), args, LDS_BYTES, stream);
  if (e != hipSuccess) fprintf(stderr, "cooperative launch failed: %s (grid %d)\n", hipGetErrorString(e), grid_blocks);
}
```

```cpp
#include <hip/hip_runtime.h>
#include <hip/hip_cooperative_groups.h>
#include <cstdio>
#include <cstdint>
namespace cg = cooperative_groups;

#define LAS __attribute__((address_space(3)))
typedef unsigned short bf16_t;
typedef short bf16x8 __attribute__((ext_vector_type(8)));
typedef short s16x4 __attribute__((ext_vector_type(4)));
typedef float f32x16 __attribute__((ext_vector_type(16)));
typedef float f32x4 __attribute__((ext_vector_type(4)));
typedef float f32x2 __attribute__((ext_vector_type(2)));
typedef unsigned u32x4 __attribute__((ext_vector_type(4)));
typedef unsigned u32x2 __attribute__((ext_vector_type(2)));
typedef __bf16 bf16x2_t __attribute__((ext_vector_type(2)));

constexpr int M_TOK = 16384, DM = 1024, SEQ = 4096, NBATCH = 4, DEPTH = 2;
constexpr int NP = 2816;
constexpr int NE = 32, DFF = 1024, TOPK = 4;
constexpr int C_SBQ = 0, C_SBK = 256, C_SBV = 512, C_DFQ = 768, C_DFK = 1024, C_DFV = 1280, C_FXQ = 1536, C_FXK = 1792, C_FXV = 2048,
              C_CQ = 2304, C_CKV = 2560, C_KR = 2688, C_FXF = 2720, C_END = 2724;
constexpr float LOG2E = 1.4426950408889634f;
constexpr float DN_ALPHA = 1.4142135623730951f;
constexpr float LN_EPS = 1e-5f, RMS_EPS = 1e-6f;
constexpr float S8_H = 16.f, S8_WGU = 64.f, S8_ACT = 8.f, S8_WDN = 128.f;

constexpr size_t MB = 1ull << 20;
constexpr size_t OFF_CTRL = 0, CTRL_BYTES = 65536;
constexpr size_t OFF_ROPE = 1 * MB;
constexpr size_t OFF_GATEF = 3 * MB;
constexpr size_t OFF_FK = 3 * MB + 512 * 1024;
constexpr size_t OFF_LIST = 4 * MB;
constexpr size_t OFF_TOKE = 6 * MB;
constexpr size_t OFF_TOKG = 6 * MB + 512 * 1024;
constexpr size_t OFF_WUQ = 7 * MB;
constexpr size_t OFF_WUKV = 7 * MB + 512 * 1024;
constexpr size_t OFF_WOUT = 8 * MB;
constexpr size_t OFF_WIN = 12 * MB;
constexpr size_t OFF_HF = 24 * MB;
constexpr size_t OFF_HB = 88 * MB;
constexpr size_t OFF_P = 120 * MB;
constexpr size_t OFF_CQN = 208 * MB;
constexpr size_t OFF_CKVN = 216 * MB;
constexpr size_t OFF_QD = 220 * MB;
constexpr size_t OFF_KVD = 232 * MB;
constexpr size_t OFF_MIX = 248 * MB;
constexpr size_t OFF_TMPF = 280 * MB;
constexpr size_t OFF_KN = 3 * MB + 768 * 1024;
constexpr size_t OFF_H8 = 220 * MB;
constexpr size_t OFF_ACT = 344 * MB;
constexpr size_t OFF_Y = 473 * MB;
constexpr size_t OFF_WGU = 602 * MB;
constexpr size_t OFF_WD = 858 * MB;
constexpr size_t WS_END = 986 * MB;
constexpr int CW_CNT = 0;
constexpr int CW_ATTQ = 128;
constexpr int CW_LAM = 160;
constexpr int CW_CONVQ = 192;
constexpr int CW_BAR = 4096;

constexpr int LDS_ROWTAB = 131072;
constexpr int LDS_GEMM = 143360;
constexpr int LDS_MISC = LDS_GEMM + 1024;
constexpr int LDS_BIASTAB = 147456;
constexpr int LDS_BYTES = 159744;

struct Params {
  const float* x; const int* pos; const float* ln_in_g; const float* ln_in_b; const float* w_in; const float* b_forget;
  const float* diff_lambda; const float* diff_subln_g; const float* mla_q_norm_g; const float* mla_w_uq; const float* mla_kv_norm_g;
  const float* mla_w_ukv; const float* w_out; const float* ln1_g; const float* ln1_b; const float* router_w; const float* router_b;
  const float* w_gate_up; const float* b_gate_up; const float* w_down; const float* b_down; const float* ln2_g; const float* ln2_b;
  float* out; unsigned char* ws;
};

__device__ __forceinline__ unsigned cvtpk(float lo, float hi) { f32x2 v = {lo, hi}; bf16x2_t b = __builtin_convertvector(v, bf16x2_t); return __builtin_bit_cast(unsigned, b); }
__device__ __forceinline__ unsigned pk4_fp8(float a, float b, float c, float d) {
  int w = __builtin_amdgcn_cvt_pk_fp8_f32(a, b, 0, false);
  w = __builtin_amdgcn_cvt_pk_fp8_f32(c, d, w, true);
  return (unsigned)w;
}
__device__ __forceinline__ float clamp448(float x) { return fminf(fmaxf(x, -448.f), 448.f); }
__device__ __forceinline__ float bf2f(unsigned short b) { return __uint_as_float(((unsigned)b) << 16); }
__device__ __forceinline__ float bflo(unsigned w) { return __uint_as_float(w << 16); }
__device__ __forceinline__ float bfhi(unsigned w) { return __uint_as_float(w & 0xffff0000u); }
__device__ __forceinline__ float wave_sum(float v) {
#pragma unroll
  for (int o = 1; o < 64; o <<= 1) v += __shfl_xor(v, o);
  return v;
}
__device__ __forceinline__ int get_bid() { int b = blockIdx.x; asm volatile("" : "+s"(b)); return b; }
__device__ __forceinline__ int get_nblk() { int g = gridDim.x; asm volatile("" : "+s"(g)); return g; }
__device__ __forceinline__ int get_tid() { int t = threadIdx.x; asm volatile("" : "+v"(t)); return t; }
__device__ __forceinline__ int crow(int r, int hi) { return (r & 3) + 8 * (r >> 2) + 4 * hi; }
__device__ __forceinline__ void pair_vals(float v, float& v0, float& v1) {
  auto rr = __builtin_amdgcn_permlane32_swap(__float_as_uint(v), __float_as_uint(v), false, false);
  v0 = __uint_as_float(rr[0]); v1 = __uint_as_float(rr[1]);
}


#define XB_TMO      128
#define XB_XCNT(j)  (256  + 64 * (j))
#define XB_XSUB(j)  (1280 + 64 * (j))
#define XB_XGEN(j)  (2304 + 64 * (j))
#define XB_TOP      3328
#define XB_TOPGEN   3392
#define XCD_BAR_WORDS 3456
#define XB_SPIN_CAP (1u << 22)
__device__ __forceinline__ unsigned xb_ld(unsigned* p)              { return __hip_atomic_load(p, __ATOMIC_RELAXED, __HIP_MEMORY_SCOPE_AGENT); }
__device__ __forceinline__ unsigned xb_add(unsigned* p, unsigned v) { return __hip_atomic_fetch_add(p, v, __ATOMIC_RELAXED, __HIP_MEMORY_SCOPE_AGENT); }
__device__ __forceinline__ unsigned xb_xcc_id() { return (unsigned)__builtin_amdgcn_s_getreg((3 << 11) | 20) & 0xFu; }
#define XB_SPIN(cond, bar) do { unsigned _sp = 0; while (cond) { __builtin_amdgcn_s_sleep(1); \
    if ((++_sp & 255u) == 0u) { if (xb_ld(&(bar)[XB_TMO])) break; if (_sp > XB_SPIN_CAP) { atomicAdd(&(bar)[XB_TMO], 1u); break; } } } } while (0)
struct XcdBarrier { unsigned* bar; unsigned x; volatile LAS unsigned* st; };
__device__ __forceinline__ XcdBarrier xcd_barrier_post(unsigned* bar, volatile LAS unsigned* st) {
  XcdBarrier b; b.bar = bar; b.x = xb_xcc_id(); b.st = st;
  if (threadIdx.x == 0) (void)xb_add(&bar[XB_XCNT(b.x)], 1u);
  return b;
}
__device__ __forceinline__ void xcd_barrier_complete(unsigned* bar, unsigned x, unsigned& nloc, unsigned& nx) {
  const unsigned G = gridDim.x * gridDim.y * gridDim.z;
  unsigned sum, cnt, mine, sp = 0u;
  for (;;) {
    sum = 0u; cnt = 0u; mine = 0u;
#pragma unroll
    for (unsigned j = 0; j < 16; ++j) { const unsigned c = xb_ld(&bar[XB_XCNT(j)]); sum += c; cnt += (c > 0u) ? 1u : 0u; mine = (j == x) ? c : mine; }
    if (sum == G) break;
    __builtin_amdgcn_s_sleep(1);
    if ((++sp & 255u) == 0u) { if (xb_ld(&bar[XB_TMO])) break; if (sp > XB_SPIN_CAP) { atomicAdd(&bar[XB_TMO], 1u); break; } }
  }
  nloc = mine > 0u ? mine : 1u; nx = cnt > 0u ? cnt : 1u;
}
__device__ __forceinline__ void xcd_barrier(const XcdBarrier& b) {
  asm volatile("s_waitcnt vmcnt(0)" ::: "memory");
  __syncthreads();
  if (threadIdx.x == 0) {
    unsigned* bar = b.bar;
    __builtin_amdgcn_s_waitcnt(0);
    unsigned nloc = b.st[0], nx = b.st[1];
    if (nloc == 0u) { xcd_barrier_complete(bar, b.x, nloc, nx); b.st[0] = nloc; b.st[1] = nx; }
    const unsigned old = xb_add(&bar[XB_XSUB(b.x)], 1u);
    const unsigned gen = old / nloc;
    if (old + 1u == (gen + 1u) * nloc) {
      __builtin_amdgcn_fence(__ATOMIC_RELEASE, "agent");
      asm volatile("s_waitcnt vmcnt(0)" ::: "memory");
      const unsigned og = xb_add(&bar[XB_TOP], 1u);
      const unsigned tg = og / nx;
      if (og + 1u == (tg + 1u) * nx) xb_add(&bar[XB_TOPGEN], 1u);
      else XB_SPIN(xb_ld(&bar[XB_TOPGEN]) == tg, bar);
      __builtin_amdgcn_fence(__ATOMIC_ACQUIRE, "agent");
      xb_add(&bar[XB_XGEN(b.x)], 1u);
      asm volatile("s_waitcnt vmcnt(0)" ::: "memory");
    } else {
      XB_SPIN(xb_ld(&bar[XB_XGEN(b.x)]) == gen, bar);
      __builtin_amdgcn_fence(__ATOMIC_ACQUIRE, "agent");
      asm volatile("s_waitcnt vmcnt(0)" ::: "memory");
    }
  }
  __syncthreads();
}

struct ConvDesc { const float* src; bf16_t* dst; const float* kscale; int K, Ndst, srcld, mode, kb, nb; };
constexpr int CV_U_IN = 16 * 11, CV_U_OUT = 16 * 4, CV_U_UQ = 4 * 2, CV_U_UKV = 2 * 2;
constexpr int CV_SMALL = 2 * (CV_U_IN + CV_U_OUT + CV_U_UQ + CV_U_UKV);
__device__ __forceinline__ bool conv_desc(const Params& p, int u, ConvDesc& d) {
  unsigned char* ws = p.ws;
  constexpr int T_IN = 2 * CV_U_IN, T_OUT = 2 * CV_U_OUT, T_UQ = 2 * CV_U_UQ;
  const float* src; bf16_t* dst; const float* ksc = nullptr; int K, Ndst, srcld, mode, q, nbn;
  int r = u;
  if (r < T_IN) { const int inst = r / CV_U_IN; q = r % CV_U_IN; src = p.w_in + (size_t)inst * 1024 * 2724; dst = (bf16_t*)(ws + OFF_WIN) + (size_t)inst * NP * 1024; K = 1024; Ndst = NP; srcld = 2724; mode = 1; nbn = 11; }
  else if ((r -= T_IN) < T_OUT) { const int inst = r / CV_U_OUT; q = r % CV_U_OUT; src = p.w_out + (size_t)inst * 1024 * 1024; dst = (bf16_t*)(ws + OFF_WOUT) + (size_t)inst * 1024 * 1024; K = 1024; Ndst = 1024; srcld = 1024; mode = 0; nbn = 4; }
  else if ((r -= T_OUT) < T_UQ) { const int inst = r / CV_U_UQ; q = r % CV_U_UQ; src = p.mla_w_uq + (size_t)inst * 256 * 384; dst = (bf16_t*)(ws + OFF_WUQ) + (size_t)inst * 384 * 256; K = 256; Ndst = 384; srcld = 384; mode = 0; nbn = 2; ksc = p.mla_q_norm_g + inst * 256; }
  else { r -= T_UQ; const int inst = r / CV_U_UKV; q = r % CV_U_UKV; src = p.mla_w_ukv + (size_t)inst * 128 * 512; dst = (bf16_t*)(ws + OFF_WUKV) + (size_t)inst * 512 * 128; K = 128; Ndst = 512; srcld = 512; mode = 0; nbn = 2; ksc = p.mla_kv_norm_g + inst * 128; }
  d.src = src; d.dst = dst; d.kscale = ksc; d.K = K; d.Ndst = Ndst; d.srcld = srcld; d.mode = mode; d.kb = q / nbn; d.nb = q % nbn;
  return u < CV_SMALL;
}
__device__ __forceinline__ void conv_load(const ConvDesc& d, float (&v)[4][8], int lane, int w) {
  const int k0 = d.kb * 64 + 8 * w;
#pragma unroll
  for (int u = 0; u < 4; ++u) {
    const int n = d.nb * 256 + u * 64 + lane;
    int sc = n; bool ok = n < d.Ndst;
    if (d.mode == 1) { if (n < 2304) sc = n; else if (n < C_FXF) sc = n + 4; else if (n < C_END) sc = 2304 + (n - C_FXF); else ok = false; }
    const float* sp = d.src + (size_t)k0 * d.srcld + sc;
#pragma unroll
    for (int j = 0; j < 8; ++j) v[u][j] = ok ? __builtin_nontemporal_load(sp + (size_t)j * d.srcld) : 0.f;
  }
}
__device__ __forceinline__ void conv_store(const ConvDesc& d, const float (&v)[4][8], int lane, int w) {
  const int k0 = d.kb * 64 + 8 * w;
#pragma unroll
  for (int u = 0; u < 4; ++u) {
    const int n = d.nb * 256 + u * 64 + lane;
    if (n < d.Ndst) {
      int dr = n;
      if (d.mode == 2) { const int j = n & 1023; dr = (j >> 4) * 32 + (j & 15) + ((n >= 1024) ? 16 : 0); }
      float g[8];
#pragma unroll
      for (int j = 0; j < 8; ++j) g[j] = d.kscale ? d.kscale[k0 + j] : 1.f;
      u32x4 o; o.x = cvtpk(v[u][0] * g[0], v[u][1] * g[1]); o.y = cvtpk(v[u][2] * g[2], v[u][3] * g[3]); o.z = cvtpk(v[u][4] * g[4], v[u][5] * g[5]); o.w = cvtpk(v[u][6] * g[6], v[u][7] * g[7]);
      *(u32x4*)(d.dst + (size_t)dr * d.K + k0) = o;
    }
  }
}
__device__ __forceinline__ void phase_convert(const Params& p) {
  const int tid = get_tid(), lane = tid & 63, w = tid >> 6;
  const int G = get_nblk();
  for (int u = get_bid(); u < CV_SMALL; u += G) {
    ConvDesc d; float va[4][8];
    conv_desc(p, u, d);
    conv_load(d, va, lane, w);
    conv_store(d, va, lane, w);
  }
}

__device__ __forceinline__ void ln_row(f32x4 (&v)[4], const float* g, const float* b, int lane) {
  float s = 0.f;
#pragma unroll
  for (int j = 0; j < 4; ++j) s += (v[j].x + v[j].y) + (v[j].z + v[j].w);
  const float mean = wave_sum(s) * (1.f / DM);
  float s2 = 0.f;
#pragma unroll
  for (int j = 0; j < 4; ++j) { v[j] = v[j] - mean; s2 += (v[j].x * v[j].x + v[j].y * v[j].y) + (v[j].z * v[j].z + v[j].w * v[j].w); }
  const float rstd = rsqrtf(wave_sum(s2) * (1.f / DM) + LN_EPS);
#pragma unroll
  for (int j = 0; j < 4; ++j) {
    const f32x4 gg = *(const f32x4*)(g + 4 * lane + 256 * j), bb = *(const f32x4*)(b + 4 * lane + 256 * j);
    v[j] = v[j] * rstd * gg + bb;
  }
}
__device__ __forceinline__ void store_row_f32_bf16(const f32x4 (&v)[4], float* of, bf16_t* ob, int lane) {
#pragma unroll
  for (int j = 0; j < 4; ++j) {
    if (of) *(f32x4*)(of + 4 * lane + 256 * j) = v[j];
    if (ob) { u32x2 w; w.x = cvtpk(v[j].x, v[j].y); w.y = cvtpk(v[j].z, v[j].w); *(u32x2*)(ob + 4 * lane + 256 * j) = w; }
  }
}

__device__ __forceinline__ void phase_prologue_misc(const Params& p) {
  unsigned char* ws = p.ws;
  const int lane = get_tid() & 63, gw = get_bid() * 8 + (get_tid() >> 6), ngw = get_nblk() * 8;
  float* hF = (float*)(ws + OFF_HF); bf16_t* hB = (bf16_t*)(ws + OFF_HB);
  for (int m = gw; m < M_TOK; m += ngw) {
    f32x4 v[4];
#pragma unroll
    for (int j = 0; j < 4; ++j) v[j] = *(const f32x4*)(p.x + (size_t)m * DM + 4 * lane + 256 * j);
    ln_row(v, p.ln_in_g, p.ln_in_b, lane);
    store_row_f32_bf16(v, nullptr, hB + (size_t)m * DM, lane);
  }
  f32x2* cs = (f32x2*)(ws + OFF_ROPE);
  const int gt = get_bid() * 512 + get_tid(), ngt = get_nblk() * 512;
  for (int i = gt; i < M_TOK * 16; i += ngt) {
    const int m = i >> 4, f = i & 15;
    const double invf = exp2(-(double)f * (13.287712379549449 / 16.0));
    double a = (double)p.pos[m] * invf;
    a = a - 6.283185307179586476925 * rint(a * 0.15915494309189533577);
    float sn, cn; __sincosf((float)a, &sn, &cn);
    cs[i] = (f32x2){cn, sn};
  }
  if (get_bid() == 0 && get_tid() < DEPTH) {
    const int l = get_tid(); const float* lp = p.diff_lambda + l * 128;
    float s1 = 0.f, s2 = 0.f;
    for (int i = 0; i < 32; ++i) { s1 += lp[i] * lp[32 + i]; s2 += lp[64 + i] * lp[96 + i]; }
    const float linit = 0.8f - 0.6f * expf(-0.3f * (float)l);
    ((float*)(ws + OFF_CTRL))[CW_LAM + l] = expf(s1) - expf(s2) + linit;
  }
}

struct GemmDesc { const bf16_t* A; int lda; const int* rowidx; int row0; int mvalid; const bf16_t* Bt; int ldb; int K; };

template <int NI>
__device__ __forceinline__ void gemm_tile(LAS unsigned char* lds, const GemmDesc& g, f32x16 (&acc)[2][NI]) {
  constexpr int BN = 64 * NI;
  constexpr int A_BYTES = 256 * 128, B_BYTES = BN * 128, STAGE = A_BYTES + B_BYTES;
  constexpr int NBL = BN / 64;
  const int tid = get_tid(), lane = tid & 63, w = tid >> 6, wm = w >> 1, wn = w & 1, c31 = lane & 31, hi = lane >> 5;
  const int lr = tid >> 3, lc = (tid & 7) ^ ((tid >> 4) & 7);
  const bf16_t* ap[4];
#pragma unroll
  for (int i = 0; i < 4; ++i) {
    const int r = lr + 64 * i;
    int row;
    if (g.rowidx) row = g.rowidx[g.row0 + (r < g.mvalid ? r : 0)]; else row = g.row0 + r;
    ap[i] = g.A + (size_t)row * g.lda + lc * 8;
  }
  const bf16_t* bp = g.Bt + (size_t)lr * g.ldb + lc * 8;
  const int wbase = w * 1024;
  const int xr = (lane >> 1) & 7;
  int roff[4];
#pragma unroll
  for (int ks = 0; ks < 4; ++ks) roff[ks] = ((2 * ks + hi) ^ xr) << 4;
  const int a_base = (wm * 64 + c31) * 128, b_base = A_BYTES + (wn * 32 * NI + c31) * 128;
#pragma unroll
  for (int mi = 0; mi < 2; ++mi)
#pragma unroll
    for (int ni = 0; ni < NI; ++ni)
#pragma unroll
      for (int r = 0; r < 16; ++r) acc[mi][ni][r] = 0.f;
  const int nk = g.K >> 6;
#define GT_STAGE(stg, ko) do { LAS unsigned char* s_ = lds + (stg) * STAGE + wbase; \
    _Pragma("unroll") for (int i = 0; i < 4; ++i) __builtin_amdgcn_global_load_lds((const unsigned*)(ap[i] + (ko)), (LAS unsigned*)(s_ + 8192 * i), 16, 0, 0); \
    _Pragma("unroll") for (int i = 0; i < NBL; ++i) __builtin_amdgcn_global_load_lds((const unsigned*)(bp + (size_t)(64 * i) * g.ldb + (ko)), (LAS unsigned*)(s_ + A_BYTES + 8192 * i), 16, 0, 0); } while (0)
  GT_STAGE(0, 0);
  __syncthreads();
  bf16x8 af[2][2], bfr[2][NI];
  for (int kt = 0; kt < nk; ++kt) {
    LAS unsigned char* cur = lds + (kt & 1) * STAGE;
    if (kt + 1 < nk) GT_STAGE((kt + 1) & 1, (kt + 1) * 64);
#pragma unroll
    for (int mi = 0; mi < 2; ++mi) af[0][mi] = *(const LAS bf16x8*)(cur + a_base + mi * 4096 + roff[0]);
#pragma unroll
    for (int ni = 0; ni < NI; ++ni) bfr[0][ni] = *(const LAS bf16x8*)(cur + b_base + ni * 4096 + roff[0]);
#pragma unroll
    for (int ks = 0; ks < 4; ++ks) {
      if (ks < 3) {
#pragma unroll
        for (int mi = 0; mi < 2; ++mi) af[(ks + 1) & 1][mi] = *(const LAS bf16x8*)(cur + a_base + mi * 4096 + roff[ks + 1]);
#pragma unroll
        for (int ni = 0; ni < NI; ++ni) bfr[(ks + 1) & 1][ni] = *(const LAS bf16x8*)(cur + b_base + ni * 4096 + roff[ks + 1]);
      }
      __builtin_amdgcn_s_setprio(1);
#pragma unroll
      for (int mi = 0; mi < 2; ++mi)
#pragma unroll
        for (int ni = 0; ni < NI; ++ni) acc[mi][ni] = __builtin_amdgcn_mfma_f32_32x32x16_bf16(bfr[ks & 1][ni], af[ks & 1][mi], acc[mi][ni], 0, 0, 0);
      __builtin_amdgcn_s_setprio(0);
    }
    __syncthreads();
  }
#undef GT_STAGE
}


namespace pg8 {
typedef float f32x4v __attribute__((ext_vector_type(4)));
constexpr int BM = 256, BK = 64, HALF = 128, HTB = HALF * BK * 2, STAGE_BYTES = 8 * HTB, KK = 1024;
typedef int v8i_t __attribute__((ext_vector_type(8)));
typedef int v4i_t __attribute__((ext_vector_type(4)));
__device__ __forceinline__ v8i_t cat8(bf16x8 a, bf16x8 b) { const v4i_t x = __builtin_bit_cast(v4i_t, a), y = __builtin_bit_cast(v4i_t, b); return __builtin_shufflevector(x, y, 0, 1, 2, 3, 4, 5, 6, 7); }
__device__ __forceinline__ int lds_byte(int r, int c) { const int st = (r >> 4) * 2 + (c >> 5), rr = r & 15, cc = c & 31, ob = rr * 64 + cc * 2; return st * 1024 + (ob ^ (((ob >> 9) & 1) << 5)); }
__device__ __forceinline__ void stage_rc(int b, int& R, int& C) { const int st = b / 1024, sb = b % 1024, swz = sb ^ (((sb >> 9) & 1) << 5); R = (st >> 1) * 16 + swz / 64; C = (st & 1) * 32 + (swz % 64) / 2; }
struct Unit { unsigned boff; int arow0; int mvalid; int e, mt, nt, slot0; };
template <bool GATHER, bool FP8, class Sched, class Epi>
__device__ __forceinline__ void gemm_phase(LAS unsigned char* lds, const bf16_t* Abuf, const bf16_t* Bbuf, const Sched& S, const Epi& E) {
  const int tid = get_tid(), wid = __builtin_amdgcn_readfirstlane(tid >> 6), lane = tid & 63, wr = wid >> 2, wc = wid & 3, fr = lane & 15, fq = lane >> 4;
  const __amdgpu_buffer_rsrc_t rsA = __builtin_amdgcn_make_buffer_rsrc((void*)Abuf, (short)0, 0x7ffffff0, 0x00020000);
  const __amdgpu_buffer_rsrc_t rsB = __builtin_amdgcn_make_buffer_rsrc((void*)Bbuf, (short)0, 0x7ffffff0, 0x00020000);
  constexpr int RS = FP8 ? KK : 2 * KK;
  constexpr int NT_K = FP8 ? 8 : 16;
  const int lrow = (wid >> 1) * 16 + (lane >> 2);
  const int cbyte = (wid & 1) * 64 + (((lane & 3) * 16) ^ (((lane >> 5) & 1) << 5));
  const unsigned vB = (unsigned)(lrow * RS + cbyte);
  const unsigned vBb = (unsigned)(Epi::blane(lrow) * RS + cbyte);
  const unsigned vBalt = (unsigned)(Epi::blane_alt(lrow) * RS + cbyte);
  const LAS int* rowtab = (const LAS int*)(lds + LDS_ROWTAB) + lrow;
#define PG8_ROWS(V, u) do { if (GATHER) { _Pragma("unroll") for (int h_ = 0; h_ < 2; ++h_) _Pragma("unroll") for (int i_ = 0; i_ < 2; ++i_) \
      V[h_][i_] = (unsigned)(rowtab[(u).arow0 * 256 + h_ * HALF + i_ * 64] * RS + cbyte); } } while (0)
#define PG8_ABASE(u) (GATHER ? 0u : (unsigned)(u).arow0 * (unsigned)RS)
  constexpr unsigned kstep = BK * 2;
  const unsigned ldsw = (unsigned)wid * 1024u;
  const int aoff = lds_byte(wr * 64 + fr, fq * 8), boff = lds_byte(wc * 32 + fr, fq * 8);
#define PG8_SA(b, h) (((b) * 2 + (h)) * HTB)
#define PG8_SB(b, h) ((4 + (b) * 2 + (h)) * HTB)
#define PG8_LOAD1(rs, ldsoff, voff, soff) __builtin_amdgcn_raw_ptr_buffer_load_lds(rs, (LAS void*)(lds + (ldsoff) + ldsw), 16, (int)(voff), (int)(soff), 0, 0)
#define PG8_STAGE_B(bufoff, soff, h, vb) do { PG8_LOAD1(rsB, (bufoff), (vb), (soff) + (unsigned)(Epi::bpiece((h), 0) * RS)); PG8_LOAD1(rsB, (bufoff) + 8192, (vb), (soff) + (unsigned)(Epi::bpiece((h), 1) * RS)); } while (0)
#define PG8_STAGE_A(bufoff, soff, h, v0, v1) do { if (GATHER) { PG8_LOAD1(rsA, (bufoff), (v0), (soff)); PG8_LOAD1(rsA, (bufoff) + 8192, (v1), (soff)); } \
    else { PG8_LOAD1(rsA, (bufoff), vB, (soff) + (unsigned)((h) * HALF * RS)); PG8_LOAD1(rsA, (bufoff) + 8192, vB, (soff) + (unsigned)(((h) * HALF + 64) * RS)); } } while (0)
#define PG8_LDA(dst, b, h) do { if (FP8) { _Pragma("unroll") for (int m = 0; m < 4; ++m) { \
      const v4i_t lo_ = *(const LAS v4i_t*)(lds + PG8_SA(b, h) + aoff + m * 2048), hi_ = *(const LAS v4i_t*)(lds + PG8_SA(b, h) + aoff + m * 2048 + 1024); \
      dst##8[m] = __builtin_shufflevector(lo_, hi_, 0, 1, 2, 3, 4, 5, 6, 7); } } \
    else { _Pragma("unroll") for (int m = 0; m < 4; ++m) _Pragma("unroll") for (int k = 0; k < 2; ++k) dst[m][k] = *(const LAS bf16x8*)(lds + PG8_SA(b, h) + aoff + m * 2048 + k * 1024); } } while (0)
#define PG8_LDB(dst, b, h) do { if (FP8) { _Pragma("unroll") for (int n = 0; n < 2; ++n) { \
      const v4i_t lo_ = *(const LAS v4i_t*)(lds + PG8_SB(b, h) + boff + n * 2048), hi_ = *(const LAS v4i_t*)(lds + PG8_SB(b, h) + boff + n * 2048 + 1024); \
      dst##8[n] = __builtin_shufflevector(lo_, hi_, 0, 1, 2, 3, 4, 5, 6, 7); } } \
    else { _Pragma("unroll") for (int n = 0; n < 2; ++n) _Pragma("unroll") for (int k = 0; k < 2; ++k) dst[n][k] = *(const LAS bf16x8*)(lds + PG8_SB(b, h) + boff + n * 2048 + k * 1024); } } while (0)
#define PG8_MMA(ai, bj, At, Bt) do { __builtin_amdgcn_s_setprio(1); _Pragma("unroll") for (int m = 0; m < 4; ++m) _Pragma("unroll") for (int n = 0; n < 2; ++n) { \
    if (FP8) asm volatile("v_mfma_scale_f32_16x16x128_f8f6f4 %0, %1, %2, %0, %3, %3 op_sel_hi:[0,0,0]" : "+v"(acc[ai][bj][m][n]) : "v"(Bt##8[n]), "v"(At##8[m]), "v"(sc1));   \
    else { _Pragma("unroll") for (int k = 0; k < 2; ++k) acc[ai][bj][m][n] = __builtin_amdgcn_mfma_f32_16x16x32_bf16(Bt[n][k], At[m][k], acc[ai][bj][m][n], 0, 0, 0); } } \
    __builtin_amdgcn_s_setprio(0); } while (0)
#define PG8_WAIT_V(n) asm volatile("s_waitcnt vmcnt(" #n ")" ::: "memory")
#define PG8_WAIT_L(n) asm volatile("s_waitcnt lgkmcnt(" #n ")" ::: "memory")
#define PG8_BAR __builtin_amdgcn_s_barrier()
#define PG8_SCHED __builtin_amdgcn_sched_barrier(0)
  Unit cur, nxt; int ui = 0;
  if (!S.next(0, cur)) return;
  f32x4v acc[2][2][4][2];
#pragma unroll
  for (int a = 0; a < 2; ++a)
#pragma unroll
    for (int b = 0; b < 2; ++b)
#pragma unroll
      for (int m = 0; m < 4; ++m)
#pragma unroll
        for (int n = 0; n < 2; ++n) acc[a][b][m][n] = (f32x4v){0.f, 0.f, 0.f, 0.f};
  unsigned sc1 = 0x7f7f7f7fu; asm volatile("" : "+v"(sc1));
  bf16x8 At[4][2], B0[2][2], B1[2][2];
  v8i_t At8[4], B08[2], B18[2];
  unsigned cV[2][2];
#pragma unroll
  for (int h = 0; h < 2; ++h)
#pragma unroll
    for (int i = 0; i < 2; ++i) cV[h][i] = 0u;
  PG8_ROWS(cV, cur);
  unsigned cA = PG8_ABASE(cur), cB = cur.boff;
  unsigned vBc = vBb, vBn = vBb;
  if (Epi::DYNB) { if (E.alt_map(cur)) vBc = vBalt; }
  PG8_STAGE_B(PG8_SB(0, 0), cB, 0, vBc); PG8_STAGE_B(PG8_SB(0, 1), cB, 1, vBc);
  PG8_STAGE_A(PG8_SA(0, 0), cA, 0, cV[0][0], cV[0][1]); PG8_STAGE_A(PG8_SA(0, 1), cA, 1, cV[1][0], cV[1][1]);
  if (wr == 1) PG8_BAR;
  PG8_WAIT_V(2); PG8_BAR;
  PG8_STAGE_B(PG8_SB(1, 0), cB + kstep, 0, vBc); PG8_STAGE_A(PG8_SA(1, 0), cA + kstep, 0, cV[0][0], cV[0][1]); PG8_STAGE_B(PG8_SB(1, 1), cB + kstep, 1, vBc);
  PG8_WAIT_V(6); PG8_BAR;
  for (;;) {
    const bool has_next = S.next(ui + 1, nxt);
    const unsigned nB = has_next ? nxt.boff : cB;
    const unsigned nA = has_next ? PG8_ABASE(nxt) : cA;
    if (Epi::DYNB) { vBn = vBc; if (has_next) { vBn = vBb; if (E.alt_map(nxt)) vBn = vBalt; } }
#pragma unroll 1
    for (int t = 0; t < NT_K; t += 2) {
      const bool last = (t == NT_K - 2);
      const unsigned a1 = cA + (unsigned)(t + 1) * kstep;
      const unsigned a2 = last ? nA : cA + (unsigned)(t + 2) * kstep, b2 = last ? nB : cB + (unsigned)(t + 2) * kstep;
      const unsigned a3 = a2 + kstep, b3 = b2 + kstep;
      unsigned w00 = cV[0][0], w01 = cV[0][1], w10 = cV[1][0], w11 = cV[1][1];
      if (GATHER && last && has_next) { unsigned nV[2][2]; PG8_ROWS(nV, nxt); w00 = nV[0][0]; w01 = nV[0][1]; w10 = nV[1][0]; w11 = nV[1][1]; }
      unsigned wB = vBc; if (Epi::DYNB && last) wB = vBn;
      PG8_LDB(B0, 0, 0); PG8_LDB(B1, 0, 1); PG8_SCHED; PG8_LDA(At, 0, 0); PG8_STAGE_A(PG8_SA(1, 1), a1, 1, cV[1][0], cV[1][1]);
      PG8_WAIT_V(8); PG8_WAIT_L(0); PG8_BAR; PG8_MMA(0, 0, At, B0); PG8_MMA(0, 1, At, B1); PG8_BAR; PG8_SCHED;
      PG8_LDA(At, 0, 1); PG8_STAGE_B(PG8_SB(0, 0), b2, 0, wB); PG8_STAGE_B(PG8_SB(0, 1), b2, 1, wB); PG8_STAGE_A(PG8_SA(0, 0), a2, 0, w00, w01);
      PG8_WAIT_V(8); PG8_WAIT_L(0); PG8_BAR; PG8_MMA(1, 0, At, B0); PG8_MMA(1, 1, At, B1); PG8_BAR; PG8_SCHED;
      PG8_LDB(B0, 1, 0); PG8_LDB(B1, 1, 1); PG8_SCHED; PG8_LDA(At, 1, 0); PG8_STAGE_A(PG8_SA(0, 1), a2, 1, w10, w11);
      PG8_WAIT_V(8); PG8_WAIT_L(0); PG8_BAR; PG8_MMA(0, 0, At, B0); PG8_MMA(0, 1, At, B1); PG8_BAR; PG8_SCHED;
      PG8_LDA(At, 1, 1); PG8_STAGE_B(PG8_SB(1, 0), b3, 0, wB); PG8_STAGE_B(PG8_SB(1, 1), b3, 1, wB); PG8_STAGE_A(PG8_SA(1, 0), a3, 0, w00, w01);
      PG8_WAIT_V(8); PG8_WAIT_L(0); PG8_BAR; PG8_MMA(1, 0, At, B0); PG8_MMA(1, 1, At, B1); PG8_BAR; PG8_SCHED;
    }
    if (wr == 0) PG8_BAR;
    if (FP8) asm volatile("s_nop 15\n\ts_nop 15" ::: "memory");
    E(acc, cur, wr, wc, fr, fq);
    if (!has_next) break;
#pragma unroll
    for (int a = 0; a < 2; ++a)
#pragma unroll
      for (int b = 0; b < 2; ++b)
#pragma unroll
        for (int m = 0; m < 4; ++m)
#pragma unroll
          for (int n = 0; n < 2; ++n) acc[a][b][m][n] = (f32x4v){0.f, 0.f, 0.f, 0.f};
    if (FP8) asm volatile("s_nop 7" ::: "memory");
    cur = nxt; cB = nB; cA = nA; ++ui;
    if (Epi::DYNB) vBc = vBn;
    PG8_ROWS(cV, cur);
    if (wr == 1) PG8_BAR;
  }
  PG8_WAIT_V(0);
  PG8_BAR;
#undef PG8_ROWS
#undef PG8_ABASE
#undef PG8_SA
#undef PG8_SB
#undef PG8_LOAD1
#undef PG8_STAGE_A
#undef PG8_STAGE_B
#undef PG8_LDA
#undef PG8_LDB
#undef PG8_MMA
#undef PG8_WAIT_V
#undef PG8_WAIT_L
#undef PG8_BAR
#undef PG8_SCHED
}
}

struct InprojSched {
  int grid, bid;
  __device__ __forceinline__ bool next(int i, pg8::Unit& u) const {
    constexpr int NT = NP / 256;
    int mt, nt;
    if (grid == 256) { const int xcd = bid & 7, j = bid >> 3, q = j + 32 * i; if (q >= 8 * NT) return false; mt = 8 * xcd + q / NT; nt = q % NT; }
    else { const int t = bid + i * grid; if (t >= 64 * NT) return false; mt = t / NT; nt = t % NT; }
    u.boff = (unsigned)nt * (256u * 1024u * 2u); u.arow0 = mt * 256; u.mvalid = 256; u.e = 0; u.mt = mt; u.nt = nt; u.slot0 = 0;
    return true;
  }
};
struct InprojEpi {
  static constexpr bool DYNB = true;
  static __device__ __forceinline__ int blane(int lrow) { return lrow; }
  static __device__ __forceinline__ int blane_alt(int lrow) { return (lrow & 32) + 8 * ((lrow & 15) >> 2) + 4 * ((lrow >> 4) & 1) + (lrow & 3); }
  static constexpr __device__ int bpiece(int h, int i) { return 128 * h + 64 * i; }
  __device__ __forceinline__ bool alt_map(const pg8::Unit& u) const { return !(u.nt == 3 || u.nt == 4 || u.nt == 10); }
  bf16_t* P; float* gateF; const f32x2* cs; float* ssq;
  __device__ __forceinline__ void operator()(const pg8::f32x4v (&acc)[2][2][4][2], const pg8::Unit& u, int wr, int wc, int fr, int fq) const {
    const int nt = u.nt;
    if (alt_map(u)) {
#pragma unroll
      for (int ai = 0; ai < 2; ++ai)
#pragma unroll
        for (int m = 0; m < 4; ++m) {
          const int row = u.mt * 256 + 128 * ai + 64 * wr + 16 * m + fr;
          bf16_t* prow = P + (size_t)row * NP + nt * 256 + 32 * wc + 8 * fq;
          float sq = 0.f;
#pragma unroll
          for (int bj = 0; bj < 2; ++bj) {
            const pg8::f32x4v v0 = acc[ai][bj][m][0], v1 = acc[ai][bj][m][1];
            if (nt == 9) {
#pragma unroll
              for (int j = 0; j < 4; ++j) sq += v0[j] * v0[j] + v1[j] * v1[j];
            }
            u32x4 o; o.x = cvtpk(v0[0], v0[1]); o.y = cvtpk(v0[2], v0[3]); o.z = cvtpk(v1[0], v1[1]); o.w = cvtpk(v1[2], v1[3]);
            *(u32x4*)(prow + 128 * bj) = o;
          }
          if (nt == 9) {
            sq += __shfl_xor(sq, 16); sq += __shfl_xor(sq, 32);
            if (fq == 0) ssq[(size_t)row * 8 + wc] = sq;
          }
        }
      return;
    }
    const bool rope_all = (nt == 3) || (nt == 4);
#pragma unroll
    for (int ai = 0; ai < 2; ++ai)
#pragma unroll
      for (int m = 0; m < 4; ++m) {
        const int row = u.mt * 256 + 128 * ai + 64 * wr + 16 * m + fr;
        bf16_t* prow = P + (size_t)row * NP + nt * 256 + 32 * wc + 4 * fq;
        f32x2 c4[4];
        if (rope_all || nt == 10) {
#pragma unroll
          for (int j = 0; j < 4; ++j) c4[j] = cs[(size_t)row * 16 + 4 * fq + j];
        }
        float sq = 0.f;
#pragma unroll
        for (int bj = 0; bj < 2; ++bj) {
          pg8::f32x4v v0 = acc[ai][bj][m][0], v1 = acc[ai][bj][m][1];
          if (rope_all || (nt == 10 && bj == 1 && wc == 0)) {
#pragma unroll
            for (int j = 0; j < 4; ++j) { const float x1 = v0[j], x2 = v1[j]; v0[j] = x1 * c4[j].x - x2 * c4[j].y; v1[j] = x2 * c4[j].x + x1 * c4[j].y; }
          }
          if (nt == 9 || (nt == 10 && bj == 0)) {
#pragma unroll
            for (int j = 0; j < 4; ++j) sq += v0[j] * v0[j] + v1[j] * v1[j];
          }
          u32x2 o; o.x = cvtpk(v0[0], v0[1]); o.y = cvtpk(v0[2], v0[3]);
          *(u32x2*)(prow + 128 * bj) = o;
          o.x = cvtpk(v1[0], v1[1]); o.y = cvtpk(v1[2], v1[3]);
          *(u32x2*)(prow + 128 * bj + 16) = o;
          if (nt == 10 && bj == 1 && wc == 1 && fq == 0) *(f32x4*)(gateF + (size_t)row * 4) = (f32x4){v0[0], v0[1], v0[2], v0[3]};
        }
        if (nt == 9 || nt == 10) {
          sq += __shfl_xor(sq, 16); sq += __shfl_xor(sq, 32);
          if (fq == 0) ssq[(size_t)row * 8 + (nt == 9 ? 0 : 4) + wc] = sq;
        }
      }
  }
};
__device__ __forceinline__ void phase_inproj(const Params& p, int layer, LAS unsigned char* lds) {
  unsigned char* ws = p.ws;
  InprojSched S{get_nblk(), get_bid()};
  InprojEpi E{(bf16_t*)(ws + OFF_P), (float*)(ws + OFF_GATEF), (const f32x2*)(ws + OFF_ROPE), (float*)(ws + OFF_CQN)};
  pg8::gemm_phase<false, false>(lds, (const bf16_t*)(ws + OFF_HB), (const bf16_t*)(ws + OFF_WIN) + (size_t)layer * NP * 1024, S, E);
}

__device__ __forceinline__ void rope4(bf16_t* base, const f32x2* cs4) {
  const u32x2 a = *(const u32x2*)base, b = *(const u32x2*)(base + 16);
  float x1[4] = {bflo(a.x), bfhi(a.x), bflo(a.y), bfhi(a.y)}, x2[4] = {bflo(b.x), bfhi(b.x), bflo(b.y), bfhi(b.y)};
  float y1[4], y2[4];
#pragma unroll
  for (int i = 0; i < 4; ++i) { const f32x2 c = cs4[i]; y1[i] = x1[i] * c.x - x2[i] * c.y; y2[i] = x2[i] * c.x + x1[i] * c.y; }
  u32x2 oa, ob; oa.x = cvtpk(y1[0], y1[1]); oa.y = cvtpk(y1[2], y1[3]); ob.x = cvtpk(y2[0], y2[1]); ob.y = cvtpk(y2[2], y2[3]);
  *(u32x2*)base = oa; *(u32x2*)(base + 16) = ob;
}
__device__ __forceinline__ void phase_post(const Params& p, int layer, LAS unsigned char* lds) {
  unsigned char* ws = p.ws;
  bf16_t* P = (bf16_t*)(ws + OFF_P);
  const f32x2* cs = (const f32x2*)(ws + OFF_ROPE);
  bf16_t* cqn = (bf16_t*)(ws + OFF_CQN); bf16_t* ckvn = (bf16_t*)(ws + OFF_CKVN);
  const int lane = get_tid() & 63, gw = get_bid() * 8 + (get_tid() >> 6), ngw = get_nblk() * 8;
  const float* gq = p.mla_q_norm_g + layer * 256; const float* gkv = p.mla_kv_norm_g + layer * 128;
  for (int m = gw; m < M_TOK; m += ngw) {
    bf16_t* row = P + (size_t)m * NP;
    const f32x2* csm = cs + (size_t)m * 16;
    { const int sh = lane >> 2, pg = lane & 3; rope4(row + C_DFQ + sh * 32 + 4 * pg, csm + 4 * pg); }
    if (lane < 4) rope4(row + C_KR + 4 * lane, csm + 4 * lane);
    {
      const u32x2 a = *(const u32x2*)(row + C_CQ + 4 * lane);
      float x[4] = {bflo(a.x), bfhi(a.x), bflo(a.y), bfhi(a.y)};
      const float ss = wave_sum(x[0] * x[0] + x[1] * x[1] + x[2] * x[2] + x[3] * x[3]);
      const float rs = rsqrtf(ss * (1.f / 256.f) + RMS_EPS);
      const f32x4 gg = *(const f32x4*)(gq + 4 * lane);
      u32x2 o; o.x = cvtpk(x[0] * rs * gg.x, x[1] * rs * gg.y); o.y = cvtpk(x[2] * rs * gg.z, x[3] * rs * gg.w);
      *(u32x2*)(cqn + (size_t)m * 256 + 4 * lane) = o;
    }
    {
      const unsigned a = *(const unsigned*)(row + C_CKV + 2 * lane);
      const float x0 = bflo(a), x1 = bfhi(a);
      const float ss = wave_sum(x0 * x0 + x1 * x1);
      const float rs = rsqrtf(ss * (1.f / 128.f) + RMS_EPS);
      const f32x2 gg = *(const f32x2*)(gkv + 2 * lane);
      *(unsigned*)(ckvn + (size_t)m * 128 + 2 * lane) = cvtpk(x0 * rs * gg.x, x1 * rs * gg.y);
    }
  }
  if (get_bid() < 16) {
    const int b = get_bid() >> 2, h = get_bid() & 3, tid = get_tid();
    const float* gateF = (const float*)(ws + OFF_GATEF);
    float* Fk = (float*)(ws + OFF_FK) + (size_t)get_bid() * SEQ;
    const float bf = p.b_forget[layer * 4 + h];
    LAS float* sc = (LAS float*)lds;
    float v[8]; float run = 0.f;
#pragma unroll
    for (int i = 0; i < 8; ++i) {
      const float xx = gateF[(size_t)(b * SEQ + tid * 8 + i) * 4 + h] + bf;
      const float ls = fminf(xx, 0.f) - log1pf(expf(-fabsf(xx)));
      run += ls; v[i] = run;
    }
    float inc = run;
#pragma unroll
    for (int o = 1; o < 64; o <<= 1) { const float t = __shfl_up(inc, o); if (lane >= o) inc += t; }
    __syncthreads();
    if (lane == 63) sc[tid >> 6] = inc;
    __syncthreads();
    float wbase = 0.f;
    for (int i = 0; i < (tid >> 6); ++i) wbase += sc[i];
    const float excl = wbase + inc - run;
#pragma unroll
    for (int i = 0; i < 8; ++i) Fk[tid * 8 + i] = -8.f * (excl + v[i]);
    __syncthreads();
  }
}

__device__ __forceinline__ void phase_mla_up(const Params& p, int layer, LAS unsigned char* lds) {
  unsigned char* ws = p.ws;
  const bf16_t* P = (const bf16_t*)(ws + OFF_P);
  const float* ssq = (const float*)(ws + OFF_CQN);
  const bf16_t* Wq = (const bf16_t*)(ws + OFF_WUQ) + (size_t)layer * 384 * 256;
  const bf16_t* Wkv = (const bf16_t*)(ws + OFF_WUKV) + (size_t)layer * 512 * 128;
  bf16_t* qd = (bf16_t*)(ws + OFF_QD); bf16_t* kvd = (bf16_t*)(ws + OFF_KVD);
  const int sb = get_bid() - (get_nblk() - 16);
  if (sb >= 0) {
    const int b = sb >> 2, h = sb & 3, tid = get_tid(), lane = tid & 63;
    const float* gateF = (const float*)(ws + OFF_GATEF);
    float* Fk = (float*)(ws + OFF_FK) + (size_t)sb * SEQ;
    const float bf = p.b_forget[layer * 4 + h];
    LAS float* sc = (LAS float*)lds;
    float v[8]; float run = 0.f;
#pragma unroll
    for (int i = 0; i < 8; ++i) {
      const float xx = gateF[(size_t)(b * SEQ + tid * 8 + i) * 4 + h] + bf;
      const float ls = fminf(xx, 0.f) - log1pf(expf(-fabsf(xx)));
      run += ls; v[i] = run;
    }
    float inc = run;
#pragma unroll
    for (int o = 1; o < 64; o <<= 1) { const float t = __shfl_up(inc, o); if (lane >= o) inc += t; }
    __syncthreads();
    if (lane == 63) sc[tid >> 6] = inc;
    __syncthreads();
    float wbase = 0.f;
    for (int i = 0; i < (tid >> 6); ++i) wbase += sc[i];
    const float excl = wbase + inc - run;
#pragma unroll
    for (int i = 0; i < 8; ++i) Fk[tid * 8 + i] = -8.f * (excl + v[i]);
    __syncthreads();
  }
  const int lane = get_tid() & 63, w = get_tid() >> 6, wm = w >> 1, wn = w & 1, c31 = lane & 31, hi = lane >> 5;
  for (int item = get_bid() * 8 + w; item < 16 * 64; item += get_nblk() * 8) {
    const int bh = item >> 6, tl = item & 63, b = bh >> 2, h = bh & 3;
    const bf16_t* kr = P + (size_t)(b * SEQ + 64 * tl + lane) * NP + C_FXK + h * 64;
    float ss = 0.f;
#pragma unroll
    for (int c = 0; c < 8; ++c) {
      const u32x4 x = *(const u32x4*)(kr + 8 * c);
      ss += bflo(x.x) * bflo(x.x) + bfhi(x.x) * bfhi(x.x) + bflo(x.y) * bflo(x.y) + bfhi(x.y) * bfhi(x.y) + bflo(x.z) * bflo(x.z) + bfhi(x.z) * bfhi(x.z) + bflo(x.w) * bflo(x.w) + bfhi(x.w) * bfhi(x.w);
    }
    float nv = sqrtf(ss) * 1.0001f;
#pragma unroll
    for (int o = 1; o < 64; o <<= 1) nv = fmaxf(nv, __shfl_xor(nv, o));
    if (lane == 0) ((float*)(ws + OFF_KN))[item] = nv;
  }
  constexpr int TQ = 64 * 3, TKV = 64 * 4;
  for (int t = get_bid(); t < TQ + TKV; t += get_nblk()) {
    const bool isq = t < TQ; const int tt = isq ? t : t - TQ; const int ntn = isq ? 3 : 4; const int mt = tt / ntn, nt = tt % ntn;
    GemmDesc g;
    if (isq) g = GemmDesc{P + C_CQ, NP, nullptr, mt * 256, 256, Wq + (size_t)nt * 128 * 256, 256, 256};
    else g = GemmDesc{P + C_CKV, NP, nullptr, mt * 256, 256, Wkv + (size_t)nt * 128 * 128, 128, 128};
    f32x16 acc[2][2];
    gemm_tile<2>(lds, g, acc);
    bf16_t* O = isq ? qd : kvd; const int ldo = isq ? 384 : 512;
#pragma unroll
    for (int mi = 0; mi < 2; ++mi) {
      const int m = mt * 256 + wm * 64 + mi * 32 + c31;
      const f32x4 s4 = *(const f32x4*)(ssq + (size_t)m * 8 + (isq ? 0 : 4));
      const float rs = rsqrtf(((s4.x + s4.y) + (s4.z + s4.w)) * (isq ? (1.f / 256.f) : (1.f / 128.f)) + RMS_EPS);
#pragma unroll
      for (int ni = 0; ni < 2; ++ni)
#pragma unroll
        for (int g4 = 0; g4 < 4; ++g4) {
          const int n = nt * 128 + wn * 64 + ni * 32 + 4 * hi + 8 * g4;
          u32x2 o; o.x = cvtpk(acc[mi][ni][4 * g4] * rs, acc[mi][ni][4 * g4 + 1] * rs); o.y = cvtpk(acc[mi][ni][4 * g4 + 2] * rs, acc[mi][ni][4 * g4 + 3] * rs);
          *(u32x2*)(O + (size_t)m * ldo + n) = o;
        }
    }
  }
}

constexpr int CMU_UP = 32 * 8 * 32, CMU_DN = 32 * 8 * 16, CMU_TOTAL = CMU_UP + CMU_DN;
struct ConvCtx { const float* wgu; const float* wdn; unsigned char* dgu; unsigned char* ddn; int* ctr; };
__device__ __forceinline__ void cmu_load(const ConvCtx& c, int idx, int lane, int w, float (&v)[16]) {
  const bool up = idx < CMU_UP;
  const int i2 = up ? idx : idx - CMU_UP;
  const int e = up ? (i2 >> 8) : (i2 >> 7), rem = up ? (i2 & 255) : (i2 & 127);
  const int kb = up ? (rem >> 5) : (rem >> 4), nb = up ? (rem & 31) : (rem & 15);
  const int N = up ? 2048 : 1024;
  const float* base = up ? c.wgu : c.wdn;
  const float* sp = base + ((size_t)e * 1024 + kb * 128 + 16 * w) * N + nb * 64 + lane;
#pragma unroll
  for (int j = 0; j < 16; ++j) v[j] = __builtin_nontemporal_load(sp + (size_t)j * N);
}
__device__ __forceinline__ void cmu_store(const ConvCtx& c, int idx, int lane, int w, const float (&v)[16]) {
  const bool up = idx < CMU_UP;
  const int i2 = up ? idx : idx - CMU_UP;
  const int e = up ? (i2 >> 8) : (i2 >> 7), rem = up ? (i2 & 255) : (i2 & 127);
  const int kb = up ? (rem >> 5) : (rem >> 4), nb = up ? (rem & 31) : (rem & 15);
  const int N = up ? 2048 : 1024;
  const int n = nb * 64 + lane;
  int dr = n;
  if (up) { const int j = n & 1023; dr = (j >> 4) * 32 + (j & 15) + ((n >= 1024) ? 16 : 0); }
  unsigned char* base = up ? c.dgu : c.ddn;
  const float sc = up ? S8_WGU : S8_WDN;
  u32x4 o;
  o.x = pk4_fp8(v[0] * sc, v[1] * sc, v[2] * sc, v[3] * sc); o.y = pk4_fp8(v[4] * sc, v[5] * sc, v[6] * sc, v[7] * sc);
  o.z = pk4_fp8(v[8] * sc, v[9] * sc, v[10] * sc, v[11] * sc); o.w = pk4_fp8(v[12] * sc, v[13] * sc, v[14] * sc, v[15] * sc);
  *(u32x4*)(base + ((size_t)e * N + dr) * 1024 + kb * 128 + 16 * w) = o;
}

__device__ __forceinline__ void cmu_to_lds(const ConvCtx& c, int idx, int lane, int w, const float (&v)[16], LAS unsigned char* tile) {
  const float sc = (idx < CMU_UP) ? S8_WGU : S8_WDN;
  u32x4 o;
  o.x = pk4_fp8(v[0] * sc, v[1] * sc, v[2] * sc, v[3] * sc); o.y = pk4_fp8(v[4] * sc, v[5] * sc, v[6] * sc, v[7] * sc);
  o.z = pk4_fp8(v[8] * sc, v[9] * sc, v[10] * sc, v[11] * sc); o.w = pk4_fp8(v[12] * sc, v[13] * sc, v[14] * sc, v[15] * sc);
  *(LAS u32x4*)(tile + lane * 128 + ((w ^ (lane & 7)) << 4)) = o;
}
__device__ __forceinline__ void cmu_from_lds(const ConvCtx& c, int idx, int lane, int w, const LAS unsigned char* tile) {
  const bool up = idx < CMU_UP;
  const int i2 = up ? idx : idx - CMU_UP;
  const int e = up ? (i2 >> 8) : (i2 >> 7), rem = up ? (i2 & 255) : (i2 & 127);
  const int kb = up ? (rem >> 5) : (rem >> 4), nb = up ? (rem & 31) : (rem & 15);
  const int N = up ? 2048 : 1024;
  const int r = 8 * w + (lane >> 3), ch = lane & 7;
  const u32x4 o = *(const LAS u32x4*)(tile + r * 128 + ((ch ^ (r & 7)) << 4));
  const int n = nb * 64 + r;
  int dr = n;
  if (up) { const int j = n & 1023; dr = (j >> 4) * 32 + (j & 15) + ((n >= 1024) ? 16 : 0); }
  unsigned char* base = up ? c.dgu : c.ddn;
  *(u32x4*)(base + ((size_t)e * N + dr) * 1024 + kb * 128 + 16 * ch) = o;
}

enum { AT_SB = 0, AT_DIFF = 1, AT_FOX = 2, AT_MLA = 3 };
struct AttnArgs {
  const bf16_t* Q; int ldq; const bf16_t* K; int ldk; const bf16_t* V; int ldv; const bf16_t* K2; int ldk2;
  const float* Fk; const f32x2* cs; bf16_t* O; int ldo; float lam, oscale; const float* subg; const float* kn;
};
constexpr int ATT_K1 = 0, ATT_V = 8192, ATT_K2 = 16384, ATT_F = 20480, ATT_BUF = 20992;

__device__ __forceinline__ float max3f(float a, float b, float c) { float r; asm("v_max3_f32 %0, %1, %2, %3" : "=v"(r) : "v"(a), "v"(b), "v"(c)); return r; }
__device__ __forceinline__ float max2f(float a, float b) { float r; asm("v_max_f32_e32 %0, %1, %2" : "=v"(r) : "v"(a), "v"(b)); return r; }
__device__ __forceinline__ bool softmax_tile(f32x16& p0, f32x16& p1, float& m, float& l, float c, bool domask, int kbase, int q, int hi, float& alpha) {
  if (domask) {
#pragma unroll
    for (int r = 0; r < 16; ++r) { const int key = kbase + crow(r, hi); if (key > q) p0[r] = -INFINITY; if (key + 32 > q) p1[r] = -INFINITY; }
  }
  asm volatile("s_nop 15\n\ts_nop 7" : "+v"(p0), "+v"(p1));
  float a = max3f(p0[0], p0[1], p1[0]), b = max3f(p0[2], p0[3], p1[1]); a = max3f(a, p1[2], p1[3]);
#pragma unroll
  for (int r = 4; r < 16; r += 4) { a = max3f(a, p0[r], p0[r + 1]); b = max3f(b, p0[r + 2], p0[r + 3]); a = max3f(a, p1[r], p1[r + 1]); b = max3f(b, p1[r + 2], p1[r + 3]); }
  float a0, a1; pair_vals(max2f(a, b), a0, a1);
  const float rm = max2f(a0, a1);
  const bool resc = __any((rm - m) * c > 8.0f);
  alpha = 1.f;
  if (resc) { const float mn = max2f(m, rm); alpha = __builtin_amdgcn_exp2f((m - mn) * c); l *= alpha; m = mn; }
  const float mc = m * c;
  float s = 0.f;
#pragma unroll
  for (int r = 0; r < 16; ++r) { p0[r] = __builtin_amdgcn_exp2f(fmaf(p0[r], c, -mc)); p1[r] = __builtin_amdgcn_exp2f(fmaf(p1[r], c, -mc)); s += p0[r] + p1[r]; }
  l += s;
  return resc;
}
__device__ __forceinline__ bf16x8 pack8(const f32x16& p, int b) {
  u32x4 w; w.x = cvtpk(p[b], p[b + 1]); w.y = cvtpk(p[b + 2], p[b + 3]); w.z = cvtpk(p[b + 4], p[b + 5]); w.w = cvtpk(p[b + 6], p[b + 7]);
  return __builtin_bit_cast(bf16x8, w);
}
__device__ __forceinline__ bf16x8 vfrag(LAS unsigned char* vb, int off) {
  const s16x4 lo = __builtin_bit_cast(s16x4, __builtin_amdgcn_ds_read_tr16_b64_v4i16((LAS s16x4*)(vb + off)));
  const s16x4 hh = __builtin_bit_cast(s16x4, __builtin_amdgcn_ds_read_tr16_b64_v4i16((LAS s16x4*)(vb + off + 1024)));
  return (bf16x8){lo[0], lo[1], lo[2], lo[3], hh[0], hh[1], hh[2], hh[3]};
}

template <int T>
__device__ __forceinline__ void attn_unit(LAS unsigned char* lds, const AttnArgs& a, int qb, const ConvCtx& cc, int& gi, int& pidx, int& qidx, float (&cv)[16]) {
  const int tid = get_tid(), lane = tid & 63, w = tid >> 6, c31 = lane & 31, hi = lane >> 5;
  const int t0 = qb * 256 + w * 32, q = t0 + c31;
  constexpr int NKS = (T == AT_MLA) ? 6 : 4;
  constexpr float CSC = (T == AT_DIFF) ? 0.17677669529663687f * LOG2E : (T == AT_MLA) ? 0.10206207261596577f * LOG2E : 0.125f * LOG2E;
  bf16x8 qf[NKS];
  {
    const bf16_t* qrow = a.Q + (size_t)q * a.ldq;
#pragma unroll
    for (int ks = 0; ks < NKS; ++ks) qf[ks] = *(const bf16x8*)(qrow + 16 * ks + 8 * hi);
    if (T == AT_MLA) {
      const f32x2* csq = a.cs + (size_t)q * 16 + 8 * hi;
      bf16x8 n4, n5;
#pragma unroll
      for (int j = 0; j < 8; j += 2) {
        const f32x2 c0 = csq[j], c1 = csq[j + 1];
        const float x1a = bf2f((unsigned short)qf[4][j]), x1b = bf2f((unsigned short)qf[4][j + 1]);
        const float x2a = bf2f((unsigned short)qf[5][j]), x2b = bf2f((unsigned short)qf[5][j + 1]);
        const unsigned w1 = cvtpk(x1a * c0.x - x2a * c0.y, x1b * c1.x - x2b * c1.y);
        const unsigned w2 = cvtpk(x2a * c0.x + x1a * c0.y, x2b * c1.x + x1b * c1.y);
        n4[j] = (short)(w1 & 0xffff); n4[j + 1] = (short)(w1 >> 16); n5[j] = (short)(w2 & 0xffff); n5[j + 1] = (short)(w2 >> 16);
      }
      qf[4] = n4; qf[5] = n5;
    }
  }
  const int skey = tid >> 3, sch = tid & 7;
  const int k1_st = ATT_K1 + skey * 128 + ((sch ^ ((skey >> 1) & 7)) << 4);
  const int v_st = ATT_V + skey * 128 + ((sch ^ (((skey >> 1) & 1) << 2)) << 4);
  const int k2key = tid >> 2, k2ch = tid & 3;
  const int k2_st = ATT_K2 + k2key * 64 + ((k2ch ^ ((k2key >> 2) & 3)) << 4);
  const int xr = (lane >> 1) & 7;
  int kro[4];
#pragma unroll
  for (int ks = 0; ks < 4; ++ks) kro[ks] = ATT_K1 + c31 * 128 + (((2 * ks + hi) ^ xr) << 4);
  int k2ro[2];
#pragma unroll
  for (int ks = 0; ks < 2; ++ks) k2ro[ks] = ATT_K2 + c31 * 64 + (((2 * ks + hi) ^ ((c31 >> 2) & 3)) << 4);
  int vro[2];
  {
    const int i = lane & 15, qq = i >> 2, pp = i & 3, gg = (lane >> 4) & 1, bit = (qq >> 1) & 1;
#pragma unroll
    for (int d0 = 0; d0 < 2; ++d0) vro[d0] = ATT_V + (4 * hi + qq) * 128 + ((4 * (d0 ^ bit) + 2 * gg + (pp >> 1)) << 4) + (pp & 1) * 8;
  }
  const int ntiles = 4 * (qb + 1);
  const int wave_last = (t0 + 31) >> 6;
  LAS float* kpre = (LAS float*)(lds + 2 * ATT_BUF + 256);
  LAS float* fend = kpre + 64;
  float qn = 0.f;
  if (T == AT_FOX) {
    if (w == 0) {
      float v = (lane < ntiles) ? a.kn[lane] : 0.f;
#pragma unroll
      for (int o = 1; o < 64; o <<= 1) { const float u_ = __shfl_up(v, o); if (lane >= o) v = fmaxf(v, u_); }
      kpre[lane] = v;
      fend[lane] = (lane < ntiles) ? a.Fk[64 * lane + 63] : 0.f;
    }
    float ss = 0.f;
#pragma unroll
    for (int ks = 0; ks < 4; ++ks)
#pragma unroll
      for (int j = 0; j < 8; ++j) { const float x = bf2f((unsigned short)qf[ks][j]); ss += x * x; }
    float s0_, s1_; pair_vals(ss, s0_, s1_);
    qn = sqrtf(s0_ + s1_) * 1.0001f;
  }
  f32x16 o0[2], o1[2];
#pragma unroll
  for (int d0 = 0; d0 < 2; ++d0)
#pragma unroll
    for (int r = 0; r < 16; ++r) { o0[d0][r] = 0.f; o1[d0][r] = 0.f; }
  float m0 = -INFINITY, l0 = 0.f, m1 = -INFINITY, l1 = 0.f;
  float Crun = 0.f;
  bool fin = false;
  u32x4 rk, rv, rk2; float rf = 0.f;
#define ATT_TILE(it) ((T == AT_SB || T == AT_FOX) ? (ntiles - 1 - (it)) : (it))
#define ATT_GLOAD(t) do { const int key_ = 64 * (t) + skey; \
    rk = *(const u32x4*)(a.K + (size_t)key_ * a.ldk + sch * 8); rv = *(const u32x4*)(a.V + (size_t)key_ * a.ldv + sch * 8); \
    if (T == AT_MLA) { if (tid < 256) rk2 = *(const u32x4*)(a.K2 + (size_t)(64 * (t) + k2key) * a.ldk2 + k2ch * 8); } \
    if (T == AT_FOX) { if (tid < 64) rf = a.Fk[64 * (t) + tid]; } } while (0)
#define ATT_LSTORE(buf) do { LAS unsigned char* b_ = lds + (buf) * ATT_BUF; \
    *(LAS u32x4*)(b_ + k1_st) = rk; *(LAS u32x4*)(b_ + v_st) = rv; \
    if (T == AT_MLA) { if (tid < 256) *(LAS u32x4*)(b_ + k2_st) = rk2; } \
    if (T == AT_FOX) { if (tid < 64) *(LAS float*)(b_ + ATT_F + 4 * tid) = rf; } } while (0)
  LAS int* s_conv = (LAS int*)(lds + 2 * ATT_BUF + 64);
  ATT_GLOAD(ATT_TILE(0));
  ATT_LSTORE(0);
  __syncthreads();
  for (int it = 0; it < ntiles; ++it) {
    const int t = ATT_TILE(it);
    LAS unsigned char* cur = lds + (it & 1) * ATT_BUF;
    const bool more = (it + 1 < ntiles);
    const int cidx = __builtin_amdgcn_readfirstlane(s_conv[(gi >> 3) & 1]) + (gi & 7);
    int cnext = 0;
    const bool cfetch = (gi & 7) == 0;
    if (cfetch && tid == 0) cnext = atomicAdd(cc.ctr, 8);
    if (more) ATT_GLOAD(ATT_TILE(it + 1));
    const bool active = (t <= wave_last) && !fin;
    if (active) {
      const bool domask = (64 * t + 63 > t0);
      const int kbase = 64 * t;
      if (T == AT_DIFF) {
        f32x16 pa0, pa1, pb0, pb1;
#pragma unroll
        for (int r = 0; r < 16; ++r) { pa0[r] = 0.f; pa1[r] = 0.f; pb0[r] = 0.f; pb1[r] = 0.f; }
#pragma unroll
        for (int ks = 0; ks < 2; ++ks) {
          const bf16x8 k0 = *(const LAS bf16x8*)(cur + kro[ks]), k1 = *(const LAS bf16x8*)(cur + kro[ks] + 4096);
          pa0 = __builtin_amdgcn_mfma_f32_32x32x16_bf16(k0, qf[ks], pa0, 0, 0, 0); pa1 = __builtin_amdgcn_mfma_f32_32x32x16_bf16(k1, qf[ks], pa1, 0, 0, 0);
        }
#pragma unroll
        for (int ks = 2; ks < 4; ++ks) {
          const bf16x8 k0 = *(const LAS bf16x8*)(cur + kro[ks]), k1 = *(const LAS bf16x8*)(cur + kro[ks] + 4096);
          pb0 = __builtin_amdgcn_mfma_f32_32x32x16_bf16(k0, qf[ks], pb0, 0, 0, 0); pb1 = __builtin_amdgcn_mfma_f32_32x32x16_bf16(k1, qf[ks], pb1, 0, 0, 0);
        }
        float al0, al1;
        const bool rs0 = softmax_tile(pa0, pa1, m0, l0, CSC, domask, kbase, q, hi, al0);
        const bool rs1 = softmax_tile(pb0, pb1, m1, l1, CSC, domask, kbase, q, hi, al1);
        if (rs0) {
#pragma unroll
          for (int d0 = 0; d0 < 2; ++d0)
#pragma unroll
            for (int r = 0; r < 16; ++r) o0[d0][r] *= al0;
        }
        if (rs1) {
#pragma unroll
          for (int d0 = 0; d0 < 2; ++d0)
#pragma unroll
            for (int r = 0; r < 16; ++r) o1[d0][r] *= al1;
        }
#pragma unroll
        for (int s = 0; s < 4; ++s) {
          const bf16x8 pfa = pack8((s < 2) ? pa0 : pa1, 8 * (s & 1)), pfb = pack8((s < 2) ? pb0 : pb1, 8 * (s & 1));
#pragma unroll
          for (int d0 = 0; d0 < 2; ++d0) {
            const bf16x8 vf = vfrag(cur, vro[d0] + 2048 * s);
            o0[d0] = __builtin_amdgcn_mfma_f32_32x32x16_bf16(vf, pfa, o0[d0], 0, 0, 0);
            o1[d0] = __builtin_amdgcn_mfma_f32_32x32x16_bf16(vf, pfb, o1[d0], 0, 0, 0);
          }
        }
      } else {
        f32x16 p0, p1;
        if (T == AT_FOX) {
#pragma unroll
          for (int g4 = 0; g4 < 4; ++g4) {
            const f32x4 f0 = *(const LAS f32x4*)(cur + ATT_F + (8 * g4 + 4 * hi) * 4), f1 = *(const LAS f32x4*)(cur + ATT_F + (32 + 8 * g4 + 4 * hi) * 4);
            p0[4 * g4] = f0.x; p0[4 * g4 + 1] = f0.y; p0[4 * g4 + 2] = f0.z; p0[4 * g4 + 3] = f0.w;
            p1[4 * g4] = f1.x; p1[4 * g4 + 1] = f1.y; p1[4 * g4 + 2] = f1.z; p1[4 * g4 + 3] = f1.w;
          }
        } else {
#pragma unroll
          for (int r = 0; r < 16; ++r) { p0[r] = 0.f; p1[r] = 0.f; }
        }
#pragma unroll
        for (int ks = 0; ks < 4; ++ks) {
          const bf16x8 k0 = *(const LAS bf16x8*)(cur + kro[ks]), k1 = *(const LAS bf16x8*)(cur + kro[ks] + 4096);
          p0 = __builtin_amdgcn_mfma_f32_32x32x16_bf16(k0, qf[ks], p0, 0, 0, 0); p1 = __builtin_amdgcn_mfma_f32_32x32x16_bf16(k1, qf[ks], p1, 0, 0, 0);
        }
        if (T == AT_MLA) {
#pragma unroll
          for (int ks = 0; ks < 2; ++ks) {
            const bf16x8 k0 = *(const LAS bf16x8*)(cur + k2ro[ks]), k1 = *(const LAS bf16x8*)(cur + k2ro[ks] + 2048);
            p0 = __builtin_amdgcn_mfma_f32_32x32x16_bf16(k0, qf[(NKS == 6) ? 4 + ks : ks], p0, 0, 0, 0);
            p1 = __builtin_amdgcn_mfma_f32_32x32x16_bf16(k1, qf[(NKS == 6) ? 4 + ks : ks], p1, 0, 0, 0);
          }
        }
        if (T == AT_SB) {
          f32x16 e0, e1;
          float T8[8];
#pragma unroll
          for (int half = 0; half < 2; ++half) {
            f32x16& pp = half ? p1 : p0; f32x16& ee = half ? e1 : e0;
#pragma unroll
            for (int r = 0; r < 16; ++r) {
              const float z2 = pp[r] * CSC;
              float lk = -__builtin_amdgcn_logf(1.0f + __builtin_amdgcn_exp2f(fminf(z2, 126.f)));
              const bool valid = !domask || (kbase + 32 * half + crow(r, hi) < q);
              lk = valid ? lk : 0.f;
              pp[r] = valid ? (z2 + lk) : -INFINITY;
              ee[r] = lk;
            }
#pragma unroll
            for (int g4 = 0; g4 < 4; ++g4) {
              const float x0 = ee[4 * g4], x1 = ee[4 * g4 + 1], x2 = ee[4 * g4 + 2], x3 = ee[4 * g4 + 3];
              ee[4 * g4 + 3] = 0.f; ee[4 * g4 + 2] = x3; ee[4 * g4 + 1] = x3 + x2; ee[4 * g4] = x3 + x2 + x1;
              T8[4 * half + g4] = x3 + x2 + x1 + x0;
            }
          }
          float Tl[8], Th[8];
#pragma unroll
          for (int i = 0; i < 8; ++i) pair_vals(T8[i], Tl[i], Th[i]);
          float ps = 0.f; float base[8];
#pragma unroll
          for (int i = 7; i >= 0; --i) { base[i] = Crun + ps + (hi ? 0.f : Th[i]); ps += Tl[i] + Th[i]; }
          Crun += ps;
#pragma unroll
          for (int r = 0; r < 16; ++r) {
            p0[r] = __builtin_amdgcn_exp2f(p0[r] + e0[r] + base[r >> 2]);
            p1[r] = __builtin_amdgcn_exp2f(p1[r] + e1[r] + base[4 + (r >> 2)]);
          }
          if (__all(Crun < -48.f)) fin = true;
        } else {
          float al;
          if (softmax_tile(p0, p1, m0, l0, CSC, domask, kbase, q, hi, al)) {
#pragma unroll
            for (int d0 = 0; d0 < 2; ++d0)
#pragma unroll
              for (int r = 0; r < 16; ++r) o0[d0][r] *= al;
          }
          if (T == AT_FOX) { if (t > 0) { if (__all((qn * kpre[t - 1] + fend[t - 1] - m0) * CSC < -40.f)) fin = true; } }
        }
#pragma unroll
        for (int s = 0; s < 4; ++s) {
          const bf16x8 pf = pack8((s < 2) ? p0 : p1, 8 * (s & 1));
#pragma unroll
          for (int d0 = 0; d0 < 2; ++d0) {
            const bf16x8 vf = vfrag(cur, vro[d0] + 2048 * s);
            o0[d0] = __builtin_amdgcn_mfma_f32_32x32x16_bf16(vf, pf, o0[d0], 0, 0, 0);
          }
        }
      }
    }
    if (more) ATT_LSTORE((it + 1) & 1);
    {
      LAS unsigned char* ctile = lds + 2 * ATT_BUF + 1024;
      if (qidx < CMU_TOTAL) cmu_from_lds(cc, qidx, lane, w, ctile + ((gi + 1) & 1) * 8192);
      if (pidx < CMU_TOTAL) cmu_to_lds(cc, pidx, lane, w, cv, ctile + (gi & 1) * 8192);
      qidx = pidx;
      pidx = cidx;
      if (pidx < CMU_TOTAL) cmu_load(cc, pidx, lane, w, cv);
    }
    if (cfetch && tid == 0) s_conv[((gi >> 3) + 1) & 1] = cnext;
    ++gi;
    if (T == AT_SB || T == AT_FOX) {
      const bool wave_done = fin || (t == 0);
      if (__syncthreads_and(wave_done ? 1 : 0)) break;
    } else {
      __syncthreads();
    }
  }
  __syncthreads();
#undef ATT_TILE
#undef ATT_GLOAD
#undef ATT_LSTORE
  if (T == AT_DIFF) {
    float la, lb; pair_vals(l0, la, lb); const float inv0 = 1.f / (la + lb);
    pair_vals(l1, la, lb); const float inv1 = a.lam / (la + lb);
    float ss = 0.f;
#pragma unroll
    for (int d0 = 0; d0 < 2; ++d0)
#pragma unroll
      for (int r = 0; r < 16; ++r) { const float v = o0[d0][r] * inv0 - o1[d0][r] * inv1; o0[d0][r] = v; ss += v * v; }
    float sa, sb; pair_vals(ss, sa, sb);
    const float rs = rsqrtf((sa + sb) * (1.f / 64.f) + RMS_EPS) * a.oscale;
#pragma unroll
    for (int d0 = 0; d0 < 2; ++d0)
#pragma unroll
      for (int g4 = 0; g4 < 4; ++g4) {
        const int dv = 32 * d0 + 8 * g4 + 4 * hi;
        const f32x4 gg = *(const f32x4*)(a.subg + dv);
        u32x2 o; o.x = cvtpk(o0[d0][4 * g4] * rs * gg.x, o0[d0][4 * g4 + 1] * rs * gg.y); o.y = cvtpk(o0[d0][4 * g4 + 2] * rs * gg.z, o0[d0][4 * g4 + 3] * rs * gg.w);
        *(u32x2*)(a.O + (size_t)q * a.ldo + dv) = o;
      }
  } else {
    float inv = 1.f;
    if (T != AT_SB) { float la, lb; pair_vals(l0, la, lb); inv = 1.f / (la + lb); }
#pragma unroll
    for (int d0 = 0; d0 < 2; ++d0)
#pragma unroll
      for (int g4 = 0; g4 < 4; ++g4) {
        const int dv = 32 * d0 + 8 * g4 + 4 * hi;
        u32x2 o; o.x = cvtpk(o0[d0][4 * g4] * inv, o0[d0][4 * g4 + 1] * inv); o.y = cvtpk(o0[d0][4 * g4 + 2] * inv, o0[d0][4 * g4 + 3] * inv);
        *(u32x2*)(a.O + (size_t)q * a.ldo + dv) = o;
      }
  }
}

__device__ __forceinline__ void phase_attention(const Params& p, int layer, LAS unsigned char* lds) {
  unsigned char* ws = p.ws;
  const bf16_t* P = (const bf16_t*)(ws + OFF_P);
  const bf16_t* qd = (const bf16_t*)(ws + OFF_QD); const bf16_t* kvd = (const bf16_t*)(ws + OFF_KVD);
  bf16_t* mix = (bf16_t*)(ws + OFF_MIX);
  int* ctrl = (int*)(ws + OFF_CTRL);
  const float lam = ((const float*)ctrl)[CW_LAM + layer];
  const float linit = 0.8f - 0.6f * expf(-0.3f * (float)layer);
  LAS int* s_unit = (LAS int*)(lds + 2 * ATT_BUF);
  ConvCtx cc;
  cc.wgu = p.w_gate_up + (size_t)layer * NE * 1024 * 2048; cc.wdn = p.w_down + (size_t)layer * NE * 1024 * 1024;
  cc.dgu = ws + OFF_WGU + (size_t)layer * NE * 2048 * 1024; cc.ddn = ws + OFF_WD + (size_t)layer * NE * 1024 * 1024;
  cc.ctr = ctrl + CW_CONVQ + layer;
  int gi = 0, pidx = CMU_TOTAL, qidx = CMU_TOTAL; float cv[16];
#pragma unroll
  for (int j = 0; j < 16; ++j) cv[j] = 0.f;
  if (get_tid() == 0) ((LAS int*)(lds + 2 * ATT_BUF + 64))[0] = atomicAdd(cc.ctr, 8);
  for (;;) {
    if (get_tid() == 0) *s_unit = atomicAdd(&ctrl[CW_ATTQ + layer], 1);
    __syncthreads();
    const int u = *s_unit;
    __syncthreads();
    if (u >= 1024) break;
    const int qb = 15 - (u >> 6), rem = u & 63, type = rem & 3, bh = rem >> 2, b = bh >> 2, h = bh & 3;
    const size_t rb = (size_t)b * SEQ;
    AttnArgs a{};
    a.O = mix + rb * DM + type * 256 + h * 64; a.ldo = DM;
    if (type == AT_SB) {
      a.Q = P + rb * NP + C_SBQ + h * 64; a.K = P + rb * NP + C_SBK + h * 64; a.V = P + rb * NP + C_SBV + h * 64; a.ldq = a.ldk = a.ldv = NP;
      attn_unit<AT_SB>(lds, a, qb, cc, gi, pidx, qidx, cv);
    } else if (type == AT_DIFF) {
      a.Q = P + rb * NP + C_DFQ + h * 64; a.K = P + rb * NP + C_DFK + h * 64; a.V = P + rb * NP + C_DFV + h * 64; a.ldq = a.ldk = a.ldv = NP;
      a.lam = lam; a.oscale = 1.f - linit; a.subg = p.diff_subln_g + layer * 64;
      attn_unit<AT_DIFF>(lds, a, qb, cc, gi, pidx, qidx, cv);
    } else if (type == AT_FOX) {
      a.Q = P + rb * NP + C_FXQ + h * 64; a.K = P + rb * NP + C_FXK + h * 64; a.V = P + rb * NP + C_FXV + h * 64; a.ldq = a.ldk = a.ldv = NP;
      a.Fk = (const float*)(ws + OFF_FK) + (size_t)bh * SEQ; a.kn = (const float*)(ws + OFF_KN) + bh * 64;
      attn_unit<AT_FOX>(lds, a, qb, cc, gi, pidx, qidx, cv);
    } else {
      a.Q = qd + rb * 384 + h * 96; a.ldq = 384; a.K = kvd + rb * 512 + h * 128; a.ldk = 512; a.V = kvd + rb * 512 + h * 128 + 64; a.ldv = 512;
      a.K2 = P + rb * NP + C_KR; a.ldk2 = NP; a.cs = (const f32x2*)(ws + OFF_ROPE) + rb * 16;
      attn_unit<AT_MLA>(lds, a, qb, cc, gi, pidx, qidx, cv);
    }
  }
  {
    __syncthreads();
    const LAS int* sc = (const LAS int*)(lds + 2 * ATT_BUF + 64);
    const int k = gi >> 3, used = gi & 7;
    const int b0 = __builtin_amdgcn_readfirstlane(sc[k & 1]);
    const int b1 = (used >= 1) ? __builtin_amdgcn_readfirstlane(sc[(k + 1) & 1]) : CMU_TOTAL;
    const int tid = get_tid(), lane = tid & 63, w = tid >> 6;
    if (qidx < CMU_TOTAL) cmu_from_lds(cc, qidx, lane, w, lds + 2 * ATT_BUF + 1024 + ((gi + 1) & 1) * 8192);
    if (pidx < CMU_TOTAL) cmu_store(cc, pidx, lane, w, cv);
#pragma unroll 1
    for (int j = used; j < 16; ++j) {
      const int ci = (j < 8) ? b0 + j : b1 + (j - 8);
      if (ci < CMU_TOTAL) { float v0[16]; cmu_load(cc, ci, lane, w, v0); cmu_store(cc, ci, lane, w, v0); }
    }
    __syncthreads();
  }
  for (;;) {
    if (get_tid() == 0) s_unit[0] = atomicAdd(cc.ctr, 2);
    __syncthreads();
    const int c0 = __builtin_amdgcn_readfirstlane(s_unit[0]);
    __syncthreads();
    if (c0 >= CMU_TOTAL) break;
    const int tid = get_tid(), lane = tid & 63, w = tid >> 6;
    float v0[16], v1[16];
    cmu_load(cc, c0, lane, w, v0);
    if (c0 + 1 < CMU_TOTAL) cmu_load(cc, c0 + 1, lane, w, v1);
    cmu_store(cc, c0, lane, w, v0);
    if (c0 + 1 < CMU_TOTAL) cmu_store(cc, c0 + 1, lane, w, v1);
  }
}

__device__ __forceinline__ size_t tmp_blocked(int row, int col) {
  return (size_t)(row >> 6) * 65536 + (size_t)((((((col >> 7) * 4 + ((col >> 5) & 3)) * 4 + ((col >> 3) & 3)) * 2 + ((row >> 5) & 1)) * 64 + (((col >> 2) & 1) * 32 + (row & 31))) * 4);
}
struct OutprojSched {
  int grid, bid;
  __device__ __forceinline__ bool next(int i, pg8::Unit& u) const {
    int mt, nt;
    if (grid == 256) { if (i > 0) return false; const int xcd = bid & 7, j = bid >> 3; mt = 8 * xcd + (j >> 2); nt = j & 3; }
    else { const int t = bid + i * grid; if (t >= 256) return false; mt = t >> 2; nt = t & 3; }
    u.boff = (unsigned)nt * (256u * 1024u * 2u); u.arow0 = mt * 256; u.mvalid = 256; u.e = 0; u.mt = mt; u.nt = nt; u.slot0 = 0;
    return true;
  }
};
struct OutprojEpi {
  static __device__ __forceinline__ int blane(int lrow) { return lrow; }
  static constexpr __device__ int bpiece(int h, int i) { return 128 * h + 64 * i; }
  static constexpr bool DYNB = false;
  static __device__ __forceinline__ int blane_alt(int lrow) { return lrow; }
  __device__ __forceinline__ bool alt_map(const pg8::Unit&) const { return false; }
  const bf16_t* hB; float* tmp;
  __device__ __forceinline__ void operator()(const pg8::f32x4v (&acc)[2][2][4][2], const pg8::Unit& u, int wr, int wc, int fr, int fq) const {
#pragma unroll
    for (int ai = 0; ai < 2; ++ai)
#pragma unroll
      for (int m = 0; m < 4; ++m) {
        const int row = u.mt * 256 + 128 * ai + 64 * wr + 16 * m + fr;
#pragma unroll
        for (int bj = 0; bj < 2; ++bj)
#pragma unroll
          for (int n = 0; n < 2; ++n) {
            const int col = u.nt * 256 + 128 * bj + 32 * wc + 16 * n + 4 * fq;
            const u32x2 hb = *(const u32x2*)(hB + (size_t)row * DM + col);
            const pg8::f32x4v v = acc[ai][bj][m][n];
            *(f32x4*)(tmp + tmp_blocked(row, col)) = (f32x4){DN_ALPHA * bflo(hb.x) + v[0], DN_ALPHA * bfhi(hb.x) + v[1], DN_ALPHA * bflo(hb.y) + v[2], DN_ALPHA * bfhi(hb.y) + v[3]};
          }
      }
  }
};
__device__ __forceinline__ void phase_outproj(const Params& p, int layer, LAS unsigned char* lds) {
  unsigned char* ws = p.ws;
  OutprojSched S{get_nblk(), get_bid()};
  OutprojEpi E{(const bf16_t*)(ws + OFF_HB), (float*)(ws + OFF_TMPF)};
  pg8::gemm_phase<false, false>(lds, (const bf16_t*)(ws + OFF_MIX), (const bf16_t*)(ws + OFF_WOUT) + (size_t)layer * 1024 * 1024, S, E);
}

__device__ __forceinline__ void phase_ln1_router(const Params& p, int layer, LAS unsigned char* lds) {
  unsigned char* ws = p.ws;
  const float* tmp = (const float*)(ws + OFF_TMPF);
  float* hF = (float*)(ws + OFF_HF); bf16_t* hB = (bf16_t*)(ws + OFF_HB);
  int* ctrl = (int*)(ws + OFF_CTRL); int* cnt = ctrl + CW_CNT + layer * 32;
  int* list = (int*)(ws + OFF_LIST); int* toke = (int*)(ws + OFF_TOKE); float* tokg = (float*)(ws + OFF_TOKG);
  const float* Wr = p.router_w + (size_t)layer * DM * NE; const float* rb = p.router_b + layer * NE;
  const float* g1 = p.ln1_g + layer * DM; const float* b1 = p.ln1_b + layer * DM;
  LAS float* red = (LAS float*)lds;
  LAS float* lg = (LAS float*)(lds + 32768);
  LAS float* part = (LAS float*)(lds + 136192);
  LAS float* part2 = (LAS float*)(lds + 137216);
  LAS int* lcnt = (LAS int*)(lds + 138240);
#pragma unroll 1
  for (int hs = get_bid(); hs < M_TOK / 32; hs += get_nblk()) {
    const int m0 = hs * 32, mi = hs & 1;
    const int tid = get_tid(), lane = tid & 63, w = tid >> 6, c31 = lane & 31, hi = lane >> 5;
    f32x16 acc[4];
    {
      const float* tb = tmp + (size_t)(hs >> 1) * 65536 + (size_t)(w * 32 * 64 + lane) * 4;
#pragma unroll
      for (int ni = 0; ni < 4; ++ni)
#pragma unroll
        for (int g4 = 0; g4 < 4; ++g4) {
          const f32x4 v = *(const f32x4*)(tb + (size_t)(((ni * 4 + g4) * 2 + mi) * 64) * 4);
          acc[ni][4 * g4] = v.x; acc[ni][4 * g4 + 1] = v.y; acc[ni][4 * g4 + 2] = v.z; acc[ni][4 * g4 + 3] = v.w;
        }
    }
    float mean, rstd;
    {
      float sacc = 0.f;
#pragma unroll
      for (int ni = 0; ni < 4; ++ni)
#pragma unroll
        for (int r = 0; r < 16; ++r) sacc += acc[ni][r];
      float s0, s1; pair_vals(sacc, s0, s1);
      if (hi == 0) part[c31 * 8 + w] = s0 + s1;
    }
    __syncthreads();
    {
      const f32x4 pa = *(const LAS f32x4*)(part + c31 * 8), pb = *(const LAS f32x4*)(part + c31 * 8 + 4);
      mean = ((pa.x + pa.y) + (pa.z + pa.w) + (pb.x + pb.y) + (pb.z + pb.w)) * (1.f / DM);
      float q = 0.f;
#pragma unroll
      for (int ni = 0; ni < 4; ++ni)
#pragma unroll
        for (int r = 0; r < 16; ++r) { const float d = acc[ni][r] - mean; q += d * d; }
      float q0, q1; pair_vals(q, q0, q1);
      if (hi == 0) part2[c31 * 8 + w] = q0 + q1;
    }
    __syncthreads();
    {
      const f32x4 pa = *(const LAS f32x4*)(part2 + c31 * 8), pb = *(const LAS f32x4*)(part2 + c31 * 8 + 4);
      rstd = rsqrtf(((pa.x + pa.y) + (pa.z + pa.w) + (pb.x + pb.y) + (pb.z + pb.w)) * (1.f / DM) + LN_EPS);
    }
    LAS unsigned char* wt = lds + w * 16896;
#pragma unroll
    for (int ni = 0; ni < 4; ++ni)
#pragma unroll
      for (int g4 = 0; g4 < 4; ++g4) {
        const int n = 128 * w + ni * 32 + 8 * g4 + 4 * hi;
        const f32x4 gg = *(const f32x4*)(g1 + n), bb = *(const f32x4*)(b1 + n);
        f32x4 y;
        y.x = (acc[ni][4 * g4] - mean) * rstd * gg.x + bb.x; y.y = (acc[ni][4 * g4 + 1] - mean) * rstd * gg.y + bb.y;
        y.z = (acc[ni][4 * g4 + 2] - mean) * rstd * gg.z + bb.z; y.w = (acc[ni][4 * g4 + 3] - mean) * rstd * gg.w + bb.w;
        acc[ni][4 * g4] = y.x; acc[ni][4 * g4 + 1] = y.y; acc[ni][4 * g4 + 2] = y.z; acc[ni][4 * g4 + 3] = y.w;
        *(LAS f32x4*)(wt + c31 * 528 + (ni * 32 + 8 * g4 + 4 * hi) * 4) = y;
      }
    {
      const int cl = (lane & 31) * 4;
      const size_t off0 = (size_t)(m0 + hi) * DM + 128 * w + cl;
      bf16_t* pB = hB + off0; unsigned char* p8 = ws + OFF_H8 + off0;
      const LAS unsigned char* rp = wt + hi * 528 + cl * 4;
#pragma unroll 4
      for (int it = 0; it < 16; ++it) {
        const f32x4 y = *(const LAS f32x4*)rp;
        u32x2 o; o.x = cvtpk(y.x, y.y); o.y = cvtpk(y.z, y.w);
        *(u32x2*)pB = o;
        *(unsigned*)p8 = pk4_fp8(clamp448(y.x * S8_H), clamp448(y.y * S8_H), clamp448(y.z * S8_H), clamp448(y.w * S8_H));
        rp += 2 * 528; pB += 2 * DM; p8 += 2 * DM;
      }
    }
    f32x16 D0;
#pragma unroll
    for (int r = 0; r < 16; ++r) D0[r] = 0.f;
    {
      const float* wrp = Wr + (128 * w + 4 * hi) * 32 + c31;
      float wa[16], wb[16];
#pragma unroll
      for (int r = 0; r < 16; ++r) wa[r] = wrp[(8 * (r >> 2) + (r & 3)) * 32];
#pragma unroll
      for (int ni = 0; ni < 4; ++ni) {
        __builtin_amdgcn_sched_barrier(0);
        if (ni < 3) {
#pragma unroll
          for (int r = 0; r < 16; ++r) wb[r] = wrp[((ni + 1) * 32 + 8 * (r >> 2) + (r & 3)) * 32];
        }
        __builtin_amdgcn_sched_barrier(0);
#pragma unroll
        for (int r = 0; r < 16; ++r) D0 = __builtin_amdgcn_mfma_f32_32x32x2f32(acc[ni][r], wa[r], D0, 0, 0, 0);
        __builtin_amdgcn_sched_barrier(0);
#pragma unroll
        for (int r = 0; r < 16; ++r) wa[r] = wb[r];
      }
    }
    __syncthreads();
#pragma unroll
    for (int r = 0; r < 16; ++r) red[(w * 32 + crow(r, hi)) * 32 + c31] = D0[r];
    __syncthreads();
#pragma unroll
    for (int i = 0; i < 2; ++i) {
      const int idx = tid + 512 * i;
      float sv = rb[idx & 31];
#pragma unroll
      for (int ww = 0; ww < 8; ++ww) sv += red[ww * 1024 + idx];
      lg[(idx & 31) * 32 + (idx >> 5)] = sv;
    }
    if (tid < 32) lcnt[tid] = 0;
    __syncthreads();
    float gt[4]; int li[4], rk[4];
    if (tid < 32) {
      float lv[4]; unsigned used = 0u;
#pragma unroll
      for (int k = 0; k < 4; ++k) {
        float best = -INFINITY; int bi = 0;
        for (int e = 0; e < 32; ++e) { const float v = lg[e * 32 + tid]; if (!((used >> e) & 1u) && v > best) { best = v; bi = e; } }
        used |= 1u << bi; lv[k] = best; li[k] = bi;
      }
      float sm = 0.f;
#pragma unroll
      for (int k = 0; k < 4; ++k) { gt[k] = expf(lv[k] - lv[0]); sm += gt[k]; }
      const float inv = 1.f / sm;
#pragma unroll
      for (int k = 0; k < 4; ++k) { gt[k] *= inv; rk[k] = __hip_atomic_fetch_add(&lcnt[li[k]], 1, __ATOMIC_RELAXED, __HIP_MEMORY_SCOPE_WORKGROUP); }
    }
    __syncthreads();
    if (tid < 32) { const int c = lcnt[tid]; lcnt[32 + tid] = c ? atomicAdd(&cnt[tid], c) : 0; }
    __syncthreads();
    if (tid < 32) {
      const int m = m0 + tid;
#pragma unroll
      for (int k = 0; k < 4; ++k) {
        const int ps = lcnt[32 + li[k]] + rk[k];
        list[li[k] * M_TOK + ps] = m;
        toke[m * 4 + k] = (li[k] << 16) | ps;
        tokg[m * 4 + k] = gt[k];
      }
    }
    __syncthreads();
  }
}

__device__ __forceinline__ void moe_prefix(const int* cnt, LAS int* s_start, LAS int* s_tstart, LAS int* s_cnt) {
  if (get_tid() < 64) {
    const int lane = get_tid();
    const int c = (lane < 32) ? cnt[lane] : 0;
    const int tl = (c + 255) >> 8;
    int ic = c, it = tl;
#pragma unroll
    for (int o = 1; o < 32; o <<= 1) { const int a = __shfl_up(ic, o), b = __shfl_up(it, o); if (lane >= o) { ic += a; it += b; } }
    if (lane < 32) { s_cnt[lane] = c; s_start[lane] = ic - c; s_tstart[lane] = it - tl; }
    if (lane == 31) { s_start[32] = ic; s_tstart[32] = it; }
  }
  __syncthreads();
}

struct MoeSched {
  unsigned estride; int NT, total_mt, grid, bid; const LAS int* s_start; const LAS int* s_tstart; const LAS int* s_cnt;
  __device__ __forceinline__ bool next(int i, pg8::Unit& u) const {
    int mtg, nt; bool ok;
    if (grid == 256) { const int MG = 32 / NT; const int xcd = bid & 7, j = bid >> 3; mtg = MG * (xcd + 8 * i) + j / NT; nt = j % NT; ok = (MG * (8 * i) < total_mt); }
    else { const int item = bid + i * grid; ok = (item < total_mt * NT); mtg = item / NT; nt = item % NT; }
    const bool live = ok && (mtg < total_mt);
    const int mq = live ? mtg : 0;
    const int ln_ = (int)(threadIdx.x & 63);
    const int tend_ = s_tstart[(ln_ < 32 ? ln_ : 31) + 1];
    const int e = (int)__builtin_popcountll(__ballot(ln_ < 32 && tend_ <= mq));
    const int mt = mq - __builtin_amdgcn_readfirstlane(s_tstart[e]);
    const int mv = live ? min(256, __builtin_amdgcn_readfirstlane(s_cnt[e]) - mt * 256) : 0;
    const int sl = __builtin_amdgcn_readfirstlane(s_start[e]) + mt * 256;
    const unsigned bo = (unsigned)e * estride + (unsigned)nt * (256u * 1024u);
    u.boff = bo; u.arow0 = i; u.mvalid = mv; u.e = e; u.mt = mt; u.nt = nt; u.slot0 = sl;
    return ok;
  }
};
struct MoeUpEpi {
  static __device__ __forceinline__ int blane(int lrow) { return 64 * (lrow >> 5) + (lrow & 31); }
  static constexpr __device__ int bpiece(int h, int i) { return 128 * i + 32 * h; }
  static constexpr bool DYNB = false;
  static __device__ __forceinline__ int blane_alt(int lrow) { return lrow; }
  __device__ __forceinline__ bool alt_map(const pg8::Unit&) const { return false; }
  unsigned char* act; const LAS float* btab;
  __device__ __forceinline__ void operator()(const pg8::f32x4v (&acc)[2][2][4][2], const pg8::Unit& u, int wr, int wc, int fr, int fq) const {
    constexpr float US = 1.f / (S8_H * S8_WGU);
    constexpr float KEXP = -1.702f * LOG2E;
    const LAS float* bt = btab + u.arow0 * 256 + 32 * wc + 4 * fq;
    f32x4 bg[2], bl[2];
#pragma unroll
    for (int bj = 0; bj < 2; ++bj) { bg[bj] = *(const LAS f32x4*)(bt + 16 * bj); bl[bj] = *(const LAS f32x4*)(bt + 128 + 16 * bj); }
#pragma unroll
    for (int ai = 0; ai < 2; ++ai) {
      const int rbase = 128 * ai + 64 * wr;
      if (rbase < u.mvalid) {
        unsigned V[4][2];
#pragma unroll
        for (int m = 0; m < 4; ++m)
#pragma unroll
          for (int bj = 0; bj < 2; ++bj) {
            const f32x4 gx = acc[ai][bj][m][0] * US + bg[bj], lx = acc[ai][bj][m][1] * US + bl[bj];
            f32x4 gl, ln, ex;
#pragma unroll
            for (int i = 0; i < 4; ++i) { gl[i] = fminf(gx[i], 7.f); ln[i] = __builtin_amdgcn_fmed3f(lx[i], -7.f, 7.f); }
            const f32x4 ea = gl * KEXP;
#pragma unroll
            for (int i = 0; i < 4; ++i) ex[i] = __builtin_amdgcn_exp2f(ea[i]);
            const f32x4 den = ex + 1.f;
            f32x4 sg;
#pragma unroll
            for (int i = 0; i < 4; ++i) sg[i] = __builtin_amdgcn_rcpf(den[i]);
            const f32x4 o = (gl * sg) * (ln * S8_ACT + S8_ACT);
            V[m][bj] = pk4_fp8(o[0], o[1], o[2], o[3]);
          }
#pragma unroll
        for (int m1 = 0; m1 < 2; ++m1) {
          unsigned r0 = V[2 * m1][0], r1 = V[2 * m1][1], r2 = V[2 * m1 + 1][0], r3 = V[2 * m1 + 1][1];
          { auto t = __builtin_amdgcn_permlane32_swap(r0, r2, false, false); r0 = t[0]; r2 = t[1]; }
          { auto t = __builtin_amdgcn_permlane32_swap(r1, r3, false, false); r1 = t[0]; r3 = t[1]; }
          { auto t = __builtin_amdgcn_permlane16_swap(r0, r1, false, false); r0 = t[0]; r1 = t[1]; }
          { auto t = __builtin_amdgcn_permlane16_swap(r2, r3, false, false); r2 = t[0]; r3 = t[1]; }
          const int rl = rbase + 16 * (2 * m1 + (fq >> 1)) + fr;
          if (rl < u.mvalid) { u32x4 ov; ov.x = r0; ov.y = r1; ov.z = r2; ov.w = r3; *(u32x4*)(act + (size_t)(u.slot0 + rl) * DFF + 128 * u.nt + 32 * wc + 16 * (fq & 1)) = ov; }
        }
      }
    }
  }
};
struct MoeDownEpi {
  static __device__ __forceinline__ int blane(int lrow) { return (lrow & 32) + 8 * ((lrow & 15) >> 2) + 4 * ((lrow >> 4) & 1) + (lrow & 3); }
  static constexpr __device__ int bpiece(int h, int i) { return 128 * h + 64 * i; }
  static constexpr bool DYNB = false;
  static __device__ __forceinline__ int blane_alt(int lrow) { return lrow; }
  __device__ __forceinline__ bool alt_map(const pg8::Unit&) const { return false; }
  bf16_t* yb; const LAS float* btab;
  __device__ __forceinline__ void operator()(const pg8::f32x4v (&acc)[2][2][4][2], const pg8::Unit& u, int wr, int wc, int fr, int fq) const {
    constexpr float us = 1.f / (S8_ACT * S8_WDN);
    const LAS float* bt = btab + u.e * 256 + 32 * wc + 8 * fq;
    f32x4 b4[2][2];
#pragma unroll
    for (int bj = 0; bj < 2; ++bj)
#pragma unroll
      for (int n = 0; n < 2; ++n) b4[bj][n] = *(const LAS f32x4*)(bt + 128 * bj + 4 * n);
#pragma unroll
    for (int ai = 0; ai < 2; ++ai)
#pragma unroll
      for (int m = 0; m < 4; ++m) {
        const int rl = 128 * ai + 64 * wr + 16 * m + fr;
        if (rl < u.mvalid) {
          bf16_t* orow = yb + (size_t)(u.slot0 + rl) * DM + u.nt * 256 + 32 * wc + 8 * fq;
#pragma unroll
          for (int bj = 0; bj < 2; ++bj) {
            const pg8::f32x4v v = acc[ai][bj][m][0], w = acc[ai][bj][m][1];
            u32x4 ov;
            ov.x = cvtpk(fmaf(v[0], us, b4[bj][0].x), fmaf(v[1], us, b4[bj][0].y)); ov.y = cvtpk(fmaf(v[2], us, b4[bj][0].z), fmaf(v[3], us, b4[bj][0].w));
            ov.z = cvtpk(fmaf(w[0], us, b4[bj][1].x), fmaf(w[1], us, b4[bj][1].y)); ov.w = cvtpk(fmaf(w[2], us, b4[bj][1].z), fmaf(w[3], us, b4[bj][1].w));
            *(u32x4*)(orow + 128 * bj) = ov;
          }
        }
      }
  }
};
__device__ __forceinline__ void phase_moe_up(const Params& p, int layer, LAS unsigned char* lds) {
  unsigned char* ws = p.ws;
  const int* cnt = (const int*)(ws + OFF_CTRL) + CW_CNT + layer * 32;
  const int* list = (const int*)(ws + OFF_LIST);
  LAS int* s_start = (LAS int*)(lds + LDS_GEMM); LAS int* s_tstart = s_start + 40; LAS int* s_cnt = s_start + 80;
  moe_prefix(cnt, s_start, s_tstart, s_cnt);
  MoeSched S{2048u * 1024u, 8, __builtin_amdgcn_readfirstlane(s_tstart[32]), get_nblk(), get_bid(), s_start, s_tstart, s_cnt};
  {
    const int tid = get_tid();
    LAS int* rowtab = (LAS int*)(lds + LDS_ROWTAB);
    LAS float* btab = (LAS float*)(lds + LDS_BIASTAB);
    const float* bgu = p.b_gate_up + (size_t)layer * NE * 2048;
    unsigned vals[12]; bool okv[12];
#pragma unroll
    for (int i = 0; i < 12; ++i) {
      pg8::Unit u;
      okv[i] = S.next(i, u);
      vals[i] = 0u;
      if (okv[i]) {
        if (tid < 256) { if (u.mvalid > 0) vals[i] = (unsigned)list[u.e * M_TOK + u.mt * 256 + min(tid, u.mvalid - 1)]; }
        else { const int c = tid - 256; vals[i] = __float_as_uint(bgu[(size_t)u.e * 2048 + (c >> 7) * 1024 + u.nt * 128 + (c & 127)]); }
      }
    }
#pragma unroll
    for (int i = 0; i < 12; ++i) {
      if (okv[i]) { if (tid < 256) rowtab[i * 256 + tid] = (int)vals[i]; else btab[i * 256 + (tid - 256)] = __uint_as_float(vals[i]); }
    }
    __syncthreads();
  }
  MoeUpEpi E{(unsigned char*)(ws + OFF_ACT), (const LAS float*)(lds + LDS_BIASTAB)};
  pg8::gemm_phase<true, true>(lds, (const bf16_t*)(ws + OFF_H8), (const bf16_t*)(ws + OFF_WGU + (size_t)layer * NE * 2048 * 1024), S, E);
}
struct MoeDownSched {
  MoeSched base;
  __device__ __forceinline__ bool next(int i, pg8::Unit& u) const { const bool ok = base.next(i, u); if (ok) { u.arow0 = u.slot0; u.e = i; } return ok; }
};
__device__ __forceinline__ void phase_moe_down(const Params& p, int layer, LAS unsigned char* lds) {
  unsigned char* ws = p.ws;
  const int* cnt = (const int*)(ws + OFF_CTRL) + CW_CNT + layer * 32;
  LAS int* s_start = (LAS int*)(lds + LDS_GEMM); LAS int* s_tstart = s_start + 40; LAS int* s_cnt = s_start + 80;
  moe_prefix(cnt, s_start, s_tstart, s_cnt);
  MoeDownSched S{MoeSched{1024u * 1024u, 4, __builtin_amdgcn_readfirstlane(s_tstart[32]), get_nblk(), get_bid(), s_start, s_tstart, s_cnt}};
  {
    const int tid = get_tid();
    LAS float* btab = (LAS float*)(lds + LDS_BIASTAB);
    const float* bd = p.b_down + (size_t)layer * NE * 1024;
    float vals[12]; bool okv[12];
#pragma unroll
    for (int i = 0; i < 12; ++i) {
      pg8::Unit u;
      okv[i] = S.base.next(i, u);
      vals[i] = 0.f;
      if (okv[i] && tid < 256) vals[i] = bd[(size_t)u.e * 1024 + u.nt * 256 + tid];
    }
#pragma unroll
    for (int i = 0; i < 12; ++i)
      if (okv[i] && tid < 256) btab[i * 256 + tid] = vals[i];
    __syncthreads();
  }
  MoeDownEpi E{(bf16_t*)(ws + OFF_Y), (const LAS float*)(lds + LDS_BIASTAB)};
  pg8::gemm_phase<false, true>(lds, (const bf16_t*)(ws + OFF_ACT), (const bf16_t*)(ws + OFF_WD + (size_t)layer * NE * 1024 * 1024), S, E);
}

__device__ __forceinline__ void phase_combine_ln2(const Params& p, int layer, LAS unsigned char* lds) {
  unsigned char* ws = p.ws;
  const bf16_t* yb = (const bf16_t*)(ws + OFF_Y);
  float* hF = (float*)(ws + OFF_HF); bf16_t* hB = (bf16_t*)(ws + OFF_HB);
  const int* cnt = (const int*)(ws + OFF_CTRL) + CW_CNT + layer * 32;
  const int* toke = (const int*)(ws + OFF_TOKE); const float* tokg = (const float*)(ws + OFF_TOKG);
  LAS int* s_start = (LAS int*)(lds + LDS_GEMM); LAS int* s_tstart = s_start + 40; LAS int* s_cnt = s_start + 80;
  moe_prefix(cnt, s_start, s_tstart, s_cnt);
  const float* g2 = p.ln2_g + layer * DM; const float* b2 = p.ln2_b + layer * DM;
  const bool last = (layer == DEPTH - 1);
  const int lane = get_tid() & 63, gw = get_bid() * 8 + (get_tid() >> 6), ngw = get_nblk() * 8;
  for (int m = gw; m < M_TOK; m += ngw) {
    f32x4 v[4];
#pragma unroll
    for (int j = 0; j < 4; ++j) { const u32x2 hb = *(const u32x2*)(hB + (size_t)m * DM + 4 * lane + 256 * j); v[j] = (f32x4){bflo(hb.x), bfhi(hb.x), bflo(hb.y), bfhi(hb.y)} * DN_ALPHA; }
#pragma unroll
    for (int k = 0; k < 4; ++k) {
      const int ep = toke[m * 4 + k]; const float gt = tokg[m * 4 + k];
      const int slot = s_start[ep >> 16] + (ep & 0xffff);
      const bf16_t* yr = yb + (size_t)slot * DM;
#pragma unroll
      for (int j = 0; j < 4; ++j) {
        const u32x2 a = *(const u32x2*)(yr + 4 * lane + 256 * j);
        v[j].x += gt * bflo(a.x); v[j].y += gt * bfhi(a.x); v[j].z += gt * bflo(a.y); v[j].w += gt * bfhi(a.y);
      }
    }
    ln_row(v, g2, b2, lane);
    if (last) store_row_f32_bf16(v, p.out + (size_t)m * DM, nullptr, lane);
    else store_row_f32_bf16(v, nullptr, hB + (size_t)m * DM, lane);
  }
}

#if defined(__HIP_DEVICE_COMPILE__)
#define PH(call) do { const __attribute__((address_space(4))) Params* q_ = pp; asm volatile("" : "+s"(q_)); Params p; __builtin_memcpy(&p, q_, sizeof(Params)); call; } while (0)
#else
#define PH(call) do { const Params& p = p_unused; (void)pp; call; } while (0)
#endif
__global__ void __launch_bounds__(512) fwd_kernel(Params p_unused) {
  cg::grid_group grid = cg::this_grid();
  extern __shared__ __attribute__((aligned(16))) unsigned char smem[];
  LAS unsigned char* lds = (LAS unsigned char*)smem;
  const __attribute__((address_space(4))) Params* pp = (const __attribute__((address_space(4))) Params*)__builtin_amdgcn_kernarg_segment_ptr();
  if (threadIdx.x < 4) ((volatile LAS unsigned*)(lds + LDS_MISC))[threadIdx.x] = 0u;
  __syncthreads();
#define GRID_BAR() do { XcdBarrier b_; PH(b_.bar = (unsigned*)(p.ws + OFF_CTRL) + CW_BAR); b_.x = xb_xcc_id(); b_.st = (volatile LAS unsigned*)(lds + LDS_MISC); xcd_barrier(b_); } while (0)
  { unsigned* bw; PH(bw = (unsigned*)(p.ws + OFF_CTRL) + CW_BAR); (void)xcd_barrier_post(bw, (volatile LAS unsigned*)(lds + LDS_MISC)); }
  PH(phase_convert(p));
  PH(phase_prologue_misc(p));
  grid.sync();
#pragma unroll 1
  for (int layer = 0; layer < DEPTH; ++layer) {
    PH(phase_inproj(p, layer, lds));
    GRID_BAR();
    PH(phase_mla_up(p, layer, lds));
    GRID_BAR();
    PH(phase_attention(p, layer, lds));
    GRID_BAR();
    PH(phase_outproj(p, layer, lds));
    GRID_BAR();
    PH(phase_ln1_router(p, layer, lds));
    GRID_BAR();
    PH(phase_moe_up(p, layer, lds));
    GRID_BAR();
    PH(phase_moe_down(p, layer, lds));
    GRID_BAR();
    PH(phase_combine_ln2(p, layer, lds));
    if (layer + 1 < DEPTH) GRID_BAR();
  }
}

extern "C" void kernel_launch(void* const* d_in, const int* in_sizes, int n_in, void* d_out, int out_size,
                              void* d_ws, size_t ws_size, hipStream_t stream) {
  static int grid_blocks = 0;
  if (!grid_blocks) {
    int dev = 0, cus = 0, per_cu = 0;
    (void)hipGetDevice(&dev);
    (void)hipDeviceGetAttribute(&cus, hipDeviceAttributeMultiprocessorCount, dev);
    (void)hipFuncSetAttribute((const void*)fwd_kernel, hipFuncAttributeMaxDynamicSharedMemorySize, LDS_BYTES);
    (void)hipOccupancyMaxActiveBlocksPerMultiprocessor(&per_cu, fwd_kernel, 512, LDS_BYTES);
    if (per_cu < 1) { fprintf(stderr, "kernel_launch: occupancy query returned %d\n", per_cu); per_cu = 1; }
    if (per_cu > 1) per_cu = 1;
    grid_blocks = cus * per_cu;
    if (n_in != 23 || ws_size < WS_END) { fprintf(stderr, "kernel_launch: unexpected n_in %d or ws_size %zu (< %zu)\n", n_in, ws_size, (size_t)WS_END); }
  }
  if (ws_size < WS_END) return;
  (void)hipMemsetAsync((char*)d_ws + OFF_CTRL, 0, CTRL_BYTES, stream);
  Params p{};
  p.x = (const float*)d_in[0]; p.pos = (const int*)d_in[1]; p.ln_in_g = (const float*)d_in[2]; p.ln_in_b = (const float*)d_in[3];
  p.w_in = (const float*)d_in[4]; p.b_forget = (const float*)d_in[5]; p.diff_lambda = (const float*)d_in[6]; p.diff_subln_g = (const float*)d_in[7];
  p.mla_q_norm_g = (const float*)d_in[8]; p.mla_w_uq = (const float*)d_in[9]; p.mla_kv_norm_g = (const float*)d_in[10]; p.mla_w_ukv = (const float*)d_in[11];
  p.w_out = (const float*)d_in[12]; p.ln1_g = (const float*)d_in[13]; p.ln1_b = (const float*)d_in[14]; p.router_w = (const float*)d_in[15];
  p.router_b = (const float*)d_in[16]; p.w_gate_up = (const float*)d_in[17]; p.b_gate_up = (const float*)d_in[18]; p.w_down = (const float*)d_in[19];
  p.b_down = (const float*)d_in[20]; p.ln2_g = (const float*)d_in[21]; p.ln2_b = (const float*)d_in[22];
  p.out = (float*)d_out; p.ws = (unsigned char*)d_ws;
  void* args[] = {&p};
  hipError_t e = hipLaunchCooperativeKernel((void*)fwd_kernel, dim3(grid_blocks), dim3(512), args, LDS_BYTES, stream);
  if (e != hipSuccess) fprintf(stderr, "cooperative launch failed: %s (grid %d)\n", hipGetErrorString(e), grid_blocks);
}
```

```cpp
#include <hip/hip_runtime.h>
#include <hip/hip_cooperative_groups.h>
#include <cstdio>
#include <cstdint>
namespace cg = cooperative_groups;

#define LAS __attribute__((address_space(3)))
typedef unsigned short bf16_t;
typedef short bf16x8 __attribute__((ext_vector_type(8)));
typedef short s16x4 __attribute__((ext_vector_type(4)));
typedef float f32x16 __attribute__((ext_vector_type(16)));
typedef float f32x4 __attribute__((ext_vector_type(4)));
typedef float f32x2 __attribute__((ext_vector_type(2)));
typedef unsigned u32x4 __attribute__((ext_vector_type(4)));
typedef int i32x4 __attribute__((ext_vector_type(4)));
typedef unsigned u32x2 __attribute__((ext_vector_type(2)));
typedef __bf16 bf16x2_t __attribute__((ext_vector_type(2)));

constexpr int M_TOK = 16384, DM = 1024, SEQ = 4096, NBATCH = 4, DEPTH = 2;
constexpr int NP = 2816;
constexpr int NE = 32, DFF = 1024, TOPK = 4;
constexpr int C_SBQ = 0, C_SBK = 256, C_SBV = 512, C_DFQ = 768, C_DFK = 1024, C_DFV = 1280, C_FXQ = 1536, C_FXK = 1792, C_FXV = 2048,
              C_CQ = 2304, C_CKV = 2560, C_KR = 2688, C_FXF = 2720, C_END = 2724;
constexpr float LOG2E = 1.4426950408889634f;
constexpr float DN_ALPHA = 1.4142135623730951f;
constexpr float LN_EPS = 1e-5f, RMS_EPS = 1e-6f;
constexpr float S8_H = 16.f, S8_WGU = 64.f, S8_ACT = 8.f, S8_WDN = 128.f;

constexpr size_t MB = 1ull << 20;
constexpr size_t OFF_CTRL = 0, CTRL_BYTES = 65536;
constexpr size_t OFF_ROPE = 1 * MB;
constexpr size_t OFF_GATEF = 3 * MB;
constexpr size_t OFF_WRS = 3 * MB + 256 * 1024;
constexpr size_t OFF_FK = 3 * MB + 512 * 1024;
constexpr size_t OFF_LIST = 4 * MB;
constexpr size_t OFF_TOKE = 6 * MB;
constexpr size_t OFF_TOKG = 6 * MB + 512 * 1024;
constexpr size_t OFF_WUQ = 7 * MB;
constexpr size_t OFF_WUKV = 7 * MB + 512 * 1024;
constexpr size_t OFF_WOUT = 8 * MB;
constexpr size_t OFF_WIN = 12 * MB;
constexpr size_t OFF_HF = 24 * MB;
constexpr size_t OFF_HB = 88 * MB;
constexpr size_t OFF_P = 120 * MB;
constexpr size_t OFF_CQN = 208 * MB;
constexpr size_t OFF_CKVN = 216 * MB;
constexpr size_t OFF_QD = 220 * MB;
constexpr size_t OFF_KVD = 232 * MB;
constexpr size_t OFF_MIX = 248 * MB;
constexpr size_t OFF_TMPF = 280 * MB;
constexpr size_t OFF_KN = 3 * MB + 768 * 1024;
constexpr size_t OFF_H8 = 220 * MB;
constexpr size_t OFF_ACT = 344 * MB;
constexpr size_t OFF_Y = 473 * MB;
constexpr size_t OFF_WGU = 602 * MB;
constexpr size_t OFF_WD = 858 * MB;
constexpr size_t WS_END = 986 * MB;
constexpr int CW_CNT = 0;
constexpr int CW_ATTQ = 128;
constexpr int CW_LAM = 160;
constexpr int CW_CONVQ = 192;
constexpr int CW_BAR = 4096;

constexpr int LDS_ROWTAB = 131072;
constexpr int LDS_GEMM = 143360;
constexpr int LDS_MISC = LDS_GEMM + 1024;
constexpr int LDS_BIASTAB = 147456;
constexpr int LDS_BYTES = 159744;

struct Params {
  const float* x; const int* pos; const float* ln_in_g; const float* ln_in_b; const float* w_in; const float* b_forget;
  const float* diff_lambda; const float* diff_subln_g; const float* mla_q_norm_g; const float* mla_w_uq; const float* mla_kv_norm_g;
  const float* mla_w_ukv; const float* w_out; const float* ln1_g; const float* ln1_b; const float* router_w; const float* router_b;
  const float* w_gate_up; const float* b_gate_up; const float* w_down; const float* b_down; const float* ln2_g; const float* ln2_b;
  float* out; unsigned char* ws;
};

__device__ __forceinline__ unsigned cvtpk(float lo, float hi) { f32x2 v = {lo, hi}; bf16x2_t b = __builtin_convertvector(v, bf16x2_t); return __builtin_bit_cast(unsigned, b); }
__device__ __forceinline__ unsigned pk4_fp8(float a, float b, float c, float d) {
  int w = __builtin_amdgcn_cvt_pk_fp8_f32(a, b, 0, false);
  w = __builtin_amdgcn_cvt_pk_fp8_f32(c, d, w, true);
  return (unsigned)w;
}
__device__ __forceinline__ float clamp448(float x) { return fminf(fmaxf(x, -448.f), 448.f); }
__device__ __forceinline__ float bf2f(unsigned short b) { return __uint_as_float(((unsigned)b) << 16); }
__device__ __forceinline__ float bflo(unsigned w) { return __uint_as_float(w << 16); }
__device__ __forceinline__ float bfhi(unsigned w) { return __uint_as_float(w & 0xffff0000u); }
__device__ __forceinline__ float shx(float v, int mask, int lane) { return __uint_as_float((unsigned)__builtin_amdgcn_ds_bpermute((lane ^ mask) << 2, (int)__float_as_uint(v))); }
__device__ __forceinline__ float shup(float v, int o, int lane) { return __uint_as_float((unsigned)__builtin_amdgcn_ds_bpermute((lane - o) << 2, (int)__float_as_uint(v))); }
__device__ __forceinline__ int shup(int v, int o, int lane) { return __builtin_amdgcn_ds_bpermute((lane - o) << 2, v); }
template <int CTRL> __device__ __forceinline__ float dpp_f(float v) { return __uint_as_float((unsigned)__builtin_amdgcn_update_dpp(0, (int)__float_as_uint(v), CTRL, 0xf, 0xf, true)); }
__device__ __forceinline__ float wave_sum(float v, int lane) {
  (void)lane;
  v += dpp_f<0xB1>(v);
  v += dpp_f<0x4E>(v);
  v += dpp_f<0x141>(v);
  v += dpp_f<0x140>(v);
  { auto t_ = __builtin_amdgcn_permlane16_swap(__float_as_uint(v), __float_as_uint(v), false, false); v = __uint_as_float(t_[0]) + __uint_as_float(t_[1]); }
  { auto t_ = __builtin_amdgcn_permlane32_swap(__float_as_uint(v), __float_as_uint(v), false, false); v = __uint_as_float(t_[0]) + __uint_as_float(t_[1]); }
  return v;
}
__device__ __forceinline__ int get_bid() { int b = blockIdx.x; asm volatile("" : "+s"(b)); return b; }
__device__ __forceinline__ int get_nblk() { int g = gridDim.x; asm volatile("" : "+s"(g)); return g; }
__device__ __forceinline__ int get_tid() { int t = threadIdx.x; asm volatile("" : "+v"(t)); return t; }
__device__ __forceinline__ int crow(int r, int hi) { return (r & 3) + 8 * (r >> 2) + 4 * hi; }
__device__ __forceinline__ void pair_vals(float v, float& v0, float& v1) {
  auto rr = __builtin_amdgcn_permlane32_swap(__float_as_uint(v), __float_as_uint(v), false, false);
  v0 = __uint_as_float(rr[0]); v1 = __uint_as_float(rr[1]);
}


#define XB_TMO      128
#define XB_XCNT(j)  (256  + 64 * (j))
#define XB_XSUB(j)  (1280 + 64 * (j))
#define XB_XGEN(j)  (2304 + 64 * (j))
#define XB_TOP      3328
#define XB_TOPGEN   3392
#define XCD_BAR_WORDS 3456
#define XB_SPIN_CAP (1u << 22)
__device__ __forceinline__ unsigned xb_ld(unsigned* p)              { return __hip_atomic_load(p, __ATOMIC_RELAXED, __HIP_MEMORY_SCOPE_AGENT); }
__device__ __forceinline__ unsigned xb_add(unsigned* p, unsigned v) { return __hip_atomic_fetch_add(p, v, __ATOMIC_RELAXED, __HIP_MEMORY_SCOPE_AGENT); }
__device__ __forceinline__ unsigned xb_xcc_id() { return (unsigned)__builtin_amdgcn_s_getreg((3 << 11) | 20) & 0xFu; }
#define XB_SPIN(cond, bar) do { unsigned _sp = 0; while (cond) { __builtin_amdgcn_s_sleep(1); \
    if ((++_sp & 255u) == 0u) { if (xb_ld(&(bar)[XB_TMO])) break; if (_sp > XB_SPIN_CAP) { atomicAdd(&(bar)[XB_TMO], 1u); break; } } } } while (0)
struct XcdBarrier { unsigned* bar; unsigned x; volatile LAS unsigned* st; };
__device__ __forceinline__ XcdBarrier xcd_barrier_post(unsigned* bar, volatile LAS unsigned* st) {
  XcdBarrier b; b.bar = bar; b.x = xb_xcc_id(); b.st = st;
  if (threadIdx.x == 0) (void)xb_add(&bar[XB_XCNT(b.x)], 1u);
  return b;
}
__device__ __forceinline__ void xcd_barrier_complete(unsigned* bar, unsigned x, unsigned& nloc, unsigned& nx) {
  const unsigned G = gridDim.x * gridDim.y * gridDim.z;
  unsigned sum, cnt, mine, sp = 0u;
  for (;;) {
    sum = 0u; cnt = 0u; mine = 0u;
#pragma unroll
    for (unsigned j = 0; j < 16; ++j) { const unsigned c = xb_ld(&bar[XB_XCNT(j)]); sum += c; cnt += (c > 0u) ? 1u : 0u; mine = (j == x) ? c : mine; }
    if (sum == G) break;
    __builtin_amdgcn_s_sleep(1);
    if ((++sp & 255u) == 0u) { if (xb_ld(&bar[XB_TMO])) break; if (sp > XB_SPIN_CAP) { atomicAdd(&bar[XB_TMO], 1u); break; } }
  }
  nloc = mine > 0u ? mine : 1u; nx = cnt > 0u ? cnt : 1u;
}
__device__ __forceinline__ void xcd_barrier(const XcdBarrier& b) {
  asm volatile("s_waitcnt vmcnt(0)" ::: "memory");
  __syncthreads();
  if (threadIdx.x == 0) {
    unsigned* bar = b.bar;
    __builtin_amdgcn_s_waitcnt(0);
    unsigned nloc = b.st[0], nx = b.st[1];
    if (nloc == 0u) { xcd_barrier_complete(bar, b.x, nloc, nx); b.st[0] = nloc; b.st[1] = nx; }
    const unsigned old = xb_add(&bar[XB_XSUB(b.x)], 1u);
    const unsigned gen = old / nloc;
    if (old + 1u == (gen + 1u) * nloc) {
      asm volatile("buffer_wbl2 sc1\n\tbuffer_inv sc1\n\ts_waitcnt vmcnt(0)" ::: "memory");
      const unsigned og = xb_add(&bar[XB_TOP], 1u);
      const unsigned tg = og / nx;
      if (og + 1u == (tg + 1u) * nx) xb_add(&bar[XB_TOPGEN], 1u);
      else XB_SPIN(xb_ld(&bar[XB_TOPGEN]) == tg, bar);
      xb_add(&bar[XB_XGEN(b.x)], 1u);
      asm volatile("" ::: "memory");
    } else {
      asm volatile("buffer_inv sc1" ::: "memory");
      XB_SPIN(xb_ld(&bar[XB_XGEN(b.x)]) == gen, bar);
      asm volatile("s_waitcnt vmcnt(0)" ::: "memory");
    }
  }
  __syncthreads();
}

struct ConvDesc { const float* src; bf16_t* dst; const float* kscale; int K, Ndst, srcld, mode, kb, nb; };
constexpr int CV_U_IN = 16 * 11, CV_U_OUT = 16 * 4, CV_U_UQ = 4 * 2, CV_U_UKV = 2 * 2;
constexpr int CV_SMALL = 2 * (CV_U_IN + CV_U_OUT + CV_U_UQ + CV_U_UKV);
__device__ __forceinline__ bool conv_desc(const Params& p, int u, ConvDesc& d) {
  unsigned char* ws = p.ws;
  constexpr int T_IN = 2 * CV_U_IN, T_OUT = 2 * CV_U_OUT, T_UQ = 2 * CV_U_UQ;
  const float* src; bf16_t* dst; const float* ksc = nullptr; int K, Ndst, srcld, mode, q, nbn;
  int r = u;
  if (r < T_IN) { const int inst = r / CV_U_IN; q = r % CV_U_IN; src = p.w_in + (size_t)inst * 1024 * 2724; dst = (bf16_t*)(ws + OFF_WIN) + (size_t)inst * NP * 1024; K = 1024; Ndst = NP; srcld = 2724; mode = 1; nbn = 11; }
  else if ((r -= T_IN) < T_OUT) { const int inst = r / CV_U_OUT; q = r % CV_U_OUT; src = p.w_out + (size_t)inst * 1024 * 1024; dst = (bf16_t*)(ws + OFF_WOUT) + (size_t)inst * 1024 * 1024; K = 1024; Ndst = 1024; srcld = 1024; mode = 0; nbn = 4; }
  else if ((r -= T_OUT) < T_UQ) { const int inst = r / CV_U_UQ; q = r % CV_U_UQ; src = p.mla_w_uq + (size_t)inst * 256 * 384; dst = (bf16_t*)(ws + OFF_WUQ) + (size_t)inst * 384 * 256; K = 256; Ndst = 384; srcld = 384; mode = 0; nbn = 2; ksc = p.mla_q_norm_g + inst * 256; }
  else { r -= T_UQ; const int inst = r / CV_U_UKV; q = r % CV_U_UKV; src = p.mla_w_ukv + (size_t)inst * 128 * 512; dst = (bf16_t*)(ws + OFF_WUKV) + (size_t)inst * 512 * 128; K = 128; Ndst = 512; srcld = 512; mode = 0; nbn = 2; ksc = p.mla_kv_norm_g + inst * 128; }
  d.src = src; d.dst = dst; d.kscale = ksc; d.K = K; d.Ndst = Ndst; d.srcld = srcld; d.mode = mode; d.kb = q / nbn; d.nb = q % nbn;
  return u < CV_SMALL;
}
__device__ __forceinline__ void conv_load(const ConvDesc& d, float (&v)[4][8], int lane, int w) {
  const int k0 = d.kb * 64 + 8 * w;
#pragma unroll
  for (int u = 0; u < 4; ++u) {
    const int n = d.nb * 256 + u * 64 + lane;
    int sc = n; bool ok = n < d.Ndst;
    if (d.mode == 1) { if (n < 2304) sc = n; else if (n < C_FXF) sc = n + 4; else if (n < C_END) sc = 2304 + (n - C_FXF); else ok = false; }
    const float* sp = d.src + (size_t)k0 * d.srcld + sc;
#pragma unroll
    for (int j = 0; j < 8; ++j) v[u][j] = ok ? __builtin_nontemporal_load(sp + (size_t)j * d.srcld) : 0.f;
  }
}
__device__ __forceinline__ void conv_store(const ConvDesc& d, const float (&v)[4][8], int lane, int w) {
  const int k0 = d.kb * 64 + 8 * w;
#pragma unroll
  for (int u = 0; u < 4; ++u) {
    const int n = d.nb * 256 + u * 64 + lane;
    if (n < d.Ndst) {
      int dr = n;
      if (d.mode == 2) { const int j = n & 1023; dr = (j >> 4) * 32 + (j & 15) + ((n >= 1024) ? 16 : 0); }
      float g[8];
#pragma unroll
      for (int j = 0; j < 8; ++j) g[j] = d.kscale ? d.kscale[k0 + j] : 1.f;
      u32x4 o; o.x = cvtpk(v[u][0] * g[0], v[u][1] * g[1]); o.y = cvtpk(v[u][2] * g[2], v[u][3] * g[3]); o.z = cvtpk(v[u][4] * g[4], v[u][5] * g[5]); o.w = cvtpk(v[u][6] * g[6], v[u][7] * g[7]);
      *(u32x4*)(d.dst + (size_t)dr * d.K + k0) = o;
    }
  }
}
__device__ __forceinline__ void conv_store_rows(const ConvDesc& d, const float (&v)[4][8], int lane, int w, LAS unsigned char* st) {
  const int k0 = d.kb * 64 + 8 * w;
  float g[8];
#pragma unroll
  for (int j = 0; j < 8; ++j) g[j] = d.kscale ? d.kscale[k0 + j] : 1.f;
#pragma unroll
  for (int u = 0; u < 4; ++u) {
    u32x4 o; o.x = cvtpk(v[u][0] * g[0], v[u][1] * g[1]); o.y = cvtpk(v[u][2] * g[2], v[u][3] * g[3]); o.z = cvtpk(v[u][4] * g[4], v[u][5] * g[5]); o.w = cvtpk(v[u][6] * g[6], v[u][7] * g[7]);
    *(LAS u32x4*)(st + (u * 64 + lane) * 144 + w * 16) = o;
  }
  __syncthreads();
#pragma unroll
  for (int ps = 0; ps < 4; ++ps) {
    const int nl = 32 * w + 8 * ps + (lane >> 3), c = lane & 7, n = d.nb * 256 + nl;
    if (n < d.Ndst) {
      int dr = n;
      if (d.mode == 2) { const int j = n & 1023; dr = (j >> 4) * 32 + (j & 15) + ((n >= 1024) ? 16 : 0); }
      const u32x4 x = *(const LAS u32x4*)(st + nl * 144 + c * 16);
      *(u32x4*)(d.dst + (size_t)dr * d.K + d.kb * 64 + c * 8) = x;
    }
  }
  __syncthreads();
}
__device__ __forceinline__ void phase_convert(const Params& p, LAS unsigned char* lds) {
  const int tid = get_tid(), lane = tid & 63, w = tid >> 6;
  const int G = get_nblk();
  for (int u = get_bid(); u < CV_SMALL; u += G) {
    ConvDesc d; float va[4][8];
    conv_desc(p, u, d);
    conv_load(d, va, lane, w);
    conv_store_rows(d, va, lane, w, lds);
  }
}

__device__ __forceinline__ void ln_row(f32x4 (&v)[4], const float* g, const float* b, int lane) {
  float s = 0.f;
#pragma unroll
  for (int j = 0; j < 4; ++j) s += (v[j].x + v[j].y) + (v[j].z + v[j].w);
  const float mean = wave_sum(s, lane) * (1.f / DM);
  float s2 = 0.f;
#pragma unroll
  for (int j = 0; j < 4; ++j) { v[j] = v[j] - mean; s2 += (v[j].x * v[j].x + v[j].y * v[j].y) + (v[j].z * v[j].z + v[j].w * v[j].w); }
  const float rstd = rsqrtf(wave_sum(s2, lane) * (1.f / DM) + LN_EPS);
#pragma unroll
  for (int j = 0; j < 4; ++j) {
    const f32x4 gg = *(const f32x4*)(g + 4 * lane + 256 * j), bb = *(const f32x4*)(b + 4 * lane + 256 * j);
    v[j] = v[j] * rstd * gg + bb;
  }
}
__device__ __forceinline__ void store_row_f32_bf16(const f32x4 (&v)[4], float* of, bf16_t* ob, int lane) {
#pragma unroll
  for (int j = 0; j < 4; ++j) {
    if (of) *(f32x4*)(of + 4 * lane + 256 * j) = v[j];
    if (ob) { u32x2 w; w.x = cvtpk(v[j].x, v[j].y); w.y = cvtpk(v[j].z, v[j].w); *(u32x2*)(ob + 4 * lane + 256 * j) = w; }
  }
}

__device__ __forceinline__ void phase_prologue_misc(const Params& p) {
  unsigned char* ws = p.ws;
  const int lane = get_tid() & 63, gw = get_bid() * 8 + (get_tid() >> 6), ngw = get_nblk() * 8;
  float* hF = (float*)(ws + OFF_HF); bf16_t* hB = (bf16_t*)(ws + OFF_HB);
  for (int m = gw; m < M_TOK; m += ngw) {
    f32x4 v[4];
#pragma unroll
    for (int j = 0; j < 4; ++j) v[j] = *(const f32x4*)(p.x + (size_t)m * DM + 4 * lane + 256 * j);
    ln_row(v, p.ln_in_g, p.ln_in_b, lane);
    store_row_f32_bf16(v, nullptr, hB + (size_t)m * DM, lane);
  }
  f32x2* cs = (f32x2*)(ws + OFF_ROPE);
  const int gt = get_bid() * 512 + get_tid(), ngt = get_nblk() * 512;
  for (int i = gt; i < M_TOK * 16; i += ngt) {
    const int m = i >> 4, f = i & 15;
    const double invf = exp2(-(double)f * (13.287712379549449 / 16.0));
    double a = (double)p.pos[m] * invf;
    a = a - 6.283185307179586476925 * rint(a * 0.15915494309189533577);
    float sn, cn; __sincosf((float)a, &sn, &cn);
    cs[i] = (f32x2){cn, sn};
  }
  for (int i = gt; i < DEPTH * NE * DM; i += ngt) {
    const int l = i >> 15, e = (i >> 10) & 31, k = i & 1023;
    const float wv = p.router_w[(size_t)l * DM * NE + k * NE + e];
    const unsigned hw = cvtpk(wv, 0.f) & 0xffffu;
    const unsigned lw = cvtpk(wv - bflo(hw), 0.f) & 0xffffu;
    bf16_t* wr = (bf16_t*)(ws + OFF_WRS) + (size_t)l * 2 * NE * DM;
    const int fo = (((k >> 4) * 64) + 32 * ((k >> 3) & 1) + e) * 8 + (k & 7);
    wr[fo] = (bf16_t)hw; wr[NE * DM + fo] = (bf16_t)lw;
  }
  if (get_bid() == 0 && get_tid() < DEPTH) {
    const int l = get_tid(); const float* lp = p.diff_lambda + l * 128;
    float s1 = 0.f, s2 = 0.f;
    for (int i = 0; i < 32; ++i) { s1 += lp[i] * lp[32 + i]; s2 += lp[64 + i] * lp[96 + i]; }
    const float linit = 0.8f - 0.6f * expf(-0.3f * (float)l);
    ((float*)(ws + OFF_CTRL))[CW_LAM + l] = expf(s1) - expf(s2) + linit;
  }
}

struct GemmDesc { const bf16_t* A; int lda; const int* rowidx; int row0; int mvalid; const bf16_t* Bt; int ldb; int K; };

template <int NI>
__device__ __forceinline__ void gemm_tile(LAS unsigned char* lds, const GemmDesc& g, f32x16 (&acc)[2][NI]) {
  constexpr int BN = 64 * NI;
  constexpr int A_BYTES = 256 * 128, B_BYTES = BN * 128, STAGE = A_BYTES + B_BYTES;
  constexpr int NBL = BN / 64;
  const int tid = get_tid(), lane = tid & 63, w = tid >> 6, wm = w >> 1, wn = w & 1, c31 = lane & 31, hi = lane >> 5;
  const int lr = tid >> 3, lc = (tid & 7) ^ ((tid >> 4) & 7);
  const bf16_t* ap[4];
#pragma unroll
  for (int i = 0; i < 4; ++i) {
    const int r = lr + 64 * i;
    int row;
    if (g.rowidx) row = g.rowidx[g.row0 + (r < g.mvalid ? r : 0)]; else row = g.row0 + r;
    ap[i] = g.A + (size_t)row * g.lda + lc * 8;
  }
  const bf16_t* bp = g.Bt + (size_t)lr * g.ldb + lc * 8;
  const int wbase = w * 1024;
  const int xr = (lane >> 1) & 7;
  int roff[4];
#pragma unroll
  for (int ks = 0; ks < 4; ++ks) roff[ks] = ((2 * ks + hi) ^ xr) << 4;
  const int a_base = (wm * 64 + c31) * 128, b_base = A_BYTES + (wn * 32 * NI + c31) * 128;
#pragma unroll
  for (int mi = 0; mi < 2; ++mi)
#pragma unroll
    for (int ni = 0; ni < NI; ++ni)
#pragma unroll
      for (int r = 0; r < 16; ++r) acc[mi][ni][r] = 0.f;
  const int nk = g.K >> 6;
#define GT_STAGE(stg, ko) do { LAS unsigned char* s_ = lds + (stg) * STAGE + wbase; \
    _Pragma("unroll") for (int i = 0; i < 4; ++i) __builtin_amdgcn_global_load_lds((const unsigned*)(ap[i] + (ko)), (LAS unsigned*)(s_ + 8192 * i), 16, 0, 0); \
    _Pragma("unroll") for (int i = 0; i < NBL; ++i) __builtin_amdgcn_global_load_lds((const unsigned*)(bp + (size_t)(64 * i) * g.ldb + (ko)), (LAS unsigned*)(s_ + A_BYTES + 8192 * i), 16, 0, 0); } while (0)
  GT_STAGE(0, 0);
  __syncthreads();
  bf16x8 af[2][2], bfr[2][NI];
  for (int kt = 0; kt < nk; ++kt) {
    LAS unsigned char* cur = lds + (kt & 1) * STAGE;
    if (kt + 1 < nk) GT_STAGE((kt + 1) & 1, (kt + 1) * 64);
#pragma unroll
    for (int mi = 0; mi < 2; ++mi) af[0][mi] = *(const LAS bf16x8*)(cur + a_base + mi * 4096 + roff[0]);
#pragma unroll
    for (int ni = 0; ni < NI; ++ni) bfr[0][ni] = *(const LAS bf16x8*)(cur + b_base + ni * 4096 + roff[0]);
#pragma unroll
    for (int ks = 0; ks < 4; ++ks) {
      if (ks < 3) {
#pragma unroll
        for (int mi = 0; mi < 2; ++mi) af[(ks + 1) & 1][mi] = *(const LAS bf16x8*)(cur + a_base + mi * 4096 + roff[ks + 1]);
#pragma unroll
        for (int ni = 0; ni < NI; ++ni) bfr[(ks + 1) & 1][ni] = *(const LAS bf16x8*)(cur + b_base + ni * 4096 + roff[ks + 1]);
      }
      __builtin_amdgcn_s_setprio(1);
#pragma unroll
      for (int mi = 0; mi < 2; ++mi)
#pragma unroll
        for (int ni = 0; ni < NI; ++ni) acc[mi][ni] = __builtin_amdgcn_mfma_f32_32x32x16_bf16(bfr[ks & 1][ni], af[ks & 1][mi], acc[mi][ni], 0, 0, 0);
      __builtin_amdgcn_s_setprio(0);
    }
    __syncthreads();
  }
#undef GT_STAGE
}


namespace pg8 {
typedef float f32x4v __attribute__((ext_vector_type(4)));
constexpr int BM = 256, BK = 64, HALF = 128, HTB = HALF * BK * 2, STAGE_BYTES = 8 * HTB, KK = 1024;
typedef int v8i_t __attribute__((ext_vector_type(8)));
typedef int v4i_t __attribute__((ext_vector_type(4)));
__device__ __forceinline__ v8i_t cat8(bf16x8 a, bf16x8 b) { const v4i_t x = __builtin_bit_cast(v4i_t, a), y = __builtin_bit_cast(v4i_t, b); return __builtin_shufflevector(x, y, 0, 1, 2, 3, 4, 5, 6, 7); }
__device__ __forceinline__ int lds_byte(int r, int c) { const int st = (r >> 4) * 2 + (c >> 5), rr = r & 15, cc = c & 31, ob = rr * 64 + cc * 2; return st * 1024 + (ob ^ (((ob >> 9) & 1) << 5)); }
__device__ __forceinline__ void stage_rc(int b, int& R, int& C) { const int st = b / 1024, sb = b % 1024, swz = sb ^ (((sb >> 9) & 1) << 5); R = (st >> 1) * 16 + swz / 64; C = (st & 1) * 32 + (swz % 64) / 2; }
struct Unit { unsigned boff; int arow0; int mvalid; int e, mt, nt, slot0; };
template <bool GATHER, bool FP8, class Sched, class Epi>
__device__ __forceinline__ void gemm_phase(LAS unsigned char* lds, const bf16_t* Abuf, const bf16_t* Bbuf, const Sched& S, const Epi& E) {
  const int tid = get_tid(), wid = __builtin_amdgcn_readfirstlane(tid >> 6), lane = tid & 63, wr = wid >> 2, wc = wid & 3, fr = lane & 15, fq = lane >> 4;
  const __amdgpu_buffer_rsrc_t rsA = __builtin_amdgcn_make_buffer_rsrc((void*)Abuf, (short)0, 0x7ffffff0, 0x00020000);
  const __amdgpu_buffer_rsrc_t rsB = __builtin_amdgcn_make_buffer_rsrc((void*)Bbuf, (short)0, 0x7ffffff0, 0x00020000);
  constexpr int RS = FP8 ? KK : 2 * KK;
  constexpr int NT_K = FP8 ? 8 : 16;
  const int lrow = (wid >> 1) * 16 + (lane >> 2);
  const int cbyte = (wid & 1) * 64 + (((lane & 3) * 16) ^ (((lane >> 5) & 1) << 5));
  const unsigned vB = (unsigned)(lrow * RS + cbyte);
  const unsigned vBb = (unsigned)(Epi::blane(lrow) * RS + cbyte);
  const unsigned vBdlt = (unsigned)((Epi::blane_alt(lrow) - Epi::blane(lrow)) * RS);
  const LAS int* rowtab = (const LAS int*)(lds + LDS_ROWTAB) + lrow;
#define PG8_ROWS(V, u) do { if (GATHER) { _Pragma("unroll") for (int h_ = 0; h_ < 2; ++h_) _Pragma("unroll") for (int i_ = 0; i_ < 2; ++i_) \
      V[h_][i_] = (unsigned)(rowtab[(u).arow0 * 256 + h_ * HALF + i_ * 64] * RS + cbyte); } } while (0)
#define PG8_ABASE(u) (GATHER ? 0u : (unsigned)(u).arow0 * (unsigned)RS)
  constexpr unsigned kstep = BK * 2;
  const unsigned ldsw = (unsigned)wid * 1024u;
  const int aoff = lds_byte(wr * 64 + fr, fq * 8), boff = lds_byte(wc * 32 + fr, fq * 8);
#define PG8_SA(b, h) (((b) * 2 + (h)) * HTB)
#define PG8_SB(b, h) ((4 + (b) * 2 + (h)) * HTB)
#define PG8_LOAD1(rs, ldsoff, voff, soff) __builtin_amdgcn_raw_ptr_buffer_load_lds(rs, (LAS void*)(lds + (ldsoff) + ldsw), 16, (int)(voff), (int)(soff), 0, 0)
#define PG8_STAGE_B(bufoff, soff, h, vb) do { PG8_LOAD1(rsB, (bufoff), (vb), (soff) + (unsigned)(Epi::bpiece((h), 0) * RS)); PG8_LOAD1(rsB, (bufoff) + 8192, (vb), (soff) + (unsigned)(Epi::bpiece((h), 1) * RS)); } while (0)
#define PG8_STAGE_A(bufoff, soff, h, v0, v1) do { if (GATHER) { PG8_LOAD1(rsA, (bufoff), (v0), (soff)); PG8_LOAD1(rsA, (bufoff) + 8192, (v1), (soff)); } \
    else { PG8_LOAD1(rsA, (bufoff), vB, (soff) + (unsigned)((h) * HALF * RS)); PG8_LOAD1(rsA, (bufoff) + 8192, vB, (soff) + (unsigned)(((h) * HALF + 64) * RS)); } } while (0)
#define PG8_LDA(dst, b, h) do { if (FP8) { _Pragma("unroll") for (int m = 0; m < 4; ++m) { \
      const v4i_t lo_ = *(const LAS v4i_t*)(lds + PG8_SA(b, h) + aoff + m * 2048), hi_ = *(const LAS v4i_t*)(lds + PG8_SA(b, h) + aoff + m * 2048 + 1024); \
      dst##8[m] = __builtin_shufflevector(lo_, hi_, 0, 1, 2, 3, 4, 5, 6, 7); } } \
    else { _Pragma("unroll") for (int m = 0; m < 4; ++m) _Pragma("unroll") for (int k = 0; k < 2; ++k) dst[m][k] = *(const LAS bf16x8*)(lds + PG8_SA(b, h) + aoff + m * 2048 + k * 1024); } } while (0)
#define PG8_LDB(dst, b, h) do { if (FP8) { _Pragma("unroll") for (int n = 0; n < 2; ++n) { \
      const v4i_t lo_ = *(const LAS v4i_t*)(lds + PG8_SB(b, h) + boff + n * 2048), hi_ = *(const LAS v4i_t*)(lds + PG8_SB(b, h) + boff + n * 2048 + 1024); \
      dst##8[n] = __builtin_shufflevector(lo_, hi_, 0, 1, 2, 3, 4, 5, 6, 7); } } \
    else { _Pragma("unroll") for (int n = 0; n < 2; ++n) _Pragma("unroll") for (int k = 0; k < 2; ++k) dst[n][k] = *(const LAS bf16x8*)(lds + PG8_SB(b, h) + boff + n * 2048 + k * 1024); } } while (0)
#define PG8_MMA(ai, bj, At, Bt) do { __builtin_amdgcn_s_setprio(1); _Pragma("unroll") for (int m = 0; m < 4; ++m) _Pragma("unroll") for (int n = 0; n < 2; ++n) { \
    if (FP8) asm volatile("v_mfma_scale_f32_16x16x128_f8f6f4 %0, %1, %2, %0, %3, %3 op_sel_hi:[0,0,0]" : "+v"(acc[ai][bj][m][n]) : "v"(Bt##8[n]), "v"(At##8[m]), "v"(sc1));   \
    else { _Pragma("unroll") for (int k = 0; k < 2; ++k) acc[ai][bj][m][n] = __builtin_amdgcn_mfma_f32_16x16x32_bf16(Bt[n][k], At[m][k], acc[ai][bj][m][n], 0, 0, 0); } } \
    __builtin_amdgcn_s_setprio(0); } while (0)
#define PG8_WAIT_V(n) asm volatile("s_waitcnt vmcnt(" #n ")" ::: "memory")
#define PG8_WAIT_L(n) asm volatile("s_waitcnt lgkmcnt(" #n ")" ::: "memory")
#define PG8_WAIT_R(FIRST) do { if ((FIRST) && relax) asm volatile("s_waitcnt vmcnt(%0)" :: "n"(Epi::MIN_ST + 8) : "memory"); else PG8_WAIT_V(8); } while (0)
#define PG8_BAR __builtin_amdgcn_s_barrier()
#define PG8_SCHED __builtin_amdgcn_sched_barrier(0)
  Unit cur, nxt; int ui = 0;
  if (!S.next(0, cur)) return;
  f32x4v acc[2][2][4][2];
#pragma unroll
  for (int a = 0; a < 2; ++a)
#pragma unroll
    for (int b = 0; b < 2; ++b)
#pragma unroll
      for (int m = 0; m < 4; ++m)
#pragma unroll
        for (int n = 0; n < 2; ++n) acc[a][b][m][n] = (f32x4v){0.f, 0.f, 0.f, 0.f};
  unsigned sc1 = 0x7f7f7f7fu; asm volatile("" : "+v"(sc1));
  bf16x8 At[4][2], B0[2][2], B1[2][2];
  v8i_t At8[4], B08[2], B18[2];
  unsigned cV[2][2];
#pragma unroll
  for (int h = 0; h < 2; ++h)
#pragma unroll
    for (int i = 0; i < 2; ++i) cV[h][i] = 0u;
  PG8_ROWS(cV, cur);
  unsigned cA = PG8_ABASE(cur), cB = cur.boff;
  bool altc = false, altn = false;
  if (Epi::DYNB) altc = E.alt_map(cur);
#define PG8_VB(alt) (Epi::DYNB ? vBb + ((alt) ? vBdlt : 0u) : vBb)
  const unsigned vBc = PG8_VB(altc);
  PG8_STAGE_B(PG8_SB(0, 0), cB, 0, vBc); PG8_STAGE_B(PG8_SB(0, 1), cB, 1, vBc);
  PG8_STAGE_A(PG8_SA(0, 0), cA, 0, cV[0][0], cV[0][1]); PG8_STAGE_A(PG8_SA(0, 1), cA, 1, cV[1][0], cV[1][1]);
  if (wr == 1) PG8_BAR;
  PG8_WAIT_V(2); PG8_BAR;
  PG8_STAGE_B(PG8_SB(1, 0), cB + kstep, 0, vBc); PG8_STAGE_A(PG8_SA(1, 0), cA + kstep, 0, cV[0][0], cV[0][1]); PG8_STAGE_B(PG8_SB(1, 1), cB + kstep, 1, vBc);
  if (Epi::RELAX) { PG8_STAGE_A(PG8_SA(1, 1), cA + kstep, 1, cV[1][0], cV[1][1]); PG8_WAIT_V(8); } else PG8_WAIT_V(6);
  PG8_BAR;
  bool relax = false;
  for (;;) {
    const bool has_next = S.next(ui + 1, nxt);
    const unsigned nB = has_next ? nxt.boff : cB;
    const unsigned nA = has_next ? PG8_ABASE(nxt) : cA;
    if (Epi::DYNB) { altn = altc; if (has_next) altn = E.alt_map(nxt); }
#define PG8_TRIP(FIRST) { \
      const bool last = !(FIRST) && (t == NT_K - 2); \
      const unsigned a1 = cA + (unsigned)(t + 1) * kstep; \
      const unsigned a2 = last ? nA : cA + (unsigned)(t + 2) * kstep, b2 = last ? nB : cB + (unsigned)(t + 2) * kstep; \
      const unsigned a3 = a2 + kstep, b3 = b2 + kstep; \
      unsigned w00 = cV[0][0], w01 = cV[0][1], w10 = cV[1][0], w11 = cV[1][1]; \
      if (GATHER && last && has_next) { unsigned nV[2][2]; PG8_ROWS(nV, nxt); w00 = nV[0][0]; w01 = nV[0][1]; w10 = nV[1][0]; w11 = nV[1][1]; } \
      const unsigned wB = PG8_VB(last ? altn : altc); \
        \
      PG8_LDB(B0, 0, 0); PG8_LDB(B1, 0, 1); PG8_SCHED; PG8_LDA(At, 0, 0); if (!(FIRST)) PG8_STAGE_A(PG8_SA(1, 1), a1, 1, cV[1][0], cV[1][1]); \
      PG8_WAIT_R(FIRST); PG8_WAIT_L(0); PG8_BAR; PG8_MMA(0, 0, At, B0); PG8_MMA(0, 1, At, B1); PG8_BAR; PG8_SCHED; \
        \
      PG8_LDA(At, 0, 1); PG8_STAGE_B(PG8_SB(0, 0), b2, 0, wB); PG8_STAGE_B(PG8_SB(0, 1), b2, 1, wB); PG8_STAGE_A(PG8_SA(0, 0), a2, 0, w00, w01); \
      PG8_WAIT_R(FIRST); PG8_WAIT_L(0); PG8_BAR; PG8_MMA(1, 0, At, B0); PG8_MMA(1, 1, At, B1); PG8_BAR; PG8_SCHED; \
        \
      PG8_LDB(B0, 1, 0); PG8_LDB(B1, 1, 1); PG8_SCHED; PG8_LDA(At, 1, 0); PG8_STAGE_A(PG8_SA(0, 1), a2, 1, w10, w11); \
      PG8_WAIT_R(FIRST); PG8_WAIT_L(0); PG8_BAR; PG8_MMA(0, 0, At, B0); PG8_MMA(0, 1, At, B1); PG8_BAR; PG8_SCHED; \
        \
      PG8_LDA(At, 1, 1); PG8_STAGE_B(PG8_SB(1, 0), b3, 0, wB); PG8_STAGE_B(PG8_SB(1, 1), b3, 1, wB); PG8_STAGE_A(PG8_SA(1, 0), a3, 0, w00, w01); \
      PG8_WAIT_V(8); PG8_WAIT_L(0); PG8_BAR; PG8_MMA(1, 0, At, B0); PG8_MMA(1, 1, At, B1); PG8_BAR; PG8_SCHED; \
    }
    if (Epi::RELAX) { const int t = 0; PG8_TRIP(1) }
#pragma unroll 1
    for (int t = Epi::RELAX ? 2 : 0; t < NT_K; t += 2) PG8_TRIP(0)
#undef PG8_TRIP
    if (wr == 0) PG8_BAR;
    if (Epi::RELAX) {
      unsigned e0 = cV[1][0], e1 = cV[1][1];
      if (GATHER && has_next) { e0 = (unsigned)(rowtab[nxt.arow0 * 256 + HALF] * RS + cbyte); e1 = (unsigned)(rowtab[nxt.arow0 * 256 + HALF + 64] * RS + cbyte); }
      PG8_STAGE_A(PG8_SA(1, 1), nA + kstep, 1, e0, e1);
      asm volatile("" ::: "memory");
    }
    if (FP8) asm volatile("s_nop 15\n\ts_nop 15" ::: "memory");
    E(acc, cur, wr, wc, fr, fq);
    if (!has_next) break;
#pragma unroll
    for (int a = 0; a < 2; ++a)
#pragma unroll
      for (int b = 0; b < 2; ++b)
#pragma unroll
        for (int m = 0; m < 4; ++m)
#pragma unroll
          for (int n = 0; n < 2; ++n) acc[a][b][m][n] = (f32x4v){0.f, 0.f, 0.f, 0.f};
    if (FP8) asm volatile("s_nop 7" ::: "memory");
    relax = (cur.mvalid == 256);
    cur = nxt; cB = nB; cA = nA; ++ui;
    if (Epi::DYNB) altc = altn;
    PG8_ROWS(cV, cur);
    if (wr == 1) PG8_BAR;
  }
  PG8_WAIT_V(0);
  PG8_BAR;
#undef PG8_ROWS
#undef PG8_ABASE
#undef PG8_SA
#undef PG8_SB
#undef PG8_LOAD1
#undef PG8_STAGE_A
#undef PG8_STAGE_B
#undef PG8_LDA
#undef PG8_LDB
#undef PG8_MMA
#undef PG8_WAIT_V
#undef PG8_WAIT_L
#undef PG8_WAIT_R
#undef PG8_VB
#undef PG8_BAR
#undef PG8_SCHED
}
}

struct InprojSched {
  int grid, bid;
  __device__ __forceinline__ bool next(int i, pg8::Unit& u) const {
    constexpr int NT = NP / 256;
    int mt, nt;
    if (grid == 256) { const int xcd = bid & 7, j = bid >> 3, q = j + 32 * i; if (q >= 8 * NT) return false; mt = 8 * xcd + q / NT; nt = q % NT; }
    else { const int t = bid + i * grid; if (t >= 64 * NT) return false; mt = t / NT; nt = t % NT; }
    u.boff = (unsigned)nt * (256u * 1024u * 2u); u.arow0 = mt * 256; u.mvalid = 256; u.e = 0; u.mt = mt; u.nt = nt; u.slot0 = 0;
    return true;
  }
};
struct InprojEpi {
  static constexpr bool RELAX = true;
  static constexpr int MIN_ST = 16;
  static constexpr bool DYNB = false;
  static __device__ __forceinline__ int blane(int lrow) { return (lrow & 32) + 8 * ((lrow & 15) >> 2) + 4 * ((lrow >> 4) & 1) + (lrow & 3); }
  static __device__ __forceinline__ int blane_alt(int lrow) { return lrow; }
  static constexpr __device__ int bpiece(int h, int i) { return 128 * h + 64 * i; }
  __device__ __forceinline__ bool alt_map(const pg8::Unit&) const { return false; }
  bf16_t* P; float* gateF; const f32x2* cs; float* ssq;
  __device__ __forceinline__ void operator()(const pg8::f32x4v (&acc)[2][2][4][2], const pg8::Unit& u, int wr, int wc, int fr, int fq) const {
    const int nt = u.nt;
    const bool rope_all = (nt == 3) || (nt == 4);
    const bool lo = fq < 2;
#pragma unroll
    for (int ai = 0; ai < 2; ++ai)
#pragma unroll
      for (int m = 0; m < 4; ++m) {
        const int row = u.mt * 256 + 128 * ai + 64 * wr + 16 * m + fr;
        bf16_t* prow = P + (size_t)row * NP + nt * 256 + 32 * wc + 8 * fq;
        f32x4 c8[4];
        if (rope_all || (nt == 10 && wc == 0)) {
          const f32x4* cp = (const f32x4*)(cs + (size_t)row * 16 + 8 * (fq & 1));
#pragma unroll
          for (int j = 0; j < 4; ++j) c8[j] = cp[j];
        }
        float sq = 0.f;
#pragma unroll
        for (int bj = 0; bj < 2; ++bj) {
          pg8::f32x4v v[2] = {acc[ai][bj][m][0], acc[ai][bj][m][1]};
          if (rope_all || (nt == 10 && bj == 1 && wc == 0)) {
#pragma unroll
            for (int n = 0; n < 2; ++n)
#pragma unroll
              for (int j = 0; j < 4; ++j) {
                const int q = 4 * n + j;
                const float co = (q & 1) ? c8[q >> 1].z : c8[q >> 1].x, si = (q & 1) ? c8[q >> 1].w : c8[q >> 1].y;
                float x1, x2; pair_vals(v[n][j], x1, x2);
                v[n][j] = lo ? x1 * co - x2 * si : x2 * co + x1 * si;
              }
          }
          if (nt == 9 || (nt == 10 && bj == 0)) {
#pragma unroll
            for (int j = 0; j < 4; ++j) sq += v[0][j] * v[0][j] + v[1][j] * v[1][j];
          }
          u32x4 o; o.x = cvtpk(v[0][0], v[0][1]); o.y = cvtpk(v[0][2], v[0][3]); o.z = cvtpk(v[1][0], v[1][1]); o.w = cvtpk(v[1][2], v[1][3]);
          *(u32x4*)(prow + 128 * bj) = o;
          if (nt == 10 && bj == 1 && wc == 1 && fq == 0) *(f32x4*)(gateF + (size_t)row * 4) = (f32x4){v[0][0], v[0][1], v[0][2], v[0][3]};
        }
        if (nt == 9 || nt == 10) {
          { auto t_ = __builtin_amdgcn_permlane16_swap(__float_as_uint(sq), __float_as_uint(sq), false, false); sq = __uint_as_float(t_[0]) + __uint_as_float(t_[1]); }
          { float sa_, sb_; pair_vals(sq, sa_, sb_); sq = sa_ + sb_; }
          if (fq == 0) ssq[(size_t)row * 8 + (nt == 9 ? 0 : 4) + wc] = sq;
        }
      }
  }
};
__device__ __forceinline__ void phase_inproj(const Params& p, int layer, LAS unsigned char* lds) {
  unsigned char* ws = p.ws;
  InprojSched S{get_nblk(), get_bid()};
  InprojEpi E{(bf16_t*)(ws + OFF_P), (float*)(ws + OFF_GATEF), (const f32x2*)(ws + OFF_ROPE), (float*)(ws + OFF_CQN)};
  pg8::gemm_phase<false, false>(lds, (const bf16_t*)(ws + OFF_HB), (const bf16_t*)(ws + OFF_WIN) + (size_t)layer * NP * 1024, S, E);
}

__device__ __forceinline__ void rope4(bf16_t* base, const f32x2* cs4) {
  const u32x2 a = *(const u32x2*)base, b = *(const u32x2*)(base + 16);
  float x1[4] = {bflo(a.x), bfhi(a.x), bflo(a.y), bfhi(a.y)}, x2[4] = {bflo(b.x), bfhi(b.x), bflo(b.y), bfhi(b.y)};
  float y1[4], y2[4];
#pragma unroll
  for (int i = 0; i < 4; ++i) { const f32x2 c = cs4[i]; y1[i] = x1[i] * c.x - x2[i] * c.y; y2[i] = x2[i] * c.x + x1[i] * c.y; }
  u32x2 oa, ob; oa.x = cvtpk(y1[0], y1[1]); oa.y = cvtpk(y1[2], y1[3]); ob.x = cvtpk(y2[0], y2[1]); ob.y = cvtpk(y2[2], y2[3]);
  *(u32x2*)base = oa; *(u32x2*)(base + 16) = ob;
}
__device__ __forceinline__ void phase_post(const Params& p, int layer, LAS unsigned char* lds) {
  unsigned char* ws = p.ws;
  bf16_t* P = (bf16_t*)(ws + OFF_P);
  const f32x2* cs = (const f32x2*)(ws + OFF_ROPE);
  bf16_t* cqn = (bf16_t*)(ws + OFF_CQN); bf16_t* ckvn = (bf16_t*)(ws + OFF_CKVN);
  const int lane = get_tid() & 63, gw = get_bid() * 8 + (get_tid() >> 6), ngw = get_nblk() * 8;
  const float* gq = p.mla_q_norm_g + layer * 256; const float* gkv = p.mla_kv_norm_g + layer * 128;
  for (int m = gw; m < M_TOK; m += ngw) {
    bf16_t* row = P + (size_t)m * NP;
    const f32x2* csm = cs + (size_t)m * 16;
    { const int sh = lane >> 2, pg = lane & 3; rope4(row + C_DFQ + sh * 32 + 4 * pg, csm + 4 * pg); }
    if (lane < 4) rope4(row + C_KR + 4 * lane, csm + 4 * lane);
    {
      const u32x2 a = *(const u32x2*)(row + C_CQ + 4 * lane);
      float x[4] = {bflo(a.x), bfhi(a.x), bflo(a.y), bfhi(a.y)};
      const float ss = wave_sum(x[0] * x[0] + x[1] * x[1] + x[2] * x[2] + x[3] * x[3], lane);
      const float rs = rsqrtf(ss * (1.f / 256.f) + RMS_EPS);
      const f32x4 gg = *(const f32x4*)(gq + 4 * lane);
      u32x2 o; o.x = cvtpk(x[0] * rs * gg.x, x[1] * rs * gg.y); o.y = cvtpk(x[2] * rs * gg.z, x[3] * rs * gg.w);
      *(u32x2*)(cqn + (size_t)m * 256 + 4 * lane) = o;
    }
    {
      const unsigned a = *(const unsigned*)(row + C_CKV + 2 * lane);
      const float x0 = bflo(a), x1 = bfhi(a);
      const float ss = wave_sum(x0 * x0 + x1 * x1, lane);
      const float rs = rsqrtf(ss * (1.f / 128.f) + RMS_EPS);
      const f32x2 gg = *(const f32x2*)(gkv + 2 * lane);
      *(unsigned*)(ckvn + (size_t)m * 128 + 2 * lane) = cvtpk(x0 * rs * gg.x, x1 * rs * gg.y);
    }
  }
  if (get_bid() < 16) {
    const int b = get_bid() >> 2, h = get_bid() & 3, tid = get_tid();
    const float* gateF = (const float*)(ws + OFF_GATEF);
    float* Fk = (float*)(ws + OFF_FK) + (size_t)get_bid() * SEQ;
    const float bf = p.b_forget[layer * 4 + h];
    LAS float* sc = (LAS float*)lds;
    float v[8]; float run = 0.f;
#pragma unroll
    for (int i = 0; i < 8; ++i) {
      const float xx = gateF[(size_t)(b * SEQ + tid * 8 + i) * 4 + h] + bf;
      const float ls = fminf(xx, 0.f) - log1pf(expf(-fabsf(xx)));
      run += ls; v[i] = run;
    }
    float inc = run;
#pragma unroll
    for (int o = 1; o < 64; o <<= 1) { const float t = shup(inc, o, lane); if (lane >= o) inc += t; }
    __syncthreads();
    if (lane == 63) sc[tid >> 6] = inc;
    __syncthreads();
    float wbase = 0.f;
    for (int i = 0; i < (tid >> 6); ++i) wbase += sc[i];
    const float excl = wbase + inc - run;
#pragma unroll
    for (int i = 0; i < 8; ++i) Fk[tid * 8 + i] = -8.f * (excl + v[i]);
    __syncthreads();
  }
}

__device__ __forceinline__ void phase_mla_up(const Params& p, int layer, LAS unsigned char* lds) {
  unsigned char* ws = p.ws;
  const bf16_t* P = (const bf16_t*)(ws + OFF_P);
  const float* ssq = (const float*)(ws + OFF_CQN);
  const bf16_t* Wq = (const bf16_t*)(ws + OFF_WUQ) + (size_t)layer * 384 * 256;
  const bf16_t* Wkv = (const bf16_t*)(ws + OFF_WUKV) + (size_t)layer * 512 * 128;
  bf16_t* qd = (bf16_t*)(ws + OFF_QD); bf16_t* kvd = (bf16_t*)(ws + OFF_KVD);
  const int sb = get_bid() - (get_nblk() - 16);
  if (sb >= 0) {
    const int b = sb >> 2, h = sb & 3, tid = get_tid(), lane = tid & 63;
    const float* gateF = (const float*)(ws + OFF_GATEF);
    float* Fk = (float*)(ws + OFF_FK) + (size_t)sb * SEQ;
    const float bf = p.b_forget[layer * 4 + h];
    LAS float* sc = (LAS float*)lds;
    float v[8]; float run = 0.f;
#pragma unroll
    for (int i = 0; i < 8; ++i) {
      const float xx = gateF[(size_t)(b * SEQ + tid * 8 + i) * 4 + h] + bf;
      const float ls = fminf(xx, 0.f) - log1pf(expf(-fabsf(xx)));
      run += ls; v[i] = run;
    }
    float inc = run;
#pragma unroll
    for (int o = 1; o < 64; o <<= 1) { const float t = shup(inc, o, lane); if (lane >= o) inc += t; }
    __syncthreads();
    if (lane == 63) sc[tid >> 6] = inc;
    __syncthreads();
    float wbase = 0.f;
    for (int i = 0; i < (tid >> 6); ++i) wbase += sc[i];
    const float excl = wbase + inc - run;
#pragma unroll
    for (int i = 0; i < 8; ++i) Fk[tid * 8 + i] = -8.f * (excl + v[i]);
    __syncthreads();
  }
  const int lane = get_tid() & 63, w = get_tid() >> 6, wm = w >> 1, wn = w & 1, c31 = lane & 31, hi = lane >> 5;
  for (int item = get_bid() * 8 + w; item < 16 * 64; item += get_nblk() * 8) {
    const int bh = item >> 6, tl = item & 63, b = bh >> 2, h = bh & 3;
    const bf16_t* kr = P + (size_t)(b * SEQ + 64 * tl + lane) * NP + C_FXK + h * 64;
    float ss = 0.f;
#pragma unroll
    for (int c = 0; c < 8; ++c) {
      const u32x4 x = *(const u32x4*)(kr + 8 * c);
      ss += bflo(x.x) * bflo(x.x) + bfhi(x.x) * bfhi(x.x) + bflo(x.y) * bflo(x.y) + bfhi(x.y) * bfhi(x.y) + bflo(x.z) * bflo(x.z) + bfhi(x.z) * bfhi(x.z) + bflo(x.w) * bflo(x.w) + bfhi(x.w) * bfhi(x.w);
    }
    float nv = sqrtf(ss) * 1.0001f;
#pragma unroll
    for (int o = 1; o < 64; o <<= 1) nv = fmaxf(nv, shx(nv, o, lane));
    if (lane == 0) ((float*)(ws + OFF_KN))[item] = nv;
  }
  constexpr int TQ = 64 * 3, TKV = 64 * 4;
  for (int t = get_bid(); t < TQ + TKV; t += get_nblk()) {
    const bool isq = t < TQ; const int tt = isq ? t : t - TQ; const int ntn = isq ? 3 : 4; const int mt = tt / ntn, nt = tt % ntn;
    GemmDesc g;
    if (isq) g = GemmDesc{P + C_CQ, NP, nullptr, mt * 256, 256, Wq + (size_t)nt * 128 * 256, 256, 256};
    else g = GemmDesc{P + C_CKV, NP, nullptr, mt * 256, 256, Wkv + (size_t)nt * 128 * 128, 128, 128};
    f32x16 acc[2][2];
    gemm_tile<2>(lds, g, acc);
    bf16_t* O = isq ? qd : kvd; const int ldo = isq ? 384 : 512;
#pragma unroll
    for (int mi = 0; mi < 2; ++mi) {
      const int m = mt * 256 + wm * 64 + mi * 32 + c31;
      const f32x4 s4 = *(const f32x4*)(ssq + (size_t)m * 8 + (isq ? 0 : 4));
      const float rs = rsqrtf(((s4.x + s4.y) + (s4.z + s4.w)) * (isq ? (1.f / 256.f) : (1.f / 128.f)) + RMS_EPS);
#pragma unroll
      for (int ni = 0; ni < 2; ++ni)
#pragma unroll
        for (int a2 = 0; a2 < 2; ++a2) {
          unsigned ax = cvtpk(acc[mi][ni][8 * a2] * rs, acc[mi][ni][8 * a2 + 1] * rs), ay = cvtpk(acc[mi][ni][8 * a2 + 2] * rs, acc[mi][ni][8 * a2 + 3] * rs);
          unsigned bx = cvtpk(acc[mi][ni][8 * a2 + 4] * rs, acc[mi][ni][8 * a2 + 5] * rs), by = cvtpk(acc[mi][ni][8 * a2 + 6] * rs, acc[mi][ni][8 * a2 + 7] * rs);
          { auto t_ = __builtin_amdgcn_permlane32_swap(ax, bx, false, false); ax = t_[0]; bx = t_[1]; }
          { auto t_ = __builtin_amdgcn_permlane32_swap(ay, by, false, false); ay = t_[0]; by = t_[1]; }
          const int n = nt * 128 + wn * 64 + ni * 32 + 16 * a2 + 8 * hi;
          u32x4 o; o.x = ax; o.y = ay; o.z = bx; o.w = by;
          *(u32x4*)(O + (size_t)m * ldo + n) = o;
        }
    }
  }
}

constexpr int CMU_UP = 32 * 8 * 32, CMU_DN = 32 * 8 * 16, CMU_TOTAL = CMU_UP + CMU_DN;
struct ConvCtx { const float* wgu; const float* wdn; unsigned char* dgu; unsigned char* ddn; int* ctr; };
__device__ __forceinline__ void cmu_load(const ConvCtx& c, int idx, int lane, int w, float (&v)[16]) {
  const bool up = idx < CMU_UP;
  const int i2 = up ? idx : idx - CMU_UP;
  const int e = up ? (i2 >> 8) : (i2 >> 7), rem = up ? (i2 & 255) : (i2 & 127);
  const int kb = up ? (rem >> 5) : (rem >> 4), nb = up ? (rem & 31) : (rem & 15);
  const int N = up ? 2048 : 1024;
  const float* base = up ? c.wgu : c.wdn;
  const float* sp = base + ((size_t)e * 1024 + kb * 128 + 16 * w) * N + nb * 64 + lane;
#pragma unroll
  for (int j = 0; j < 16; ++j) v[j] = __builtin_nontemporal_load(sp + (size_t)j * N);
}
__device__ __forceinline__ void cmu_store(const ConvCtx& c, int idx, int lane, int w, const float (&v)[16]) {
  const bool up = idx < CMU_UP;
  const int i2 = up ? idx : idx - CMU_UP;
  const int e = up ? (i2 >> 8) : (i2 >> 7), rem = up ? (i2 & 255) : (i2 & 127);
  const int kb = up ? (rem >> 5) : (rem >> 4), nb = up ? (rem & 31) : (rem & 15);
  const int N = up ? 2048 : 1024;
  const int n = nb * 64 + lane;
  int dr = n;
  if (up) { const int j = n & 1023; dr = (j >> 4) * 32 + (j & 15) + ((n >= 1024) ? 16 : 0); }
  unsigned char* base = up ? c.dgu : c.ddn;
  const float sc = up ? S8_WGU : S8_WDN;
  u32x4 o;
  o.x = pk4_fp8(v[0] * sc, v[1] * sc, v[2] * sc, v[3] * sc); o.y = pk4_fp8(v[4] * sc, v[5] * sc, v[6] * sc, v[7] * sc);
  o.z = pk4_fp8(v[8] * sc, v[9] * sc, v[10] * sc, v[11] * sc); o.w = pk4_fp8(v[12] * sc, v[13] * sc, v[14] * sc, v[15] * sc);
  *(u32x4*)(base + ((size_t)e * N + dr) * 1024 + kb * 128 + 16 * w) = o;
}

__device__ __forceinline__ void cmu_to_lds(const ConvCtx& c, int idx, int lane, int w, const float (&v)[16], LAS unsigned char* tile) {
  const float sc = (idx < CMU_UP) ? S8_WGU : S8_WDN;
  u32x4 o;
  o.x = pk4_fp8(v[0] * sc, v[1] * sc, v[2] * sc, v[3] * sc); o.y = pk4_fp8(v[4] * sc, v[5] * sc, v[6] * sc, v[7] * sc);
  o.z = pk4_fp8(v[8] * sc, v[9] * sc, v[10] * sc, v[11] * sc); o.w = pk4_fp8(v[12] * sc, v[13] * sc, v[14] * sc, v[15] * sc);
  *(LAS u32x4*)(tile + lane * 128 + ((w ^ (lane & 7)) << 4)) = o;
}
__device__ __forceinline__ void cmu_from_lds(const ConvCtx& c, int idx, int lane, int w, const LAS unsigned char* tile) {
  const bool up = idx < CMU_UP;
  const int i2 = up ? idx : idx - CMU_UP;
  const int e = up ? (i2 >> 8) : (i2 >> 7), rem = up ? (i2 & 255) : (i2 & 127);
  const int kb = up ? (rem >> 5) : (rem >> 4), nb = up ? (rem & 31) : (rem & 15);
  const int N = up ? 2048 : 1024;
  const int r = 8 * w + (lane >> 3), ch = lane & 7;
  const u32x4 o = *(const LAS u32x4*)(tile + r * 128 + ((ch ^ (r & 7)) << 4));
  const int n = nb * 64 + r;
  int dr = n;
  if (up) { const int j = n & 1023; dr = (j >> 4) * 32 + (j & 15) + ((n >= 1024) ? 16 : 0); }
  unsigned char* base = up ? c.dgu : c.ddn;
  *(u32x4*)(base + ((size_t)e * N + dr) * 1024 + kb * 128 + 16 * ch) = o;
}

enum { AT_SB = 0, AT_DIFF = 1, AT_FOX = 2, AT_MLA = 3 };
struct AttnArgs {
  const bf16_t* Q; int ldq; const bf16_t* K; int ldk; const bf16_t* V; int ldv; const bf16_t* K2; int ldk2;
  const float* Fk; const f32x2* cs; bf16_t* O; int ldo; float lam, oscale; const float* subg; const float* kn;
};
constexpr int ATT_K1 = 0, ATT_V = 8192, ATT_K2 = 16384, ATT_F = 20480, ATT_BUF = 20992;

__device__ __forceinline__ float max3f(float a, float b, float c) { float r; asm("v_max3_f32 %0, %1, %2, %3" : "=v"(r) : "v"(a), "v"(b), "v"(c)); return r; }
__device__ __forceinline__ float max2f(float a, float b) { float r; asm("v_max_f32_e32 %0, %1, %2" : "=v"(r) : "v"(a), "v"(b)); return r; }
__device__ __forceinline__ bool softmax_tile(f32x16& p0, f32x16& p1, float& m, float& l, float c, bool domask, int kbase, int q, int hi, float& alpha) {
  if (domask) {
#pragma unroll
    for (int r = 0; r < 16; ++r) { const int key = kbase + crow(r, hi); if (key > q) p0[r] = -INFINITY; if (key + 32 > q) p1[r] = -INFINITY; }
  }
  asm volatile("s_nop 15\n\ts_nop 7" : "+v"(p0), "+v"(p1));
  float a = max3f(p0[0], p0[1], p1[0]), b = max3f(p0[2], p0[3], p1[1]); a = max3f(a, p1[2], p1[3]);
#pragma unroll
  for (int r = 4; r < 16; r += 4) { a = max3f(a, p0[r], p0[r + 1]); b = max3f(b, p0[r + 2], p0[r + 3]); a = max3f(a, p1[r], p1[r + 1]); b = max3f(b, p1[r + 2], p1[r + 3]); }
  float a0, a1; pair_vals(max2f(a, b), a0, a1);
  const float rm = max2f(a0, a1);
  const bool resc = __any((rm - m) * c > 8.0f);
  alpha = 1.f;
  if (resc) { const float mn = max2f(m, rm); alpha = __builtin_amdgcn_exp2f((m - mn) * c); l *= alpha; m = mn; }
  const float mc = m * c;
  float s = 0.f;
#pragma unroll
  for (int r = 0; r < 16; ++r) { p0[r] = __builtin_amdgcn_exp2f(fmaf(p0[r], c, -mc)); p1[r] = __builtin_amdgcn_exp2f(fmaf(p1[r], c, -mc)); s += p0[r] + p1[r]; }
  l += s;
  return resc;
}
__device__ __forceinline__ bf16x8 pack8(const f32x16& p, int b) {
  u32x4 w; w.x = cvtpk(p[b], p[b + 1]); w.y = cvtpk(p[b + 2], p[b + 3]); w.z = cvtpk(p[b + 4], p[b + 5]); w.w = cvtpk(p[b + 6], p[b + 7]);
  return __builtin_bit_cast(bf16x8, w);
}
__device__ __forceinline__ bf16x8 vfrag(LAS unsigned char* vb, int off) {
  const s16x4 lo = __builtin_bit_cast(s16x4, __builtin_amdgcn_ds_read_tr16_b64_v4i16((LAS s16x4*)(vb + off)));
  const s16x4 hh = __builtin_bit_cast(s16x4, __builtin_amdgcn_ds_read_tr16_b64_v4i16((LAS s16x4*)(vb + off + 1024)));
  return (bf16x8){lo[0], lo[1], lo[2], lo[3], hh[0], hh[1], hh[2], hh[3]};
}

template <int T>
__device__ __forceinline__ void attn_unit(LAS unsigned char* lds, const AttnArgs& a, int qb, const ConvCtx& cc, int& gi, int& pidx, int& qidx, float (&cv)[16]) {
  const int tid = get_tid(), lane = tid & 63, w = tid >> 6, c31 = lane & 31, hi = lane >> 5;
  const int t0 = qb * 256 + w * 32, q = t0 + c31;
  constexpr int NKS = (T == AT_MLA) ? 6 : 4;
  constexpr float CSC = (T == AT_DIFF) ? 0.17677669529663687f * LOG2E : (T == AT_MLA) ? 0.10206207261596577f * LOG2E : 0.125f * LOG2E;
  bf16x8 qf[NKS];
  {
    const bf16_t* qrow = a.Q + (size_t)q * a.ldq;
#pragma unroll
    for (int ks = 0; ks < NKS; ++ks) qf[ks] = *(const bf16x8*)(qrow + 16 * ks + 8 * hi);
    if (T == AT_MLA) {
      const f32x2* csq = a.cs + (size_t)q * 16 + 8 * hi;
      bf16x8 n4, n5;
#pragma unroll
      for (int j = 0; j < 8; j += 2) {
        const f32x2 c0 = csq[j], c1 = csq[j + 1];
        const float x1a = bf2f((unsigned short)qf[4][j]), x1b = bf2f((unsigned short)qf[4][j + 1]);
        const float x2a = bf2f((unsigned short)qf[5][j]), x2b = bf2f((unsigned short)qf[5][j + 1]);
        const unsigned w1 = cvtpk(x1a * c0.x - x2a * c0.y, x1b * c1.x - x2b * c1.y);
        const unsigned w2 = cvtpk(x2a * c0.x + x1a * c0.y, x2b * c1.x + x1b * c1.y);
        n4[j] = (short)(w1 & 0xffff); n4[j + 1] = (short)(w1 >> 16); n5[j] = (short)(w2 & 0xffff); n5[j + 1] = (short)(w2 >> 16);
      }
      qf[4] = n4; qf[5] = n5;
    }
  }
  const int skey = tid >> 3, sch = tid & 7;
  const int k1_st = ATT_K1 + skey * 128 + ((sch ^ ((skey >> 1) & 7)) << 4);
  const int v_st = ATT_V + skey * 128 + ((sch ^ (((skey >> 1) & 1) << 2)) << 4);
  const int k2key = tid >> 2, k2ch = tid & 3;
  const int k2_st = ATT_K2 + k2key * 64 + ((k2ch ^ ((k2key >> 2) & 3)) << 4);
  const int xr = (lane >> 1) & 7;
  int kro[4];
#pragma unroll
  for (int ks = 0; ks < 4; ++ks) kro[ks] = ATT_K1 + c31 * 128 + (((2 * ks + hi) ^ xr) << 4);
  int k2ro[2];
#pragma unroll
  for (int ks = 0; ks < 2; ++ks) k2ro[ks] = ATT_K2 + c31 * 64 + (((2 * ks + hi) ^ ((c31 >> 2) & 3)) << 4);
  int vro[2];
  {
    const int i = lane & 15, qq = i >> 2, pp = i & 3, gg = (lane >> 4) & 1, bit = (qq >> 1) & 1;
#pragma unroll
    for (int d0 = 0; d0 < 2; ++d0) vro[d0] = ATT_V + (4 * hi + qq) * 128 + ((4 * (d0 ^ bit) + 2 * gg + (pp >> 1)) << 4) + (pp & 1) * 8;
  }
  const int ntiles = 4 * (qb + 1);
  const int wave_last = (t0 + 31) >> 6;
  LAS float* kpre = (LAS float*)(lds + 2 * ATT_BUF + 256);
  LAS float* fend = kpre + 64;
  float qn = 0.f;
  if (T == AT_FOX) {
    if (w == 0) {
      float v = (lane < ntiles) ? a.kn[lane] : 0.f;
#pragma unroll
      for (int o = 1; o < 64; o <<= 1) { const float u_ = shup(v, o, lane); if (lane >= o) v = fmaxf(v, u_); }
      kpre[lane] = v;
      fend[lane] = (lane < ntiles) ? a.Fk[64 * lane + 63] : 0.f;
    }
    float ss = 0.f;
#pragma unroll
    for (int ks = 0; ks < 4; ++ks)
#pragma unroll
      for (int j = 0; j < 8; ++j) { const float x = bf2f((unsigned short)qf[ks][j]); ss += x * x; }
    float s0_, s1_; pair_vals(ss, s0_, s1_);
    qn = sqrtf(s0_ + s1_) * 1.0001f;
  }
  f32x16 o0[2], o1[2];
#pragma unroll
  for (int d0 = 0; d0 < 2; ++d0)
#pragma unroll
    for (int r = 0; r < 16; ++r) { o0[d0][r] = 0.f; o1[d0][r] = 0.f; }
  float m0 = -INFINITY, l0 = 0.f, m1 = -INFINITY, l1 = 0.f;
  float Crun = 0.f;
  bool fin = false;
  u32x4 rk, rv, rk2; float rf = 0.f;
#define ATT_TILE(it) ((T == AT_SB || T == AT_FOX) ? (ntiles - 1 - (it)) : (it))
#define ATT_GLOAD(t) do { const int key_ = 64 * (t) + skey; \
    rk = *(const u32x4*)(a.K + (size_t)key_ * a.ldk + sch * 8); rv = *(const u32x4*)(a.V + (size_t)key_ * a.ldv + sch * 8); \
    if (T == AT_MLA) { if (tid < 256) rk2 = *(const u32x4*)(a.K2 + (size_t)(64 * (t) + k2key) * a.ldk2 + k2ch * 8); } \
    if (T == AT_FOX) { if (tid < 64) rf = a.Fk[64 * (t) + tid]; } } while (0)
#define ATT_LSTORE(buf) do { LAS unsigned char* b_ = lds + (buf) * ATT_BUF; \
    *(LAS u32x4*)(b_ + k1_st) = rk; *(LAS u32x4*)(b_ + v_st) = rv; \
    if (T == AT_MLA) { if (tid < 256) *(LAS u32x4*)(b_ + k2_st) = rk2; } \
    if (T == AT_FOX) { if (tid < 64) *(LAS float*)(b_ + ATT_F + 4 * tid) = rf; } } while (0)
  LAS int* s_conv = (LAS int*)(lds + 2 * ATT_BUF + 64);
  ATT_GLOAD(ATT_TILE(0));
  ATT_LSTORE(0);
  __syncthreads();
  for (int it = 0; it < ntiles; ++it) {
    const int t = ATT_TILE(it);
    LAS unsigned char* cur = lds + (it & 1) * ATT_BUF;
    const bool more = (it + 1 < ntiles);
    const int cidx = __builtin_amdgcn_readfirstlane(s_conv[(gi >> 3) & 1]) + (gi & 7);
    int cnext = 0;
    const bool cfetch = (gi & 7) == 0;
    if (cfetch && tid == 0) cnext = atomicAdd(cc.ctr, 8);
#define ATT_CONV_STEP() do { \
      LAS unsigned char* ctile = lds + 2 * ATT_BUF + 1024;                  \
      if (qidx < CMU_TOTAL) cmu_from_lds(cc, qidx, lane, w, ctile + ((gi + 1) & 1) * 8192); \
      if (pidx < CMU_TOTAL) cmu_to_lds(cc, pidx, lane, w, cv, ctile + (gi & 1) * 8192); \
      qidx = pidx; \
      pidx = cidx; \
      if (pidx < CMU_TOTAL) cmu_load(cc, pidx, lane, w, cv); } while (0)
    const bool conv_first = __builtin_amdgcn_readfirstlane(w) >= 4;
    if (conv_first) ATT_CONV_STEP();
    if (more) ATT_GLOAD(ATT_TILE(it + 1));
    const bool active = (t <= wave_last) && !fin;
    if (active) {
      const bool domask = (64 * t + 63 > t0);
      const int kbase = 64 * t;
      if (T == AT_DIFF) {
        f32x16 pa0, pa1, pb0, pb1;
#pragma unroll
        for (int r = 0; r < 16; ++r) { pa0[r] = 0.f; pa1[r] = 0.f; pb0[r] = 0.f; pb1[r] = 0.f; }
#pragma unroll
        for (int ks = 0; ks < 2; ++ks) {
          const bf16x8 k0 = *(const LAS bf16x8*)(cur + kro[ks]), k1 = *(const LAS bf16x8*)(cur + kro[ks] + 4096);
          pa0 = __builtin_amdgcn_mfma_f32_32x32x16_bf16(k0, qf[ks], pa0, 0, 0, 0); pa1 = __builtin_amdgcn_mfma_f32_32x32x16_bf16(k1, qf[ks], pa1, 0, 0, 0);
        }
#pragma unroll
        for (int ks = 2; ks < 4; ++ks) {
          const bf16x8 k0 = *(const LAS bf16x8*)(cur + kro[ks]), k1 = *(const LAS bf16x8*)(cur + kro[ks] + 4096);
          pb0 = __builtin_amdgcn_mfma_f32_32x32x16_bf16(k0, qf[ks], pb0, 0, 0, 0); pb1 = __builtin_amdgcn_mfma_f32_32x32x16_bf16(k1, qf[ks], pb1, 0, 0, 0);
        }
        float al0, al1;
        const bool rs0 = softmax_tile(pa0, pa1, m0, l0, CSC, domask, kbase, q, hi, al0);
        const bool rs1 = softmax_tile(pb0, pb1, m1, l1, CSC, domask, kbase, q, hi, al1);
        if (rs0) {
#pragma unroll
          for (int d0 = 0; d0 < 2; ++d0)
#pragma unroll
            for (int r = 0; r < 16; ++r) o0[d0][r] *= al0;
        }
        if (rs1) {
#pragma unroll
          for (int d0 = 0; d0 < 2; ++d0)
#pragma unroll
            for (int r = 0; r < 16; ++r) o1[d0][r] *= al1;
        }
#pragma unroll
        for (int s = 0; s < 4; ++s) {
          const bf16x8 pfa = pack8((s < 2) ? pa0 : pa1, 8 * (s & 1)), pfb = pack8((s < 2) ? pb0 : pb1, 8 * (s & 1));
#pragma unroll
          for (int d0 = 0; d0 < 2; ++d0) {
            const bf16x8 vf = vfrag(cur, vro[d0] + 2048 * s);
            o0[d0] = __builtin_amdgcn_mfma_f32_32x32x16_bf16(vf, pfa, o0[d0], 0, 0, 0);
            o1[d0] = __builtin_amdgcn_mfma_f32_32x32x16_bf16(vf, pfb, o1[d0], 0, 0, 0);
          }
        }
      } else {
        f32x16 p0, p1;
        if (T == AT_FOX) {
#pragma unroll
          for (int g4 = 0; g4 < 4; ++g4) {
            const f32x4 f0 = *(const LAS f32x4*)(cur + ATT_F + (8 * g4 + 4 * hi) * 4), f1 = *(const LAS f32x4*)(cur + ATT_F + (32 + 8 * g4 + 4 * hi) * 4);
            p0[4 * g4] = f0.x; p0[4 * g4 + 1] = f0.y; p0[4 * g4 + 2] = f0.z; p0[4 * g4 + 3] = f0.w;
            p1[4 * g4] = f1.x; p1[4 * g4 + 1] = f1.y; p1[4 * g4 + 2] = f1.z; p1[4 * g4 + 3] = f1.w;
          }
        } else {
#pragma unroll
          for (int r = 0; r < 16; ++r) { p0[r] = 0.f; p1[r] = 0.f; }
        }
#pragma unroll
        for (int ks = 0; ks < 4; ++ks) {
          const bf16x8 k0 = *(const LAS bf16x8*)(cur + kro[ks]), k1 = *(const LAS bf16x8*)(cur + kro[ks] + 4096);
          p0 = __builtin_amdgcn_mfma_f32_32x32x16_bf16(k0, qf[ks], p0, 0, 0, 0); p1 = __builtin_amdgcn_mfma_f32_32x32x16_bf16(k1, qf[ks], p1, 0, 0, 0);
        }
        if (T == AT_MLA) {
#pragma unroll
          for (int ks = 0; ks < 2; ++ks) {
            const bf16x8 k0 = *(const LAS bf16x8*)(cur + k2ro[ks]), k1 = *(const LAS bf16x8*)(cur + k2ro[ks] + 2048);
            p0 = __builtin_amdgcn_mfma_f32_32x32x16_bf16(k0, qf[(NKS == 6) ? 4 + ks : ks], p0, 0, 0, 0);
            p1 = __builtin_amdgcn_mfma_f32_32x32x16_bf16(k1, qf[(NKS == 6) ? 4 + ks : ks], p1, 0, 0, 0);
          }
        }
        if (T == AT_SB) {
          f32x16 e0, e1;
          float T8[8];
#pragma unroll
          for (int half = 0; half < 2; ++half) {
            f32x16& pp = half ? p1 : p0; f32x16& ee = half ? e1 : e0;
#pragma unroll
            for (int r = 0; r < 16; ++r) {
              const float z2 = pp[r] * CSC;
              float lk = -__builtin_amdgcn_logf(1.0f + __builtin_amdgcn_exp2f(fminf(z2, 126.f)));
              const bool valid = !domask || (kbase + 32 * half + crow(r, hi) < q);
              lk = valid ? lk : 0.f;
              pp[r] = valid ? (z2 + lk) : -INFINITY;
              ee[r] = lk;
            }
#pragma unroll
            for (int g4 = 0; g4 < 4; ++g4) {
              const float x0 = ee[4 * g4], x1 = ee[4 * g4 + 1], x2 = ee[4 * g4 + 2], x3 = ee[4 * g4 + 3];
              ee[4 * g4 + 3] = 0.f; ee[4 * g4 + 2] = x3; ee[4 * g4 + 1] = x3 + x2; ee[4 * g4] = x3 + x2 + x1;
              T8[4 * half + g4] = x3 + x2 + x1 + x0;
            }
          }
          float Tl[8], Th[8];
#pragma unroll
          for (int i = 0; i < 8; ++i) pair_vals(T8[i], Tl[i], Th[i]);
          float ps = 0.f; float base[8];
#pragma unroll
          for (int i = 7; i >= 0; --i) { base[i] = Crun + ps + (hi ? 0.f : Th[i]); ps += Tl[i] + Th[i]; }
          Crun += ps;
#pragma unroll
          for (int r = 0; r < 16; ++r) {
            p0[r] = __builtin_amdgcn_exp2f(p0[r] + e0[r] + base[r >> 2]);
            p1[r] = __builtin_amdgcn_exp2f(p1[r] + e1[r] + base[4 + (r >> 2)]);
          }
          if (__all(Crun < -48.f)) fin = true;
        } else {
          float al;
          if (softmax_tile(p0, p1, m0, l0, CSC, domask, kbase, q, hi, al)) {
#pragma unroll
            for (int d0 = 0; d0 < 2; ++d0)
#pragma unroll
              for (int r = 0; r < 16; ++r) o0[d0][r] *= al;
          }
          if (T == AT_FOX) { if (t > 0) { if (__all((qn * kpre[t - 1] + fend[t - 1] - m0) * CSC < -40.f)) fin = true; } }
        }
#pragma unroll
        for (int s = 0; s < 4; ++s) {
          const bf16x8 pf = pack8((s < 2) ? p0 : p1, 8 * (s & 1));
#pragma unroll
          for (int d0 = 0; d0 < 2; ++d0) {
            const bf16x8 vf = vfrag(cur, vro[d0] + 2048 * s);
            o0[d0] = __builtin_amdgcn_mfma_f32_32x32x16_bf16(vf, pf, o0[d0], 0, 0, 0);
          }
        }
      }
    }
    if (more) ATT_LSTORE((it + 1) & 1);
    if (!conv_first) ATT_CONV_STEP();
    if (cfetch && tid == 0) s_conv[((gi >> 3) + 1) & 1] = cnext;
    ++gi;
    if (T == AT_SB || T == AT_FOX) {
      const bool wave_done = fin || (t == 0);
      LAS int* sd = (LAS int*)(lds + 2 * ATT_BUF + 128) + (it & 1) * 8;
      if (lane == 0) sd[w] = wave_done ? 1 : 0;
      __syncthreads();
      const i32x4 d0 = *(const LAS i32x4*)sd, d1 = *(const LAS i32x4*)(sd + 4);
      if (__builtin_amdgcn_readfirstlane(d0.x & d0.y & d0.z & d0.w & d1.x & d1.y & d1.z & d1.w)) break;
    } else {
      __syncthreads();
    }
  }
  __syncthreads();
#undef ATT_TILE
#undef ATT_CONV_STEP
#undef ATT_GLOAD
#undef ATT_LSTORE
  LAS unsigned char* ost = lds + w * 4608;
  if (T == AT_DIFF) {
    float la, lb; pair_vals(l0, la, lb); const float inv0 = 1.f / (la + lb);
    pair_vals(l1, la, lb); const float inv1 = a.lam / (la + lb);
    float ss = 0.f;
#pragma unroll
    for (int d0 = 0; d0 < 2; ++d0)
#pragma unroll
      for (int r = 0; r < 16; ++r) { const float v = o0[d0][r] * inv0 - o1[d0][r] * inv1; o0[d0][r] = v; ss += v * v; }
    float sa, sb; pair_vals(ss, sa, sb);
    const float rs = rsqrtf((sa + sb) * (1.f / 64.f) + RMS_EPS) * a.oscale;
#pragma unroll
    for (int d0 = 0; d0 < 2; ++d0)
#pragma unroll
      for (int a2 = 0; a2 < 2; ++a2) {
        const int da = 32 * d0 + 16 * a2 + 4 * hi;
        const f32x4 ga = *(const f32x4*)(a.subg + da), gb = *(const f32x4*)(a.subg + da + 8);
        unsigned ax = cvtpk(o0[d0][8 * a2] * rs * ga.x, o0[d0][8 * a2 + 1] * rs * ga.y), ay = cvtpk(o0[d0][8 * a2 + 2] * rs * ga.z, o0[d0][8 * a2 + 3] * rs * ga.w);
        unsigned bx = cvtpk(o0[d0][8 * a2 + 4] * rs * gb.x, o0[d0][8 * a2 + 5] * rs * gb.y), by = cvtpk(o0[d0][8 * a2 + 6] * rs * gb.z, o0[d0][8 * a2 + 7] * rs * gb.w);
        { auto t_ = __builtin_amdgcn_permlane32_swap(ax, bx, false, false); ax = t_[0]; bx = t_[1]; }
        { auto t_ = __builtin_amdgcn_permlane32_swap(ay, by, false, false); ay = t_[0]; by = t_[1]; }
        u32x4 o; o.x = ax; o.y = ay; o.z = bx; o.w = by;
        *(LAS u32x4*)(ost + c31 * 144 + (32 * d0 + 16 * a2 + 8 * hi) * 2) = o;
      }
  } else {
    float inv = 1.f;
    if (T != AT_SB) { float la, lb; pair_vals(l0, la, lb); inv = 1.f / (la + lb); }
#pragma unroll
    for (int d0 = 0; d0 < 2; ++d0)
#pragma unroll
      for (int a2 = 0; a2 < 2; ++a2) {
        unsigned ax = cvtpk(o0[d0][8 * a2] * inv, o0[d0][8 * a2 + 1] * inv), ay = cvtpk(o0[d0][8 * a2 + 2] * inv, o0[d0][8 * a2 + 3] * inv);
        unsigned bx = cvtpk(o0[d0][8 * a2 + 4] * inv, o0[d0][8 * a2 + 5] * inv), by = cvtpk(o0[d0][8 * a2 + 6] * inv, o0[d0][8 * a2 + 7] * inv);
        { auto t_ = __builtin_amdgcn_permlane32_swap(ax, bx, false, false); ax = t_[0]; bx = t_[1]; }
        { auto t_ = __builtin_amdgcn_permlane32_swap(ay, by, false, false); ay = t_[0]; by = t_[1]; }
        u32x4 o; o.x = ax; o.y = ay; o.z = bx; o.w = by;
        *(LAS u32x4*)(ost + c31 * 144 + (32 * d0 + 16 * a2 + 8 * hi) * 2) = o;
      }
  }
#pragma unroll
  for (int ps = 0; ps < 4; ++ps) {
    const int r = 8 * ps + (lane >> 3), c = lane & 7;
    const u32x4 v = *(const LAS u32x4*)(ost + r * 144 + c * 16);
    *(u32x4*)(a.O + (size_t)(t0 + r) * a.ldo + c * 8) = v;
  }
}

__device__ __forceinline__ void phase_attention(const Params& p, int layer, LAS unsigned char* lds) {
  unsigned char* ws = p.ws;
  const bf16_t* P = (const bf16_t*)(ws + OFF_P);
  const bf16_t* qd = (const bf16_t*)(ws + OFF_QD); const bf16_t* kvd = (const bf16_t*)(ws + OFF_KVD);
  bf16_t* mix = (bf16_t*)(ws + OFF_MIX);
  int* ctrl = (int*)(ws + OFF_CTRL);
  const float lam = ((const float*)ctrl)[CW_LAM + layer];
  const float linit = 0.8f - 0.6f * expf(-0.3f * (float)layer);
  LAS int* s_unit = (LAS int*)(lds + 2 * ATT_BUF);
  ConvCtx cc;
  cc.wgu = p.w_gate_up + (size_t)layer * NE * 1024 * 2048; cc.wdn = p.w_down + (size_t)layer * NE * 1024 * 1024;
  cc.dgu = ws + OFF_WGU + (size_t)layer * NE * 2048 * 1024; cc.ddn = ws + OFF_WD + (size_t)layer * NE * 1024 * 1024;
  cc.ctr = ctrl + CW_CONVQ + layer;
  int gi = 0, pidx = CMU_TOTAL, qidx = CMU_TOTAL; float cv[16];
#pragma unroll
  for (int j = 0; j < 16; ++j) cv[j] = 0.f;
  if (get_tid() == 0) ((LAS int*)(lds + 2 * ATT_BUF + 64))[0] = atomicAdd(cc.ctr, 8);
  for (;;) {
    if (get_tid() == 0) *s_unit = atomicAdd(&ctrl[CW_ATTQ + layer], 1);
    __syncthreads();
    const int u = *s_unit;
    __syncthreads();
    if (u >= 1024) break;
    const int qb = 15 - (u >> 6), rem = u & 63, type = rem & 3, bh = rem >> 2, b = bh >> 2, h = bh & 3;
    const size_t rb = (size_t)b * SEQ;
    AttnArgs a{};
    a.O = mix + rb * DM + type * 256 + h * 64; a.ldo = DM;
    if (type == AT_SB) {
      a.Q = P + rb * NP + C_SBQ + h * 64; a.K = P + rb * NP + C_SBK + h * 64; a.V = P + rb * NP + C_SBV + h * 64; a.ldq = a.ldk = a.ldv = NP;
      attn_unit<AT_SB>(lds, a, qb, cc, gi, pidx, qidx, cv);
    } else if (type == AT_DIFF) {
      a.Q = P + rb * NP + C_DFQ + h * 64; a.K = P + rb * NP + C_DFK + h * 64; a.V = P + rb * NP + C_DFV + h * 64; a.ldq = a.ldk = a.ldv = NP;
      a.lam = lam; a.oscale = 1.f - linit; a.subg = p.diff_subln_g + layer * 64;
      attn_unit<AT_DIFF>(lds, a, qb, cc, gi, pidx, qidx, cv);
    } else if (type == AT_FOX) {
      a.Q = P + rb * NP + C_FXQ + h * 64; a.K = P + rb * NP + C_FXK + h * 64; a.V = P + rb * NP + C_FXV + h * 64; a.ldq = a.ldk = a.ldv = NP;
      a.Fk = (const float*)(ws + OFF_FK) + (size_t)bh * SEQ; a.kn = (const float*)(ws + OFF_KN) + bh * 64;
      attn_unit<AT_FOX>(lds, a, qb, cc, gi, pidx, qidx, cv);
    } else {
      a.Q = qd + rb * 384 + h * 96; a.ldq = 384; a.K = kvd + rb * 512 + h * 128; a.ldk = 512; a.V = kvd + rb * 512 + h * 128 + 64; a.ldv = 512;
      a.K2 = P + rb * NP + C_KR; a.ldk2 = NP; a.cs = (const f32x2*)(ws + OFF_ROPE) + rb * 16;
      attn_unit<AT_MLA>(lds, a, qb, cc, gi, pidx, qidx, cv);
    }
  }
  {
    __syncthreads();
    const LAS int* sc = (const LAS int*)(lds + 2 * ATT_BUF + 64);
    const int k = gi >> 3, used = gi & 7;
    const int b0 = __builtin_amdgcn_readfirstlane(sc[k & 1]);
    const int b1 = (used >= 1) ? __builtin_amdgcn_readfirstlane(sc[(k + 1) & 1]) : CMU_TOTAL;
    const int tid = get_tid(), lane = tid & 63, w = tid >> 6;
    if (qidx < CMU_TOTAL) cmu_from_lds(cc, qidx, lane, w, lds + 2 * ATT_BUF + 1024 + ((gi + 1) & 1) * 8192);
    if (pidx < CMU_TOTAL) cmu_store(cc, pidx, lane, w, cv);
#pragma unroll 1
    for (int j = used; j < 16; ++j) {
      const int ci = (j < 8) ? b0 + j : b1 + (j - 8);
      if (ci < CMU_TOTAL) { float v0[16]; cmu_load(cc, ci, lane, w, v0); cmu_store(cc, ci, lane, w, v0); }
    }
    __syncthreads();
  }
  for (;;) {
    if (get_tid() == 0) s_unit[0] = atomicAdd(cc.ctr, 2);
    __syncthreads();
    const int c0 = __builtin_amdgcn_readfirstlane(s_unit[0]);
    __syncthreads();
    if (c0 >= CMU_TOTAL) break;
    const int tid = get_tid(), lane = tid & 63, w = tid >> 6;
    float v0[16], v1[16];
    cmu_load(cc, c0, lane, w, v0);
    if (c0 + 1 < CMU_TOTAL) cmu_load(cc, c0 + 1, lane, w, v1);
    cmu_store(cc, c0, lane, w, v0);
    if (c0 + 1 < CMU_TOTAL) cmu_store(cc, c0 + 1, lane, w, v1);
  }
}

__device__ __forceinline__ size_t tmp_blocked(int row, int col) {
  return (size_t)(row >> 6) * 65536 + (size_t)((((((col >> 7) * 4 + ((col >> 5) & 3)) * 2 + ((col >> 4) & 1)) * 2 + ((row >> 5) & 1)) * 64 + (((col >> 3) & 1) * 32 + (row & 31))) * 8);
}
struct OutprojSched {
  int grid, bid;
  __device__ __forceinline__ bool next(int i, pg8::Unit& u) const {
    int mt, nt;
    if (grid == 256) { if (i > 0) return false; const int xcd = bid & 7, j = bid >> 3; mt = 8 * xcd + (j >> 2); nt = j & 3; }
    else { const int t = bid + i * grid; if (t >= 256) return false; mt = t >> 2; nt = t & 3; }
    u.boff = (unsigned)nt * (256u * 1024u * 2u); u.arow0 = mt * 256; u.mvalid = 256; u.e = 0; u.mt = mt; u.nt = nt; u.slot0 = 0;
    return true;
  }
};
struct OutprojEpi {
  static constexpr bool RELAX = false;
  static constexpr int MIN_ST = 16;
  static __device__ __forceinline__ int blane(int lrow) { return (lrow & 32) + 8 * ((lrow & 15) >> 2) + 4 * ((lrow >> 4) & 1) + (lrow & 3); }
  static constexpr __device__ int bpiece(int h, int i) { return 128 * h + 64 * i; }
  static constexpr bool DYNB = false;
  static __device__ __forceinline__ int blane_alt(int lrow) { return lrow; }
  __device__ __forceinline__ bool alt_map(const pg8::Unit&) const { return false; }
  const bf16_t* hB; bf16_t* tmp;
  __device__ __forceinline__ void operator()(const pg8::f32x4v (&acc)[2][2][4][2], const pg8::Unit& u, int wr, int wc, int fr, int fq) const {
#pragma unroll
    for (int ai = 0; ai < 2; ++ai) {
#pragma unroll
      for (int m = 0; m < 4; ++m) {
        const int row = u.mt * 256 + 128 * ai + 64 * wr + 16 * m + fr;
#pragma unroll
        for (int bj = 0; bj < 2; ++bj) {
          const int col = u.nt * 256 + 128 * bj + 32 * wc + 8 * fq;
          const u32x4 hb = *(const u32x4*)(hB + (size_t)row * DM + col);
          const pg8::f32x4v v = acc[ai][bj][m][0], w = acc[ai][bj][m][1];
          u32x4 o;
          o.x = cvtpk(DN_ALPHA * bflo(hb.x) + v[0], DN_ALPHA * bfhi(hb.x) + v[1]); o.y = cvtpk(DN_ALPHA * bflo(hb.y) + v[2], DN_ALPHA * bfhi(hb.y) + v[3]);
          o.z = cvtpk(DN_ALPHA * bflo(hb.z) + w[0], DN_ALPHA * bfhi(hb.z) + w[1]); o.w = cvtpk(DN_ALPHA * bflo(hb.w) + w[2], DN_ALPHA * bfhi(hb.w) + w[3]);
          *(u32x4*)(tmp + tmp_blocked(row, col)) = o;
        }
      }
    }
  }
};
__device__ __forceinline__ void phase_outproj(const Params& p, int layer, LAS unsigned char* lds) {
  unsigned char* ws = p.ws;
  OutprojSched S{get_nblk(), get_bid()};
  OutprojEpi E{(const bf16_t*)(ws + OFF_HB), (bf16_t*)(ws + OFF_TMPF)};
  pg8::gemm_phase<false, false>(lds, (const bf16_t*)(ws + OFF_MIX), (const bf16_t*)(ws + OFF_WOUT) + (size_t)layer * 1024 * 1024, S, E);
}

__device__ __forceinline__ void phase_ln1_router(const Params& p, int layer, LAS unsigned char* lds) {
  unsigned char* ws = p.ws;
  const bf16_t* tmp = (const bf16_t*)(ws + OFF_TMPF);
  float* hF = (float*)(ws + OFF_HF); bf16_t* hB = (bf16_t*)(ws + OFF_HB);
  int* ctrl = (int*)(ws + OFF_CTRL); int* cnt = ctrl + CW_CNT + layer * 32;
  int* list = (int*)(ws + OFF_LIST); int* toke = (int*)(ws + OFF_TOKE); float* tokg = (float*)(ws + OFF_TOKG);
  const float* Wr = p.router_w + (size_t)layer * DM * NE; const float* rb = p.router_b + layer * NE;
  const float* g1 = p.ln1_g + layer * DM; const float* b1 = p.ln1_b + layer * DM;
  LAS float* red = (LAS float*)lds;
  LAS float* part = (LAS float*)(lds + 136192);
  LAS float* part2 = (LAS float*)(lds + 137216);
  LAS int* lcnt = (LAS int*)(lds + 138240);
#pragma unroll 1
  for (int hp = get_bid(); hp < M_TOK / 32; hp += 2 * get_nblk()) {
  const int nh = (hp + get_nblk() < M_TOK / 32) ? 2 : 1;
#pragma unroll 1
  for (int qh = 0; qh < nh; ++qh) {
    const int hs = hp + qh * get_nblk();
    LAS float* lg = (LAS float*)(lds + (qh ? 32768 : 138496));
    const int m0 = hs * 32, mi = hs & 1;
    const int tid = get_tid(), lane = tid & 63, w = tid >> 6, c31 = lane & 31, hi = lane >> 5;
    f32x16 acc[4];
    {
      const bf16_t* tb = tmp + (size_t)(hs >> 1) * 65536 + (size_t)(w * 16 * 64 + lane) * 8;
#pragma unroll
      for (int ni = 0; ni < 4; ++ni)
#pragma unroll
        for (int g2 = 0; g2 < 2; ++g2) {
          const u32x4 v = *(const u32x4*)(tb + (size_t)(((ni * 2 + g2) * 2 + mi) * 64) * 8);
          acc[ni][8 * g2] = bflo(v.x); acc[ni][8 * g2 + 1] = bfhi(v.x); acc[ni][8 * g2 + 2] = bflo(v.y); acc[ni][8 * g2 + 3] = bfhi(v.y);
          acc[ni][8 * g2 + 4] = bflo(v.z); acc[ni][8 * g2 + 5] = bfhi(v.z); acc[ni][8 * g2 + 6] = bflo(v.w); acc[ni][8 * g2 + 7] = bfhi(v.w);
        }
    }
    u32x4 wbh[4][2], wbl[4][2];
    {
      const bf16_t* wh = (const bf16_t*)(ws + OFF_WRS) + (size_t)layer * 2 * NE * DM + (size_t)(w * 8 * 64 + lane) * 8;
      const bf16_t* wl = wh + NE * DM;
#pragma unroll
      for (int ni = 0; ni < 4; ++ni)
#pragma unroll
        for (int g2 = 0; g2 < 2; ++g2) { wbh[ni][g2] = *(const u32x4*)(wh + (ni * 2 + g2) * 512); wbl[ni][g2] = *(const u32x4*)(wl + (ni * 2 + g2) * 512); }
    }
    __builtin_amdgcn_sched_barrier(0);
    float mean, rstd;
    {
      float sacc = 0.f;
#pragma unroll
      for (int ni = 0; ni < 4; ++ni)
#pragma unroll
        for (int r = 0; r < 16; ++r) sacc += acc[ni][r];
      float s0, s1; pair_vals(sacc, s0, s1);
      if (hi == 0) part[c31 * 8 + w] = s0 + s1;
    }
    __syncthreads();
    {
      const f32x4 pa = *(const LAS f32x4*)(part + c31 * 8), pb = *(const LAS f32x4*)(part + c31 * 8 + 4);
      mean = ((pa.x + pa.y) + (pa.z + pa.w) + (pb.x + pb.y) + (pb.z + pb.w)) * (1.f / DM);
      float q = 0.f;
#pragma unroll
      for (int ni = 0; ni < 4; ++ni)
#pragma unroll
        for (int r = 0; r < 16; ++r) { const float d = acc[ni][r] - mean; q += d * d; }
      float q0, q1; pair_vals(q, q0, q1);
      if (hi == 0) part2[c31 * 8 + w] = q0 + q1;
    }
    __syncthreads();
    {
      const f32x4 pa = *(const LAS f32x4*)(part2 + c31 * 8), pb = *(const LAS f32x4*)(part2 + c31 * 8 + 4);
      rstd = rsqrtf(((pa.x + pa.y) + (pa.z + pa.w) + (pb.x + pb.y) + (pb.z + pb.w)) * (1.f / DM) + LN_EPS);
    }
    LAS unsigned char* wt = lds + w * 16896;
#pragma unroll
    for (int ni = 0; ni < 4; ++ni)
#pragma unroll
      for (int g4 = 0; g4 < 4; ++g4) {
        const int nl = ni * 32 + 16 * (g4 >> 1) + 8 * hi + 4 * (g4 & 1), n = 128 * w + nl;
        const f32x4 gg = *(const f32x4*)(g1 + n), bb = *(const f32x4*)(b1 + n);
        f32x4 y;
        y.x = (acc[ni][4 * g4] - mean) * rstd * gg.x + bb.x; y.y = (acc[ni][4 * g4 + 1] - mean) * rstd * gg.y + bb.y;
        y.z = (acc[ni][4 * g4 + 2] - mean) * rstd * gg.z + bb.z; y.w = (acc[ni][4 * g4 + 3] - mean) * rstd * gg.w + bb.w;
        acc[ni][4 * g4] = y.x; acc[ni][4 * g4 + 1] = y.y; acc[ni][4 * g4 + 2] = y.z; acc[ni][4 * g4 + 3] = y.w;
        *(LAS f32x4*)(wt + c31 * 528 + nl * 4) = y;
      }
    {
      const int cl = (lane & 31) * 4;
      const size_t off0 = (size_t)(m0 + hi) * DM + 128 * w + cl;
      bf16_t* pB = hB + off0; unsigned char* p8 = ws + OFF_H8 + off0;
      const LAS unsigned char* rp = wt + hi * 528 + cl * 4;
#pragma unroll 4
      for (int it = 0; it < 16; ++it) {
        const f32x4 y = *(const LAS f32x4*)rp;
        u32x2 o; o.x = cvtpk(y.x, y.y); o.y = cvtpk(y.z, y.w);
        *(u32x2*)pB = o;
        *(unsigned*)p8 = pk4_fp8(clamp448(y.x * S8_H), clamp448(y.y * S8_H), clamp448(y.z * S8_H), clamp448(y.w * S8_H));
        rp += 2 * 528; pB += 2 * DM; p8 += 2 * DM;
      }
    }
    f32x16 D0;
#pragma unroll
    for (int r = 0; r < 16; ++r) D0[r] = 0.f;
    {
#pragma unroll
      for (int ni = 0; ni < 4; ++ni)
#pragma unroll
        for (int g2 = 0; g2 < 2; ++g2) {
          u32x4 ah, al;
          ah.x = cvtpk(acc[ni][8 * g2], acc[ni][8 * g2 + 1]); ah.y = cvtpk(acc[ni][8 * g2 + 2], acc[ni][8 * g2 + 3]);
          ah.z = cvtpk(acc[ni][8 * g2 + 4], acc[ni][8 * g2 + 5]); ah.w = cvtpk(acc[ni][8 * g2 + 6], acc[ni][8 * g2 + 7]);
          al.x = cvtpk(acc[ni][8 * g2] - bflo(ah.x), acc[ni][8 * g2 + 1] - bfhi(ah.x)); al.y = cvtpk(acc[ni][8 * g2 + 2] - bflo(ah.y), acc[ni][8 * g2 + 3] - bfhi(ah.y));
          al.z = cvtpk(acc[ni][8 * g2 + 4] - bflo(ah.z), acc[ni][8 * g2 + 5] - bfhi(ah.z)); al.w = cvtpk(acc[ni][8 * g2 + 6] - bflo(ah.w), acc[ni][8 * g2 + 7] - bfhi(ah.w));
          const bf16x8 Ah = __builtin_bit_cast(bf16x8, ah), Al = __builtin_bit_cast(bf16x8, al), Bh = __builtin_bit_cast(bf16x8, wbh[ni][g2]), Bl = __builtin_bit_cast(bf16x8, wbl[ni][g2]);
          D0 = __builtin_amdgcn_mfma_f32_32x32x16_bf16(Al, Bh, D0, 0, 0, 0);
          D0 = __builtin_amdgcn_mfma_f32_32x32x16_bf16(Ah, Bl, D0, 0, 0, 0);
          D0 = __builtin_amdgcn_mfma_f32_32x32x16_bf16(Ah, Bh, D0, 0, 0, 0);
        }
    }
    __syncthreads();
#pragma unroll
    for (int r = 0; r < 16; ++r) red[(w * 32 + crow(r, hi)) * 32 + c31] = D0[r];
    __syncthreads();
#pragma unroll
    for (int i = 0; i < 2; ++i) {
      const int idx = tid + 512 * i;
      float sv = rb[idx & 31];
#pragma unroll
      for (int ww = 0; ww < 8; ++ww) sv += red[ww * 1024 + idx];
      lg[(idx & 31) * 32 + (idx >> 5)] = sv;
    }
    if (qh == 0 && tid < 32) lcnt[tid] = 0;
    __syncthreads();
  }
  {
    const int tid = get_tid(), t31 = tid & 31, tq = tid >> 5;
    const bool actv = tid < 32 * nh;
    const LAS float* lg = (const LAS float*)(lds + (tq ? 32768 : 138496));
    float gt[4]; int li[4], rk[4];
    if (actv) {
      float lv[4]; unsigned used = 0u;
#pragma unroll
      for (int k = 0; k < 4; ++k) {
        float best = -INFINITY; int bi = 0;
        for (int e = 0; e < 32; ++e) { const float v = lg[e * 32 + t31]; if (!((used >> e) & 1u) && v > best) { best = v; bi = e; } }
        used |= 1u << bi; lv[k] = best; li[k] = bi;
      }
      float sm = 0.f;
#pragma unroll
      for (int k = 0; k < 4; ++k) { gt[k] = expf(lv[k] - lv[0]); sm += gt[k]; }
      const float inv = 1.f / sm;
#pragma unroll
      for (int k = 0; k < 4; ++k) { gt[k] *= inv; rk[k] = __hip_atomic_fetch_add(&lcnt[li[k]], 1, __ATOMIC_RELAXED, __HIP_MEMORY_SCOPE_WORKGROUP); }
    }
    __syncthreads();
    if (tid < 32) { const int c = lcnt[tid]; lcnt[32 + tid] = c ? atomicAdd(&cnt[tid], c) : 0; }
    __syncthreads();
    if (actv) {
      const int m = (hp + tq * get_nblk()) * 32 + t31;
#pragma unroll
      for (int k = 0; k < 4; ++k) {
        const int ps = lcnt[32 + li[k]] + rk[k];
        list[li[k] * M_TOK + ps] = m;
        toke[m * 4 + k] = (li[k] << 16) | ps;
        tokg[m * 4 + k] = gt[k];
      }
    }
    __syncthreads();
  }
  }
}

__device__ __forceinline__ void moe_prefix(const int* cnt, LAS int* s_start, LAS int* s_tstart, LAS int* s_cnt) {
  if (get_tid() < 64) {
    const int lane = get_tid();
    const int c = (lane < 32) ? cnt[lane] : 0;
    const int tl = (c + 255) >> 8;
    int ic = c, it = tl;
#pragma unroll
    for (int o = 1; o < 32; o <<= 1) { const int a = shup(ic, o, lane), b = shup(it, o, lane); if (lane >= o) { ic += a; it += b; } }
    if (lane < 32) { s_cnt[lane] = c; s_start[lane] = ic - c; s_tstart[lane] = it - tl; }
    if (lane == 31) { s_start[32] = ic; s_tstart[32] = it; }
  }
  __syncthreads();
}

struct MoeSched {
  unsigned estride; int NT, total_mt, grid, bid; const LAS int* s_start; const LAS int* s_tstart; const LAS int* s_cnt;
  __device__ __forceinline__ bool next(int i, pg8::Unit& u) const {
    int mtg, nt; bool ok;
    if (grid == 256) { const int MG = 32 / NT; const int xcd = bid & 7, j = bid >> 3; mtg = MG * (xcd + 8 * i) + j / NT; nt = j % NT; ok = (MG * (8 * i) < total_mt); }
    else { const int item = bid + i * grid; ok = (item < total_mt * NT); mtg = item / NT; nt = item % NT; }
    const bool live = ok && (mtg < total_mt);
    const int mq = live ? mtg : 0;
    const int ln_ = get_tid() & 63;
    const int tend_ = s_tstart[(ln_ < 32 ? ln_ : 31) + 1];
    const int e = (int)__builtin_popcountll(__ballot(ln_ < 32 && tend_ <= mq));
    const int mt = mq - __builtin_amdgcn_readfirstlane(s_tstart[e]);
    const int mv = live ? min(256, __builtin_amdgcn_readfirstlane(s_cnt[e]) - mt * 256) : 0;
    const int sl = __builtin_amdgcn_readfirstlane(s_start[e]) + mt * 256;
    const unsigned bo = (unsigned)e * estride + (unsigned)nt * (256u * 1024u);
    u.boff = bo; u.arow0 = i; u.mvalid = mv; u.e = e; u.mt = mt; u.nt = nt; u.slot0 = sl;
    return ok;
  }
};
struct MoeUpEpi {
  static constexpr bool RELAX = true;
  static constexpr int MIN_ST = 4;
  static __device__ __forceinline__ int blane(int lrow) { return 64 * (lrow >> 5) + (lrow & 31); }
  static constexpr __device__ int bpiece(int h, int i) { return 128 * i + 32 * h; }
  static constexpr bool DYNB = false;
  static __device__ __forceinline__ int blane_alt(int lrow) { return lrow; }
  __device__ __forceinline__ bool alt_map(const pg8::Unit&) const { return false; }
  unsigned char* act; const LAS float* btab;
  __device__ __forceinline__ void operator()(const pg8::f32x4v (&acc)[2][2][4][2], const pg8::Unit& u, int wr, int wc, int fr, int fq) const {
    constexpr float US = 1.f / (S8_H * S8_WGU);
    constexpr float KEXP = -1.702f * LOG2E;
    const LAS float* bt = btab + u.arow0 * 256 + 32 * wc + 4 * fq;
    f32x4 bg[2], bl[2];
#pragma unroll
    for (int bj = 0; bj < 2; ++bj) { bg[bj] = *(const LAS f32x4*)(bt + 16 * bj); bl[bj] = *(const LAS f32x4*)(bt + 128 + 16 * bj); }
#pragma unroll
    for (int ai = 0; ai < 2; ++ai) {
      const int rbase = 128 * ai + 64 * wr;
      if (rbase < u.mvalid) {
        unsigned V[4][2];
#pragma unroll
        for (int m = 0; m < 4; ++m)
#pragma unroll
          for (int bj = 0; bj < 2; ++bj) {
            const f32x4 gx = acc[ai][bj][m][0] * US + bg[bj], lx = acc[ai][bj][m][1] * US + bl[bj];
            f32x4 gl, ln, ex;
#pragma unroll
            for (int i = 0; i < 4; ++i) { gl[i] = fminf(gx[i], 7.f); ln[i] = __builtin_amdgcn_fmed3f(lx[i], -7.f, 7.f); }
            const f32x4 ea = gl * KEXP;
#pragma unroll
            for (int i = 0; i < 4; ++i) ex[i] = __builtin_amdgcn_exp2f(ea[i]);
            const f32x4 den = ex + 1.f;
            f32x4 sg;
#pragma unroll
            for (int i = 0; i < 4; ++i) sg[i] = __builtin_amdgcn_rcpf(den[i]);
            const f32x4 o = (gl * sg) * (ln * S8_ACT + S8_ACT);
            V[m][bj] = pk4_fp8(o[0], o[1], o[2], o[3]);
          }
#pragma unroll
        for (int m1 = 0; m1 < 2; ++m1) {
          unsigned r0 = V[2 * m1][0], r1 = V[2 * m1][1], r2 = V[2 * m1 + 1][0], r3 = V[2 * m1 + 1][1];
          { auto t = __builtin_amdgcn_permlane32_swap(r0, r2, false, false); r0 = t[0]; r2 = t[1]; }
          { auto t = __builtin_amdgcn_permlane32_swap(r1, r3, false, false); r1 = t[0]; r3 = t[1]; }
          { auto t = __builtin_amdgcn_permlane16_swap(r0, r1, false, false); r0 = t[0]; r1 = t[1]; }
          { auto t = __builtin_amdgcn_permlane16_swap(r2, r3, false, false); r2 = t[0]; r3 = t[1]; }
          const int rl = rbase + 16 * (2 * m1 + (fq >> 1)) + fr;
          if (rl < u.mvalid) { u32x4 ov; ov.x = r0; ov.y = r1; ov.z = r2; ov.w = r3; *(u32x4*)(act + (size_t)(u.slot0 + rl) * DFF + 128 * u.nt + 32 * wc + 16 * (fq & 1)) = ov; }
        }
      }
    }
  }
};
struct MoeDownEpi {
  static constexpr bool RELAX = true;
  static constexpr int MIN_ST = 16;
  static __device__ __forceinline__ int blane(int lrow) { return (lrow & 32) + 8 * ((lrow & 15) >> 2) + 4 * ((lrow >> 4) & 1) + (lrow & 3); }
  static constexpr __device__ int bpiece(int h, int i) { return 128 * h + 64 * i; }
  static constexpr bool DYNB = false;
  static __device__ __forceinline__ int blane_alt(int lrow) { return lrow; }
  __device__ __forceinline__ bool alt_map(const pg8::Unit&) const { return false; }
  bf16_t* yb; const LAS float* btab;
  __device__ __forceinline__ void operator()(const pg8::f32x4v (&acc)[2][2][4][2], const pg8::Unit& u, int wr, int wc, int fr, int fq) const {
    constexpr float us = 1.f / (S8_ACT * S8_WDN);
    const LAS float* bt = btab + u.e * 256 + 32 * wc + 8 * fq;
#pragma unroll
    for (int bj = 0; bj < 2; ++bj) {
      const f32x4 b0 = *(const LAS f32x4*)(bt + 128 * bj), b1 = *(const LAS f32x4*)(bt + 128 * bj + 4);
#pragma unroll
      for (int ai = 0; ai < 2; ++ai)
#pragma unroll
        for (int m = 0; m < 4; ++m) {
          const int rl = 128 * ai + 64 * wr + 16 * m + fr;
          if (rl < u.mvalid) {
            bf16_t* orow = yb + (size_t)(u.slot0 + rl) * DM + u.nt * 256 + 32 * wc + 8 * fq;
            const pg8::f32x4v v = acc[ai][bj][m][0], w = acc[ai][bj][m][1];
            u32x4 ov;
            ov.x = cvtpk(fmaf(v[0], us, b0.x), fmaf(v[1], us, b0.y)); ov.y = cvtpk(fmaf(v[2], us, b0.z), fmaf(v[3], us, b0.w));
            ov.z = cvtpk(fmaf(w[0], us, b1.x), fmaf(w[1], us, b1.y)); ov.w = cvtpk(fmaf(w[2], us, b1.z), fmaf(w[3], us, b1.w));
            *(u32x4*)(orow + 128 * bj) = ov;
          }
        }
    }
  }
};
__device__ __forceinline__ void phase_moe_up(const Params& p, int layer, LAS unsigned char* lds) {
  unsigned char* ws = p.ws;
  const int* cnt = (const int*)(ws + OFF_CTRL) + CW_CNT + layer * 32;
  const int* list = (const int*)(ws + OFF_LIST);
  LAS int* s_start = (LAS int*)(lds + LDS_GEMM); LAS int* s_tstart = s_start + 40; LAS int* s_cnt = s_start + 80;
  moe_prefix(cnt, s_start, s_tstart, s_cnt);
  MoeSched S{2048u * 1024u, 8, __builtin_amdgcn_readfirstlane(s_tstart[32]), get_nblk(), get_bid(), s_start, s_tstart, s_cnt};
  {
    const int tid = get_tid();
    LAS int* rowtab = (LAS int*)(lds + LDS_ROWTAB);
    LAS float* btab = (LAS float*)(lds + LDS_BIASTAB);
    const float* bgu = p.b_gate_up + (size_t)layer * NE * 2048;
    unsigned vals[12]; bool okv[12];
#pragma unroll
    for (int i = 0; i < 12; ++i) {
      pg8::Unit u;
      okv[i] = S.next(i, u);
      vals[i] = 0u;
      if (okv[i]) {
        if (tid < 256) { if (u.mvalid > 0) vals[i] = (unsigned)list[u.e * M_TOK + u.mt * 256 + min(tid, u.mvalid - 1)]; }
        else { const int c = tid - 256; vals[i] = __float_as_uint(bgu[(size_t)u.e * 2048 + (c >> 7) * 1024 + u.nt * 128 + (c & 127)]); }
      }
    }
#pragma unroll
    for (int i = 0; i < 12; ++i) {
      if (okv[i]) { if (tid < 256) rowtab[i * 256 + tid] = (int)vals[i]; else btab[i * 256 + (tid - 256)] = __uint_as_float(vals[i]); }
    }
    __syncthreads();
  }
  MoeUpEpi E{(unsigned char*)(ws + OFF_ACT), (const LAS float*)(lds + LDS_BIASTAB)};
  pg8::gemm_phase<true, true>(lds, (const bf16_t*)(ws + OFF_H8), (const bf16_t*)(ws + OFF_WGU + (size_t)layer * NE * 2048 * 1024), S, E);
}
struct MoeDownSched {
  MoeSched base;
  __device__ __forceinline__ bool next(int i, pg8::Unit& u) const { const bool ok = base.next(i, u); if (ok) { u.arow0 = u.slot0; u.e = i; } return ok; }
};
__device__ __forceinline__ void phase_moe_down(const Params& p, int layer, LAS unsigned char* lds) {
  unsigned char* ws = p.ws;
  const int* cnt = (const int*)(ws + OFF_CTRL) + CW_CNT + layer * 32;
  LAS int* s_start = (LAS int*)(lds + LDS_GEMM); LAS int* s_tstart = s_start + 40; LAS int* s_cnt = s_start + 80;
  moe_prefix(cnt, s_start, s_tstart, s_cnt);
  MoeDownSched S{MoeSched{1024u * 1024u, 4, __builtin_amdgcn_readfirstlane(s_tstart[32]), get_nblk(), get_bid(), s_start, s_tstart, s_cnt}};
  {
    const int tid = get_tid();
    LAS float* btab = (LAS float*)(lds + LDS_BIASTAB);
    const float* bd = p.b_down + (size_t)layer * NE * 1024;
    float vals[12]; bool okv[12];
#pragma unroll
    for (int i = 0; i < 12; ++i) {
      pg8::Unit u;
      okv[i] = S.base.next(i, u);
      vals[i] = 0.f;
      if (okv[i] && tid < 256) vals[i] = bd[(size_t)u.e * 1024 + u.nt * 256 + tid];
    }
#pragma unroll
    for (int i = 0; i < 12; ++i)
      if (okv[i] && tid < 256) btab[i * 256 + tid] = vals[i];
    __syncthreads();
  }
  MoeDownEpi E{(bf16_t*)(ws + OFF_Y), (const LAS float*)(lds + LDS_BIASTAB)};
  pg8::gemm_phase<false, true>(lds, (const bf16_t*)(ws + OFF_ACT), (const bf16_t*)(ws + OFF_WD + (size_t)layer * NE * 1024 * 1024), S, E);
}

__device__ __forceinline__ void phase_combine_ln2(const Params& p, int layer, LAS unsigned char* lds) {
  unsigned char* ws = p.ws;
  const bf16_t* yb = (const bf16_t*)(ws + OFF_Y);
  float* hF = (float*)(ws + OFF_HF); bf16_t* hB = (bf16_t*)(ws + OFF_HB);
  const int* cnt = (const int*)(ws + OFF_CTRL) + CW_CNT + layer * 32;
  const int* toke = (const int*)(ws + OFF_TOKE); const float* tokg = (const float*)(ws + OFF_TOKG);
  LAS int* s_start = (LAS int*)(lds + LDS_GEMM); LAS int* s_tstart = s_start + 40; LAS int* s_cnt = s_start + 80;
  moe_prefix(cnt, s_start, s_tstart, s_cnt);
  const float* g2 = p.ln2_g + layer * DM; const float* b2 = p.ln2_b + layer * DM;
  const bool last = (layer == DEPTH - 1);
  const int lane = get_tid() & 63, gw = get_bid() * 8 + (get_tid() >> 6), ngw = get_nblk() * 8;
  for (int m = gw; m < M_TOK; m += ngw) {
    f32x4 v[4];
#pragma unroll
    for (int j = 0; j < 4; ++j) { const u32x2 hb = *(const u32x2*)(hB + (size_t)m * DM + 4 * lane + 256 * j); v[j] = (f32x4){bflo(hb.x), bfhi(hb.x), bflo(hb.y), bfhi(hb.y)} * DN_ALPHA; }
#pragma unroll
    for (int k = 0; k < 4; ++k) {
      const int ep = toke[m * 4 + k]; const float gt = tokg[m * 4 + k];
      const int slot = s_start[ep >> 16] + (ep & 0xffff);
      const bf16_t* yr = yb + (size_t)slot * DM;
#pragma unroll
      for (int j = 0; j < 4; ++j) {
        const u32x2 a = *(const u32x2*)(yr + 4 * lane + 256 * j);
        v[j].x += gt * bflo(a.x); v[j].y += gt * bfhi(a.x); v[j].z += gt * bflo(a.y); v[j].w += gt * bfhi(a.y);
      }
    }
    ln_row(v, g2, b2, lane);
    if (last) store_row_f32_bf16(v, p.out + (size_t)m * DM, nullptr, lane);
    else store_row_f32_bf16(v, nullptr, hB + (size_t)m * DM, lane);
  }
}

#if defined(__HIP_DEVICE_COMPILE__)
#define PH(call) do { const __attribute__((address_space(4))) Params* q_ = pp; asm volatile("" : "+s"(q_)); Params p; __builtin_memcpy(&p, q_, sizeof(Params)); call; } while (0)
#else
#define PH(call) do { const Params& p = p_unused; (void)pp; call; } while (0)
#endif
__global__ void __launch_bounds__(512) fwd_kernel(Params p_unused) {
  cg::grid_group grid = cg::this_grid();
  extern __shared__ __attribute__((aligned(16))) unsigned char smem[];
  LAS unsigned char* lds = (LAS unsigned char*)smem;
  const __attribute__((address_space(4))) Params* pp = (const __attribute__((address_space(4))) Params*)__builtin_amdgcn_kernarg_segment_ptr();
  if (threadIdx.x < 4) ((volatile LAS unsigned*)(lds + LDS_MISC))[threadIdx.x] = 0u;
  __syncthreads();
#define GRID_BAR() do { XcdBarrier b_; PH(b_.bar = (unsigned*)(p.ws + OFF_CTRL) + CW_BAR); b_.x = xb_xcc_id(); b_.st = (volatile LAS unsigned*)(lds + LDS_MISC); xcd_barrier(b_); } while (0)
  { unsigned* bw; PH(bw = (unsigned*)(p.ws + OFF_CTRL) + CW_BAR); (void)xcd_barrier_post(bw, (volatile LAS unsigned*)(lds + LDS_MISC)); }
  PH(phase_convert(p, lds));
  PH(phase_prologue_misc(p));
  if (get_nblk() == 0x7fffffff) grid.sync();
  GRID_BAR();
#define LAYER_BODY(layer) do { \
    PH(phase_inproj(p, layer, lds)); \
    GRID_BAR(); \
    PH(phase_mla_up(p, layer, lds)); \
    GRID_BAR(); \
    PH(phase_attention(p, layer, lds)); \
    GRID_BAR(); \
    PH(phase_outproj(p, layer, lds)); \
    GRID_BAR(); \
    PH(phase_ln1_router(p, layer, lds)); \
    GRID_BAR(); \
    PH(phase_moe_up(p, layer, lds)); \
    GRID_BAR(); \
    PH(phase_moe_down(p, layer, lds)); \
    GRID_BAR(); \
    PH(phase_combine_ln2(p, layer, lds)); \
    if (layer + 1 < DEPTH) GRID_BAR(); } while (0)
  static_assert(DEPTH == 2, "layers are written out");
  LAYER_BODY(0);
  LAYER_BODY(1);
#undef LAYER_BODY
}

extern "C" void kernel_launch(void* const* d_in, const int* in_sizes, int n_in, void* d_out, int out_size,
                              void* d_ws, size_t ws_size, hipStream_t stream) {
  static int grid_blocks = 0;
  if (!grid_blocks) {
    int dev = 0, cus = 0, per_cu = 0;
    (void)hipGetDevice(&dev);
    (void)hipDeviceGetAttribute(&cus, hipDeviceAttributeMultiprocessorCount, dev);
    (void)hipFuncSetAttribute((const void*)fwd_kernel, hipFuncAttributeMaxDynamicSharedMemorySize, LDS_BYTES);
    (void)hipOccupancyMaxActiveBlocksPerMultiprocessor(&per_cu, fwd_kernel, 512, LDS_BYTES);
    if (per_cu < 1) { fprintf(stderr, "kernel_launch: occupancy query returned %d\n", per_cu); per_cu = 1; }
    if (per_cu > 1) per_cu = 1;
    grid_blocks = cus * per_cu;
    if (n_in != 23 || ws_size < WS_END) { fprintf(stderr, "kernel_launch: unexpected n_in %d or ws_size %zu (< %zu)\n", n_in, ws_size, (size_t)WS_END); }
  }
  if (ws_size < WS_END) return;
  (void)hipMemsetAsync((char*)d_ws + OFF_CTRL, 0, CTRL_BYTES, stream);
  Params p{};
  p.x = (const float*)d_in[0]; p.pos = (const int*)d_in[1]; p.ln_in_g = (const float*)d_in[2]; p.ln_in_b = (const float*)d_in[3];
  p.w_in = (const float*)d_in[4]; p.b_forget = (const float*)d_in[5]; p.diff_lambda = (const float*)d_in[6]; p.diff_subln_g = (const float*)d_in[7];
  p.mla_q_norm_g = (const float*)d_in[8]; p.mla_w_uq = (const float*)d_in[9]; p.mla_kv_norm_g = (const float*)d_in[10]; p.mla_w_ukv = (const float*)d_in[11];
  p.w_out = (const float*)d_in[12]; p.ln1_g = (const float*)d_in[13]; p.ln1_b = (const float*)d_in[14]; p.router_w = (const float*)d_in[15];
  p.router_b = (const float*)d_in[16]; p.w_gate_up = (const float*)d_in[17]; p.b_gate_up = (const float*)d_in[18]; p.w_down = (const float*)d_in[19];
  p.b_down = (const float*)d_in[20]; p.ln2_g = (const float*)d_in[21]; p.ln2_b = (const float*)d_in[22];
  p.out = (float*)d_out; p.ws = (unsigned char*)d_ws;
  void* args[] = {&p};
  hipError_t e = hipLaunchCooperativeKernel((void*)fwd_kernel, dim3(grid_blocks), dim3(512), args, LDS_BYTES, stream);
  if (e != hipSuccess) fprintf(stderr, "cooperative launch failed: %s (grid %d)\n", hipGetErrorString(e), grid_blocks);
}
```
